# Optimizing an MI355X kernel written in HIP

```python
import jax, jax.numpy as jnp
from jax import lax
import numpy as np

D_MODEL = 1024
BATCH = 8
SEQ = 2048
DEPTH = 2

POOL_WINDOWS = (2, 4, 8, 16)
POOL_GROUPS = len(POOL_WINDOWS)
POOL_GROUP_DIM = D_MODEL // POOL_GROUPS
POOL_WIDTH = POOL_GROUPS * POOL_GROUP_DIM
ATTN_GROUPS = ((128, 1), (512, 4), (2048, 16))
HEADS_PER_GROUP = 4
N_HEADS = HEADS_PER_GROUP * len(ATTN_GROUPS)
HEAD_DIM = D_MODEL // 8
ATTN_WIDTH = N_HEADS * HEAD_DIM
ATTN_OUT = HEADS_PER_GROUP * HEAD_DIM
Q_BLOCK = 64
NEG_INF = -1e30
N_BUCKETS = 32
MAX_DISTANCE = 1024
D_FF = ((8 * D_MODEL // 3 + 255) // 256) * 256
CONV_WIDTH = 3
EPS = 1e-6
SPLITS = [int(s) for s in np.cumsum([POOL_WIDTH, ATTN_WIDTH, ATTN_WIDTH, ATTN_WIDTH, D_MODEL])]
IN_WIDTH = POOL_WIDTH + 3 * ATTN_WIDTH + 2 * D_MODEL

kernel_name = "hybrid_pool_dilated_attn_convffn_encoder"


def _rmsnorm(x, g):
    xf = x.astype(jnp.float32)
    y = xf * lax.rsqrt(jnp.mean(xf * xf, axis=-1, keepdims=True) + EPS)
    return (y * g.astype(jnp.float32)).astype(x.dtype)


def _t5_buckets(rel):
    n = -rel
    half = N_BUCKETS // 2
    ret = (n < 0).astype(np.int32) * half
    n = np.abs(n)
    max_exact = half // 2
    large = max_exact + (np.log(np.maximum(n, 1) / max_exact)
                         / np.log(MAX_DISTANCE / max_exact) * (half - max_exact)).astype(np.int32)
    large = np.minimum(large, half - 1)
    return (ret + np.where(n < max_exact, n, large)).astype(np.int32)


def _centred_mean(u, window):
    S = u.shape[1]
    c = jnp.pad(jnp.cumsum(u.astype(jnp.float32), axis=1), ((0, 0), (1, 0), (0, 0)))
    i = np.arange(S)
    lo = np.clip(i - window // 2, 0, S)
    hi = np.clip(i - window // 2 + window, 0, S)
    count = (hi - lo).astype(np.float32)
    return ((c[:, hi] - c[:, lo]) / count[None, :, None]).astype(u.dtype)


def _dilated_group(q, k, v, bias, window, dilation):
    B, S, H, Dh = q.shape
    half = window // (2 * dilation)
    offs = dilation * np.arange(-half, half + 1)
    pad = half * dilation
    k_pad = jnp.pad(k, ((0, 0), (pad, pad), (0, 0), (0, 0)))
    v_pad = jnp.pad(v, ((0, 0), (pad, pad), (0, 0), (0, 0)))
    t = np.arange(Q_BLOCK)
    scale = HEAD_DIM ** -0.5

    def block(q0):
        pos = q0 + t[:, None] + offs[None, :]
        valid = (pos >= 0) & (pos < S)
        idx = pos + pad
        kb = jnp.take(k_pad, idx, axis=1)
        vb = jnp.take(v_pad, idx, axis=1)
        qb = lax.dynamic_slice_in_dim(q, q0, Q_BLOCK, axis=1)
        logits = jnp.einsum('bqhd,bqkhd->bhqk', qb, kb,
                            preferred_element_type=jnp.float32) * scale
        logits = logits + bias.astype(jnp.float32)[None, :, None, :]
        logits = jnp.where(valid[None, None], logits, NEG_INF)
        lse = jax.nn.logsumexp(logits, axis=-1)
        p = jnp.exp(logits - lse[..., None]).astype(vb.dtype)
        o = jnp.einsum('bhqk,bqkhd->bqhd', p, vb)
        return o, lse

    starts = jnp.arange(S // Q_BLOCK, dtype=jnp.int32) * Q_BLOCK
    o, lse = lax.map(block, starts)
    o = o.transpose(1, 0, 2, 3, 4).reshape(B, S, H, Dh)
    lse = lse.transpose(1, 0, 3, 2).reshape(B, S, H)
    return o, lse


def _token_mixer(xn, w_in, w_pool, pool_scale, w_a, w_b, w_o, rel_bias):
    B, S, _ = xn.shape
    u, q, k, v, g_pool, g_attn = jnp.split(xn @ w_in, SPLITS, axis=-1)

    ug = u.reshape(B, S, POOL_GROUPS, POOL_GROUP_DIM)
    pooled = jnp.stack([_centred_mean(ug[:, :, gi], w) for gi, w in enumerate(POOL_WINDOWS)], axis=2) - ug
    pool_out = jnp.einsum('bsgc,gcd->bsgd', pooled, w_pool).reshape(B, S, POOL_WIDTH) * pool_scale

    q = q.reshape(B, S, N_HEADS, HEAD_DIM)
    k = k.reshape(B, S, N_HEADS, HEAD_DIM)
    v = v.reshape(B, S, N_HEADS, HEAD_DIM)
    outs, lses = [], []
    for gi, (window, dilation) in enumerate(ATTN_GROUPS):
        hs = slice(gi * HEADS_PER_GROUP, (gi + 1) * HEADS_PER_GROUP)
        half = window // (2 * dilation)
        buckets = _t5_buckets(dilation * np.arange(-half, half + 1))
        bias = rel_bias[buckets][:, hs].T
        o_g, lse_g = _dilated_group(q[:, :, hs], k[:, :, hs], v[:, :, hs], bias, window, dilation)
        outs.append(o_g)
        lses.append(lse_g)
    wts = jax.nn.softmax(jnp.stack(lses, axis=0), axis=0)
    attn = jnp.einsum('gbsh,gbshd->bshd', wts, jnp.stack(outs, axis=0).astype(jnp.float32))
    attn_out = attn.astype(xn.dtype).reshape(B, S, ATTN_OUT)

    merged = jax.nn.sigmoid(g_pool) * (pool_out @ w_a) + jax.nn.sigmoid(g_attn) * (attn_out @ w_b)
    return merged @ w_o


def _conv_ffn(xn, w_up, conv_w, conv_b, w_down):
    a, gval = jnp.split(xn @ w_up, 2, axis=-1)
    a = lax.conv_general_dilated(a, conv_w[:, None, :], window_strides=(1,),
                                 padding=((CONV_WIDTH // 2, CONV_WIDTH // 2),),
                                 dimension_numbers=('NWC', 'WIO', 'NWC'),
                                 feature_group_count=D_FF) + conv_b
    return (jax.nn.gelu(a) * gval) @ w_down


def setup_inputs(seed: int = 0) -> dict:
    key = jax.random.key(seed)
    ks = jax.random.split(key, 16)
    f32 = jnp.float32

    def nrm(k, shape, scale):
        return jax.random.normal(k, shape, f32) * scale

    return {
        "x": nrm(ks[0], (BATCH, SEQ, D_MODEL), 1.0),
        "w_in": nrm(ks[1], (DEPTH, D_MODEL, IN_WIDTH), D_MODEL ** -0.5),
        "w_pool": nrm(ks[2], (DEPTH, POOL_GROUPS, POOL_GROUP_DIM, POOL_GROUP_DIM), POOL_GROUP_DIM ** -0.5),
        "pool_scale": 1.0 + nrm(ks[3], (DEPTH, POOL_WIDTH), 0.02),
        "w_a": nrm(ks[4], (DEPTH, POOL_WIDTH, D_MODEL), POOL_WIDTH ** -0.5),
        "w_b": nrm(ks[5], (DEPTH, ATTN_OUT, D_MODEL), ATTN_OUT ** -0.5),
        "w_o": nrm(ks[6], (DEPTH, D_MODEL, D_MODEL), D_MODEL ** -0.5),
        "norm1": 1.0 + nrm(ks[7], (DEPTH, D_MODEL), 0.02),
        "norm2": 1.0 + nrm(ks[8], (DEPTH, D_MODEL), 0.02),
        "w_up": nrm(ks[9], (DEPTH, D_MODEL, 2 * D_FF), D_MODEL ** -0.5),
        "conv_w": nrm(ks[10], (DEPTH, CONV_WIDTH, D_FF), CONV_WIDTH ** -0.5),
        "conv_b": nrm(ks[11], (DEPTH, D_FF), 0.01),
        "w_down": nrm(ks[12], (DEPTH, D_FF, D_MODEL), D_FF ** -0.5),
        "rel_bias": nrm(ks[13], (N_BUCKETS, N_HEADS), 0.2),
        "norm_f": 1.0 + nrm(ks[14], (D_MODEL,), 0.02),
    }


def reference(x, w_in, w_pool, pool_scale, w_a, w_b, w_o, norm1, norm2,
              w_up, conv_w, conv_b, w_down, rel_bias, norm_f):
    h = x
    for layer in range(DEPTH):
        h = h + _token_mixer(_rmsnorm(h, norm1[layer]), w_in[layer], w_pool[layer], pool_scale[layer],
                             w_a[layer], w_b[layer], w_o[layer], rel_bias)
        h = h + _conv_ffn(_rmsnorm(h, norm2[layer]), w_up[layer], conv_w[layer], conv_b[layer], w_down[layer])
    return _rmsnorm(h, norm_f)
```

```cpp
#include <hip/hip_runtime.h>
#include <cstdio>
#include <cstdint>

#ifndef MK_N_LAUNCHES
#define MK_N_LAUNCHES 1
#endif

namespace pg8 {
#define PG8_LAS __attribute__((address_space(3)))
typedef unsigned short bf16_t;
typedef short bf16x8 __attribute__((ext_vector_type(8)));
typedef float f32x4 __attribute__((ext_vector_type(4)));
typedef unsigned u32x4 __attribute__((ext_vector_type(4)));
typedef unsigned u32x2 __attribute__((ext_vector_type(2)));
constexpr int BM = 256, BK = 64, HALF = 128, HTB = HALF * BK * 2  , STAGE_BYTES = 8 * HTB, NXCD = 8, WGM = 8;

__host__ __device__ __forceinline__ int lds_byte(int r, int c) { const int st = (r >> 4) * 2 + (c >> 5), rr = r & 15, cc = c & 31, ob = rr * 64 + cc * 2; return st * 1024 + (ob ^ (((ob >> 9) & 1) << 5)); }
__host__ __device__ __forceinline__ void stage_rc(int b, int& R, int& C) { const int st = b / 1024, sb = b % 1024, swz = sb ^ (((sb >> 9) & 1) << 5); R = (st >> 1) * 16 + swz / 64; C = (st & 1) * 32 + (swz % 64) / 2; }
__host__ __device__ __forceinline__ int perm32(int rho) { const int n = rho >> 4, i = rho & 15; return 8 * (i >> 2) + 4 * n + (i & 3); }

struct Unit { int pm, pn; };
struct Gemm { const bf16_t* A; const bf16_t* Bt; int M, N, K, lda; };

struct StaticOrder {
    int nM, nN, nwg, G, c;
    __host__ __device__ void init(int M, int N, int G_, int c_) { nM = M / BM; nN = N / BM; nwg = nM * nN; G = G_; c = c_; }
    __host__ __device__ bool next(int i, Unit& u) const {
        const long L = (long)i * G + c; if (L >= nwg) return false;
        int wgid = (int)L; { const int q = nwg / NXCD, r = nwg % NXCD, xcd = wgid % NXCD, off = wgid / NXCD; wgid = (xcd < r ? xcd * (q + 1) : r * (q + 1) + (xcd - r) * q) + off; }
        const int nig = WGM * nN, gid = wgid / nig, fm = gid * WGM, gsz = (nM - fm) < WGM ? (nM - fm) : WGM;
        u.pm = fm + ((wgid % nig) % gsz); u.pn = (wgid % nig) / gsz; return true;
    }
    __device__ __forceinline__ void a_ready(const Unit&) const {}
    __device__ __forceinline__ void done(const Unit&) const {}
};

typedef float f32x2_t __attribute__((ext_vector_type(2))); typedef __bf16 bf16x2_t __attribute__((ext_vector_type(2)));
__device__ __forceinline__ unsigned cvt_pk_bf16(float lo, float hi) { f32x2_t v = {lo, hi}; bf16x2_t b = __builtin_convertvector(v, bf16x2_t); return __builtin_bit_cast(unsigned, b); }
__device__ __forceinline__ float bf_lo(unsigned w) { return __uint_as_float(w << 16); }
__device__ __forceinline__ float bf_hi(unsigned w) { return __uint_as_float(w & 0xffff0000u); }

__device__ __forceinline__ void wave_rstd(const float* part, int Mrows, int rowbase, int lane, float eps, float (&rs)[2]) {
#pragma unroll
    for (int ai = 0; ai < 2; ++ai) { const float* p = part + rowbase + ai * HALF + lane; float s = 0.f;
#pragma unroll
        for (int t = 0; t < 16; ++t) s += p[(size_t)t * Mrows];
        rs[ai] = 1.0f / sqrtf(s * (1.0f / 1024.0f) + eps); }
}

template <int MODE, class CFG> struct EpiB {
    static constexpr bool PERM = true, AFTER_DRAIN = false;
    bf16_t* O;
    const float* part;
    const bf16_t* X1; const bf16_t* X2;
    static constexpr int Mrows = 16384, ldx = 1024; static constexpr float eps = 1e-6f;
    __device__ __forceinline__ void operator()(const f32x4 (&acc)[2][2][4][2], const Unit& u, int wr, int wc, int fr, int fq) const {
        const int lane = fr + 16 * fq;
        long boff = 0; int ldc = CFG::ld0, sst = 0;
        if (u.pn >= CFG::st1) { boff = CFG::off1; ldc = CFG::ld1; sst = CFG::st1; }
        if (u.pn >= CFG::st2) { boff = CFG::off2; sst = CFG::st2; }
        if (u.pn >= CFG::st3) { boff = CFG::off3; sst = CFG::st3; }
        bf16_t* base = (bf16_t*)((char*)O + boff);
        const int col0 = (u.pn - sst) * BM + wc * 32 + 8 * fq;
        const int row0 = u.pm * BM + wr * 64 + fr;
        float rs[2] = {1.f, 1.f};
        if (MODE <= 1) wave_rstd(part, Mrows, u.pm * BM + wr * 64, lane, eps, rs);
#pragma unroll
        for (int ai = 0; ai < 2; ++ai)
#pragma unroll
            for (int m = 0; m < 4; ++m) {
                const int row = row0 + ai * HALF + m * 16;
                float r = 1.f; if (MODE <= 1) r = __shfl(rs[ai], m * 16 + fr);
                bf16_t* rowp = base + (size_t)row * ldc + col0;
#pragma unroll
                for (int bj = 0; bj < 2; ++bj) {
                    f32x4 v0 = acc[ai][bj][m][0], v1 = acc[ai][bj][m][1];
                    if (MODE <= 1) { v0 = v0 * r; v1 = v1 * r; }
                    if (MODE == 1) {
#pragma unroll
                        for (int e = 0; e < 4; ++e) { v0[e] = __builtin_amdgcn_rcpf(1.0f + __expf(-v0[e])); v1[e] = __builtin_amdgcn_rcpf(1.0f + __expf(-v1[e])); }
                    }
                    if (MODE == 2) {
                        const u32x4 x = *(const u32x4*)(X1 + (size_t)row * ldx + col0 + bj * HALF);
                        v0[0] *= bf_lo(x.x); v0[1] *= bf_hi(x.x); v0[2] *= bf_lo(x.y); v0[3] *= bf_hi(x.y);
                        v1[0] *= bf_lo(x.z); v1[1] *= bf_hi(x.z); v1[2] *= bf_lo(x.w); v1[3] *= bf_hi(x.w);
                    }
                    if (MODE == 3) {
                        const u32x4 x = *(const u32x4*)(X1 + (size_t)row * ldx + col0 + bj * HALF);
                        const u32x4 y = *(const u32x4*)(X2 + (size_t)row * ldx + col0 + bj * HALF);
                        v0[0] = bf_lo(x.x) + v0[0] * bf_lo(y.x); v0[1] = bf_hi(x.x) + v0[1] * bf_hi(y.x); v0[2] = bf_lo(x.y) + v0[2] * bf_lo(y.y); v0[3] = bf_hi(x.y) + v0[3] * bf_hi(y.y);
                        v1[0] = bf_lo(x.z) + v1[0] * bf_lo(y.z); v1[1] = bf_hi(x.z) + v1[1] * bf_hi(y.z); v1[2] = bf_lo(x.w) + v1[2] * bf_lo(y.w); v1[3] = bf_hi(x.w) + v1[3] * bf_hi(y.w);
                    }
                    u32x4 w; w.x = cvt_pk_bf16(v0[0], v0[1]); w.y = cvt_pk_bf16(v0[2], v0[3]); w.z = cvt_pk_bf16(v1[0], v1[1]); w.w = cvt_pk_bf16(v1[2], v1[3]);
                    *(u32x4*)(rowp + bj * HALF) = w;
                }
                if (MODE >= 2) asm volatile("" ::: "memory");
            }
    }
};

struct EpiRes {
    static constexpr bool PERM = false, AFTER_DRAIN = false;
    const float* base; float* out; bf16_t* hb; float* part; int Mrows;
    __device__ __forceinline__ void operator()(const f32x4 (&acc)[2][2][4][2], const Unit& u, int wr, int wc, int fr, int fq) const {
        const int col0 = u.pn * BM + wc * 32 + 4 * fq;
#pragma unroll
        for (int ai = 0; ai < 2; ++ai)
#pragma unroll
            for (int m = 0; m < 4; ++m) {
                const int row = u.pm * BM + ai * HALF + wr * 64 + m * 16 + fr; const size_t off = (size_t)row * 1024 + col0;
                float ss = 0.f;
#pragma unroll
                for (int bj = 0; bj < 2; ++bj)
#pragma unroll
                    for (int n = 0; n < 2; ++n) {
                        const f32x4 bs = *(const f32x4*)(base + off + bj * HALF + n * 16);
                        const f32x4 o = bs + acc[ai][bj][m][n];
                        *(f32x4*)(out + off + bj * HALF + n * 16) = o;
                        u32x2 w; w.x = cvt_pk_bf16(o[0], o[1]); w.y = cvt_pk_bf16(o[2], o[3]);
                        *(u32x2*)(hb + off + bj * HALF + n * 16) = w;
                        ss += (o[0] * o[0] + o[1] * o[1]) + (o[2] * o[2] + o[3] * o[3]);
                    }
                ss += __shfl_xor(ss, 16); ss += __shfl_xor(ss, 32);
                if (fq == 0) part[(size_t)(u.pn * 4 + wc) * Mrows + row] = ss;
                asm volatile("" ::: "memory");
            }
    }
};

template <class Epi, int GN, int GK, int GLDA, bool ALIGN_EPI = false, bool SP2 = false>
__device__ __forceinline__ void gemm_phase(PG8_LAS unsigned char* lds, const bf16_t* gA, const bf16_t* gBt, int G_, int c_, const Epi& E) {
    struct { const bf16_t* A; const bf16_t* Bt; int K, lda; } g{gA, gBt, GK, GLDA};
    StaticOrder S; S.nM = 16384 / BM; S.nN = GN / BM; S.nwg = S.nM * S.nN; S.G = G_; S.c = c_;
    int tid_ = threadIdx.x; asm volatile("" : "+v"(tid_));
    const int tid = tid_, wid = __builtin_amdgcn_readfirstlane(tid >> 6), lane = tid & 63, wr = wid >> 2, wc = wid & 3, fr = lane & 15, fq = lane >> 4;
    const int K = g.K, nt = K / BK, lda = g.lda;
    unsigned voffA[2], voffB[2];
#pragma unroll
    for (int i = 0; i < 2; ++i) { int R, C; stage_rc(tid * 16 + i * 8192, R, C); const int Rb = Epi::PERM ? ((R & ~31) + perm32(R & 31)) : R;
        voffA[i] = (unsigned)(R * lda + C) * 2u; voffB[i] = (unsigned)(Rb * K + C) * 2u; }
    const size_t kstep = (size_t)(BK * 2);
    const size_t hstepA = (size_t)HALF * lda * 2, hstepB = (size_t)HALF * K * 2;
    const size_t tstepA = 2 * hstepA, tstepB = 2 * hstepB;
    const unsigned ldsw = (unsigned)wid * 1024u;
    const int aoff = lds_byte(wr * 64 + fr, fq * 8), boff = lds_byte(wc * 32 + fr, fq * 8);
#define PG8_SA(b, h) (((b) * 2 + (h)) * HTB)
#define PG8_SB(b, h) ((4 + (b) * 2 + (h)) * HTB)
#define PG8_STAGE(bufoff, gbase, voff) do { _Pragma("unroll") for (int _i = 0; _i < 2; ++_i) \
        __builtin_amdgcn_global_load_lds((const unsigned*)((const char*)(gbase) + (voff)[_i]), (PG8_LAS unsigned*)(lds + (bufoff) + ldsw + _i * 8192), 16, 0, 0); } while (0)
#define PG8_LDA(dst, b, h) do { _Pragma("unroll") for (int m = 0; m < 4; ++m) _Pragma("unroll") for (int k = 0; k < 2; ++k) dst[m][k] = *(const PG8_LAS bf16x8*)(lds + PG8_SA(b, h) + aoff + m * 2048 + k * 1024); } while (0)
#define PG8_LDB(dst, b, h) do { _Pragma("unroll") for (int n = 0; n < 2; ++n) _Pragma("unroll") for (int k = 0; k < 2; ++k) dst[n][k] = *(const PG8_LAS bf16x8*)(lds + PG8_SB(b, h) + boff + n * 2048 + k * 1024); } while (0)
#define PG8_MMA(ai, bj, At, Bt) do { __builtin_amdgcn_s_setprio(1); _Pragma("unroll") for (int m = 0; m < 4; ++m) _Pragma("unroll") for (int n = 0; n < 2; ++n) _Pragma("unroll") for (int k = 0; k < 2; ++k) \
        acc[ai][bj][m][n] = __builtin_amdgcn_mfma_f32_16x16x32_bf16(Bt[n][k], At[m][k], acc[ai][bj][m][n], 0, 0, 0); __builtin_amdgcn_s_setprio(0); } while (0)
#define PG8_WAIT_V(n) asm volatile("s_waitcnt vmcnt(" #n ")" ::: "memory")
#define PG8_WAIT_L(n) asm volatile("s_waitcnt lgkmcnt(" #n ")" ::: "memory")
#define PG8_BAR __builtin_amdgcn_s_barrier()
#define PG8_SCHED __builtin_amdgcn_sched_barrier(0)
    Unit cur, nxt; int ui = 0;
    if (!S.next(0, cur)) return;
    f32x4 acc[2][2][4][2];
#pragma unroll
    for (int a = 0; a < 2; ++a)
#pragma unroll
        for (int b = 0; b < 2; ++b)
#pragma unroll
            for (int m = 0; m < 4; ++m)
#pragma unroll
                for (int n = 0; n < 2; ++n) acc[a][b][m][n] = (f32x4){0.f, 0.f, 0.f, 0.f};
    bf16x8 At[4][2], B0[2][2], B1[2][2];
    const char* cA = (const char*)g.A + (size_t)cur.pm * tstepA; const char* cB = (const char*)g.Bt + (size_t)cur.pn * tstepB;
    S.a_ready(cur);
    if constexpr (SP2) {
        PG8_STAGE(PG8_SB(0, 0), cB, voffB); PG8_STAGE(PG8_SB(0, 1), cB + hstepB, voffB); PG8_STAGE(PG8_SA(0, 0), cA, voffA); PG8_STAGE(PG8_SA(0, 1), cA + hstepA, voffA);
        if (wr == 1) PG8_BAR;
        PG8_WAIT_V(2); PG8_BAR;
        PG8_STAGE(PG8_SB(1, 0), cB + kstep, voffB); PG8_STAGE(PG8_SA(1, 0), cA + kstep, voffA); PG8_STAGE(PG8_SB(1, 1), cB + hstepB + kstep, voffB);
        PG8_WAIT_V(6); PG8_BAR;
    } else {
        PG8_STAGE(PG8_SB(0, 0), cB, voffB); PG8_STAGE(PG8_SA(0, 0), cA, voffA); PG8_STAGE(PG8_SB(0, 1), cB + hstepB, voffB); PG8_STAGE(PG8_SA(0, 1), cA + hstepA, voffA);
        if (wr == 1) PG8_BAR;
        PG8_WAIT_V(4); PG8_BAR;
        PG8_STAGE(PG8_SB(1, 0), cB + kstep, voffB); PG8_STAGE(PG8_SA(1, 0), cA + kstep, voffA); PG8_STAGE(PG8_SB(1, 1), cB + hstepB + kstep, voffB);
        PG8_WAIT_V(6); PG8_BAR;
    }
    for (;;) {
        const bool has_next = S.next(ui + 1, nxt);
        const char* nA = has_next ? (const char*)g.A + (size_t)nxt.pm * tstepA : cA; const char* nB = has_next ? (const char*)g.Bt + (size_t)nxt.pn * tstepB : cB;
        for (int t = 0; t < nt; t += 2) {
            const bool last = (t == nt - 2);
            const char* a1 = cA + (size_t)(t + 1) * kstep;
            const char* a2 = last ? nA : cA + (size_t)(t + 2) * kstep; const char* b2 = last ? nB : cB + (size_t)(t + 2) * kstep;
            const char* a3 = a2 + kstep; const char* b3 = b2 + kstep;
            if (last && has_next) S.a_ready(nxt);
            if constexpr (SP2) {
            PG8_LDB(B0, 0, 0); PG8_LDB(B1, 0, 1); PG8_SCHED; PG8_LDA(At, 0, 0); PG8_STAGE(PG8_SA(1, 1), a1 + hstepA, voffA);
            PG8_WAIT_V(8); PG8_WAIT_L(0); PG8_BAR; PG8_MMA(0, 0, At, B0); PG8_MMA(0, 1, At, B1); PG8_BAR; PG8_SCHED;
            PG8_LDA(At, 0, 1); PG8_STAGE(PG8_SB(0, 0), b2, voffB); PG8_STAGE(PG8_SB(0, 1), b2 + hstepB, voffB); PG8_STAGE(PG8_SA(0, 0), a2, voffA);
            PG8_WAIT_V(8); PG8_WAIT_L(0); PG8_BAR; PG8_MMA(1, 0, At, B0); PG8_MMA(1, 1, At, B1); PG8_BAR; PG8_SCHED;
            PG8_LDB(B0, 1, 0); PG8_LDB(B1, 1, 1); PG8_SCHED; PG8_LDA(At, 1, 0); PG8_STAGE(PG8_SA(0, 1), a2 + hstepA, voffA);
            PG8_WAIT_V(8); PG8_WAIT_L(0); PG8_BAR; PG8_MMA(0, 0, At, B0); PG8_MMA(0, 1, At, B1); PG8_BAR; PG8_SCHED;
            PG8_LDA(At, 1, 1); PG8_STAGE(PG8_SB(1, 0), b3, voffB); PG8_STAGE(PG8_SB(1, 1), b3 + hstepB, voffB); PG8_STAGE(PG8_SA(1, 0), a3, voffA);
            PG8_WAIT_V(8); PG8_WAIT_L(0); PG8_BAR; PG8_MMA(1, 0, At, B0); PG8_MMA(1, 1, At, B1); PG8_BAR; PG8_SCHED;
            } else {
            PG8_LDB(B0, 0, 0); PG8_SCHED; PG8_LDA(At, 0, 0); PG8_STAGE(PG8_SA(1, 1), a1 + hstepA, voffA);
            PG8_WAIT_L(8); PG8_BAR; PG8_WAIT_L(0); PG8_MMA(0, 0, At, B0); PG8_BAR; PG8_SCHED;
            PG8_LDB(B1, 0, 1); PG8_STAGE(PG8_SB(0, 0), b2, voffB);
            PG8_BAR; PG8_WAIT_L(0); PG8_MMA(0, 1, At, B1); PG8_BAR;
            PG8_LDA(At, 0, 1); PG8_STAGE(PG8_SA(0, 0), a2, voffA);
            PG8_BAR; PG8_WAIT_L(0); PG8_MMA(1, 0, At, B0); PG8_BAR; PG8_SCHED;
            PG8_STAGE(PG8_SB(0, 1), b2 + hstepB, voffB);
            PG8_WAIT_V(6); PG8_BAR; PG8_MMA(1, 1, At, B1); PG8_BAR;
            PG8_LDB(B0, 1, 0); PG8_SCHED; PG8_LDA(At, 1, 0); PG8_STAGE(PG8_SA(0, 1), a2 + hstepA, voffA);
            PG8_WAIT_L(8); PG8_BAR; PG8_WAIT_L(0); PG8_MMA(0, 0, At, B0); PG8_BAR; PG8_SCHED;
            PG8_LDB(B1, 1, 1); PG8_STAGE(PG8_SB(1, 0), b3, voffB);
            PG8_BAR; PG8_WAIT_L(0); PG8_MMA(0, 1, At, B1); PG8_BAR;
            PG8_LDA(At, 1, 1); PG8_STAGE(PG8_SA(1, 0), a3, voffA);
            PG8_BAR; PG8_WAIT_L(0); PG8_MMA(1, 0, At, B0); PG8_BAR; PG8_SCHED;
            PG8_STAGE(PG8_SB(1, 1), b3 + hstepB, voffB);
            PG8_WAIT_V(6); PG8_BAR; PG8_MMA(1, 1, At, B1); PG8_BAR;
            }
        }
        if constexpr (ALIGN_EPI) { if (wr == 0) PG8_BAR; }
        if constexpr (!Epi::AFTER_DRAIN) { E(acc, cur, wr, wc, fr, fq); S.done(cur); }
        if (!has_next) break;
#pragma unroll
        for (int a = 0; a < 2; ++a)
#pragma unroll
            for (int b = 0; b < 2; ++b)
#pragma unroll
                for (int m = 0; m < 4; ++m)
#pragma unroll
                    for (int n = 0; n < 2; ++n) acc[a][b][m][n] = (f32x4){0.f, 0.f, 0.f, 0.f};
        cur = nxt; cA = nA; cB = nB; ++ui;
        if constexpr (ALIGN_EPI) { if (wr == 1) PG8_BAR; }
    }
    PG8_WAIT_V(0);
    if constexpr (!ALIGN_EPI) { if (wr == 0) PG8_BAR; }
    PG8_BAR;
#undef PG8_SA
#undef PG8_SB
#undef PG8_STAGE
#undef PG8_LDA
#undef PG8_LDB
#undef PG8_MMA
#undef PG8_WAIT_V
#undef PG8_WAIT_L
#undef PG8_BAR
#undef PG8_SCHED
}
}

#ifndef PG8_SP2
#define PG8_SP2 true
#endif
#ifndef PG8_ALIGN
#define PG8_ALIGN true
#endif

constexpr int NWAVES = 8;
constexpr int BATCH = 8, S = 2048, D = 1024, DEPTH = 2;
constexpr int M = BATCH * S;
constexpr int NIN = 7680, NUQKV = 5632, NGATE = 2048, AW = 1536, AO = 512, DFF = 2816, NUP = 5632, HD = 128;
constexpr float EPS = 1e-6f;
constexpr int N_PHASES = 2 + 10 * DEPTH;

constexpr size_t MiB = 1u << 20;
constexpr size_t WS_CTL = 0, CTL_ZERO_BYTES = 64 * 1024;
constexpr size_t WS_PART = 1 * MiB;
constexpr size_t WS_W = 4 * MiB;
constexpr size_t WO_WIN = 0, WO_WC = 15 * MiB, WO_WB = 17 * MiB, WO_WO = 18 * MiB, WO_WUP = 20 * MiB, WO_WDN = 31 * MiB, WDN_BYTES = (size_t)D * DFF * 2;
constexpr size_t WS_HB = 46 * MiB;
constexpr size_t WS_Y = 78 * MiB;
constexpr size_t Y_U = 0, Y_Q = 32 * MiB, Y_K = 80 * MiB, Y_V = 128 * MiB;
constexpr size_t WS_END = 254 * MiB;
static_assert(WO_WDN + 2 * WDN_BYTES <= 42 * MiB && WS_W + 42 * MiB <= WS_HB && WS_HB + 32 * MiB <= WS_Y && WS_Y + 176 * MiB <= WS_END, "d_ws map");
constexpr int CW_BAR = 1024;

constexpr int RING_OFF = 0, RING_BYTES = 131072;
constexpr int LDSCTL_OFF = RING_BYTES, MISC_OFF = LDSCTL_OFF + 320;
constexpr int LDS_BYTES = 147456;

#define GAS __attribute__((address_space(1)))
#define LAS __attribute__((address_space(3)))
typedef unsigned short bf16;
typedef unsigned v4u __attribute__((ext_vector_type(4)));
typedef unsigned v2u __attribute__((ext_vector_type(2)));
typedef float f32x4 __attribute__((ext_vector_type(4)));
typedef GAS unsigned gu32;
#define RLX_AGENT __ATOMIC_RELAXED, __HIP_MEMORY_SCOPE_AGENT
#define LDS_WAIT() asm volatile("s_waitcnt lgkmcnt(0)" ::: "memory")
#define VM_WAIT() asm volatile("s_waitcnt vmcnt(0)" ::: "memory")
__device__ __forceinline__ unsigned f2bf(float f) { unsigned u = __builtin_bit_cast(unsigned, f); return (u + 0x7fffu + ((u >> 16) & 1u)) >> 16; }
__device__ __forceinline__ unsigned pk2(float lo, float hi) { return f2bf(lo) | (f2bf(hi) << 16); }
__device__ __forceinline__ float bflo(unsigned w) { return __uint_as_float(w << 16); }
__device__ __forceinline__ float bfhi(unsigned w) { return __uint_as_float(w & 0xffff0000u); }

#define XB_TMO      128
#define XB_XCNT(j)  (256  + 64 * (j))
#define XB_XSUB(j)  (1280 + 64 * (j))
#define XB_XGEN(j)  (2304 + 64 * (j))
#define XB_TOP      3328
#define XB_TOPGEN   3392
#define XCD_BAR_WORDS 3456
#define XB_SPIN_CAP (1u << 18)
static_assert((CW_BAR + XCD_BAR_WORDS) * 4 <= (int)CTL_ZERO_BYTES, "barrier words inside the zeroed region");

__device__ __forceinline__ unsigned xb_ld(unsigned* p)              { return __hip_atomic_load(p, __ATOMIC_RELAXED, __HIP_MEMORY_SCOPE_AGENT); }
__device__ __forceinline__ unsigned xb_add(unsigned* p, unsigned v) { return __hip_atomic_fetch_add(p, v, __ATOMIC_RELAXED, __HIP_MEMORY_SCOPE_AGENT); }
__device__ __forceinline__ unsigned xb_xcc_id() { return (unsigned)__builtin_amdgcn_s_getreg((3 << 11) | 20) & 0xFu; }
#define XB_SPIN(cond, bar) do { unsigned _sp = 0; while (cond) { __builtin_amdgcn_s_sleep(1); \
    if ((++_sp & 255u) == 0u) { if (xb_ld(&(bar)[XB_TMO])) break; if (_sp > XB_SPIN_CAP) { atomicAdd(&(bar)[XB_TMO], 1u); break; } } } } while (0)

struct XcdBarrier { unsigned* bar; unsigned x; volatile LAS unsigned* st; };

__device__ __forceinline__ XcdBarrier xcd_barrier_post(unsigned* bar, volatile LAS unsigned* st) {
    XcdBarrier b; b.bar = bar; b.x = xb_xcc_id(); b.st = st;
    if (threadIdx.x == 0) (void)xb_add(&bar[XB_XCNT(b.x)], 1u);
    return b;
}
__device__ __forceinline__ void xcd_barrier_complete(unsigned* bar, unsigned x, unsigned& nloc, unsigned& nx) {
    const unsigned G = gridDim.x * gridDim.y * gridDim.z;
    unsigned sum, cnt, mine, sp = 0u;
    for (;;) {
        sum = 0u; cnt = 0u; mine = 0u;
#pragma unroll
        for (unsigned j = 0; j < 16; ++j) { const unsigned c = xb_ld(&bar[XB_XCNT(j)]); sum += c; cnt += (c > 0u) ? 1u : 0u; mine = (j == x) ? c : mine; }
        if (sum == G) break;
        __builtin_amdgcn_s_sleep(1);
        if ((++sp & 255u) == 0u) { if (xb_ld(&bar[XB_TMO])) break; if (sp > XB_SPIN_CAP) { atomicAdd(&bar[XB_TMO], 1u); break; } }
    }
    nloc = mine > 0u ? mine : 1u; nx = cnt > 0u ? cnt : 1u;
}
__device__ __forceinline__ void xcd_barrier(const XcdBarrier& b) {
    asm volatile("s_waitcnt vmcnt(0)" ::: "memory");
    __syncthreads();
    if (threadIdx.x == 0) {
        unsigned* bar = b.bar; unsigned bx_ = b.x; asm volatile("" : "+s"(bar), "+s"(bx_));
        __builtin_amdgcn_s_waitcnt(0);
        unsigned nloc = b.st[0], nx = b.st[1];
        if (nloc == 0u) { xcd_barrier_complete(bar, bx_, nloc, nx); b.st[0] = nloc; b.st[1] = nx; }
        const unsigned old = xb_add(&bar[XB_XSUB(bx_)], 1u);
        const unsigned gen = old / nloc;
        if (old + 1u == (gen + 1u) * nloc) {
            __builtin_amdgcn_fence(__ATOMIC_RELEASE, "agent");
            asm volatile("s_waitcnt vmcnt(0)" ::: "memory");
            const unsigned og = xb_add(&bar[XB_TOP], 1u);
            const unsigned tg = og / nx;
            if (og + 1u == (tg + 1u) * nx) xb_add(&bar[XB_TOPGEN], 1u);
            else XB_SPIN(xb_ld(&bar[XB_TOPGEN]) == tg, bar);
            __builtin_amdgcn_fence(__ATOMIC_ACQUIRE, "agent");
            xb_add(&bar[XB_XGEN(bx_)], 1u);
            asm volatile("s_waitcnt vmcnt(0)" ::: "memory");
        } else {
            XB_SPIN(xb_ld(&bar[XB_XGEN(bx_)]) == gen, bar);
            __builtin_amdgcn_fence(__ATOMIC_ACQUIRE, "agent");
            asm volatile("s_waitcnt vmcnt(0)" ::: "memory");
        }
    }
    __syncthreads();
}

struct Frame {
    LAS unsigned char* lds;
    volatile LAS unsigned* MISC;
    gu32* ctl;
    int tid, lane, wave;
    int vcu, G;
    int gw, NGW;
    unsigned char* ws;
    const float* const* in; float* out;
};

__device__ __forceinline__ float wave_sum(float v) {
#pragma unroll
    for (int o = 1; o < 64; o <<= 1) v += __shfl_xor(v, o);
    return v;
}
__device__ __forceinline__ float wave_max(float v) {
#pragma unroll
    for (int o = 1; o < 64; o <<= 1) v = fmaxf(v, __shfl_xor(v, o));
    return v;
}

__device__ __forceinline__ void p0_transpose_item(const float* W, const float* gain, int K, int N, bf16* WT, LAS float* scr, int item, int lane) {
    const int nblk = N / 32, kb = item / nblk, nb = item % nblk, k0 = 64 * kb, n0 = 32 * nb;
#pragma unroll 8
    for (int i = 0; i < 32; ++i) { const int kk = 2 * i + (lane >> 5); const float gsc = gain ? gain[k0 + kk] : 1.0f; scr[kk * 33 + (lane & 31)] = W[(size_t)(k0 + kk) * N + n0 + (lane & 31)] * gsc; }
    LDS_WAIT(); asm volatile("" ::: "memory");
    const int c = lane & 7;
#pragma unroll
    for (int j = 0; j < 4; ++j) { const int n = (lane >> 3) + 8 * j; const LAS float* s = scr + (8 * c) * 33 + n;
        v4u o; o.x = pk2(s[0 * 33], s[1 * 33]); o.y = pk2(s[2 * 33], s[3 * 33]); o.z = pk2(s[4 * 33], s[5 * 33]); o.w = pk2(s[6 * 33], s[7 * 33]);
        *(GAS v4u*)(WT + (size_t)(n0 + n) * K + k0 + 8 * c) = o; }
    LDS_WAIT(); asm volatile("" ::: "memory");
}

__device__ __forceinline__ void convert_weights(Frame& F, int l, bool with_down) {
    LAS float* scr = (LAS float*)(F.lds + RING_OFF + F.wave * 16384);
    unsigned char* wb = F.ws + WS_W;
    const float* w_in = F.in[1] + (size_t)l * D * NIN; const float* w_b = F.in[5] + (size_t)l * AO * D; const float* w_o = F.in[6] + (size_t)l * D * D;
    const float* w_up = F.in[9] + (size_t)l * D * NUP; const float* n1 = F.in[7] + (size_t)l * D; const float* n2 = F.in[8] + (size_t)l * D;
    constexpr int I_IN = (D / 64) * (NIN / 32), I_B = (AO / 64) * (D / 32), I_O = (D / 64) * (D / 32), I_UP = (D / 64) * (NUP / 32), I_DN = (DFF / 64) * (D / 32);
    const int nitems = I_IN + I_B + I_O + I_UP + (with_down ? 2 * I_DN : 0);
    for (int it = F.gw; it < nitems; it += F.NGW) {
        int r = it;
        if (r < I_IN) { p0_transpose_item(w_in, n1, D, NIN, (bf16*)(wb + WO_WIN), scr, r, F.lane); continue; } r -= I_IN;
        if (r < I_B) { p0_transpose_item(w_b, nullptr, AO, D, (bf16*)(wb + WO_WB), scr, r, F.lane); continue; } r -= I_B;
        if (r < I_O) { p0_transpose_item(w_o, nullptr, D, D, (bf16*)(wb + WO_WO), scr, r, F.lane); continue; } r -= I_O;
        if (r < I_UP) { p0_transpose_item(w_up, n2, D, NUP, (bf16*)(wb + WO_WUP), scr, r, F.lane); continue; } r -= I_UP;
        const int ll = r / I_DN; r -= ll * I_DN;
        p0_transpose_item(F.in[12] + (size_t)ll * DFF * D, nullptr, DFF, D, (bf16*)(wb + WO_WDN + ll * WDN_BYTES), scr, r, F.lane);
    }
    const float* w_pool = F.in[2] + (size_t)l * 4 * 256 * 256; const float* ps = F.in[3] + (size_t)l * D; const float* w_a = F.in[4] + (size_t)l * D * D;
    bf16* Wc = (bf16*)(wb + WO_WC);
    for (int o = F.gw * 64 + F.lane; o < D * D; o += F.NGW * 64) {
        const int n = o >> 10, kk = o & 1023, g = kk >> 8, c = kk & 255;
        const float* wp = w_pool + ((size_t)g * 256 + c) * 256; const float* psg = ps + g * 256; const float* wa = w_a + (size_t)(g * 256) * D + n;
        float acc = 0.f;
#pragma unroll 4
        for (int d = 0; d < 256; d += 4) { const f32x4 p = *(const f32x4*)(wp + d); const f32x4 sc = *(const f32x4*)(psg + d);
            acc += p[0] * sc[0] * wa[(size_t)(d + 0) * D]; acc += p[1] * sc[1] * wa[(size_t)(d + 1) * D]; acc += p[2] * sc[2] * wa[(size_t)(d + 2) * D]; acc += p[3] * sc[3] * wa[(size_t)(d + 3) * D]; }
        Wc[o] = (bf16)f2bf(acc);
    }
}

__device__ __forceinline__ void p0_x_rows(Frame& F) {
    const float* x = F.in[0]; bf16* hb = (bf16*)(F.ws + WS_HB); float* part = (float*)(F.ws + WS_PART);
    for (int m = F.gw; m < M; m += F.NGW) {
        const GAS f32x4* xr = (const GAS f32x4*)(x + (size_t)m * D) + F.lane;
        f32x4 v[4]; float s = 0.f;
#pragma unroll
        for (int j = 0; j < 4; ++j) { v[j] = xr[64 * j]; s += (v[j].x * v[j].x + v[j].y * v[j].y) + (v[j].z * v[j].z + v[j].w * v[j].w); }
        s = wave_sum(s);
        GAS unsigned long long* o8 = (GAS unsigned long long*)(hb + (size_t)m * D) + F.lane;
#pragma unroll
        for (int j = 0; j < 4; ++j) o8[64 * j] = (unsigned long long)pk2(v[j].x, v[j].y) | ((unsigned long long)pk2(v[j].z, v[j].w) << 32);
        if (F.lane < 16) part[(size_t)F.lane * M + m] = (F.lane == 0) ? s : 0.f;
    }
}

__device__ __forceinline__ int t5_bucket(int rel) {
    const int ret = rel > 0 ? 16 : 0; const int n = rel < 0 ? -rel : rel;
    int b;
    if (n < 8) b = n; else if (n < 15) b = 8; else if (n < 27) b = 9; else if (n < 50) b = 10; else if (n < 91) b = 11; else if (n < 166) b = 12; else if (n < 305) b = 13; else if (n < 559) b = 14; else b = 15;
    return ret + b;
}

__device__ __forceinline__ void attn_simple(Frame& F) {
    bf16* Q = (bf16*)(F.ws + WS_Y + Y_Q); const bf16* Kb = (const bf16*)(F.ws + WS_Y + Y_K); const bf16* V = (const bf16*)(F.ws + WS_Y + Y_V);
    const float* rel_bias = F.in[13];
    LAS float* qs = (LAS float*)(F.lds + RING_OFF + F.wave * 2048);
    const int lane = F.lane; const float scale = 0.08838834764831845f;
    for (int item = F.gw; item < M * 4; item += F.NGW) {
        const int tok = item >> 2, h = item & 3, b = tok >> 11, s = tok & (S - 1);
#pragma unroll
        for (int g = 0; g < 3; ++g) { const unsigned w = *(const GAS unsigned*)(Q + (size_t)tok * AW + (g * 4 + h) * HD + 2 * lane); qs[g * 128 + 2 * lane] = bflo(w); qs[g * 128 + 2 * lane + 1] = bfhi(w); }
        LDS_WAIT(); asm volatile("" ::: "memory");
        float mrun = -1e30f, lrun = 0.f, o0 = 0.f, o1 = 0.f;
#pragma unroll 1
        for (int g = 0; g < 3; ++g) {
            const int dl = 1 << (2 * g), head = g * 4 + h;
            float sc[3];
#pragma unroll
            for (int p = 0; p < 3; ++p) {
                const int jj = lane + 64 * p, j = jj - 64, pos = s + dl * j;
                const bool valid = (jj <= 128) && pos >= 0 && pos < S;
                float dot = 0.f;
                if (valid) {
                    const bf16* krow = Kb + ((size_t)b * S + pos) * AW + head * HD;
#pragma unroll 4
                    for (int c = 0; c < 16; ++c) { const v4u kv = *(const GAS v4u*)(krow + 8 * c); const LAS float* qq = qs + g * 128 + 8 * c;
                        dot += bflo(kv.x) * qq[0] + bfhi(kv.x) * qq[1] + bflo(kv.y) * qq[2] + bfhi(kv.y) * qq[3] + bflo(kv.z) * qq[4] + bfhi(kv.z) * qq[5] + bflo(kv.w) * qq[6] + bfhi(kv.w) * qq[7]; }
                }
                const float bias = (jj <= 128) ? rel_bias[t5_bucket(dl * j) * 12 + head] : 0.f;
                sc[p] = valid ? dot * scale + bias : -1e30f;
            }
            const float gmax = wave_max(fmaxf(fmaxf(sc[0], sc[1]), sc[2]));
            const float mnew = fmaxf(mrun, gmax);
            const float alpha = __expf(mrun - mnew);
            float pr[3];
#pragma unroll
            for (int p = 0; p < 3; ++p) pr[p] = (sc[p] > -1e29f) ? __expf(sc[p] - mnew) : 0.f;
            const float psum = wave_sum(pr[0] + pr[1] + pr[2]);
            lrun = lrun * alpha + psum; o0 *= alpha; o1 *= alpha; mrun = mnew;
#pragma unroll 1
            for (int jj = 0; jj <= 128; ++jj) {
                const int pos = s + dl * (jj - 64);
                if (pos < 0 || pos >= S) continue;
                const float pj = __shfl(jj < 64 ? pr[0] : (jj < 128 ? pr[1] : pr[2]), jj & 63);
                const unsigned w = *(const GAS unsigned*)(V + ((size_t)b * S + pos) * AW + head * HD + 2 * lane);
                o0 += pj * bflo(w); o1 += pj * bfhi(w);
            }
        }
        const float inv = 1.0f / lrun;
        *(GAS unsigned*)(Q + (size_t)tok * AW + h * HD + 2 * lane) = pk2(o0 * inv, o1 * inv);
        LDS_WAIT(); asm volatile("" ::: "memory");
    }
}

__device__ __forceinline__ void pool_simple(Frame& F) {
    const bf16* U = (const bf16*)(F.ws + WS_Y + Y_U); bf16* P = (bf16*)(F.ws + WS_Y + Y_K);
    const int total = M * (D / 8);
    for (int it = F.gw * 64 + F.lane; it < total; it += F.NGW * 64) {
        const int tok = it >> 7, ch = it & 127, s = tok & (S - 1), g = ch >> 5, w = 2 << g;
        int lo = s - (w >> 1), hi = lo + w; lo = lo < 0 ? 0 : lo; hi = hi > S ? S : hi;
        const bf16* base = U + (size_t)(tok - s) * D + ch * 8;
        float a[8];
#pragma unroll
        for (int e = 0; e < 8; ++e) a[e] = 0.f;
        for (int r = lo; r < hi; ++r) { const v4u v = *(const GAS v4u*)(base + (size_t)r * D);
            a[0] += bflo(v.x); a[1] += bfhi(v.x); a[2] += bflo(v.y); a[3] += bfhi(v.y); a[4] += bflo(v.z); a[5] += bfhi(v.z); a[6] += bflo(v.w); a[7] += bfhi(v.w); }
        const float inv = 1.0f / (float)(hi - lo);
        const v4u c = *(const GAS v4u*)(base + (size_t)s * D);
        v4u o; o.x = pk2(a[0] * inv - bflo(c.x), a[1] * inv - bfhi(c.x)); o.y = pk2(a[2] * inv - bflo(c.y), a[3] * inv - bfhi(c.y));
        o.z = pk2(a[4] * inv - bflo(c.z), a[5] * inv - bfhi(c.z)); o.w = pk2(a[6] * inv - bflo(c.w), a[7] * inv - bfhi(c.w));
        *(GAS v4u*)(P + (size_t)tok * D + ch * 8) = o;
    }
}

__device__ __forceinline__ float gelu_tanh(float x) {
    const float y = 0.7978845608028654f * (x + 0.044715f * x * x * x);
    const float t = 1.0f - 2.0f / (__expf(2.0f * y) + 1.0f);
    return 0.5f * x * (1.0f + t);
}
__device__ __forceinline__ void conv_simple(Frame& F, int l) {
    bf16* AG = (bf16*)(F.ws + WS_Y);
    const float* cw = F.in[10] + (size_t)l * 3 * DFF; const float* cb = F.in[11] + (size_t)l * DFF;
    constexpr int CH = DFF / 8; const int total = M * CH;
    for (int it = F.gw * 64 + F.lane; it < total; it += F.NGW * 64) {
        const int tok = it / CH, ch = it - tok * CH, s = tok & (S - 1), c0 = ch * 8;
        const bf16* ap = AG + (size_t)tok * NUP + c0;
        const v4u z = {0u, 0u, 0u, 0u};
        const v4u am = (s > 0) ? *(const GAS v4u*)(ap - NUP) : z;
        const v4u a0 = *(const GAS v4u*)(ap);
        const v4u ap1 = (s < S - 1) ? *(const GAS v4u*)(ap + NUP) : z;
        const v4u gv = *(const GAS v4u*)(ap + DFF);
        float xm[8] = {bflo(am.x), bfhi(am.x), bflo(am.y), bfhi(am.y), bflo(am.z), bfhi(am.z), bflo(am.w), bfhi(am.w)};
        float x0[8] = {bflo(a0.x), bfhi(a0.x), bflo(a0.y), bfhi(a0.y), bflo(a0.z), bfhi(a0.z), bflo(a0.w), bfhi(a0.w)};
        float xp[8] = {bflo(ap1.x), bfhi(ap1.x), bflo(ap1.y), bfhi(ap1.y), bflo(ap1.z), bfhi(ap1.z), bflo(ap1.w), bfhi(ap1.w)};
        float gg[8] = {bflo(gv.x), bfhi(gv.x), bflo(gv.y), bfhi(gv.y), bflo(gv.z), bfhi(gv.z), bflo(gv.w), bfhi(gv.w)};
        float r[8];
#pragma unroll
        for (int e = 0; e < 8; ++e) { const float v = cw[c0 + e] * xm[e] + cw[DFF + c0 + e] * x0[e] + cw[2 * DFF + c0 + e] * xp[e] + cb[c0 + e]; r[e] = gelu_tanh(v) * gg[e]; }
        v4u o; o.x = pk2(r[0], r[1]); o.y = pk2(r[2], r[3]); o.z = pk2(r[4], r[5]); o.w = pk2(r[6], r[7]);
        *(GAS v4u*)(AG + (size_t)tok * NUP + DFF + c0) = o;
    }
}

__device__ __forceinline__ void final_norm(Frame& F) {
    const float* part = (const float*)(F.ws + WS_PART); const float* nf = F.in[14];
    for (int m = F.gw; m < M; m += F.NGW) {
        float s = 0.f;
#pragma unroll
        for (int t = 0; t < 16; ++t) s += part[(size_t)t * M + m];
        const float rstd = 1.0f / sqrtf(s * (1.0f / 1024.0f) + EPS);
        GAS f32x4* xr = (GAS f32x4*)(F.out + (size_t)m * D) + F.lane; const GAS f32x4* gr = (const GAS f32x4*)nf + F.lane;
#pragma unroll
        for (int j = 0; j < 4; ++j) { const f32x4 v = xr[64 * j]; const f32x4 gq = gr[64 * j]; xr[64 * j] = v * rstd * gq; }
    }
}

struct Args { const float* in[15]; float* out; unsigned char* ws; int ph_lo, ph_hi; int pad0, pad1; };

struct CfgP1 { static constexpr int st1 = 4, st2 = 10, st3 = 16, ld0 = D, ld1 = AW; static constexpr long off1 = (long)(Y_Q - Y_U), off2 = (long)(Y_K - Y_U), off3 = (long)(Y_V - Y_U); };
struct CfgGate { static constexpr int st1 = 4, st2 = 1 << 20, st3 = 1 << 20, ld0 = D, ld1 = D; static constexpr long off1 = (long)Y_U - (long)Y_V, off2 = 0, off3 = 0; };
struct CfgOne { static constexpr int st1 = 1 << 20, st2 = 1 << 20, st3 = 1 << 20, ld0 = D, ld1 = D; static constexpr long off1 = 0, off2 = 0, off3 = 0; };
struct CfgUp { static constexpr int st1 = 1 << 20, st2 = 1 << 20, st3 = 1 << 20, ld0 = NUP, ld1 = NUP; static constexpr long off1 = 0, off2 = 0, off3 = 0; };
template <int MODE, class CFG, int GN, int GK, int GLDA> __device__ __forceinline__ void run_gemm_b(Frame& F, const bf16* A, const bf16* Bt, bf16* O, const bf16* X1, const bf16* X2) {
    pg8::EpiB<MODE, CFG> E; E.O = O; E.part = (const float*)(F.ws + WS_PART); E.X1 = X1; E.X2 = X2;
    pg8::gemm_phase<pg8::EpiB<MODE, CFG>, GN, GK, GLDA, PG8_ALIGN, PG8_SP2>(F.lds + RING_OFF, A, Bt, F.G, (int)blockIdx.x, E);
}
template <int GK, int GLDA> __device__ __forceinline__ void run_gemm_r(Frame& F, const bf16* A, const bf16* Bt, const float* base) {
    pg8::EpiRes E{base, F.out, (bf16*)(F.ws + WS_HB), (float*)(F.ws + WS_PART), M};
    pg8::gemm_phase<pg8::EpiRes, D, GK, GLDA, PG8_ALIGN, PG8_SP2>(F.lds + RING_OFF, A, Bt, F.G, (int)blockIdx.x, E);
}

#define IN(k) (lo <= (k) && (k) < hi)
#define SEAM(k) do { if (IN(k) && IN((k) + 1)) xcd_barrier(bar); } while (0)
template <int L> __device__ __forceinline__ void layer_phases(Frame& F, int lo, int hi, const XcdBarrier& bar) {
    constexpr int pb = 1 + 10 * L;
    unsigned char* ws = F.ws;
    bf16* HB = (bf16*)(ws + WS_HB);
    bf16* YU = (bf16*)(ws + WS_Y + Y_U); bf16* YQ = (bf16*)(ws + WS_Y + Y_Q); bf16* YK = (bf16*)(ws + WS_Y + Y_K); bf16* YV = (bf16*)(ws + WS_Y + Y_V);
    bf16* W_IN = (bf16*)(ws + WS_W + WO_WIN);
    if (IN(pb + 0)) { run_gemm_b<0, CfgP1, NUQKV, D, D>(F, HB, W_IN, YU, nullptr, nullptr); SEAM(pb + 0); }
    if (IN(pb + 1)) { attn_simple(F); SEAM(pb + 1); }
    if (IN(pb + 2)) { pool_simple(F); SEAM(pb + 2); }
    if (IN(pb + 3)) { run_gemm_b<1, CfgGate, NGATE, D, D>(F, HB, W_IN + (size_t)NUQKV * D, YV, nullptr, nullptr); SEAM(pb + 3); }
    if (IN(pb + 4)) { run_gemm_b<2, CfgOne, D, D, D>(F, YK, (const bf16*)(ws + WS_W + WO_WC), YV, YV, nullptr); SEAM(pb + 4); }
    if (IN(pb + 5)) { run_gemm_b<3, CfgOne, D, AO, AW>(F, YQ, (const bf16*)(ws + WS_W + WO_WB), YV, YV, YU); SEAM(pb + 5); }
    if (IN(pb + 6)) { run_gemm_r<D, D>(F, YV, (const bf16*)(ws + WS_W + WO_WO), L == 0 ? F.in[0] : (const float*)F.out); SEAM(pb + 6); }
    if (IN(pb + 7)) { run_gemm_b<0, CfgUp, NUP, D, D>(F, HB, (const bf16*)(ws + WS_W + WO_WUP), YU, nullptr, nullptr); SEAM(pb + 7); }
    if (IN(pb + 8)) { conv_simple(F, L); if (L + 1 < DEPTH) convert_weights(F, L + 1, false); SEAM(pb + 8); }
    if (IN(pb + 9)) { run_gemm_r<DFF, NUP>(F, YU + DFF, (const bf16*)(ws + WS_W + WO_WDN + L * WDN_BYTES), (const float*)F.out); SEAM(pb + 9); }
}
#undef IN
#undef SEAM

__global__ void __launch_bounds__(NWAVES * 64, 2) fwd_kernel(Args args) {
    extern __shared__ __attribute__((aligned(16))) unsigned char lds[];
    Frame F;
    F.lds = (LAS unsigned char*)lds;
    F.MISC = (volatile LAS unsigned*)(F.lds + MISC_OFF);
    F.tid = threadIdx.x; F.lane = F.tid & 63; F.wave = __builtin_amdgcn_readfirstlane(F.tid >> 6);
    F.G = gridDim.x; { const int bx = blockIdx.x; F.vcu = (F.G % 8 == 0) ? (bx % 8) * (F.G / 8) + bx / 8 : bx; }
    F.gw = F.vcu * NWAVES + F.wave; F.NGW = F.G * NWAVES;
    F.ws = args.ws; F.ctl = (gu32*)(args.ws + WS_CTL); F.out = args.out;
    F.in = args.in;
    for (int u = F.tid; u < (LDS_BYTES - LDSCTL_OFF) / 4; u += NWAVES * 64) ((LAS unsigned*)(F.lds + LDSCTL_OFF))[u] = 0u;
    __syncthreads();
    const int lo = args.ph_lo, hi = args.ph_hi;
    XcdBarrier bar; bar.bar = (unsigned*)(F.ctl + CW_BAR); bar.x = 0; bar.st = nullptr;
    if (hi - lo > 1) bar = xcd_barrier_post((unsigned*)(F.ctl + CW_BAR), F.MISC + 8);

#define IN(k) (lo <= (k) && (k) < hi)
#define SEAM(k) do { if (IN(k) && IN((k) + 1)) xcd_barrier(bar); } while (0)
    if (IN(0)) { convert_weights(F, 0, true); p0_x_rows(F); SEAM(0); }
    layer_phases<0>(F, lo, hi, bar);
    layer_phases<1>(F, lo, hi, bar);
    if (IN(N_PHASES - 1)) final_norm(F);
}
#undef IN
#undef SEAM

#ifdef DBG_STOP
__global__ void dbg_dump(const unsigned char* ws, float* out, size_t o0, size_t o1, size_t o2, size_t o3, int n_off, int is_f32) {
    const size_t n = (size_t)M * D;
    for (size_t i = (size_t)blockIdx.x * blockDim.x + threadIdx.x; i < n; i += (size_t)gridDim.x * blockDim.x) {
        float acc = 0.f; const size_t offs[4] = {o0, o1, o2, o3};
        for (int r = 0; r < n_off; ++r) { if (is_f32) acc += ((const float*)(ws + offs[r]))[i]; else acc += __uint_as_float((unsigned)((const unsigned short*)(ws + offs[r]))[i] << 16); }
        out[i] = acc;
    }
}
#endif
extern "C" void kernel_launch(void* const* d_in, const int* in_sizes, int n_in, void* d_out, int out_size, void* d_ws, size_t ws_size, hipStream_t stream) {
    static int grid = 0;
    if (grid == 0) {
        if (n_in != 15 || in_sizes[0] != M * D || out_size != M * D || ws_size < WS_END) { fprintf(stderr, "kernel_launch: unexpected problem shape (n_in %d, in0 %d, out %d, ws %zu); nothing launched\n", n_in, n_in > 0 ? in_sizes[0] : -1, out_size, ws_size); grid = -1; return; }
        int dev = 0, cus = 0, per_cu = 0;
        if (hipGetDevice(&dev) != hipSuccess || hipDeviceGetAttribute(&cus, hipDeviceAttributeMultiprocessorCount, dev) != hipSuccess) { grid = -1; return; }
        if (hipFuncSetAttribute((const void*)fwd_kernel, hipFuncAttributeMaxDynamicSharedMemorySize, LDS_BYTES) != hipSuccess) { fprintf(stderr, "kernel_launch: hipFuncSetAttribute failed\n"); grid = -1; return; }
        if (hipOccupancyMaxActiveBlocksPerMultiprocessor(&per_cu, (const void*)fwd_kernel, NWAVES * 64, LDS_BYTES) != hipSuccess || per_cu < 1) { fprintf(stderr, "kernel_launch: occupancy query reports %d blocks per CU\n", per_cu); (void)hipGetLastError(); grid = -1; return; }
        grid = cus;
    }
    if (grid < 0) return;
    (void)hipMemsetAsync((char*)d_ws + WS_CTL, 0, CTL_ZERO_BYTES, stream);
    Args a{};
    for (int i = 0; i < 15; ++i) a.in[i] = (const float*)d_in[i];
    a.out = (float*)d_out; a.ws = (unsigned char*)d_ws;
#if MK_N_LAUNCHES == 1
    a.ph_lo = 0; a.ph_hi = N_PHASES;
    hipLaunchKernelGGL(fwd_kernel, dim3(grid), dim3(NWAVES * 64), LDS_BYTES, stream, a);
#else
#ifdef DBG_STOP
    for (int p = 0; p <= DBG_STOP; ++p) { a.ph_lo = p; a.ph_hi = p + 1; hipLaunchKernelGGL(fwd_kernel, dim3(grid), dim3(NWAVES * 64), LDS_BYTES, stream, a); }
    { const size_t offs[4] = {DBG_OFFS}; hipLaunchKernelGGL(dbg_dump, dim3(2048), dim3(256), 0, stream, (const unsigned char*)d_ws, (float*)d_out, offs[0], offs[1], offs[2], offs[3], DBG_NOFF, DBG_F32); }
#else
    for (int p = 0; p < N_PHASES; ++p) { a.ph_lo = p; a.ph_hi = p + 1; hipLaunchKernelGGL(fwd_kernel, dim3(grid), dim3(NWAVES * 64), LDS_BYTES, stream, a); }
#endif
#endif
}
```

```cpp
#include <hip/hip_runtime.h>
#include <cstdio>
#include <cstdint>

#ifndef MK_N_LAUNCHES
#define MK_N_LAUNCHES 1
#endif

namespace pg8 {
#define PG8_LAS __attribute__((address_space(3)))
typedef unsigned short bf16_t;
typedef short bf16x8 __attribute__((ext_vector_type(8)));
typedef float f32x4 __attribute__((ext_vector_type(4)));
typedef unsigned u32x4 __attribute__((ext_vector_type(4)));
typedef unsigned u32x2 __attribute__((ext_vector_type(2)));
constexpr int BM = 256, BK = 64, HALF = 128, HTB = HALF * BK * 2  , STAGE_BYTES = 8 * HTB, NXCD = 8, WGM = 8;

__host__ __device__ __forceinline__ int lds_byte(int r, int c) { const int st = (r >> 4) * 2 + (c >> 5), rr = r & 15, cc = c & 31, ob = rr * 64 + cc * 2; return st * 1024 + (ob ^ (((ob >> 9) & 1) << 5)); }
__host__ __device__ __forceinline__ void stage_rc(int b, int& R, int& C) { const int st = b / 1024, sb = b % 1024, swz = sb ^ (((sb >> 9) & 1) << 5); R = (st >> 1) * 16 + swz / 64; C = (st & 1) * 32 + (swz % 64) / 2; }
__host__ __device__ __forceinline__ int perm32(int rho) { const int n = rho >> 4, i = rho & 15; return 8 * (i >> 2) + 4 * n + (i & 3); }

struct Unit { int pm, pn; };
struct Gemm { const bf16_t* A; const bf16_t* Bt; int M, N, K, lda; };

struct StaticOrder {
    int nM, nN, nwg, G, c;
    __host__ __device__ void init(int M, int N, int G_, int c_) { nM = M / BM; nN = N / BM; nwg = nM * nN; G = G_; c = c_; }
    __host__ __device__ bool next(int i, Unit& u) const {
        const long L = (long)i * G + c; if (L >= nwg) return false;
        int wgid = (int)L; { const int q = nwg / NXCD, r = nwg % NXCD, xcd = wgid % NXCD, off = wgid / NXCD; wgid = (xcd < r ? xcd * (q + 1) : r * (q + 1) + (xcd - r) * q) + off; }
        const int nig = WGM * nN, gid = wgid / nig, fm = gid * WGM, gsz = (nM - fm) < WGM ? (nM - fm) : WGM;
        u.pm = fm + ((wgid % nig) % gsz); u.pn = (wgid % nig) / gsz; return true;
    }
    __device__ __forceinline__ void a_ready(const Unit&) const {}
    __device__ __forceinline__ void done(const Unit&) const {}
};

typedef float f32x2_t __attribute__((ext_vector_type(2))); typedef __bf16 bf16x2_t __attribute__((ext_vector_type(2)));
__device__ __forceinline__ unsigned cvt_pk_bf16(float lo, float hi) { f32x2_t v = {lo, hi}; bf16x2_t b = __builtin_convertvector(v, bf16x2_t); return __builtin_bit_cast(unsigned, b); }
__device__ __forceinline__ float bf_lo(unsigned w) { return __uint_as_float(w << 16); }
__device__ __forceinline__ float bf_hi(unsigned w) { return __uint_as_float(w & 0xffff0000u); }

__device__ __forceinline__ void wave_rstd(const float* part, int Mrows, int rowbase, int lane, float eps, float (&rs)[2]) {
#pragma unroll
    for (int ai = 0; ai < 2; ++ai) { const float* p = part + rowbase + ai * HALF + lane; float s = 0.f;
#pragma unroll
        for (int t = 0; t < 16; ++t) s += p[(size_t)t * Mrows];
        rs[ai] = 1.0f / sqrtf(s * (1.0f / 1024.0f) + eps); }
}

template <int MODE, class CFG> struct EpiB {
    static constexpr bool PERM = true, AFTER_DRAIN = false;
    bf16_t* O;
    const float* part;
    const bf16_t* X1; const bf16_t* X2;
    static constexpr int Mrows = 16384, ldx = 1024; static constexpr float eps = 1e-6f;
    __device__ __forceinline__ void operator()(const f32x4 (&acc)[2][2][4][2], const Unit& u, int wr, int wc, int fr, int fq) const {
        const int lane = fr + 16 * fq;
        long boff = 0; int ldc = CFG::ld0, sst = 0;
        if (u.pn >= CFG::st1) { boff = CFG::off1; ldc = CFG::ld1; sst = CFG::st1; }
        if (u.pn >= CFG::st2) { boff = CFG::off2; sst = CFG::st2; }
        if (u.pn >= CFG::st3) { boff = CFG::off3; sst = CFG::st3; }
        bf16_t* base = (bf16_t*)((char*)O + boff);
        const int col0 = (u.pn - sst) * BM + wc * 32 + 8 * fq;
        const int row0 = u.pm * BM + wr * 64 + fr;
        float rs[2] = {1.f, 1.f};
        if (MODE <= 1) wave_rstd(part, Mrows, u.pm * BM + wr * 64, lane, eps, rs);
#pragma unroll
        for (int ai = 0; ai < 2; ++ai)
#pragma unroll
            for (int m = 0; m < 4; ++m) {
                const int row = row0 + ai * HALF + m * 16;
                float r = 1.f; if (MODE <= 1) r = __shfl(rs[ai], m * 16 + fr);
                bf16_t* rowp = base + (size_t)row * ldc + col0;
#pragma unroll
                for (int bj = 0; bj < 2; ++bj) {
                    f32x4 v0 = acc[ai][bj][m][0], v1 = acc[ai][bj][m][1];
                    if (MODE <= 1) { v0 = v0 * r; v1 = v1 * r; }
                    if (MODE == 1) {
#pragma unroll
                        for (int e = 0; e < 4; ++e) { v0[e] = __builtin_amdgcn_rcpf(1.0f + __expf(-v0[e])); v1[e] = __builtin_amdgcn_rcpf(1.0f + __expf(-v1[e])); }
                    }
                    if (MODE == 2) {
                        const u32x4 x = *(const u32x4*)(X1 + (size_t)row * ldx + col0 + bj * HALF);
                        v0[0] *= bf_lo(x.x); v0[1] *= bf_hi(x.x); v0[2] *= bf_lo(x.y); v0[3] *= bf_hi(x.y);
                        v1[0] *= bf_lo(x.z); v1[1] *= bf_hi(x.z); v1[2] *= bf_lo(x.w); v1[3] *= bf_hi(x.w);
                    }
                    if (MODE == 3) {
                        const u32x4 x = *(const u32x4*)(X1 + (size_t)row * ldx + col0 + bj * HALF);
                        const u32x4 y = *(const u32x4*)(X2 + (size_t)row * ldx + col0 + bj * HALF);
                        v0[0] = bf_lo(x.x) + v0[0] * bf_lo(y.x); v0[1] = bf_hi(x.x) + v0[1] * bf_hi(y.x); v0[2] = bf_lo(x.y) + v0[2] * bf_lo(y.y); v0[3] = bf_hi(x.y) + v0[3] * bf_hi(y.y);
                        v1[0] = bf_lo(x.z) + v1[0] * bf_lo(y.z); v1[1] = bf_hi(x.z) + v1[1] * bf_hi(y.z); v1[2] = bf_lo(x.w) + v1[2] * bf_lo(y.w); v1[3] = bf_hi(x.w) + v1[3] * bf_hi(y.w);
                    }
                    u32x4 w; w.x = cvt_pk_bf16(v0[0], v0[1]); w.y = cvt_pk_bf16(v0[2], v0[3]); w.z = cvt_pk_bf16(v1[0], v1[1]); w.w = cvt_pk_bf16(v1[2], v1[3]);
                    *(u32x4*)(rowp + bj * HALF) = w;
                }
                if (MODE >= 2) asm volatile("" ::: "memory");
            }
    }
};

struct EpiRes {
    static constexpr bool PERM = false, AFTER_DRAIN = false;
    const float* base; float* out; bf16_t* hb; float* part; int Mrows;
    __device__ __forceinline__ void operator()(const f32x4 (&acc)[2][2][4][2], const Unit& u, int wr, int wc, int fr, int fq) const {
        const int col0 = u.pn * BM + wc * 32 + 4 * fq;
#pragma unroll
        for (int ai = 0; ai < 2; ++ai)
#pragma unroll
            for (int m = 0; m < 4; ++m) {
                const int row = u.pm * BM + ai * HALF + wr * 64 + m * 16 + fr; const size_t off = (size_t)row * 1024 + col0;
                float ss = 0.f;
#pragma unroll
                for (int bj = 0; bj < 2; ++bj)
#pragma unroll
                    for (int n = 0; n < 2; ++n) {
                        const f32x4 bs = *(const f32x4*)(base + off + bj * HALF + n * 16);
                        const f32x4 o = bs + acc[ai][bj][m][n];
                        *(f32x4*)(out + off + bj * HALF + n * 16) = o;
                        u32x2 w; w.x = cvt_pk_bf16(o[0], o[1]); w.y = cvt_pk_bf16(o[2], o[3]);
                        *(u32x2*)(hb + off + bj * HALF + n * 16) = w;
                        ss += (o[0] * o[0] + o[1] * o[1]) + (o[2] * o[2] + o[3] * o[3]);
                    }
                ss += __shfl_xor(ss, 16); ss += __shfl_xor(ss, 32);
                if (fq == 0) part[(size_t)(u.pn * 4 + wc) * Mrows + row] = ss;
                asm volatile("" ::: "memory");
            }
    }
};

template <class Epi, int GN, int GK, int GLDA, bool ALIGN_EPI = false, bool SP2 = false>
__device__ __forceinline__ void gemm_phase(PG8_LAS unsigned char* lds, const bf16_t* gA, const bf16_t* gBt, int G_, int c_, const Epi& E) {
    struct { const bf16_t* A; const bf16_t* Bt; int K, lda; } g{gA, gBt, GK, GLDA};
    StaticOrder S; S.nM = 16384 / BM; S.nN = GN / BM; S.nwg = S.nM * S.nN; S.G = G_; S.c = c_;
    int tid_ = threadIdx.x; asm volatile("" : "+v"(tid_));
    const int tid = tid_, wid = __builtin_amdgcn_readfirstlane(tid >> 6), lane = tid & 63, wr = wid >> 2, wc = wid & 3, fr = lane & 15, fq = lane >> 4;
    const int K = g.K, nt = K / BK, lda = g.lda;
    unsigned voffA[2], voffB[2];
#pragma unroll
    for (int i = 0; i < 2; ++i) { int R, C; stage_rc(tid * 16 + i * 8192, R, C); const int Rb = Epi::PERM ? ((R & ~31) + perm32(R & 31)) : R;
        voffA[i] = (unsigned)(R * lda + C) * 2u; voffB[i] = (unsigned)(Rb * K + C) * 2u; }
    const size_t kstep = (size_t)(BK * 2);
    const size_t hstepA = (size_t)HALF * lda * 2, hstepB = (size_t)HALF * K * 2;
    const size_t tstepA = 2 * hstepA, tstepB = 2 * hstepB;
    const unsigned ldsw = (unsigned)wid * 1024u;
    const int aoff = lds_byte(wr * 64 + fr, fq * 8), boff = lds_byte(wc * 32 + fr, fq * 8);
#define PG8_SA(b, h) (((b) * 2 + (h)) * HTB)
#define PG8_SB(b, h) ((4 + (b) * 2 + (h)) * HTB)
#define PG8_STAGE(bufoff, gbase, voff) do { _Pragma("unroll") for (int _i = 0; _i < 2; ++_i) \
        __builtin_amdgcn_global_load_lds((const unsigned*)((const char*)(gbase) + (voff)[_i]), (PG8_LAS unsigned*)(lds + (bufoff) + ldsw + _i * 8192), 16, 0, 0); } while (0)
#define PG8_LDA(dst, b, h) do { _Pragma("unroll") for (int m = 0; m < 4; ++m) _Pragma("unroll") for (int k = 0; k < 2; ++k) dst[m][k] = *(const PG8_LAS bf16x8*)(lds + PG8_SA(b, h) + aoff + m * 2048 + k * 1024); } while (0)
#define PG8_LDB(dst, b, h) do { _Pragma("unroll") for (int n = 0; n < 2; ++n) _Pragma("unroll") for (int k = 0; k < 2; ++k) dst[n][k] = *(const PG8_LAS bf16x8*)(lds + PG8_SB(b, h) + boff + n * 2048 + k * 1024); } while (0)
#define PG8_MMA(ai, bj, At, Bt) do { __builtin_amdgcn_s_setprio(1); _Pragma("unroll") for (int m = 0; m < 4; ++m) _Pragma("unroll") for (int n = 0; n < 2; ++n) _Pragma("unroll") for (int k = 0; k < 2; ++k) \
        acc[ai][bj][m][n] = __builtin_amdgcn_mfma_f32_16x16x32_bf16(Bt[n][k], At[m][k], acc[ai][bj][m][n], 0, 0, 0); __builtin_amdgcn_s_setprio(0); } while (0)
#define PG8_WAIT_V(n) asm volatile("s_waitcnt vmcnt(" #n ")" ::: "memory")
#define PG8_WAIT_L(n) asm volatile("s_waitcnt lgkmcnt(" #n ")" ::: "memory")
#define PG8_BAR __builtin_amdgcn_s_barrier()
#define PG8_SCHED __builtin_amdgcn_sched_barrier(0)
    Unit cur, nxt; int ui = 0;
    if (!S.next(0, cur)) return;
    f32x4 acc[2][2][4][2];
#pragma unroll
    for (int a = 0; a < 2; ++a)
#pragma unroll
        for (int b = 0; b < 2; ++b)
#pragma unroll
            for (int m = 0; m < 4; ++m)
#pragma unroll
                for (int n = 0; n < 2; ++n) acc[a][b][m][n] = (f32x4){0.f, 0.f, 0.f, 0.f};
    bf16x8 At[4][2], B0[2][2], B1[2][2];
    const char* cA = (const char*)g.A + (size_t)cur.pm * tstepA; const char* cB = (const char*)g.Bt + (size_t)cur.pn * tstepB;
    S.a_ready(cur);
    if constexpr (SP2) {
        PG8_STAGE(PG8_SB(0, 0), cB, voffB); PG8_STAGE(PG8_SB(0, 1), cB + hstepB, voffB); PG8_STAGE(PG8_SA(0, 0), cA, voffA); PG8_STAGE(PG8_SA(0, 1), cA + hstepA, voffA);
        if (wr == 1) PG8_BAR;
        PG8_WAIT_V(2); PG8_BAR;
        PG8_STAGE(PG8_SB(1, 0), cB + kstep, voffB); PG8_STAGE(PG8_SA(1, 0), cA + kstep, voffA); PG8_STAGE(PG8_SB(1, 1), cB + hstepB + kstep, voffB);
        PG8_WAIT_V(6); PG8_BAR;
    } else {
        PG8_STAGE(PG8_SB(0, 0), cB, voffB); PG8_STAGE(PG8_SA(0, 0), cA, voffA); PG8_STAGE(PG8_SB(0, 1), cB + hstepB, voffB); PG8_STAGE(PG8_SA(0, 1), cA + hstepA, voffA);
        if (wr == 1) PG8_BAR;
        PG8_WAIT_V(4); PG8_BAR;
        PG8_STAGE(PG8_SB(1, 0), cB + kstep, voffB); PG8_STAGE(PG8_SA(1, 0), cA + kstep, voffA); PG8_STAGE(PG8_SB(1, 1), cB + hstepB + kstep, voffB);
        PG8_WAIT_V(6); PG8_BAR;
    }
    for (;;) {
        const bool has_next = S.next(ui + 1, nxt);
        const char* nA = has_next ? (const char*)g.A + (size_t)nxt.pm * tstepA : cA; const char* nB = has_next ? (const char*)g.Bt + (size_t)nxt.pn * tstepB : cB;
        for (int t = 0; t < nt; t += 2) {
            const bool last = (t == nt - 2);
            const char* a1 = cA + (size_t)(t + 1) * kstep;
            const char* a2 = last ? nA : cA + (size_t)(t + 2) * kstep; const char* b2 = last ? nB : cB + (size_t)(t + 2) * kstep;
            const char* a3 = a2 + kstep; const char* b3 = b2 + kstep;
            if (last && has_next) S.a_ready(nxt);
            if constexpr (SP2) {
            PG8_LDB(B0, 0, 0); PG8_LDB(B1, 0, 1); PG8_SCHED; PG8_LDA(At, 0, 0); PG8_STAGE(PG8_SA(1, 1), a1 + hstepA, voffA);
            PG8_WAIT_V(8); PG8_WAIT_L(0); PG8_BAR; PG8_MMA(0, 0, At, B0); PG8_MMA(0, 1, At, B1); PG8_BAR; PG8_SCHED;
            PG8_LDA(At, 0, 1); PG8_STAGE(PG8_SB(0, 0), b2, voffB); PG8_STAGE(PG8_SB(0, 1), b2 + hstepB, voffB); PG8_STAGE(PG8_SA(0, 0), a2, voffA);
            PG8_WAIT_V(8); PG8_WAIT_L(0); PG8_BAR; PG8_MMA(1, 0, At, B0); PG8_MMA(1, 1, At, B1); PG8_BAR; PG8_SCHED;
            PG8_LDB(B0, 1, 0); PG8_LDB(B1, 1, 1); PG8_SCHED; PG8_LDA(At, 1, 0); PG8_STAGE(PG8_SA(0, 1), a2 + hstepA, voffA);
            PG8_WAIT_V(8); PG8_WAIT_L(0); PG8_BAR; PG8_MMA(0, 0, At, B0); PG8_MMA(0, 1, At, B1); PG8_BAR; PG8_SCHED;
            PG8_LDA(At, 1, 1); PG8_STAGE(PG8_SB(1, 0), b3, voffB); PG8_STAGE(PG8_SB(1, 1), b3 + hstepB, voffB); PG8_STAGE(PG8_SA(1, 0), a3, voffA);
            PG8_WAIT_V(8); PG8_WAIT_L(0); PG8_BAR; PG8_MMA(1, 0, At, B0); PG8_MMA(1, 1, At, B1); PG8_BAR; PG8_SCHED;
            } else {
            PG8_LDB(B0, 0, 0); PG8_SCHED; PG8_LDA(At, 0, 0); PG8_STAGE(PG8_SA(1, 1), a1 + hstepA, voffA);
            PG8_WAIT_L(8); PG8_BAR; PG8_WAIT_L(0); PG8_MMA(0, 0, At, B0); PG8_BAR; PG8_SCHED;
            PG8_LDB(B1, 0, 1); PG8_STAGE(PG8_SB(0, 0), b2, voffB);
            PG8_BAR; PG8_WAIT_L(0); PG8_MMA(0, 1, At, B1); PG8_BAR;
            PG8_LDA(At, 0, 1); PG8_STAGE(PG8_SA(0, 0), a2, voffA);
            PG8_BAR; PG8_WAIT_L(0); PG8_MMA(1, 0, At, B0); PG8_BAR; PG8_SCHED;
            PG8_STAGE(PG8_SB(0, 1), b2 + hstepB, voffB);
            PG8_WAIT_V(6); PG8_BAR; PG8_MMA(1, 1, At, B1); PG8_BAR;
            PG8_LDB(B0, 1, 0); PG8_SCHED; PG8_LDA(At, 1, 0); PG8_STAGE(PG8_SA(0, 1), a2 + hstepA, voffA);
            PG8_WAIT_L(8); PG8_BAR; PG8_WAIT_L(0); PG8_MMA(0, 0, At, B0); PG8_BAR; PG8_SCHED;
            PG8_LDB(B1, 1, 1); PG8_STAGE(PG8_SB(1, 0), b3, voffB);
            PG8_BAR; PG8_WAIT_L(0); PG8_MMA(0, 1, At, B1); PG8_BAR;
            PG8_LDA(At, 1, 1); PG8_STAGE(PG8_SA(1, 0), a3, voffA);
            PG8_BAR; PG8_WAIT_L(0); PG8_MMA(1, 0, At, B0); PG8_BAR; PG8_SCHED;
            PG8_STAGE(PG8_SB(1, 1), b3 + hstepB, voffB);
            PG8_WAIT_V(6); PG8_BAR; PG8_MMA(1, 1, At, B1); PG8_BAR;
            }
        }
        if constexpr (ALIGN_EPI) { if (wr == 0) PG8_BAR; }
        if constexpr (!Epi::AFTER_DRAIN) { E(acc, cur, wr, wc, fr, fq); S.done(cur); }
        if (!has_next) break;
#pragma unroll
        for (int a = 0; a < 2; ++a)
#pragma unroll
            for (int b = 0; b < 2; ++b)
#pragma unroll
                for (int m = 0; m < 4; ++m)
#pragma unroll
                    for (int n = 0; n < 2; ++n) acc[a][b][m][n] = (f32x4){0.f, 0.f, 0.f, 0.f};
        cur = nxt; cA = nA; cB = nB; ++ui;
        if constexpr (ALIGN_EPI) { if (wr == 1) PG8_BAR; }
    }
    PG8_WAIT_V(0);
    if constexpr (!ALIGN_EPI) { if (wr == 0) PG8_BAR; }
    PG8_BAR;
#undef PG8_SA
#undef PG8_SB
#undef PG8_STAGE
#undef PG8_LDA
#undef PG8_LDB
#undef PG8_MMA
#undef PG8_WAIT_V
#undef PG8_WAIT_L
#undef PG8_BAR
#undef PG8_SCHED
}
}

#ifndef PG8_SP2
#define PG8_SP2 true
#endif
#ifndef PG8_ALIGN
#define PG8_ALIGN true
#endif

constexpr int NWAVES = 8;
constexpr int BATCH = 8, S = 2048, D = 1024, DEPTH = 2;
constexpr int M = BATCH * S;
constexpr int NIN = 7680, NUQKV = 5632, NGATE = 2048, AW = 1536, AO = 512, DFF = 2816, NUP = 5632, HD = 128;
constexpr float EPS = 1e-6f;
constexpr int N_PHASES = 2 + 10 * DEPTH;

constexpr size_t MiB = 1u << 20;
constexpr size_t WS_CTL = 0, CTL_ZERO_BYTES = 64 * 1024;
constexpr size_t WS_PART = 1 * MiB;
constexpr size_t WS_LSE = 2 * MiB;
constexpr size_t WS_W = 4 * MiB;
constexpr size_t WO_WIN = 0, WO_WC = 15 * MiB, WO_WB = 17 * MiB, WO_WO = 18 * MiB, WO_WUP = 20 * MiB, WO_WDN = 31 * MiB, WDN_BYTES = (size_t)D * DFF * 2;
constexpr size_t WS_HB = 46 * MiB;
constexpr size_t WS_Y = 78 * MiB;
constexpr size_t Y_U = 0, Y_Q = 32 * MiB, Y_K = 80 * MiB, Y_V = 128 * MiB;
constexpr size_t WS_END = 254 * MiB;
static_assert(WO_WDN + 2 * WDN_BYTES <= 42 * MiB && WS_W + 42 * MiB <= WS_HB && WS_HB + 32 * MiB <= WS_Y && WS_Y + 176 * MiB <= WS_END, "d_ws map");
constexpr int CW_BAR = 1024;

constexpr int RING_OFF = 0, RING_BYTES = 131072;
constexpr int LDSCTL_OFF = RING_BYTES, MISC_OFF = LDSCTL_OFF + 320;
constexpr int LDS_BYTES = 147456;

#define GAS __attribute__((address_space(1)))
#define LAS __attribute__((address_space(3)))
typedef unsigned short bf16;
typedef unsigned v4u __attribute__((ext_vector_type(4)));
typedef unsigned v2u __attribute__((ext_vector_type(2)));
typedef float f32x4 __attribute__((ext_vector_type(4)));
typedef GAS unsigned gu32;
#define RLX_AGENT __ATOMIC_RELAXED, __HIP_MEMORY_SCOPE_AGENT
#define LDS_WAIT() asm volatile("s_waitcnt lgkmcnt(0)" ::: "memory")
#define VM_WAIT() asm volatile("s_waitcnt vmcnt(0)" ::: "memory")
__device__ __forceinline__ unsigned f2bf(float f) { unsigned u = __builtin_bit_cast(unsigned, f); return (u + 0x7fffu + ((u >> 16) & 1u)) >> 16; }
__device__ __forceinline__ unsigned pk2(float lo, float hi) { return f2bf(lo) | (f2bf(hi) << 16); }
__device__ __forceinline__ float bflo(unsigned w) { return __uint_as_float(w << 16); }
__device__ __forceinline__ float bfhi(unsigned w) { return __uint_as_float(w & 0xffff0000u); }

#define XB_TMO      128
#define XB_XCNT(j)  (256  + 64 * (j))
#define XB_XSUB(j)  (1280 + 64 * (j))
#define XB_XGEN(j)  (2304 + 64 * (j))
#define XB_TOP      3328
#define XB_TOPGEN   3392
#define XCD_BAR_WORDS 3456
#define XB_SPIN_CAP (1u << 18)
static_assert((CW_BAR + XCD_BAR_WORDS) * 4 <= (int)CTL_ZERO_BYTES, "barrier words inside the zeroed region");

__device__ __forceinline__ unsigned xb_ld(unsigned* p)              { return __hip_atomic_load(p, __ATOMIC_RELAXED, __HIP_MEMORY_SCOPE_AGENT); }
__device__ __forceinline__ unsigned xb_add(unsigned* p, unsigned v) { return __hip_atomic_fetch_add(p, v, __ATOMIC_RELAXED, __HIP_MEMORY_SCOPE_AGENT); }
__device__ __forceinline__ unsigned xb_xcc_id() { return (unsigned)__builtin_amdgcn_s_getreg((3 << 11) | 20) & 0xFu; }
#define XB_SPIN(cond, bar) do { unsigned _sp = 0; while (cond) { __builtin_amdgcn_s_sleep(1); \
    if ((++_sp & 255u) == 0u) { if (xb_ld(&(bar)[XB_TMO])) break; if (_sp > XB_SPIN_CAP) { atomicAdd(&(bar)[XB_TMO], 1u); break; } } } } while (0)

struct XcdBarrier { unsigned* bar; unsigned x; volatile LAS unsigned* st; };

__device__ __forceinline__ XcdBarrier xcd_barrier_post(unsigned* bar, volatile LAS unsigned* st) {
    XcdBarrier b; b.bar = bar; b.x = xb_xcc_id(); b.st = st;
    if (threadIdx.x == 0) (void)xb_add(&bar[XB_XCNT(b.x)], 1u);
    return b;
}
__device__ __forceinline__ void xcd_barrier_complete(unsigned* bar, unsigned x, unsigned& nloc, unsigned& nx) {
    const unsigned G = gridDim.x * gridDim.y * gridDim.z;
    unsigned sum, cnt, mine, sp = 0u;
    for (;;) {
        sum = 0u; cnt = 0u; mine = 0u;
#pragma unroll
        for (unsigned j = 0; j < 16; ++j) { const unsigned c = xb_ld(&bar[XB_XCNT(j)]); sum += c; cnt += (c > 0u) ? 1u : 0u; mine = (j == x) ? c : mine; }
        if (sum == G) break;
        __builtin_amdgcn_s_sleep(1);
        if ((++sp & 255u) == 0u) { if (xb_ld(&bar[XB_TMO])) break; if (sp > XB_SPIN_CAP) { atomicAdd(&bar[XB_TMO], 1u); break; } }
    }
    nloc = mine > 0u ? mine : 1u; nx = cnt > 0u ? cnt : 1u;
}
__device__ __forceinline__ void xcd_barrier(const XcdBarrier& b) {
    asm volatile("s_waitcnt vmcnt(0)" ::: "memory");
    __syncthreads();
    if (threadIdx.x == 0) {
        unsigned* bar = b.bar; unsigned bx_ = b.x; asm volatile("" : "+s"(bar), "+s"(bx_));
        __builtin_amdgcn_s_waitcnt(0);
        unsigned nloc = b.st[0], nx = b.st[1];
        if (nloc == 0u) { xcd_barrier_complete(bar, bx_, nloc, nx); b.st[0] = nloc; b.st[1] = nx; }
        const unsigned old = xb_add(&bar[XB_XSUB(bx_)], 1u);
        const unsigned gen = old / nloc;
        if (old + 1u == (gen + 1u) * nloc) {
            __builtin_amdgcn_fence(__ATOMIC_RELEASE, "agent");
            asm volatile("s_waitcnt vmcnt(0)" ::: "memory");
            const unsigned og = xb_add(&bar[XB_TOP], 1u);
            const unsigned tg = og / nx;
            if (og + 1u == (tg + 1u) * nx) xb_add(&bar[XB_TOPGEN], 1u);
            else XB_SPIN(xb_ld(&bar[XB_TOPGEN]) == tg, bar);
            __builtin_amdgcn_fence(__ATOMIC_ACQUIRE, "agent");
            xb_add(&bar[XB_XGEN(bx_)], 1u);
            asm volatile("s_waitcnt vmcnt(0)" ::: "memory");
        } else {
            XB_SPIN(xb_ld(&bar[XB_XGEN(bx_)]) == gen, bar);
            __builtin_amdgcn_fence(__ATOMIC_ACQUIRE, "agent");
            asm volatile("s_waitcnt vmcnt(0)" ::: "memory");
        }
    }
    __syncthreads();
}

struct Frame {
    LAS unsigned char* lds;
    volatile LAS unsigned* MISC;
    gu32* ctl;
    int tid, lane, wave;
    int vcu, G;
    int gw, NGW;
    unsigned char* ws;
    const float* const* in; float* out;
};

__device__ __forceinline__ float wave_sum(float v) {
#pragma unroll
    for (int o = 1; o < 64; o <<= 1) v += __shfl_xor(v, o);
    return v;
}
__device__ __forceinline__ float wave_max(float v) {
#pragma unroll
    for (int o = 1; o < 64; o <<= 1) v = fmaxf(v, __shfl_xor(v, o));
    return v;
}

__device__ __forceinline__ void p0_transpose_item(const float* W, const float* gain, int K, int N, bf16* WT, LAS float* scr, int item, int lane) {
    const int nblk = N / 32, kb = item / nblk, nb = item % nblk, k0 = 64 * kb, n0 = 32 * nb;
#pragma unroll 8
    for (int i = 0; i < 32; ++i) { const int kk = 2 * i + (lane >> 5); const float gsc = gain ? gain[k0 + kk] : 1.0f; scr[kk * 33 + (lane & 31)] = W[(size_t)(k0 + kk) * N + n0 + (lane & 31)] * gsc; }
    LDS_WAIT(); asm volatile("" ::: "memory");
    const int c = lane & 7;
#pragma unroll
    for (int j = 0; j < 4; ++j) { const int n = (lane >> 3) + 8 * j; const LAS float* s = scr + (8 * c) * 33 + n;
        v4u o; o.x = pk2(s[0 * 33], s[1 * 33]); o.y = pk2(s[2 * 33], s[3 * 33]); o.z = pk2(s[4 * 33], s[5 * 33]); o.w = pk2(s[6 * 33], s[7 * 33]);
        *(GAS v4u*)(WT + (size_t)(n0 + n) * K + k0 + 8 * c) = o; }
    LDS_WAIT(); asm volatile("" ::: "memory");
}

__device__ __forceinline__ void convert_weights(Frame& F, int l, bool with_down) {
    LAS float* scr = (LAS float*)(F.lds + RING_OFF + F.wave * 16384);
    unsigned char* wb = F.ws + WS_W;
    const float* w_in = F.in[1] + (size_t)l * D * NIN; const float* w_b = F.in[5] + (size_t)l * AO * D; const float* w_o = F.in[6] + (size_t)l * D * D;
    const float* w_up = F.in[9] + (size_t)l * D * NUP; const float* n1 = F.in[7] + (size_t)l * D; const float* n2 = F.in[8] + (size_t)l * D;
    constexpr int I_IN = (D / 64) * (NIN / 32), I_B = (AO / 64) * (D / 32), I_O = (D / 64) * (D / 32), I_UP = (D / 64) * (NUP / 32), I_DN = (DFF / 64) * (D / 32);
    const int nitems = I_IN + I_B + I_O + I_UP + (with_down ? 2 * I_DN : 0);
    for (int it = F.gw; it < nitems; it += F.NGW) {
        int r = it;
        if (r < I_IN) { p0_transpose_item(w_in, n1, D, NIN, (bf16*)(wb + WO_WIN), scr, r, F.lane); continue; } r -= I_IN;
        if (r < I_B) { p0_transpose_item(w_b, nullptr, AO, D, (bf16*)(wb + WO_WB), scr, r, F.lane); continue; } r -= I_B;
        if (r < I_O) { p0_transpose_item(w_o, nullptr, D, D, (bf16*)(wb + WO_WO), scr, r, F.lane); continue; } r -= I_O;
        if (r < I_UP) { p0_transpose_item(w_up, n2, D, NUP, (bf16*)(wb + WO_WUP), scr, r, F.lane); continue; } r -= I_UP;
        const int ll = r / I_DN; r -= ll * I_DN;
        p0_transpose_item(F.in[12] + (size_t)ll * DFF * D, nullptr, DFF, D, (bf16*)(wb + WO_WDN + ll * WDN_BYTES), scr, r, F.lane);
    }
    const float* w_pool = F.in[2] + (size_t)l * 4 * 256 * 256; const float* ps = F.in[3] + (size_t)l * D; const float* w_a = F.in[4] + (size_t)l * D * D;
    bf16* Wc = (bf16*)(wb + WO_WC);
    for (int o = F.gw * 64 + F.lane; o < D * D; o += F.NGW * 64) {
        const int n = o >> 10, kk = o & 1023, g = kk >> 8, c = kk & 255;
        const float* wp = w_pool + ((size_t)g * 256 + c) * 256; const float* psg = ps + g * 256; const float* wa = w_a + (size_t)(g * 256) * D + n;
        float acc = 0.f;
#pragma unroll 4
        for (int d = 0; d < 256; d += 4) { const f32x4 p = *(const f32x4*)(wp + d); const f32x4 sc = *(const f32x4*)(psg + d);
            acc += p[0] * sc[0] * wa[(size_t)(d + 0) * D]; acc += p[1] * sc[1] * wa[(size_t)(d + 1) * D]; acc += p[2] * sc[2] * wa[(size_t)(d + 2) * D]; acc += p[3] * sc[3] * wa[(size_t)(d + 3) * D]; }
        Wc[o] = (bf16)f2bf(acc);
    }
}

__device__ __forceinline__ void p0_x_rows(Frame& F) {
    const float* x = F.in[0]; bf16* hb = (bf16*)(F.ws + WS_HB); float* part = (float*)(F.ws + WS_PART);
    for (int m = F.gw; m < M; m += F.NGW) {
        const GAS f32x4* xr = (const GAS f32x4*)(x + (size_t)m * D) + F.lane;
        f32x4 v[4]; float s = 0.f;
#pragma unroll
        for (int j = 0; j < 4; ++j) { v[j] = xr[64 * j]; s += (v[j].x * v[j].x + v[j].y * v[j].y) + (v[j].z * v[j].z + v[j].w * v[j].w); }
        s = wave_sum(s);
        GAS unsigned long long* o8 = (GAS unsigned long long*)(hb + (size_t)m * D) + F.lane;
#pragma unroll
        for (int j = 0; j < 4; ++j) o8[64 * j] = (unsigned long long)pk2(v[j].x, v[j].y) | ((unsigned long long)pk2(v[j].z, v[j].w) << 32);
        if (F.lane < 16) part[(size_t)F.lane * M + m] = (F.lane == 0) ? s : 0.f;
    }
}

__device__ __forceinline__ int t5_bucket(int rel) {
    const int ret = rel > 0 ? 16 : 0; const int n = rel < 0 ? -rel : rel;
    int b;
    if (n < 8) b = n; else if (n < 15) b = 8; else if (n < 27) b = 9; else if (n < 50) b = 10; else if (n < 91) b = 11; else if (n < 166) b = 12; else if (n < 305) b = 13; else if (n < 559) b = 14; else b = 15;
    return ret + b;
}

__device__ __forceinline__ void attn_simple(Frame& F) {
    bf16* Q = (bf16*)(F.ws + WS_Y + Y_Q); const bf16* Kb = (const bf16*)(F.ws + WS_Y + Y_K); const bf16* V = (const bf16*)(F.ws + WS_Y + Y_V);
    const float* rel_bias = F.in[13];
    LAS float* qs = (LAS float*)(F.lds + RING_OFF + F.wave * 2048);
    const int lane = F.lane; const float scale = 0.08838834764831845f;
    for (int item = F.gw; item < M * 4; item += F.NGW) {
        const int tok = item >> 2, h = item & 3, b = tok >> 11, s = tok & (S - 1);
#pragma unroll
        for (int g = 0; g < 3; ++g) { const unsigned w = *(const GAS unsigned*)(Q + (size_t)tok * AW + (g * 4 + h) * HD + 2 * lane); qs[g * 128 + 2 * lane] = bflo(w); qs[g * 128 + 2 * lane + 1] = bfhi(w); }
        LDS_WAIT(); asm volatile("" ::: "memory");
        float mrun = -1e30f, lrun = 0.f, o0 = 0.f, o1 = 0.f;
#pragma unroll 1
        for (int g = 0; g < 3; ++g) {
            const int dl = 1 << (2 * g), head = g * 4 + h;
            float sc[3];
#pragma unroll
            for (int p = 0; p < 3; ++p) {
                const int jj = lane + 64 * p, j = jj - 64, pos = s + dl * j;
                const bool valid = (jj <= 128) && pos >= 0 && pos < S;
                float dot = 0.f;
                if (valid) {
                    const bf16* krow = Kb + ((size_t)b * S + pos) * AW + head * HD;
#pragma unroll 4
                    for (int c = 0; c < 16; ++c) { const v4u kv = *(const GAS v4u*)(krow + 8 * c); const LAS float* qq = qs + g * 128 + 8 * c;
                        dot += bflo(kv.x) * qq[0] + bfhi(kv.x) * qq[1] + bflo(kv.y) * qq[2] + bfhi(kv.y) * qq[3] + bflo(kv.z) * qq[4] + bfhi(kv.z) * qq[5] + bflo(kv.w) * qq[6] + bfhi(kv.w) * qq[7]; }
                }
                const float bias = (jj <= 128) ? rel_bias[t5_bucket(dl * j) * 12 + head] : 0.f;
                sc[p] = valid ? dot * scale + bias : -1e30f;
            }
            const float gmax = wave_max(fmaxf(fmaxf(sc[0], sc[1]), sc[2]));
            const float mnew = fmaxf(mrun, gmax);
            const float alpha = __expf(mrun - mnew);
            float pr[3];
#pragma unroll
            for (int p = 0; p < 3; ++p) pr[p] = (sc[p] > -1e29f) ? __expf(sc[p] - mnew) : 0.f;
            const float psum = wave_sum(pr[0] + pr[1] + pr[2]);
            lrun = lrun * alpha + psum; o0 *= alpha; o1 *= alpha; mrun = mnew;
#pragma unroll 1
            for (int jj = 0; jj <= 128; ++jj) {
                const int pos = s + dl * (jj - 64);
                if (pos < 0 || pos >= S) continue;
                const float pj = __shfl(jj < 64 ? pr[0] : (jj < 128 ? pr[1] : pr[2]), jj & 63);
                const unsigned w = *(const GAS unsigned*)(V + ((size_t)b * S + pos) * AW + head * HD + 2 * lane);
                o0 += pj * bflo(w); o1 += pj * bfhi(w);
            }
        }
        const float inv = 1.0f / lrun;
        *(GAS unsigned*)(Q + (size_t)tok * AW + h * HD + 2 * lane) = pk2(o0 * inv, o1 * inv);
        LDS_WAIT(); asm volatile("" ::: "memory");
    }
}

namespace att {
typedef short bf16x8 __attribute__((ext_vector_type(8)));
typedef short s16x4 __attribute__((ext_vector_type(4)));
typedef float f32x16 __attribute__((ext_vector_type(16)));
__device__ __forceinline__ unsigned off_b(unsigned row, unsigned ch) { return 256u * row + 16u * (ch ^ (((row & 3u) << 2) | ((row >> 2) & 3u))); }
__device__ __forceinline__ s16x4 vtr(const LAS unsigned char* p) { return __builtin_bit_cast(s16x4, __builtin_amdgcn_ds_read_tr16_b64_v4i16((LAS s16x4*)p)); }
constexpr int N_UNITS = BATCH * 3 * 2 * 16;
constexpr int BIAS_OFF = RING_BYTES + 2048;
}
__device__ __forceinline__ void attn_mfma(Frame& F) {
    using namespace att;
    bf16* Q = (bf16*)(F.ws + WS_Y + Y_Q); const bf16* Kg = (const bf16*)(F.ws + WS_Y + Y_K); const bf16* Vg = (const bf16*)(F.ws + WS_Y + Y_V);
    float* LSE = (float*)(F.ws + WS_LSE); const float* rel_bias = F.in[13];
    const int lane = F.lane, wave = F.wave, half = wave >> 2, j = wave & 3, ql = lane & 31, hh = lane >> 5, th = F.tid & 255;
    const float LOG2E = 1.4426950408889634f, CS = 0.08838834764831845f * 1.4426950408889634f;
    LAS unsigned char* hb = F.lds + RING_OFF + half * 65536;
    LAS float* bt = (LAS float*)(F.lds + BIAS_OFF + half * 1024);
    const int nper = (N_UNITS + F.G - 1) / F.G;
    const int u_lo = F.vcu * nper, u_hi = (u_lo + nper < N_UNITS) ? u_lo + nper : N_UNITS;
#pragma unroll 1
    for (int u = u_lo; u < u_hi; ++u) {
        const int t16 = u & 15, rest = u >> 4, hp = rest & 1, g = (rest >> 1) % 3, b = rest / 6;
        const int sh = 2 * g, dl = 1 << sh, L = S >> sh;
        const int r = (g == 0) ? 0 : (g == 1 ? (t16 >> 2) : t16), mt = (g == 0) ? t16 : (g == 1 ? (t16 & 3) : 0), m0 = mt * 128;
        const int hl = hp * 2 + half, hd = g * 4 + hl;
        const size_t tokbase = (size_t)b * S + r;
        { const int jrel = th - 128; float v = 0.f; if (jrel >= -64 && jrel <= 64) v = rel_bias[t5_bucket(dl * jrel) * 12 + hd] * LOG2E; bt[th] = v; }
        const int mq = m0 + 32 * j + ql;
        bf16* qrow = Q + (tokbase + (size_t)dl * mq) * AW + hd * HD;
        bf16x8 qf[8];
#pragma unroll
        for (int s2 = 0; s2 < 8; ++s2) qf[s2] = *(const GAS bf16x8*)(qrow + 16 * s2 + 8 * hh);
        const int kb_lo = (m0 == 0) ? 1 : 0; int kb_hi = (L - 1 - m0 + 64) >> 6; kb_hi = kb_hi > 3 ? 3 : kb_hi;
        v4u kreg[4], vreg[4];
        const int srow = th >> 4, sch = th & 15;
#define ATT_STAGE_LOAD(kb_) do { _Pragma("unroll") for (int i = 0; i < 4; ++i) { const int row = srow + 16 * i, mk = m0 - 64 + 64 * (kb_) + row; const bool ok = (unsigned)mk < (unsigned)L; \
                const size_t off = (tokbase + (size_t)dl * (ok ? mk : 0)) * AW + hd * HD + sch * 8; const v4u z = {0u, 0u, 0u, 0u}; \
                kreg[i] = ok ? *(const GAS v4u*)(Kg + off) : z; vreg[i] = ok ? *(const GAS v4u*)(Vg + off) : z; } } while (0)
#define ATT_STAGE_WRITE(buf_) do { _Pragma("unroll") for (int i = 0; i < 4; ++i) { const unsigned o = off_b((unsigned)(srow + 16 * i), (unsigned)sch); \
                *(LAS v4u*)(hb + (buf_) * 16384 + o) = kreg[i]; *(LAS v4u*)(hb + 32768 + (buf_) * 16384 + o) = vreg[i]; } } while (0)
        float m_run = -1e20f, l_run = 0.f;
        f32x16 O[4];
#pragma unroll
        for (int c = 0; c < 4; ++c)
#pragma unroll
            for (int i = 0; i < 16; ++i) O[c][i] = 0.f;
        ATT_STAGE_LOAD(kb_lo); ATT_STAGE_WRITE(0);
        __syncthreads();
#pragma unroll 1
        for (int kb = kb_lo; kb <= kb_hi; ++kb) {
            const int cur = (kb - kb_lo) & 1;
            if (kb < kb_hi) ATT_STAGE_LOAD(kb + 1);
            if (kb >= (j >> 1) && kb <= (j >> 1) + 2) {
                const LAS unsigned char* kbuf = hb + cur * 16384; const LAS unsigned char* vbuf = hb + 32768 + cur * 16384;
                f32x16 s0, s1;
#pragma unroll
                for (int i = 0; i < 16; ++i) { s0[i] = 0.f; s1[i] = 0.f; }
#pragma unroll
                for (int s2 = 0; s2 < 8; ++s2) {
                    const bf16x8 a0 = *(const LAS bf16x8*)(kbuf + off_b((unsigned)ql, (unsigned)(2 * s2 + hh)));
                    const bf16x8 a1 = *(const LAS bf16x8*)(kbuf + off_b((unsigned)(32 + ql), (unsigned)(2 * s2 + hh)));
                    s0 = __builtin_amdgcn_mfma_f32_32x32x16_bf16(a0, qf[s2], s0, 0, 0, 0);
                    s1 = __builtin_amdgcn_mfma_f32_32x32x16_bf16(a1, qf[s2], s1, 0, 0, 0);
                }
                const int jb = 64 * kb - 64 - 32 * j - ql, mkb = m0 - 64 + 64 * kb;
                float bmax = -1e30f;
#pragma unroll
                for (int i = 0; i < 16; ++i) {
                    const int kr = (i & 3) + 8 * (i >> 2) + 4 * hh;
                    { const int jrel = jb + kr, mk = mkb + kr; const bool ok = (unsigned)(jrel + 64) <= 128u && (unsigned)mk < (unsigned)L;
                      const float t = ok ? fmaf(s0[i], CS, bt[jrel + 128]) : -1e30f; s0[i] = t; bmax = fmaxf(bmax, t); }
                    { const int jrel = jb + 32 + kr, mk = mkb + 32 + kr; const bool ok = (unsigned)(jrel + 64) <= 128u && (unsigned)mk < (unsigned)L;
                      const float t = ok ? fmaf(s1[i], CS, bt[jrel + 128]) : -1e30f; s1[i] = t; bmax = fmaxf(bmax, t); }
                }
                bmax = fmaxf(bmax, __shfl_xor(bmax, 32));
                const float m_new = fmaxf(m_run, bmax), alpha = __builtin_amdgcn_exp2f(m_run - m_new);
                m_run = m_new;
                float psum = 0.f;
#pragma unroll
                for (int i = 0; i < 16; ++i) { s0[i] = __builtin_amdgcn_exp2f(s0[i] - m_new); s1[i] = __builtin_amdgcn_exp2f(s1[i] - m_new); psum += s0[i] + s1[i]; }
                l_run = l_run * alpha + psum;
#pragma unroll
                for (int c = 0; c < 4; ++c)
#pragma unroll
                    for (int i = 0; i < 16; ++i) O[c][i] *= alpha;
                v4u pk[4];
#pragma unroll
                for (int s2 = 0; s2 < 2; ++s2) {
                    pk[s2].x = pg8::cvt_pk_bf16(s0[8 * s2 + 0], s0[8 * s2 + 1]); pk[s2].y = pg8::cvt_pk_bf16(s0[8 * s2 + 2], s0[8 * s2 + 3]);
                    pk[s2].z = pg8::cvt_pk_bf16(s0[8 * s2 + 4], s0[8 * s2 + 5]); pk[s2].w = pg8::cvt_pk_bf16(s0[8 * s2 + 6], s0[8 * s2 + 7]);
                    pk[2 + s2].x = pg8::cvt_pk_bf16(s1[8 * s2 + 0], s1[8 * s2 + 1]); pk[2 + s2].y = pg8::cvt_pk_bf16(s1[8 * s2 + 2], s1[8 * s2 + 3]);
                    pk[2 + s2].z = pg8::cvt_pk_bf16(s1[8 * s2 + 4], s1[8 * s2 + 5]); pk[2 + s2].w = pg8::cvt_pk_bf16(s1[8 * s2 + 6], s1[8 * s2 + 7]);
                }
                const unsigned blk = (lane >> 4) & 1, tq = (lane & 15) >> 2, tp = lane & 3;
#pragma unroll
                for (int ks = 0; ks < 4; ++ks) {
                    const bf16x8 pb = __builtin_bit_cast(bf16x8, pk[ks]);
#pragma unroll
                    for (int c = 0; c < 4; ++c) {
                        const unsigned chn = 4 * c + 2 * blk + (tp >> 1);
                        const s16x4 lo = vtr(vbuf + off_b(16 * ks + 4 * hh + tq, chn) + 8 * (tp & 1));
                        const s16x4 hi = vtr(vbuf + off_b(16 * ks + 8 + 4 * hh + tq, chn) + 8 * (tp & 1));
                        const bf16x8 va = {lo[0], lo[1], lo[2], lo[3], hi[0], hi[1], hi[2], hi[3]};
                        O[c] = __builtin_amdgcn_mfma_f32_32x32x16_bf16(va, pb, O[c], 0, 0, 0);
                    }
                }
            }
            if (kb < kb_hi) ATT_STAGE_WRITE(cur ^ 1);
            __syncthreads();
        }
#undef ATT_STAGE_LOAD
#undef ATT_STAGE_WRITE
        const float l_tot = l_run + __shfl_xor(l_run, 32);
        const float inv = 1.0f / l_tot;
#pragma unroll
        for (int c = 0; c < 4; ++c)
#pragma unroll
            for (int i4 = 0; i4 < 4; ++i4) {
                v2u w; w.x = pg8::cvt_pk_bf16(O[c][4 * i4 + 0] * inv, O[c][4 * i4 + 1] * inv); w.y = pg8::cvt_pk_bf16(O[c][4 * i4 + 2] * inv, O[c][4 * i4 + 3] * inv);
                *(GAS v2u*)(qrow + 32 * c + 8 * i4 + 4 * hh) = w;
            }
        if (hh == 0) LSE[((size_t)g * M + tokbase + (size_t)dl * mq) * 4 + hl] = m_run + __log2f(l_tot);
    }
}

__device__ __forceinline__ void attn_combine(Frame& F) {
    bf16* Q = (bf16*)(F.ws + WS_Y + Y_Q); const float* LSE = (const float*)(F.ws + WS_LSE);
    const int total = M * 64;
    for (int it = F.gw * 64 + F.lane; it < total; it += F.NGW * 64) {
        const int tok = it >> 6, h = (it >> 4) & 3, ch = it & 15;
        const float l0 = LSE[((size_t)0 * M + tok) * 4 + h], l1 = LSE[((size_t)1 * M + tok) * 4 + h], l2 = LSE[((size_t)2 * M + tok) * 4 + h];
        const float mx = fmaxf(l0, fmaxf(l1, l2));
        float w0 = __builtin_amdgcn_exp2f(l0 - mx), w1 = __builtin_amdgcn_exp2f(l1 - mx), w2 = __builtin_amdgcn_exp2f(l2 - mx);
        const float inv = 1.0f / (w0 + w1 + w2); w0 *= inv; w1 *= inv; w2 *= inv;
        bf16* p = Q + (size_t)tok * AW + h * HD + ch * 8;
        const v4u a = *(const GAS v4u*)(p), b2 = *(const GAS v4u*)(p + 512), c = *(const GAS v4u*)(p + 1024);
        v4u o;
        o.x = pk2(w0 * bflo(a.x) + w1 * bflo(b2.x) + w2 * bflo(c.x), w0 * bfhi(a.x) + w1 * bfhi(b2.x) + w2 * bfhi(c.x));
        o.y = pk2(w0 * bflo(a.y) + w1 * bflo(b2.y) + w2 * bflo(c.y), w0 * bfhi(a.y) + w1 * bfhi(b2.y) + w2 * bfhi(c.y));
        o.z = pk2(w0 * bflo(a.z) + w1 * bflo(b2.z) + w2 * bflo(c.z), w0 * bfhi(a.z) + w1 * bfhi(b2.z) + w2 * bfhi(c.z));
        o.w = pk2(w0 * bflo(a.w) + w1 * bflo(b2.w) + w2 * bflo(c.w), w0 * bfhi(a.w) + w1 * bfhi(b2.w) + w2 * bfhi(c.w));
        *(GAS v4u*)(p) = o;
    }
}

__device__ __forceinline__ void pool_simple(Frame& F) {
    const bf16* U = (const bf16*)(F.ws + WS_Y + Y_U); bf16* P = (bf16*)(F.ws + WS_Y + Y_K);
    const int total = M * (D / 8);
    for (int it = F.gw * 64 + F.lane; it < total; it += F.NGW * 64) {
        const int tok = it >> 7, ch = it & 127, s = tok & (S - 1), g = ch >> 5, w = 2 << g;
        int lo = s - (w >> 1), hi = lo + w; lo = lo < 0 ? 0 : lo; hi = hi > S ? S : hi;
        const bf16* base = U + (size_t)(tok - s) * D + ch * 8;
        float a[8];
#pragma unroll
        for (int e = 0; e < 8; ++e) a[e] = 0.f;
        for (int r = lo; r < hi; ++r) { const v4u v = *(const GAS v4u*)(base + (size_t)r * D);
            a[0] += bflo(v.x); a[1] += bfhi(v.x); a[2] += bflo(v.y); a[3] += bfhi(v.y); a[4] += bflo(v.z); a[5] += bfhi(v.z); a[6] += bflo(v.w); a[7] += bfhi(v.w); }
        const float inv = 1.0f / (float)(hi - lo);
        const v4u c = *(const GAS v4u*)(base + (size_t)s * D);
        v4u o; o.x = pk2(a[0] * inv - bflo(c.x), a[1] * inv - bfhi(c.x)); o.y = pk2(a[2] * inv - bflo(c.y), a[3] * inv - bfhi(c.y));
        o.z = pk2(a[4] * inv - bflo(c.z), a[5] * inv - bfhi(c.z)); o.w = pk2(a[6] * inv - bflo(c.w), a[7] * inv - bfhi(c.w));
        *(GAS v4u*)(P + (size_t)tok * D + ch * 8) = o;
    }
}

__device__ __forceinline__ float gelu_tanh(float x) {
    const float y = 0.7978845608028654f * (x + 0.044715f * x * x * x);
    const float t = 1.0f - 2.0f / (__expf(2.0f * y) + 1.0f);
    return 0.5f * x * (1.0f + t);
}
__device__ __forceinline__ void conv_simple(Frame& F, int l) {
    bf16* AG = (bf16*)(F.ws + WS_Y);
    const float* cw = F.in[10] + (size_t)l * 3 * DFF; const float* cb = F.in[11] + (size_t)l * DFF;
    constexpr int CH = DFF / 8; const int total = M * CH;
    for (int it = F.gw * 64 + F.lane; it < total; it += F.NGW * 64) {
        const int tok = it / CH, ch = it - tok * CH, s = tok & (S - 1), c0 = ch * 8;
        const bf16* ap = AG + (size_t)tok * NUP + c0;
        const v4u z = {0u, 0u, 0u, 0u};
        const v4u am = (s > 0) ? *(const GAS v4u*)(ap - NUP) : z;
        const v4u a0 = *(const GAS v4u*)(ap);
        const v4u ap1 = (s < S - 1) ? *(const GAS v4u*)(ap + NUP) : z;
        const v4u gv = *(const GAS v4u*)(ap + DFF);
        float xm[8] = {bflo(am.x), bfhi(am.x), bflo(am.y), bfhi(am.y), bflo(am.z), bfhi(am.z), bflo(am.w), bfhi(am.w)};
        float x0[8] = {bflo(a0.x), bfhi(a0.x), bflo(a0.y), bfhi(a0.y), bflo(a0.z), bfhi(a0.z), bflo(a0.w), bfhi(a0.w)};
        float xp[8] = {bflo(ap1.x), bfhi(ap1.x), bflo(ap1.y), bfhi(ap1.y), bflo(ap1.z), bfhi(ap1.z), bflo(ap1.w), bfhi(ap1.w)};
        float gg[8] = {bflo(gv.x), bfhi(gv.x), bflo(gv.y), bfhi(gv.y), bflo(gv.z), bfhi(gv.z), bflo(gv.w), bfhi(gv.w)};
        float r[8];
#pragma unroll
        for (int e = 0; e < 8; ++e) { const float v = cw[c0 + e] * xm[e] + cw[DFF + c0 + e] * x0[e] + cw[2 * DFF + c0 + e] * xp[e] + cb[c0 + e]; r[e] = gelu_tanh(v) * gg[e]; }
        v4u o; o.x = pk2(r[0], r[1]); o.y = pk2(r[2], r[3]); o.z = pk2(r[4], r[5]); o.w = pk2(r[6], r[7]);
        *(GAS v4u*)(AG + (size_t)tok * NUP + DFF + c0) = o;
    }
}

__device__ __forceinline__ void final_norm(Frame& F) {
    const float* part = (const float*)(F.ws + WS_PART); const float* nf = F.in[14];
    for (int m = F.gw; m < M; m += F.NGW) {
        float s = 0.f;
#pragma unroll
        for (int t = 0; t < 16; ++t) s += part[(size_t)t * M + m];
        const float rstd = 1.0f / sqrtf(s * (1.0f / 1024.0f) + EPS);
        GAS f32x4* xr = (GAS f32x4*)(F.out + (size_t)m * D) + F.lane; const GAS f32x4* gr = (const GAS f32x4*)nf + F.lane;
#pragma unroll
        for (int j = 0; j < 4; ++j) { const f32x4 v = xr[64 * j]; const f32x4 gq = gr[64 * j]; xr[64 * j] = v * rstd * gq; }
    }
}

struct Args { const float* in[15]; float* out; unsigned char* ws; int ph_lo, ph_hi; int pad0, pad1; };

struct CfgP1 { static constexpr int st1 = 4, st2 = 10, st3 = 16, ld0 = D, ld1 = AW; static constexpr long off1 = (long)(Y_Q - Y_U), off2 = (long)(Y_K - Y_U), off3 = (long)(Y_V - Y_U); };
struct CfgGate { static constexpr int st1 = 4, st2 = 1 << 20, st3 = 1 << 20, ld0 = D, ld1 = D; static constexpr long off1 = (long)Y_U - (long)Y_V, off2 = 0, off3 = 0; };
struct CfgOne { static constexpr int st1 = 1 << 20, st2 = 1 << 20, st3 = 1 << 20, ld0 = D, ld1 = D; static constexpr long off1 = 0, off2 = 0, off3 = 0; };
struct CfgUp { static constexpr int st1 = 1 << 20, st2 = 1 << 20, st3 = 1 << 20, ld0 = NUP, ld1 = NUP; static constexpr long off1 = 0, off2 = 0, off3 = 0; };
template <int MODE, class CFG, int GN, int GK, int GLDA> __device__ __forceinline__ void run_gemm_b(Frame& F, const bf16* A, const bf16* Bt, bf16* O, const bf16* X1, const bf16* X2) {
    pg8::EpiB<MODE, CFG> E; E.O = O; E.part = (const float*)(F.ws + WS_PART); E.X1 = X1; E.X2 = X2;
    pg8::gemm_phase<pg8::EpiB<MODE, CFG>, GN, GK, GLDA, PG8_ALIGN, PG8_SP2>(F.lds + RING_OFF, A, Bt, F.G, (int)blockIdx.x, E);
}
template <int GK, int GLDA> __device__ __forceinline__ void run_gemm_r(Frame& F, const bf16* A, const bf16* Bt, const float* base) {
    pg8::EpiRes E{base, F.out, (bf16*)(F.ws + WS_HB), (float*)(F.ws + WS_PART), M};
    pg8::gemm_phase<pg8::EpiRes, D, GK, GLDA, PG8_ALIGN, PG8_SP2>(F.lds + RING_OFF, A, Bt, F.G, (int)blockIdx.x, E);
}

#define IN(k) (lo <= (k) && (k) < hi)
#define SEAM(k) do { if (IN(k) && IN((k) + 1)) xcd_barrier(bar); } while (0)
template <int L> __device__ __forceinline__ void layer_phases(Frame& F, int lo, int hi, const XcdBarrier& bar) {
    constexpr int pb = 1 + 10 * L;
    unsigned char* ws = F.ws;
    bf16* HB = (bf16*)(ws + WS_HB);
    bf16* YU = (bf16*)(ws + WS_Y + Y_U); bf16* YQ = (bf16*)(ws + WS_Y + Y_Q); bf16* YK = (bf16*)(ws + WS_Y + Y_K); bf16* YV = (bf16*)(ws + WS_Y + Y_V);
    bf16* W_IN = (bf16*)(ws + WS_W + WO_WIN);
    if (IN(pb + 0)) { run_gemm_b<0, CfgP1, NUQKV, D, D>(F, HB, W_IN, YU, nullptr, nullptr); SEAM(pb + 0); }
#if defined(ATTN_ORACLE)
    if (IN(pb + 1)) { attn_simple(F); SEAM(pb + 1); }
#else
    if (IN(pb + 1)) { attn_mfma(F); SEAM(pb + 1); }
#endif
#if defined(ATTN_ORACLE)
    if (IN(pb + 2)) { pool_simple(F); SEAM(pb + 2); }
#else
    if (IN(pb + 2)) { attn_combine(F); pool_simple(F); SEAM(pb + 2); }
#endif
    if (IN(pb + 3)) { run_gemm_b<1, CfgGate, NGATE, D, D>(F, HB, W_IN + (size_t)NUQKV * D, YV, nullptr, nullptr); SEAM(pb + 3); }
    if (IN(pb + 4)) { run_gemm_b<2, CfgOne, D, D, D>(F, YK, (const bf16*)(ws + WS_W + WO_WC), YV, YV, nullptr); SEAM(pb + 4); }
    if (IN(pb + 5)) { run_gemm_b<3, CfgOne, D, AO, AW>(F, YQ, (const bf16*)(ws + WS_W + WO_WB), YV, YV, YU); SEAM(pb + 5); }
    if (IN(pb + 6)) { run_gemm_r<D, D>(F, YV, (const bf16*)(ws + WS_W + WO_WO), L == 0 ? F.in[0] : (const float*)F.out); SEAM(pb + 6); }
    if (IN(pb + 7)) { run_gemm_b<0, CfgUp, NUP, D, D>(F, HB, (const bf16*)(ws + WS_W + WO_WUP), YU, nullptr, nullptr); SEAM(pb + 7); }
    if (IN(pb + 8)) { conv_simple(F, L); if (L + 1 < DEPTH) convert_weights(F, L + 1, false); SEAM(pb + 8); }
    if (IN(pb + 9)) { run_gemm_r<DFF, NUP>(F, YU + DFF, (const bf16*)(ws + WS_W + WO_WDN + L * WDN_BYTES), (const float*)F.out); SEAM(pb + 9); }
}
#undef IN
#undef SEAM

__global__ void __launch_bounds__(NWAVES * 64, 2) fwd_kernel(Args args) {
    extern __shared__ __attribute__((aligned(16))) unsigned char lds[];
    Frame F;
    F.lds = (LAS unsigned char*)lds;
    F.MISC = (volatile LAS unsigned*)(F.lds + MISC_OFF);
    F.tid = threadIdx.x; F.lane = F.tid & 63; F.wave = __builtin_amdgcn_readfirstlane(F.tid >> 6);
    F.G = gridDim.x; { const int bx = blockIdx.x; F.vcu = (F.G % 8 == 0) ? (bx % 8) * (F.G / 8) + bx / 8 : bx; }
    F.gw = F.vcu * NWAVES + F.wave; F.NGW = F.G * NWAVES;
    F.ws = args.ws; F.ctl = (gu32*)(args.ws + WS_CTL); F.out = args.out;
    F.in = args.in;
    for (int u = F.tid; u < (LDS_BYTES - LDSCTL_OFF) / 4; u += NWAVES * 64) ((LAS unsigned*)(F.lds + LDSCTL_OFF))[u] = 0u;
    __syncthreads();
    const int lo = args.ph_lo, hi = args.ph_hi;
    XcdBarrier bar; bar.bar = (unsigned*)(F.ctl + CW_BAR); bar.x = 0; bar.st = nullptr;
    if (hi - lo > 1) bar = xcd_barrier_post((unsigned*)(F.ctl + CW_BAR), F.MISC + 8);

#define IN(k) (lo <= (k) && (k) < hi)
#define SEAM(k) do { if (IN(k) && IN((k) + 1)) xcd_barrier(bar); } while (0)
    if (IN(0)) { convert_weights(F, 0, true); p0_x_rows(F); SEAM(0); }
    layer_phases<0>(F, lo, hi, bar);
    layer_phases<1>(F, lo, hi, bar);
    if (IN(N_PHASES - 1)) final_norm(F);
}
#undef IN
#undef SEAM

#ifdef DBG_STOP
__global__ void dbg_dump(const unsigned char* ws, float* out, size_t o0, size_t o1, size_t o2, size_t o3, int n_off, int is_f32) {
    const size_t n = (size_t)M * D;
    for (size_t i = (size_t)blockIdx.x * blockDim.x + threadIdx.x; i < n; i += (size_t)gridDim.x * blockDim.x) {
        float acc = 0.f; const size_t offs[4] = {o0, o1, o2, o3};
        for (int r = 0; r < n_off; ++r) { if (is_f32) acc += ((const float*)(ws + offs[r]))[i]; else acc += __uint_as_float((unsigned)((const unsigned short*)(ws + offs[r]))[i] << 16); }
        out[i] = acc;
    }
}
#endif
extern "C" void kernel_launch(void* const* d_in, const int* in_sizes, int n_in, void* d_out, int out_size, void* d_ws, size_t ws_size, hipStream_t stream) {
    static int grid = 0;
    if (grid == 0) {
        if (n_in != 15 || in_sizes[0] != M * D || out_size != M * D || ws_size < WS_END) { fprintf(stderr, "kernel_launch: unexpected problem shape (n_in %d, in0 %d, out %d, ws %zu); nothing launched\n", n_in, n_in > 0 ? in_sizes[0] : -1, out_size, ws_size); grid = -1; return; }
        int dev = 0, cus = 0, per_cu = 0;
        if (hipGetDevice(&dev) != hipSuccess || hipDeviceGetAttribute(&cus, hipDeviceAttributeMultiprocessorCount, dev) != hipSuccess) { grid = -1; return; }
        if (hipFuncSetAttribute((const void*)fwd_kernel, hipFuncAttributeMaxDynamicSharedMemorySize, LDS_BYTES) != hipSuccess) { fprintf(stderr, "kernel_launch: hipFuncSetAttribute failed\n"); grid = -1; return; }
        if (hipOccupancyMaxActiveBlocksPerMultiprocessor(&per_cu, (const void*)fwd_kernel, NWAVES * 64, LDS_BYTES) != hipSuccess || per_cu < 1) { fprintf(stderr, "kernel_launch: occupancy query reports %d blocks per CU\n", per_cu); (void)hipGetLastError(); grid = -1; return; }
        grid = cus;
    }
    if (grid < 0) return;
    (void)hipMemsetAsync((char*)d_ws + WS_CTL, 0, CTL_ZERO_BYTES, stream);
    Args a{};
    for (int i = 0; i < 15; ++i) a.in[i] = (const float*)d_in[i];
    a.out = (float*)d_out; a.ws = (unsigned char*)d_ws;
#if MK_N_LAUNCHES == 1
    a.ph_lo = 0; a.ph_hi = N_PHASES;
    hipLaunchKernelGGL(fwd_kernel, dim3(grid), dim3(NWAVES * 64), LDS_BYTES, stream, a);
#else
#ifdef DBG_STOP
    for (int p = 0; p <= DBG_STOP; ++p) { a.ph_lo = p; a.ph_hi = p + 1; hipLaunchKernelGGL(fwd_kernel, dim3(grid), dim3(NWAVES * 64), LDS_BYTES, stream, a); }
    { const size_t offs[4] = {DBG_OFFS}; hipLaunchKernelGGL(dbg_dump, dim3(2048), dim3(256), 0, stream, (const unsigned char*)d_ws, (float*)d_out, offs[0], offs[1], offs[2], offs[3], DBG_NOFF, DBG_F32); }
#else
    for (int p = 0; p < N_PHASES; ++p) { a.ph_lo = p; a.ph_hi = p + 1; hipLaunchKernelGGL(fwd_kernel, dim3(grid), dim3(NWAVES * 64), LDS_BYTES, stream, a); }
#endif
#endif
}
```

```cpp
#include <hip/hip_runtime.h>
#include <cstdio>
#include <cstdint>

#ifndef MK_N_LAUNCHES
#define MK_N_LAUNCHES 1
#endif

namespace pg8 {
#define PG8_LAS __attribute__((address_space(3)))
typedef unsigned short bf16_t;
typedef short bf16x8 __attribute__((ext_vector_type(8)));
typedef float f32x4 __attribute__((ext_vector_type(4)));
typedef unsigned u32x4 __attribute__((ext_vector_type(4)));
typedef unsigned u32x2 __attribute__((ext_vector_type(2)));
constexpr int BM = 256, BK = 64, HALF = 128, HTB = HALF * BK * 2  , STAGE_BYTES = 8 * HTB, NXCD = 8, WGM = 8;

__host__ __device__ __forceinline__ int lds_byte(int r, int c) { const int st = (r >> 4) * 2 + (c >> 5), rr = r & 15, cc = c & 31, ob = rr * 64 + cc * 2; return st * 1024 + (ob ^ (((ob >> 9) & 1) << 5)); }
__host__ __device__ __forceinline__ void stage_rc(int b, int& R, int& C) { const int st = b / 1024, sb = b % 1024, swz = sb ^ (((sb >> 9) & 1) << 5); R = (st >> 1) * 16 + swz / 64; C = (st & 1) * 32 + (swz % 64) / 2; }
__host__ __device__ __forceinline__ int perm32(int rho) { const int n = rho >> 4, i = rho & 15; return 8 * (i >> 2) + 4 * n + (i & 3); }

struct Unit { int pm, pn; };
struct Gemm { const bf16_t* A; const bf16_t* Bt; int M, N, K, lda; };

struct StaticOrder {
    int nM, nN, nwg, G, c;
    __host__ __device__ void init(int M, int N, int G_, int c_) { nM = M / BM; nN = N / BM; nwg = nM * nN; G = G_; c = c_; }
    __host__ __device__ bool next(int i, Unit& u) const {
        const long L = (long)i * G + c; if (L >= nwg) return false;
        int wgid = (int)L; { const int q = nwg / NXCD, r = nwg % NXCD, xcd = wgid % NXCD, off = wgid / NXCD; wgid = (xcd < r ? xcd * (q + 1) : r * (q + 1) + (xcd - r) * q) + off; }
        const int nig = WGM * nN, gid = wgid / nig, fm = gid * WGM, gsz = (nM - fm) < WGM ? (nM - fm) : WGM;
        u.pm = fm + ((wgid % nig) % gsz); u.pn = (wgid % nig) / gsz; return true;
    }
    __device__ __forceinline__ void a_ready(const Unit&) const {}
    __device__ __forceinline__ void done(const Unit&) const {}
};

typedef float f32x2_t __attribute__((ext_vector_type(2))); typedef __bf16 bf16x2_t __attribute__((ext_vector_type(2)));
__device__ __forceinline__ unsigned cvt_pk_bf16(float lo, float hi) { f32x2_t v = {lo, hi}; bf16x2_t b = __builtin_convertvector(v, bf16x2_t); return __builtin_bit_cast(unsigned, b); }
__device__ __forceinline__ float bf_lo(unsigned w) { return __uint_as_float(w << 16); }
__device__ __forceinline__ float bf_hi(unsigned w) { return __uint_as_float(w & 0xffff0000u); }

__device__ __forceinline__ void wave_rstd(const float* part, int Mrows, int rowbase, int lane, float eps, float (&rs)[2]) {
#pragma unroll
    for (int ai = 0; ai < 2; ++ai) { const float* p = part + rowbase + ai * HALF + lane; float s = 0.f;
#pragma unroll
        for (int t = 0; t < 16; ++t) s += p[(size_t)t * Mrows];
        rs[ai] = 1.0f / sqrtf(s * (1.0f / 1024.0f) + eps); }
}

template <int MODE, class CFG> struct EpiB {
    static constexpr bool PERM = true, AFTER_DRAIN = false;
    bf16_t* O;
    const float* part;
    const bf16_t* X1; const bf16_t* X2;
    static constexpr int Mrows = 16384, ldx = 1024; static constexpr float eps = 1e-6f;
    __device__ __forceinline__ void operator()(const f32x4 (&acc)[2][2][4][2], const Unit& u, int wr, int wc, int fr, int fq) const {
        const int lane = fr + 16 * fq;
        long boff = 0; int ldc = CFG::ld0, sst = 0;
        if (u.pn >= CFG::st1) { boff = CFG::off1; ldc = CFG::ld1; sst = CFG::st1; }
        if (u.pn >= CFG::st2) { boff = CFG::off2; sst = CFG::st2; }
        if (u.pn >= CFG::st3) { boff = CFG::off3; sst = CFG::st3; }
        bf16_t* base = (bf16_t*)((char*)O + boff);
        const int col0 = (u.pn - sst) * BM + wc * 32 + 8 * fq;
        const int row0 = u.pm * BM + wr * 64 + fr;
        float rs[2] = {1.f, 1.f};
        if (MODE <= 1) wave_rstd(part, Mrows, u.pm * BM + wr * 64, lane, eps, rs);
#pragma unroll
        for (int ai = 0; ai < 2; ++ai)
#pragma unroll
            for (int m = 0; m < 4; ++m) {
                const int row = row0 + ai * HALF + m * 16;
                float r = 1.f; if (MODE <= 1) r = __shfl(rs[ai], m * 16 + fr);
                bf16_t* rowp = base + (size_t)row * ldc + col0;
#pragma unroll
                for (int bj = 0; bj < 2; ++bj) {
                    f32x4 v0 = acc[ai][bj][m][0], v1 = acc[ai][bj][m][1];
                    if (MODE <= 1) { v0 = v0 * r; v1 = v1 * r; }
                    if (MODE == 1) {
#pragma unroll
                        for (int e = 0; e < 4; ++e) { v0[e] = __builtin_amdgcn_rcpf(1.0f + __expf(-v0[e])); v1[e] = __builtin_amdgcn_rcpf(1.0f + __expf(-v1[e])); }
                    }
                    if (MODE == 2) {
                        const u32x4 x = *(const u32x4*)(X1 + (size_t)row * ldx + col0 + bj * HALF);
                        v0[0] *= bf_lo(x.x); v0[1] *= bf_hi(x.x); v0[2] *= bf_lo(x.y); v0[3] *= bf_hi(x.y);
                        v1[0] *= bf_lo(x.z); v1[1] *= bf_hi(x.z); v1[2] *= bf_lo(x.w); v1[3] *= bf_hi(x.w);
                    }
                    if (MODE == 3) {
                        const u32x4 x = *(const u32x4*)(X1 + (size_t)row * ldx + col0 + bj * HALF);
                        const u32x4 y = *(const u32x4*)(X2 + (size_t)row * ldx + col0 + bj * HALF);
                        v0[0] = bf_lo(x.x) + v0[0] * bf_lo(y.x); v0[1] = bf_hi(x.x) + v0[1] * bf_hi(y.x); v0[2] = bf_lo(x.y) + v0[2] * bf_lo(y.y); v0[3] = bf_hi(x.y) + v0[3] * bf_hi(y.y);
                        v1[0] = bf_lo(x.z) + v1[0] * bf_lo(y.z); v1[1] = bf_hi(x.z) + v1[1] * bf_hi(y.z); v1[2] = bf_lo(x.w) + v1[2] * bf_lo(y.w); v1[3] = bf_hi(x.w) + v1[3] * bf_hi(y.w);
                    }
                    u32x4 w; w.x = cvt_pk_bf16(v0[0], v0[1]); w.y = cvt_pk_bf16(v0[2], v0[3]); w.z = cvt_pk_bf16(v1[0], v1[1]); w.w = cvt_pk_bf16(v1[2], v1[3]);
                    *(u32x4*)(rowp + bj * HALF) = w;
                }
                if (MODE >= 2) asm volatile("" ::: "memory");
            }
    }
};

struct EpiRes {
    static constexpr bool PERM = false, AFTER_DRAIN = false;
    const float* base; float* out; bf16_t* hb; float* part; int Mrows;
    __device__ __forceinline__ void operator()(const f32x4 (&acc)[2][2][4][2], const Unit& u, int wr, int wc, int fr, int fq) const {
        const int col0 = u.pn * BM + wc * 32 + 4 * fq;
#pragma unroll
        for (int ai = 0; ai < 2; ++ai)
#pragma unroll
            for (int m = 0; m < 4; ++m) {
                const int row = u.pm * BM + ai * HALF + wr * 64 + m * 16 + fr; const size_t off = (size_t)row * 1024 + col0;
                float ss = 0.f;
#pragma unroll
                for (int bj = 0; bj < 2; ++bj)
#pragma unroll
                    for (int n = 0; n < 2; ++n) {
                        const f32x4 bs = *(const f32x4*)(base + off + bj * HALF + n * 16);
                        const f32x4 o = bs + acc[ai][bj][m][n];
                        *(f32x4*)(out + off + bj * HALF + n * 16) = o;
                        u32x2 w; w.x = cvt_pk_bf16(o[0], o[1]); w.y = cvt_pk_bf16(o[2], o[3]);
                        *(u32x2*)(hb + off + bj * HALF + n * 16) = w;
                        ss += (o[0] * o[0] + o[1] * o[1]) + (o[2] * o[2] + o[3] * o[3]);
                    }
                ss += __shfl_xor(ss, 16); ss += __shfl_xor(ss, 32);
                if (fq == 0) part[(size_t)(u.pn * 4 + wc) * Mrows + row] = ss;
                asm volatile("" ::: "memory");
            }
    }
};

template <class Epi, int GN, int GK, int GLDA, bool ALIGN_EPI = false, bool SP2 = false>
__device__ __forceinline__ void gemm_phase(PG8_LAS unsigned char* lds, const bf16_t* gA, const bf16_t* gBt, int G_, int c_, const Epi& E) {
    struct { const bf16_t* A; const bf16_t* Bt; int K, lda; } g{gA, gBt, GK, GLDA};
    StaticOrder S; S.nM = 16384 / BM; S.nN = GN / BM; S.nwg = S.nM * S.nN; S.G = G_; S.c = c_;
    int tid_ = threadIdx.x; asm volatile("" : "+v"(tid_));
    const int tid = tid_, wid = __builtin_amdgcn_readfirstlane(tid >> 6), lane = tid & 63, wr = wid >> 2, wc = wid & 3, fr = lane & 15, fq = lane >> 4;
    const int K = g.K, nt = K / BK, lda = g.lda;
    unsigned voffA[2], voffB[2];
#pragma unroll
    for (int i = 0; i < 2; ++i) { int R, C; stage_rc(tid * 16 + i * 8192, R, C); const int Rb = Epi::PERM ? ((R & ~31) + perm32(R & 31)) : R;
        voffA[i] = (unsigned)(R * lda + C) * 2u; voffB[i] = (unsigned)(Rb * K + C) * 2u; }
    const size_t kstep = (size_t)(BK * 2);
    const size_t hstepA = (size_t)HALF * lda * 2, hstepB = (size_t)HALF * K * 2;
    const size_t tstepA = 2 * hstepA, tstepB = 2 * hstepB;
    const unsigned ldsw = (unsigned)wid * 1024u;
    const int aoff = lds_byte(wr * 64 + fr, fq * 8), boff = lds_byte(wc * 32 + fr, fq * 8);
#define PG8_SA(b, h) (((b) * 2 + (h)) * HTB)
#define PG8_SB(b, h) ((4 + (b) * 2 + (h)) * HTB)
#define PG8_STAGE(bufoff, gbase, voff) do { _Pragma("unroll") for (int _i = 0; _i < 2; ++_i) \
        __builtin_amdgcn_global_load_lds((const unsigned*)((const char*)(gbase) + (voff)[_i]), (PG8_LAS unsigned*)(lds + (bufoff) + ldsw + _i * 8192), 16, 0, 0); } while (0)
#define PG8_LDA(dst, b, h) do { _Pragma("unroll") for (int m = 0; m < 4; ++m) _Pragma("unroll") for (int k = 0; k < 2; ++k) dst[m][k] = *(const PG8_LAS bf16x8*)(lds + PG8_SA(b, h) + aoff + m * 2048 + k * 1024); } while (0)
#define PG8_LDB(dst, b, h) do { _Pragma("unroll") for (int n = 0; n < 2; ++n) _Pragma("unroll") for (int k = 0; k < 2; ++k) dst[n][k] = *(const PG8_LAS bf16x8*)(lds + PG8_SB(b, h) + boff + n * 2048 + k * 1024); } while (0)
#define PG8_MMA(ai, bj, At, Bt) do { __builtin_amdgcn_s_setprio(1); _Pragma("unroll") for (int m = 0; m < 4; ++m) _Pragma("unroll") for (int n = 0; n < 2; ++n) _Pragma("unroll") for (int k = 0; k < 2; ++k) \
        acc[ai][bj][m][n] = __builtin_amdgcn_mfma_f32_16x16x32_bf16(Bt[n][k], At[m][k], acc[ai][bj][m][n], 0, 0, 0); __builtin_amdgcn_s_setprio(0); } while (0)
#define PG8_WAIT_V(n) asm volatile("s_waitcnt vmcnt(" #n ")" ::: "memory")
#define PG8_WAIT_L(n) asm volatile("s_waitcnt lgkmcnt(" #n ")" ::: "memory")
#define PG8_BAR __builtin_amdgcn_s_barrier()
#define PG8_SCHED __builtin_amdgcn_sched_barrier(0)
    Unit cur, nxt; int ui = 0;
    if (!S.next(0, cur)) return;
    f32x4 acc[2][2][4][2];
#pragma unroll
    for (int a = 0; a < 2; ++a)
#pragma unroll
        for (int b = 0; b < 2; ++b)
#pragma unroll
            for (int m = 0; m < 4; ++m)
#pragma unroll
                for (int n = 0; n < 2; ++n) acc[a][b][m][n] = (f32x4){0.f, 0.f, 0.f, 0.f};
    bf16x8 At[4][2], B0[2][2], B1[2][2];
    const char* cA = (const char*)g.A + (size_t)cur.pm * tstepA; const char* cB = (const char*)g.Bt + (size_t)cur.pn * tstepB;
    S.a_ready(cur);
    if constexpr (SP2) {
        PG8_STAGE(PG8_SB(0, 0), cB, voffB); PG8_STAGE(PG8_SB(0, 1), cB + hstepB, voffB); PG8_STAGE(PG8_SA(0, 0), cA, voffA); PG8_STAGE(PG8_SA(0, 1), cA + hstepA, voffA);
        if (wr == 1) PG8_BAR;
        PG8_WAIT_V(2); PG8_BAR;
        PG8_STAGE(PG8_SB(1, 0), cB + kstep, voffB); PG8_STAGE(PG8_SA(1, 0), cA + kstep, voffA); PG8_STAGE(PG8_SB(1, 1), cB + hstepB + kstep, voffB);
        PG8_WAIT_V(6); PG8_BAR;
    } else {
        PG8_STAGE(PG8_SB(0, 0), cB, voffB); PG8_STAGE(PG8_SA(0, 0), cA, voffA); PG8_STAGE(PG8_SB(0, 1), cB + hstepB, voffB); PG8_STAGE(PG8_SA(0, 1), cA + hstepA, voffA);
        if (wr == 1) PG8_BAR;
        PG8_WAIT_V(4); PG8_BAR;
        PG8_STAGE(PG8_SB(1, 0), cB + kstep, voffB); PG8_STAGE(PG8_SA(1, 0), cA + kstep, voffA); PG8_STAGE(PG8_SB(1, 1), cB + hstepB + kstep, voffB);
        PG8_WAIT_V(6); PG8_BAR;
    }
    for (;;) {
        const bool has_next = S.next(ui + 1, nxt);
        const char* nA = has_next ? (const char*)g.A + (size_t)nxt.pm * tstepA : cA; const char* nB = has_next ? (const char*)g.Bt + (size_t)nxt.pn * tstepB : cB;
        for (int t = 0; t < nt; t += 2) {
            const bool last = (t == nt - 2);
            const char* a1 = cA + (size_t)(t + 1) * kstep;
            const char* a2 = last ? nA : cA + (size_t)(t + 2) * kstep; const char* b2 = last ? nB : cB + (size_t)(t + 2) * kstep;
            const char* a3 = a2 + kstep; const char* b3 = b2 + kstep;
            if (last && has_next) S.a_ready(nxt);
            if constexpr (SP2) {
            PG8_LDB(B0, 0, 0); PG8_LDB(B1, 0, 1); PG8_SCHED; PG8_LDA(At, 0, 0); PG8_STAGE(PG8_SA(1, 1), a1 + hstepA, voffA);
            PG8_WAIT_V(8); PG8_WAIT_L(0); PG8_BAR; PG8_MMA(0, 0, At, B0); PG8_MMA(0, 1, At, B1); PG8_BAR; PG8_SCHED;
            PG8_LDA(At, 0, 1); PG8_STAGE(PG8_SB(0, 0), b2, voffB); PG8_STAGE(PG8_SB(0, 1), b2 + hstepB, voffB); PG8_STAGE(PG8_SA(0, 0), a2, voffA);
            PG8_WAIT_V(8); PG8_WAIT_L(0); PG8_BAR; PG8_MMA(1, 0, At, B0); PG8_MMA(1, 1, At, B1); PG8_BAR; PG8_SCHED;
            PG8_LDB(B0, 1, 0); PG8_LDB(B1, 1, 1); PG8_SCHED; PG8_LDA(At, 1, 0); PG8_STAGE(PG8_SA(0, 1), a2 + hstepA, voffA);
            PG8_WAIT_V(8); PG8_WAIT_L(0); PG8_BAR; PG8_MMA(0, 0, At, B0); PG8_MMA(0, 1, At, B1); PG8_BAR; PG8_SCHED;
            PG8_LDA(At, 1, 1); PG8_STAGE(PG8_SB(1, 0), b3, voffB); PG8_STAGE(PG8_SB(1, 1), b3 + hstepB, voffB); PG8_STAGE(PG8_SA(1, 0), a3, voffA);
            PG8_WAIT_V(8); PG8_WAIT_L(0); PG8_BAR; PG8_MMA(1, 0, At, B0); PG8_MMA(1, 1, At, B1); PG8_BAR; PG8_SCHED;
            } else {
            PG8_LDB(B0, 0, 0); PG8_SCHED; PG8_LDA(At, 0, 0); PG8_STAGE(PG8_SA(1, 1), a1 + hstepA, voffA);
            PG8_WAIT_L(8); PG8_BAR; PG8_WAIT_L(0); PG8_MMA(0, 0, At, B0); PG8_BAR; PG8_SCHED;
            PG8_LDB(B1, 0, 1); PG8_STAGE(PG8_SB(0, 0), b2, voffB);
            PG8_BAR; PG8_WAIT_L(0); PG8_MMA(0, 1, At, B1); PG8_BAR;
            PG8_LDA(At, 0, 1); PG8_STAGE(PG8_SA(0, 0), a2, voffA);
            PG8_BAR; PG8_WAIT_L(0); PG8_MMA(1, 0, At, B0); PG8_BAR; PG8_SCHED;
            PG8_STAGE(PG8_SB(0, 1), b2 + hstepB, voffB);
            PG8_WAIT_V(6); PG8_BAR; PG8_MMA(1, 1, At, B1); PG8_BAR;
            PG8_LDB(B0, 1, 0); PG8_SCHED; PG8_LDA(At, 1, 0); PG8_STAGE(PG8_SA(0, 1), a2 + hstepA, voffA);
            PG8_WAIT_L(8); PG8_BAR; PG8_WAIT_L(0); PG8_MMA(0, 0, At, B0); PG8_BAR; PG8_SCHED;
            PG8_LDB(B1, 1, 1); PG8_STAGE(PG8_SB(1, 0), b3, voffB);
            PG8_BAR; PG8_WAIT_L(0); PG8_MMA(0, 1, At, B1); PG8_BAR;
            PG8_LDA(At, 1, 1); PG8_STAGE(PG8_SA(1, 0), a3, voffA);
            PG8_BAR; PG8_WAIT_L(0); PG8_MMA(1, 0, At, B0); PG8_BAR; PG8_SCHED;
            PG8_STAGE(PG8_SB(1, 1), b3 + hstepB, voffB);
            PG8_WAIT_V(6); PG8_BAR; PG8_MMA(1, 1, At, B1); PG8_BAR;
            }
        }
        if constexpr (ALIGN_EPI) { if (wr == 0) PG8_BAR; }
        if constexpr (!Epi::AFTER_DRAIN) { E(acc, cur, wr, wc, fr, fq); S.done(cur); }
        if (!has_next) break;
#pragma unroll
        for (int a = 0; a < 2; ++a)
#pragma unroll
            for (int b = 0; b < 2; ++b)
#pragma unroll
                for (int m = 0; m < 4; ++m)
#pragma unroll
                    for (int n = 0; n < 2; ++n) acc[a][b][m][n] = (f32x4){0.f, 0.f, 0.f, 0.f};
        cur = nxt; cA = nA; cB = nB; ++ui;
        if constexpr (ALIGN_EPI) { if (wr == 1) PG8_BAR; }
    }
    PG8_WAIT_V(0);
    if constexpr (!ALIGN_EPI) { if (wr == 0) PG8_BAR; }
    PG8_BAR;
#undef PG8_SA
#undef PG8_SB
#undef PG8_STAGE
#undef PG8_LDA
#undef PG8_LDB
#undef PG8_MMA
#undef PG8_WAIT_V
#undef PG8_WAIT_L
#undef PG8_BAR
#undef PG8_SCHED
}
}

#ifndef PG8_SP2
#define PG8_SP2 true
#endif
#ifndef PG8_ALIGN
#define PG8_ALIGN true
#endif

constexpr int NWAVES = 8;
constexpr int BATCH = 8, S = 2048, D = 1024, DEPTH = 2;
constexpr int M = BATCH * S;
constexpr int NIN = 7680, NUQKV = 5632, NGATE = 2048, AW = 1536, AO = 512, DFF = 2816, NUP = 5632, HD = 128;
constexpr float EPS = 1e-6f;
constexpr int N_PHASES = 2 + 10 * DEPTH;

constexpr size_t MiB = 1u << 20;
constexpr size_t WS_CTL = 0, CTL_ZERO_BYTES = 64 * 1024;
constexpr size_t WS_PART = 1 * MiB;
constexpr size_t WS_LSE = 2 * MiB;
constexpr size_t WS_W = 4 * MiB;
constexpr size_t WO_WIN = 0, WO_WC = 15 * MiB, WO_WB = 17 * MiB, WO_WO = 18 * MiB, WO_WUP = 20 * MiB, WO_WDN = 31 * MiB, WDN_BYTES = (size_t)D * DFF * 2;
constexpr size_t WS_HB = 46 * MiB;
constexpr size_t WS_Y = 78 * MiB;
constexpr size_t Y_U = 0, Y_Q = 32 * MiB, Y_K = 80 * MiB, Y_V = 128 * MiB;
constexpr size_t WS_END = 254 * MiB;
static_assert(WO_WDN + 2 * WDN_BYTES <= 42 * MiB && WS_W + 42 * MiB <= WS_HB && WS_HB + 32 * MiB <= WS_Y && WS_Y + 176 * MiB <= WS_END, "d_ws map");
constexpr int CW_BAR = 1024;

constexpr int RING_OFF = 0, RING_BYTES = 131072;
constexpr int LDSCTL_OFF = RING_BYTES, MISC_OFF = LDSCTL_OFF + 320;
constexpr int LDS_BYTES = 147456;

#define GAS __attribute__((address_space(1)))
#define LAS __attribute__((address_space(3)))
typedef unsigned short bf16;
typedef unsigned v4u __attribute__((ext_vector_type(4)));
typedef unsigned v2u __attribute__((ext_vector_type(2)));
typedef float f32x4 __attribute__((ext_vector_type(4)));
typedef GAS unsigned gu32;
#define RLX_AGENT __ATOMIC_RELAXED, __HIP_MEMORY_SCOPE_AGENT
#define LDS_WAIT() asm volatile("s_waitcnt lgkmcnt(0)" ::: "memory")
#define VM_WAIT() asm volatile("s_waitcnt vmcnt(0)" ::: "memory")
__device__ __forceinline__ unsigned f2bf(float f) { unsigned u = __builtin_bit_cast(unsigned, f); return (u + 0x7fffu + ((u >> 16) & 1u)) >> 16; }
__device__ __forceinline__ unsigned pk2(float lo, float hi) { return f2bf(lo) | (f2bf(hi) << 16); }
__device__ __forceinline__ float bflo(unsigned w) { return __uint_as_float(w << 16); }
__device__ __forceinline__ float bfhi(unsigned w) { return __uint_as_float(w & 0xffff0000u); }

#define XB_TMO      128
#define XB_XCNT(j)  (256  + 64 * (j))
#define XB_XSUB(j)  (1280 + 64 * (j))
#define XB_XGEN(j)  (2304 + 64 * (j))
#define XB_TOP      3328
#define XB_TOPGEN   3392
#define XCD_BAR_WORDS 3456
#define XB_SPIN_CAP (1u << 18)
static_assert((CW_BAR + XCD_BAR_WORDS) * 4 <= (int)CTL_ZERO_BYTES, "barrier words inside the zeroed region");

__device__ __forceinline__ unsigned xb_ld(unsigned* p)              { return __hip_atomic_load(p, __ATOMIC_RELAXED, __HIP_MEMORY_SCOPE_AGENT); }
__device__ __forceinline__ unsigned xb_add(unsigned* p, unsigned v) { return __hip_atomic_fetch_add(p, v, __ATOMIC_RELAXED, __HIP_MEMORY_SCOPE_AGENT); }
__device__ __forceinline__ unsigned xb_xcc_id() { return (unsigned)__builtin_amdgcn_s_getreg((3 << 11) | 20) & 0xFu; }
#define XB_SPIN(cond, bar) do { unsigned _sp = 0; while (cond) { __builtin_amdgcn_s_sleep(1); \
    if ((++_sp & 255u) == 0u) { if (xb_ld(&(bar)[XB_TMO])) break; if (_sp > XB_SPIN_CAP) { atomicAdd(&(bar)[XB_TMO], 1u); break; } } } } while (0)

struct XcdBarrier { unsigned* bar; unsigned x; volatile LAS unsigned* st; };

__device__ __forceinline__ XcdBarrier xcd_barrier_post(unsigned* bar, volatile LAS unsigned* st) {
    XcdBarrier b; b.bar = bar; b.x = xb_xcc_id(); b.st = st;
    if (threadIdx.x == 0) (void)xb_add(&bar[XB_XCNT(b.x)], 1u);
    return b;
}
__device__ __forceinline__ void xcd_barrier_complete(unsigned* bar, unsigned x, unsigned& nloc, unsigned& nx) {
    const unsigned G = gridDim.x * gridDim.y * gridDim.z;
    unsigned sum, cnt, mine, sp = 0u;
    for (;;) {
        sum = 0u; cnt = 0u; mine = 0u;
#pragma unroll
        for (unsigned j = 0; j < 16; ++j) { const unsigned c = xb_ld(&bar[XB_XCNT(j)]); sum += c; cnt += (c > 0u) ? 1u : 0u; mine = (j == x) ? c : mine; }
        if (sum == G) break;
        __builtin_amdgcn_s_sleep(1);
        if ((++sp & 255u) == 0u) { if (xb_ld(&bar[XB_TMO])) break; if (sp > XB_SPIN_CAP) { atomicAdd(&bar[XB_TMO], 1u); break; } }
    }
    nloc = mine > 0u ? mine : 1u; nx = cnt > 0u ? cnt : 1u;
}
__device__ __forceinline__ void xcd_barrier(const XcdBarrier& b) {
    asm volatile("s_waitcnt vmcnt(0)" ::: "memory");
    __syncthreads();
    if (threadIdx.x == 0) {
        unsigned* bar = b.bar; unsigned bx_ = b.x; asm volatile("" : "+s"(bar), "+s"(bx_));
        __builtin_amdgcn_s_waitcnt(0);
        unsigned nloc = b.st[0], nx = b.st[1];
        if (nloc == 0u) { xcd_barrier_complete(bar, bx_, nloc, nx); b.st[0] = nloc; b.st[1] = nx; }
        const unsigned old = xb_add(&bar[XB_XSUB(bx_)], 1u);
        const unsigned gen = old / nloc;
        if (old + 1u == (gen + 1u) * nloc) {
            __builtin_amdgcn_fence(__ATOMIC_RELEASE, "agent");
            asm volatile("s_waitcnt vmcnt(0)" ::: "memory");
            const unsigned og = xb_add(&bar[XB_TOP], 1u);
            const unsigned tg = og / nx;
            if (og + 1u == (tg + 1u) * nx) xb_add(&bar[XB_TOPGEN], 1u);
            else XB_SPIN(xb_ld(&bar[XB_TOPGEN]) == tg, bar);
            __builtin_amdgcn_fence(__ATOMIC_ACQUIRE, "agent");
            xb_add(&bar[XB_XGEN(bx_)], 1u);
            asm volatile("s_waitcnt vmcnt(0)" ::: "memory");
        } else {
            XB_SPIN(xb_ld(&bar[XB_XGEN(bx_)]) == gen, bar);
            __builtin_amdgcn_fence(__ATOMIC_ACQUIRE, "agent");
            asm volatile("s_waitcnt vmcnt(0)" ::: "memory");
        }
    }
    __syncthreads();
}

struct Frame {
    LAS unsigned char* lds;
    volatile LAS unsigned* MISC;
    gu32* ctl;
    int tid, lane, wave;
    int vcu, G;
    int gw, NGW;
    unsigned char* ws;
    const float* const* in; float* out;
};

__device__ __forceinline__ float wave_sum(float v) {
#pragma unroll
    for (int o = 1; o < 64; o <<= 1) v += __shfl_xor(v, o);
    return v;
}
__device__ __forceinline__ float wave_max(float v) {
#pragma unroll
    for (int o = 1; o < 64; o <<= 1) v = fmaxf(v, __shfl_xor(v, o));
    return v;
}

__device__ __forceinline__ void p0_transpose_item(const float* W, const float* gain, int K, int N, bf16* WT, LAS float* scr, int item, int lane) {
    const int nblk = N / 32, kb = item / nblk, nb = item % nblk, k0 = 64 * kb, n0 = 32 * nb;
#pragma unroll 8
    for (int i = 0; i < 32; ++i) { const int kk = 2 * i + (lane >> 5); const float gsc = gain ? gain[k0 + kk] : 1.0f; scr[kk * 33 + (lane & 31)] = W[(size_t)(k0 + kk) * N + n0 + (lane & 31)] * gsc; }
    LDS_WAIT(); asm volatile("" ::: "memory");
    const int c = lane & 7;
#pragma unroll
    for (int j = 0; j < 4; ++j) { const int n = (lane >> 3) + 8 * j; const LAS float* s = scr + (8 * c) * 33 + n;
        v4u o; o.x = pk2(s[0 * 33], s[1 * 33]); o.y = pk2(s[2 * 33], s[3 * 33]); o.z = pk2(s[4 * 33], s[5 * 33]); o.w = pk2(s[6 * 33], s[7 * 33]);
        *(GAS v4u*)(WT + (size_t)(n0 + n) * K + k0 + 8 * c) = o; }
    LDS_WAIT(); asm volatile("" ::: "memory");
}

__device__ __forceinline__ void convert_weights(Frame& F, int l, bool with_down) {
    LAS float* scr = (LAS float*)(F.lds + RING_OFF + F.wave * 16384);
    unsigned char* wb = F.ws + WS_W;
    const float* w_in = F.in[1] + (size_t)l * D * NIN; const float* w_b = F.in[5] + (size_t)l * AO * D; const float* w_o = F.in[6] + (size_t)l * D * D;
    const float* w_up = F.in[9] + (size_t)l * D * NUP; const float* n1 = F.in[7] + (size_t)l * D; const float* n2 = F.in[8] + (size_t)l * D;
    constexpr int I_IN = (D / 64) * (NIN / 32), I_B = (AO / 64) * (D / 32), I_O = (D / 64) * (D / 32), I_UP = (D / 64) * (NUP / 32), I_DN = (DFF / 64) * (D / 32);
    const int nitems = I_IN + I_B + I_O + I_UP + (with_down ? 2 * I_DN : 0);
    for (int it = F.gw; it < nitems; it += F.NGW) {
        int r = it;
        if (r < I_IN) { p0_transpose_item(w_in, n1, D, NIN, (bf16*)(wb + WO_WIN), scr, r, F.lane); continue; } r -= I_IN;
        if (r < I_B) { p0_transpose_item(w_b, nullptr, AO, D, (bf16*)(wb + WO_WB), scr, r, F.lane); continue; } r -= I_B;
        if (r < I_O) { p0_transpose_item(w_o, nullptr, D, D, (bf16*)(wb + WO_WO), scr, r, F.lane); continue; } r -= I_O;
        if (r < I_UP) { p0_transpose_item(w_up, n2, D, NUP, (bf16*)(wb + WO_WUP), scr, r, F.lane); continue; } r -= I_UP;
        const int ll = r / I_DN; r -= ll * I_DN;
        p0_transpose_item(F.in[12] + (size_t)ll * DFF * D, nullptr, DFF, D, (bf16*)(wb + WO_WDN + ll * WDN_BYTES), scr, r, F.lane);
    }
    const float* w_pool = F.in[2] + (size_t)l * 4 * 256 * 256; const float* ps = F.in[3] + (size_t)l * D; const float* w_a = F.in[4] + (size_t)l * D * D;
    bf16* Wc = (bf16*)(wb + WO_WC);
    LAS float* As = (LAS float*)(F.lds + RING_OFF);
    LAS float* Bs = (LAS float*)(F.lds + RING_OFF + 64 * 129 * 4);
    __syncthreads();
    for (int tile = F.vcu; tile < 4 * 4 * 16; tile += F.G) {
        const int g = tile >> 6, cb = (tile >> 4) & 3, nb = tile & 15, c0 = cb * 64, n0 = nb * 64;
        float acc[8];
#pragma unroll
        for (int e = 0; e < 8; ++e) acc[e] = 0.f;
        for (int dc = 0; dc < 2; ++dc) {
            const int d0 = dc * 128;
            for (int i = F.tid; i < 64 * 128; i += NWAVES * 64) { const int c = i >> 7, d = i & 127; As[c * 129 + d] = w_pool[((size_t)g * 256 + c0 + c) * 256 + d0 + d] * ps[g * 256 + d0 + d]; }
            for (int i = F.tid; i < 128 * 64; i += NWAVES * 64) { const int d = i >> 6, n = i & 63; Bs[d * 65 + n] = w_a[(size_t)(g * 256 + d0 + d) * D + n0 + n]; }
            __syncthreads();
            const LAS float* ap = As + (F.wave * 8) * 129; const LAS float* bp = Bs + F.lane;
#pragma unroll 4
            for (int d = 0; d < 128; ++d) { const float bv = bp[d * 65];
#pragma unroll
                for (int e = 0; e < 8; ++e) acc[e] += ap[e * 129 + d] * bv; }
            __syncthreads();
        }
        v4u o; o.x = pk2(acc[0], acc[1]); o.y = pk2(acc[2], acc[3]); o.z = pk2(acc[4], acc[5]); o.w = pk2(acc[6], acc[7]);
        *(GAS v4u*)(Wc + (size_t)(n0 + F.lane) * D + g * 256 + c0 + F.wave * 8) = o;
    }
}

__device__ __forceinline__ void p0_x_rows(Frame& F) {
    const float* x = F.in[0]; bf16* hb = (bf16*)(F.ws + WS_HB); float* part = (float*)(F.ws + WS_PART);
    for (int m = F.gw; m < M; m += F.NGW) {
        const GAS f32x4* xr = (const GAS f32x4*)(x + (size_t)m * D) + F.lane;
        f32x4 v[4]; float s = 0.f;
#pragma unroll
        for (int j = 0; j < 4; ++j) { v[j] = xr[64 * j]; s += (v[j].x * v[j].x + v[j].y * v[j].y) + (v[j].z * v[j].z + v[j].w * v[j].w); }
        s = wave_sum(s);
        GAS unsigned long long* o8 = (GAS unsigned long long*)(hb + (size_t)m * D) + F.lane;
#pragma unroll
        for (int j = 0; j < 4; ++j) o8[64 * j] = (unsigned long long)pk2(v[j].x, v[j].y) | ((unsigned long long)pk2(v[j].z, v[j].w) << 32);
        if (F.lane < 16) part[(size_t)F.lane * M + m] = (F.lane == 0) ? s : 0.f;
    }
}

__device__ __forceinline__ int t5_bucket(int rel) {
    const int ret = rel > 0 ? 16 : 0; const int n = rel < 0 ? -rel : rel;
    int b;
    if (n < 8) b = n; else if (n < 15) b = 8; else if (n < 27) b = 9; else if (n < 50) b = 10; else if (n < 91) b = 11; else if (n < 166) b = 12; else if (n < 305) b = 13; else if (n < 559) b = 14; else b = 15;
    return ret + b;
}

__device__ __forceinline__ void attn_simple(Frame& F) {
    bf16* Q = (bf16*)(F.ws + WS_Y + Y_Q); const bf16* Kb = (const bf16*)(F.ws + WS_Y + Y_K); const bf16* V = (const bf16*)(F.ws + WS_Y + Y_V);
    const float* rel_bias = F.in[13];
    LAS float* qs = (LAS float*)(F.lds + RING_OFF + F.wave * 2048);
    const int lane = F.lane; const float scale = 0.08838834764831845f;
    for (int item = F.gw; item < M * 4; item += F.NGW) {
        const int tok = item >> 2, h = item & 3, b = tok >> 11, s = tok & (S - 1);
#pragma unroll
        for (int g = 0; g < 3; ++g) { const unsigned w = *(const GAS unsigned*)(Q + (size_t)tok * AW + (g * 4 + h) * HD + 2 * lane); qs[g * 128 + 2 * lane] = bflo(w); qs[g * 128 + 2 * lane + 1] = bfhi(w); }
        LDS_WAIT(); asm volatile("" ::: "memory");
        float mrun = -1e30f, lrun = 0.f, o0 = 0.f, o1 = 0.f;
#pragma unroll 1
        for (int g = 0; g < 3; ++g) {
            const int dl = 1 << (2 * g), head = g * 4 + h;
            float sc[3];
#pragma unroll
            for (int p = 0; p < 3; ++p) {
                const int jj = lane + 64 * p, j = jj - 64, pos = s + dl * j;
                const bool valid = (jj <= 128) && pos >= 0 && pos < S;
                float dot = 0.f;
                if (valid) {
                    const bf16* krow = Kb + ((size_t)b * S + pos) * AW + head * HD;
#pragma unroll 4
                    for (int c = 0; c < 16; ++c) { const v4u kv = *(const GAS v4u*)(krow + 8 * c); const LAS float* qq = qs + g * 128 + 8 * c;
                        dot += bflo(kv.x) * qq[0] + bfhi(kv.x) * qq[1] + bflo(kv.y) * qq[2] + bfhi(kv.y) * qq[3] + bflo(kv.z) * qq[4] + bfhi(kv.z) * qq[5] + bflo(kv.w) * qq[6] + bfhi(kv.w) * qq[7]; }
                }
                const float bias = (jj <= 128) ? rel_bias[t5_bucket(dl * j) * 12 + head] : 0.f;
                sc[p] = valid ? dot * scale + bias : -1e30f;
            }
            const float gmax = wave_max(fmaxf(fmaxf(sc[0], sc[1]), sc[2]));
            const float mnew = fmaxf(mrun, gmax);
            const float alpha = __expf(mrun - mnew);
            float pr[3];
#pragma unroll
            for (int p = 0; p < 3; ++p) pr[p] = (sc[p] > -1e29f) ? __expf(sc[p] - mnew) : 0.f;
            const float psum = wave_sum(pr[0] + pr[1] + pr[2]);
            lrun = lrun * alpha + psum; o0 *= alpha; o1 *= alpha; mrun = mnew;
#pragma unroll 1
            for (int jj = 0; jj <= 128; ++jj) {
                const int pos = s + dl * (jj - 64);
                if (pos < 0 || pos >= S) continue;
                const float pj = __shfl(jj < 64 ? pr[0] : (jj < 128 ? pr[1] : pr[2]), jj & 63);
                const unsigned w = *(const GAS unsigned*)(V + ((size_t)b * S + pos) * AW + head * HD + 2 * lane);
                o0 += pj * bflo(w); o1 += pj * bfhi(w);
            }
        }
        const float inv = 1.0f / lrun;
        *(GAS unsigned*)(Q + (size_t)tok * AW + h * HD + 2 * lane) = pk2(o0 * inv, o1 * inv);
        LDS_WAIT(); asm volatile("" ::: "memory");
    }
}

namespace att {
typedef short bf16x8 __attribute__((ext_vector_type(8)));
typedef short s16x4 __attribute__((ext_vector_type(4)));
typedef float f32x16 __attribute__((ext_vector_type(16)));
__device__ __forceinline__ unsigned off_b(unsigned row, unsigned ch) { return 256u * row + 16u * (ch ^ (((row & 3u) << 2) | ((row >> 2) & 3u))); }
__device__ __forceinline__ s16x4 vtr(const LAS unsigned char* p) { return __builtin_bit_cast(s16x4, __builtin_amdgcn_ds_read_tr16_b64_v4i16((LAS s16x4*)p)); }
constexpr int N_UNITS = BATCH * 3 * 2 * 16;
constexpr int BIAS_OFF = RING_BYTES + 2048;
}
__device__ __forceinline__ void attn_mfma(Frame& F) {
    using namespace att;
    bf16* Q = (bf16*)(F.ws + WS_Y + Y_Q); const bf16* Kg = (const bf16*)(F.ws + WS_Y + Y_K); const bf16* Vg = (const bf16*)(F.ws + WS_Y + Y_V);
    float* LSE = (float*)(F.ws + WS_LSE); const float* rel_bias = F.in[13];
    const int lane = F.lane, wave = F.wave, half = wave >> 2, j = wave & 3, ql = lane & 31, hh = lane >> 5, th = F.tid & 255;
    const float LOG2E = 1.4426950408889634f, CS = 0.08838834764831845f * 1.4426950408889634f;
    LAS unsigned char* hb = F.lds + RING_OFF + half * 65536;
    LAS float* bt = (LAS float*)(F.lds + BIAS_OFF + half * 1024);
    const int nper = (N_UNITS + F.G - 1) / F.G;
    const int u_lo = F.vcu * nper, u_hi = (u_lo + nper < N_UNITS) ? u_lo + nper : N_UNITS;
#pragma unroll 1
    for (int u = u_lo; u < u_hi; ++u) {
        const int t16 = u & 15, rest = u >> 4, hp = rest & 1, g = (rest >> 1) % 3, b = rest / 6;
        const int sh = 2 * g, dl = 1 << sh, L = S >> sh;
        const int r = (g == 0) ? 0 : (g == 1 ? (t16 >> 2) : t16), mt = (g == 0) ? t16 : (g == 1 ? (t16 & 3) : 0), m0 = mt * 128;
        const int hl = hp * 2 + half, hd = g * 4 + hl;
        const size_t tokbase = (size_t)b * S + r;
        { const int jrel = th - 128; float v = 0.f; if (jrel >= -64 && jrel <= 64) v = rel_bias[t5_bucket(dl * jrel) * 12 + hd] * LOG2E; bt[th] = v; }
        const int mq = m0 + 32 * j + ql;
        bf16* qrow = Q + (tokbase + (size_t)dl * mq) * AW + hd * HD;
        bf16x8 qf[8];
#pragma unroll
        for (int s2 = 0; s2 < 8; ++s2) qf[s2] = *(const GAS bf16x8*)(qrow + 16 * s2 + 8 * hh);
        const int kb_lo = (m0 == 0) ? 1 : 0; int kb_hi = (L - 1 - m0 + 64) >> 6; kb_hi = kb_hi > 3 ? 3 : kb_hi;
        v4u kreg[4], vreg[4];
        const int srow = th >> 4, sch = th & 15;
#define ATT_STAGE_LOAD(kb_) do { _Pragma("unroll") for (int i = 0; i < 4; ++i) { const int row = srow + 16 * i, mk = m0 - 64 + 64 * (kb_) + row; const bool ok = (unsigned)mk < (unsigned)L; \
                const size_t off = (tokbase + (size_t)dl * (ok ? mk : 0)) * AW + hd * HD + sch * 8; const v4u z = {0u, 0u, 0u, 0u}; \
                kreg[i] = ok ? *(const GAS v4u*)(Kg + off) : z; vreg[i] = ok ? *(const GAS v4u*)(Vg + off) : z; } } while (0)
#define ATT_STAGE_WRITE(buf_) do { _Pragma("unroll") for (int i = 0; i < 4; ++i) { const unsigned o = off_b((unsigned)(srow + 16 * i), (unsigned)sch); \
                *(LAS v4u*)(hb + (buf_) * 16384 + o) = kreg[i]; *(LAS v4u*)(hb + 32768 + (buf_) * 16384 + o) = vreg[i]; } } while (0)
        float m_run = -1e20f, l_run = 0.f;
        f32x16 O[4];
#pragma unroll
        for (int c = 0; c < 4; ++c)
#pragma unroll
            for (int i = 0; i < 16; ++i) O[c][i] = 0.f;
        ATT_STAGE_LOAD(kb_lo); ATT_STAGE_WRITE(0);
        __syncthreads();
#pragma unroll 1
        for (int kb = kb_lo; kb <= kb_hi; ++kb) {
            const int cur = (kb - kb_lo) & 1;
            if (kb < kb_hi) ATT_STAGE_LOAD(kb + 1);
            if (kb >= (j >> 1) && kb <= (j >> 1) + 2) {
                const LAS unsigned char* kbuf = hb + cur * 16384; const LAS unsigned char* vbuf = hb + 32768 + cur * 16384;
                f32x16 s0, s1;
#pragma unroll
                for (int i = 0; i < 16; ++i) { s0[i] = 0.f; s1[i] = 0.f; }
#pragma unroll
                for (int s2 = 0; s2 < 8; ++s2) {
                    const bf16x8 a0 = *(const LAS bf16x8*)(kbuf + off_b((unsigned)ql, (unsigned)(2 * s2 + hh)));
                    const bf16x8 a1 = *(const LAS bf16x8*)(kbuf + off_b((unsigned)(32 + ql), (unsigned)(2 * s2 + hh)));
                    s0 = __builtin_amdgcn_mfma_f32_32x32x16_bf16(a0, qf[s2], s0, 0, 0, 0);
                    s1 = __builtin_amdgcn_mfma_f32_32x32x16_bf16(a1, qf[s2], s1, 0, 0, 0);
                }
                const int jb = 64 * kb - 64 - 32 * j - ql, mkb = m0 - 64 + 64 * kb;
                float bmax = -1e30f;
#pragma unroll
                for (int i = 0; i < 16; ++i) {
                    const int kr = (i & 3) + 8 * (i >> 2) + 4 * hh;
                    { const int jrel = jb + kr, mk = mkb + kr; const bool ok = (unsigned)(jrel + 64) <= 128u && (unsigned)mk < (unsigned)L;
                      const float t = ok ? fmaf(s0[i], CS, bt[jrel + 128]) : -1e30f; s0[i] = t; bmax = fmaxf(bmax, t); }
                    { const int jrel = jb + 32 + kr, mk = mkb + 32 + kr; const bool ok = (unsigned)(jrel + 64) <= 128u && (unsigned)mk < (unsigned)L;
                      const float t = ok ? fmaf(s1[i], CS, bt[jrel + 128]) : -1e30f; s1[i] = t; bmax = fmaxf(bmax, t); }
                }
                bmax = fmaxf(bmax, __shfl_xor(bmax, 32));
                const float m_new = fmaxf(m_run, bmax), alpha = __builtin_amdgcn_exp2f(m_run - m_new);
                m_run = m_new;
                float psum = 0.f;
#pragma unroll
                for (int i = 0; i < 16; ++i) { s0[i] = __builtin_amdgcn_exp2f(s0[i] - m_new); s1[i] = __builtin_amdgcn_exp2f(s1[i] - m_new); psum += s0[i] + s1[i]; }
                l_run = l_run * alpha + psum;
#pragma unroll
                for (int c = 0; c < 4; ++c)
#pragma unroll
                    for (int i = 0; i < 16; ++i) O[c][i] *= alpha;
                v4u pk[4];
#pragma unroll
                for (int s2 = 0; s2 < 2; ++s2) {
                    pk[s2].x = pg8::cvt_pk_bf16(s0[8 * s2 + 0], s0[8 * s2 + 1]); pk[s2].y = pg8::cvt_pk_bf16(s0[8 * s2 + 2], s0[8 * s2 + 3]);
                    pk[s2].z = pg8::cvt_pk_bf16(s0[8 * s2 + 4], s0[8 * s2 + 5]); pk[s2].w = pg8::cvt_pk_bf16(s0[8 * s2 + 6], s0[8 * s2 + 7]);
                    pk[2 + s2].x = pg8::cvt_pk_bf16(s1[8 * s2 + 0], s1[8 * s2 + 1]); pk[2 + s2].y = pg8::cvt_pk_bf16(s1[8 * s2 + 2], s1[8 * s2 + 3]);
                    pk[2 + s2].z = pg8::cvt_pk_bf16(s1[8 * s2 + 4], s1[8 * s2 + 5]); pk[2 + s2].w = pg8::cvt_pk_bf16(s1[8 * s2 + 6], s1[8 * s2 + 7]);
                }
                const unsigned blk = (lane >> 4) & 1, tq = (lane & 15) >> 2, tp = lane & 3;
#pragma unroll
                for (int ks = 0; ks < 4; ++ks) {
                    const bf16x8 pb = __builtin_bit_cast(bf16x8, pk[ks]);
#pragma unroll
                    for (int c = 0; c < 4; ++c) {
                        const unsigned chn = 4 * c + 2 * blk + (tp >> 1);
                        const s16x4 lo = vtr(vbuf + off_b(16 * ks + 4 * hh + tq, chn) + 8 * (tp & 1));
                        const s16x4 hi = vtr(vbuf + off_b(16 * ks + 8 + 4 * hh + tq, chn) + 8 * (tp & 1));
                        const bf16x8 va = {lo[0], lo[1], lo[2], lo[3], hi[0], hi[1], hi[2], hi[3]};
                        O[c] = __builtin_amdgcn_mfma_f32_32x32x16_bf16(va, pb, O[c], 0, 0, 0);
                    }
                }
            }
            if (kb < kb_hi) ATT_STAGE_WRITE(cur ^ 1);
            __syncthreads();
        }
#undef ATT_STAGE_LOAD
#undef ATT_STAGE_WRITE
        const float l_tot = l_run + __shfl_xor(l_run, 32);
        const float inv = 1.0f / l_tot;
#pragma unroll
        for (int c = 0; c < 4; ++c)
#pragma unroll
            for (int i4 = 0; i4 < 4; ++i4) {
                v2u w; w.x = pg8::cvt_pk_bf16(O[c][4 * i4 + 0] * inv, O[c][4 * i4 + 1] * inv); w.y = pg8::cvt_pk_bf16(O[c][4 * i4 + 2] * inv, O[c][4 * i4 + 3] * inv);
                *(GAS v2u*)(qrow + 32 * c + 8 * i4 + 4 * hh) = w;
            }
        if (hh == 0) LSE[((size_t)g * M + tokbase + (size_t)dl * mq) * 4 + hl] = m_run + __log2f(l_tot);
    }
}

__device__ __forceinline__ void attn_combine(Frame& F) {
    bf16* Q = (bf16*)(F.ws + WS_Y + Y_Q); const float* LSE = (const float*)(F.ws + WS_LSE);
    const int total = M * 64;
    for (int it = F.gw * 64 + F.lane; it < total; it += F.NGW * 64) {
        const int tok = it >> 6, h = (it >> 4) & 3, ch = it & 15;
        const float l0 = LSE[((size_t)0 * M + tok) * 4 + h], l1 = LSE[((size_t)1 * M + tok) * 4 + h], l2 = LSE[((size_t)2 * M + tok) * 4 + h];
        const float mx = fmaxf(l0, fmaxf(l1, l2));
        float w0 = __builtin_amdgcn_exp2f(l0 - mx), w1 = __builtin_amdgcn_exp2f(l1 - mx), w2 = __builtin_amdgcn_exp2f(l2 - mx);
        const float inv = 1.0f / (w0 + w1 + w2); w0 *= inv; w1 *= inv; w2 *= inv;
        bf16* p = Q + (size_t)tok * AW + h * HD + ch * 8;
        const v4u a = *(const GAS v4u*)(p), b2 = *(const GAS v4u*)(p + 512), c = *(const GAS v4u*)(p + 1024);
        v4u o;
        o.x = pk2(w0 * bflo(a.x) + w1 * bflo(b2.x) + w2 * bflo(c.x), w0 * bfhi(a.x) + w1 * bfhi(b2.x) + w2 * bfhi(c.x));
        o.y = pk2(w0 * bflo(a.y) + w1 * bflo(b2.y) + w2 * bflo(c.y), w0 * bfhi(a.y) + w1 * bfhi(b2.y) + w2 * bfhi(c.y));
        o.z = pk2(w0 * bflo(a.z) + w1 * bflo(b2.z) + w2 * bflo(c.z), w0 * bfhi(a.z) + w1 * bfhi(b2.z) + w2 * bfhi(c.z));
        o.w = pk2(w0 * bflo(a.w) + w1 * bflo(b2.w) + w2 * bflo(c.w), w0 * bfhi(a.w) + w1 * bfhi(b2.w) + w2 * bfhi(c.w));
        *(GAS v4u*)(p) = o;
    }
}

__device__ __forceinline__ void pool_simple(Frame& F) {
    const bf16* U = (const bf16*)(F.ws + WS_Y + Y_U); bf16* P = (bf16*)(F.ws + WS_Y + Y_K);
    const int total = M * (D / 8);
    for (int it = F.gw * 64 + F.lane; it < total; it += F.NGW * 64) {
        const int tok = it >> 7, ch = it & 127, s = tok & (S - 1), g = ch >> 5, w = 2 << g;
        int lo = s - (w >> 1), hi = lo + w; lo = lo < 0 ? 0 : lo; hi = hi > S ? S : hi;
        const bf16* base = U + (size_t)(tok - s) * D + ch * 8;
        float a[8];
#pragma unroll
        for (int e = 0; e < 8; ++e) a[e] = 0.f;
        for (int r = lo; r < hi; ++r) { const v4u v = *(const GAS v4u*)(base + (size_t)r * D);
            a[0] += bflo(v.x); a[1] += bfhi(v.x); a[2] += bflo(v.y); a[3] += bfhi(v.y); a[4] += bflo(v.z); a[5] += bfhi(v.z); a[6] += bflo(v.w); a[7] += bfhi(v.w); }
        const float inv = 1.0f / (float)(hi - lo);
        const v4u c = *(const GAS v4u*)(base + (size_t)s * D);
        v4u o; o.x = pk2(a[0] * inv - bflo(c.x), a[1] * inv - bfhi(c.x)); o.y = pk2(a[2] * inv - bflo(c.y), a[3] * inv - bfhi(c.y));
        o.z = pk2(a[4] * inv - bflo(c.z), a[5] * inv - bfhi(c.z)); o.w = pk2(a[6] * inv - bflo(c.w), a[7] * inv - bfhi(c.w));
        *(GAS v4u*)(P + (size_t)tok * D + ch * 8) = o;
    }
}

__device__ __forceinline__ float gelu_tanh(float x) {
    const float y = 0.7978845608028654f * (x + 0.044715f * x * x * x);
    const float t = 1.0f - 2.0f / (__expf(2.0f * y) + 1.0f);
    return 0.5f * x * (1.0f + t);
}
__device__ __forceinline__ void conv_simple(Frame& F, int l) {
    bf16* AG = (bf16*)(F.ws + WS_Y);
    const float* cw = F.in[10] + (size_t)l * 3 * DFF; const float* cb = F.in[11] + (size_t)l * DFF;
    constexpr int CH = DFF / 8; const int total = M * CH;
    for (int it = F.gw * 64 + F.lane; it < total; it += F.NGW * 64) {
        const int tok = it / CH, ch = it - tok * CH, s = tok & (S - 1), c0 = ch * 8;
        const bf16* ap = AG + (size_t)tok * NUP + c0;
        const v4u z = {0u, 0u, 0u, 0u};
        const v4u am = (s > 0) ? *(const GAS v4u*)(ap - NUP) : z;
        const v4u a0 = *(const GAS v4u*)(ap);
        const v4u ap1 = (s < S - 1) ? *(const GAS v4u*)(ap + NUP) : z;
        const v4u gv = *(const GAS v4u*)(ap + DFF);
        float xm[8] = {bflo(am.x), bfhi(am.x), bflo(am.y), bfhi(am.y), bflo(am.z), bfhi(am.z), bflo(am.w), bfhi(am.w)};
        float x0[8] = {bflo(a0.x), bfhi(a0.x), bflo(a0.y), bfhi(a0.y), bflo(a0.z), bfhi(a0.z), bflo(a0.w), bfhi(a0.w)};
        float xp[8] = {bflo(ap1.x), bfhi(ap1.x), bflo(ap1.y), bfhi(ap1.y), bflo(ap1.z), bfhi(ap1.z), bflo(ap1.w), bfhi(ap1.w)};
        float gg[8] = {bflo(gv.x), bfhi(gv.x), bflo(gv.y), bfhi(gv.y), bflo(gv.z), bfhi(gv.z), bflo(gv.w), bfhi(gv.w)};
        float r[8];
#pragma unroll
        for (int e = 0; e < 8; ++e) { const float v = cw[c0 + e] * xm[e] + cw[DFF + c0 + e] * x0[e] + cw[2 * DFF + c0 + e] * xp[e] + cb[c0 + e]; r[e] = gelu_tanh(v) * gg[e]; }
        v4u o; o.x = pk2(r[0], r[1]); o.y = pk2(r[2], r[3]); o.z = pk2(r[4], r[5]); o.w = pk2(r[6], r[7]);
        *(GAS v4u*)(AG + (size_t)tok * NUP + DFF + c0) = o;
    }
}

__device__ __forceinline__ void final_norm(Frame& F) {
    const float* part = (const float*)(F.ws + WS_PART); const float* nf = F.in[14];
    for (int m = F.gw; m < M; m += F.NGW) {
        float s = 0.f;
#pragma unroll
        for (int t = 0; t < 16; ++t) s += part[(size_t)t * M + m];
        const float rstd = 1.0f / sqrtf(s * (1.0f / 1024.0f) + EPS);
        GAS f32x4* xr = (GAS f32x4*)(F.out + (size_t)m * D) + F.lane; const GAS f32x4* gr = (const GAS f32x4*)nf + F.lane;
#pragma unroll
        for (int j = 0; j < 4; ++j) { const f32x4 v = xr[64 * j]; const f32x4 gq = gr[64 * j]; xr[64 * j] = v * rstd * gq; }
    }
}

struct Args { const float* in[15]; float* out; unsigned char* ws; int ph_lo, ph_hi; int pad0, pad1; };

struct CfgP1 { static constexpr int st1 = 4, st2 = 10, st3 = 16, ld0 = D, ld1 = AW; static constexpr long off1 = (long)(Y_Q - Y_U), off2 = (long)(Y_K - Y_U), off3 = (long)(Y_V - Y_U); };
struct CfgGate { static constexpr int st1 = 4, st2 = 1 << 20, st3 = 1 << 20, ld0 = D, ld1 = D; static constexpr long off1 = (long)Y_U - (long)Y_V, off2 = 0, off3 = 0; };
struct CfgOne { static constexpr int st1 = 1 << 20, st2 = 1 << 20, st3 = 1 << 20, ld0 = D, ld1 = D; static constexpr long off1 = 0, off2 = 0, off3 = 0; };
struct CfgUp { static constexpr int st1 = 1 << 20, st2 = 1 << 20, st3 = 1 << 20, ld0 = NUP, ld1 = NUP; static constexpr long off1 = 0, off2 = 0, off3 = 0; };
template <int MODE, class CFG, int GN, int GK, int GLDA> __device__ __forceinline__ void run_gemm_b(Frame& F, const bf16* A, const bf16* Bt, bf16* O, const bf16* X1, const bf16* X2) {
    pg8::EpiB<MODE, CFG> E; E.O = O; E.part = (const float*)(F.ws + WS_PART); E.X1 = X1; E.X2 = X2;
    pg8::gemm_phase<pg8::EpiB<MODE, CFG>, GN, GK, GLDA, PG8_ALIGN, PG8_SP2>(F.lds + RING_OFF, A, Bt, F.G, (int)blockIdx.x, E);
}
template <int GK, int GLDA> __device__ __forceinline__ void run_gemm_r(Frame& F, const bf16* A, const bf16* Bt, const float* base) {
    pg8::EpiRes E{base, F.out, (bf16*)(F.ws + WS_HB), (float*)(F.ws + WS_PART), M};
    pg8::gemm_phase<pg8::EpiRes, D, GK, GLDA, PG8_ALIGN, PG8_SP2>(F.lds + RING_OFF, A, Bt, F.G, (int)blockIdx.x, E);
}

#define IN(k) (lo <= (k) && (k) < hi)
#define SEAM(k) do { if (IN(k) && IN((k) + 1)) xcd_barrier(bar); } while (0)
template <int L> __device__ __forceinline__ void layer_phases(Frame& F, int lo, int hi, const XcdBarrier& bar) {
    constexpr int pb = 1 + 10 * L;
    unsigned char* ws = F.ws;
    bf16* HB = (bf16*)(ws + WS_HB);
    bf16* YU = (bf16*)(ws + WS_Y + Y_U); bf16* YQ = (bf16*)(ws + WS_Y + Y_Q); bf16* YK = (bf16*)(ws + WS_Y + Y_K); bf16* YV = (bf16*)(ws + WS_Y + Y_V);
    bf16* W_IN = (bf16*)(ws + WS_W + WO_WIN);
    if (IN(pb + 0)) { run_gemm_b<0, CfgP1, NUQKV, D, D>(F, HB, W_IN, YU, nullptr, nullptr); SEAM(pb + 0); }
#if defined(ATTN_ORACLE)
    if (IN(pb + 1)) { attn_simple(F); SEAM(pb + 1); }
#else
    if (IN(pb + 1)) { attn_mfma(F); SEAM(pb + 1); }
#endif
#if defined(ATTN_ORACLE)
    if (IN(pb + 2)) { pool_simple(F); SEAM(pb + 2); }
#else
    if (IN(pb + 2)) { attn_combine(F); pool_simple(F); SEAM(pb + 2); }
#endif
    if (IN(pb + 3)) { run_gemm_b<1, CfgGate, NGATE, D, D>(F, HB, W_IN + (size_t)NUQKV * D, YV, nullptr, nullptr); SEAM(pb + 3); }
    if (IN(pb + 4)) { run_gemm_b<2, CfgOne, D, D, D>(F, YK, (const bf16*)(ws + WS_W + WO_WC), YV, YV, nullptr); SEAM(pb + 4); }
    if (IN(pb + 5)) { run_gemm_b<3, CfgOne, D, AO, AW>(F, YQ, (const bf16*)(ws + WS_W + WO_WB), YV, YV, YU); SEAM(pb + 5); }
    if (IN(pb + 6)) { run_gemm_r<D, D>(F, YV, (const bf16*)(ws + WS_W + WO_WO), L == 0 ? F.in[0] : (const float*)F.out); SEAM(pb + 6); }
    if (IN(pb + 7)) { run_gemm_b<0, CfgUp, NUP, D, D>(F, HB, (const bf16*)(ws + WS_W + WO_WUP), YU, nullptr, nullptr); SEAM(pb + 7); }
    if (IN(pb + 8)) { conv_simple(F, L); if (L + 1 < DEPTH) convert_weights(F, L + 1, false); SEAM(pb + 8); }
    if (IN(pb + 9)) { run_gemm_r<DFF, NUP>(F, YU + DFF, (const bf16*)(ws + WS_W + WO_WDN + L * WDN_BYTES), (const float*)F.out); SEAM(pb + 9); }
}
#undef IN
#undef SEAM

__global__ void __launch_bounds__(NWAVES * 64, 2) fwd_kernel(Args args) {
    extern __shared__ __attribute__((aligned(16))) unsigned char lds[];
    Frame F;
    F.lds = (LAS unsigned char*)lds;
    F.MISC = (volatile LAS unsigned*)(F.lds + MISC_OFF);
    F.tid = threadIdx.x; F.lane = F.tid & 63; F.wave = __builtin_amdgcn_readfirstlane(F.tid >> 6);
    F.G = gridDim.x; { const int bx = blockIdx.x; F.vcu = (F.G % 8 == 0) ? (bx % 8) * (F.G / 8) + bx / 8 : bx; }
    F.gw = F.vcu * NWAVES + F.wave; F.NGW = F.G * NWAVES;
    F.ws = args.ws; F.ctl = (gu32*)(args.ws + WS_CTL); F.out = args.out;
    F.in = args.in;
    for (int u = F.tid; u < (LDS_BYTES - LDSCTL_OFF) / 4; u += NWAVES * 64) ((LAS unsigned*)(F.lds + LDSCTL_OFF))[u] = 0u;
    __syncthreads();
    const int lo = args.ph_lo, hi = args.ph_hi;
    XcdBarrier bar; bar.bar = (unsigned*)(F.ctl + CW_BAR); bar.x = 0; bar.st = nullptr;
    if (hi - lo > 1) bar = xcd_barrier_post((unsigned*)(F.ctl + CW_BAR), F.MISC + 8);

#define IN(k) (lo <= (k) && (k) < hi)
#define SEAM(k) do { if (IN(k) && IN((k) + 1)) xcd_barrier(bar); } while (0)
    if (IN(0)) { convert_weights(F, 0, true); p0_x_rows(F); SEAM(0); }
    layer_phases<0>(F, lo, hi, bar);
    layer_phases<1>(F, lo, hi, bar);
    if (IN(N_PHASES - 1)) final_norm(F);
}
#undef IN
#undef SEAM

#ifdef DBG_STOP
__global__ void dbg_dump(const unsigned char* ws, float* out, size_t o0, size_t o1, size_t o2, size_t o3, int n_off, int is_f32) {
    const size_t n = (size_t)M * D;
    for (size_t i = (size_t)blockIdx.x * blockDim.x + threadIdx.x; i < n; i += (size_t)gridDim.x * blockDim.x) {
        float acc = 0.f; const size_t offs[4] = {o0, o1, o2, o3};
        for (int r = 0; r < n_off; ++r) { if (is_f32) acc += ((const float*)(ws + offs[r]))[i]; else acc += __uint_as_float((unsigned)((const unsigned short*)(ws + offs[r]))[i] << 16); }
        out[i] = acc;
    }
}
#endif
extern "C" void kernel_launch(void* const* d_in, const int* in_sizes, int n_in, void* d_out, int out_size, void* d_ws, size_t ws_size, hipStream_t stream) {
    static int grid = 0;
    if (grid == 0) {
        if (n_in != 15 || in_sizes[0] != M * D || out_size != M * D || ws_size < WS_END) { fprintf(stderr, "kernel_launch: unexpected problem shape (n_in %d, in0 %d, out %d, ws %zu); nothing launched\n", n_in, n_in > 0 ? in_sizes[0] : -1, out_size, ws_size); grid = -1; return; }
        int dev = 0, cus = 0, per_cu = 0;
        if (hipGetDevice(&dev) != hipSuccess || hipDeviceGetAttribute(&cus, hipDeviceAttributeMultiprocessorCount, dev) != hipSuccess) { grid = -1; return; }
        if (hipFuncSetAttribute((const void*)fwd_kernel, hipFuncAttributeMaxDynamicSharedMemorySize, LDS_BYTES) != hipSuccess) { fprintf(stderr, "kernel_launch: hipFuncSetAttribute failed\n"); grid = -1; return; }
        if (hipOccupancyMaxActiveBlocksPerMultiprocessor(&per_cu, (const void*)fwd_kernel, NWAVES * 64, LDS_BYTES) != hipSuccess || per_cu < 1) { fprintf(stderr, "kernel_launch: occupancy query reports %d blocks per CU\n", per_cu); (void)hipGetLastError(); grid = -1; return; }
        grid = cus;
    }
    if (grid < 0) return;
    (void)hipMemsetAsync((char*)d_ws + WS_CTL, 0, CTL_ZERO_BYTES, stream);
    Args a{};
    for (int i = 0; i < 15; ++i) a.in[i] = (const float*)d_in[i];
    a.out = (float*)d_out; a.ws = (unsigned char*)d_ws;
#if MK_N_LAUNCHES == 1
    a.ph_lo = 0; a.ph_hi = N_PHASES;
    hipLaunchKernelGGL(fwd_kernel, dim3(grid), dim3(NWAVES * 64), LDS_BYTES, stream, a);
#else
#ifdef DBG_STOP
    for (int p = 0; p <= DBG_STOP; ++p) { a.ph_lo = p; a.ph_hi = p + 1; hipLaunchKernelGGL(fwd_kernel, dim3(grid), dim3(NWAVES * 64), LDS_BYTES, stream, a); }
    { const size_t offs[4] = {DBG_OFFS}; hipLaunchKernelGGL(dbg_dump, dim3(2048), dim3(256), 0, stream, (const unsigned char*)d_ws, (float*)d_out, offs[0], offs[1], offs[2], offs[3], DBG_NOFF, DBG_F32); }
#else
    for (int p = 0; p < N_PHASES; ++p) { a.ph_lo = p; a.ph_hi = p + 1; hipLaunchKernelGGL(fwd_kernel, dim3(grid), dim3(NWAVES * 64), LDS_BYTES, stream, a); }
#endif
#endif
}
```

```cpp
#include <hip/hip_runtime.h>
#include <cstdio>
#include <cstdint>

#ifndef MK_N_LAUNCHES
#define MK_N_LAUNCHES 1
#endif

namespace pg8 {
#define PG8_LAS __attribute__((address_space(3)))
typedef unsigned short bf16_t;
typedef short bf16x8 __attribute__((ext_vector_type(8)));
typedef float f32x4 __attribute__((ext_vector_type(4)));
typedef unsigned u32x4 __attribute__((ext_vector_type(4)));
typedef unsigned u32x2 __attribute__((ext_vector_type(2)));
constexpr int BM = 256, BK = 64, HALF = 128, HTB = HALF * BK * 2  , STAGE_BYTES = 8 * HTB, NXCD = 8, WGM = 8;

__host__ __device__ __forceinline__ int lds_byte(int r, int c) { const int st = (r >> 4) * 2 + (c >> 5), rr = r & 15, cc = c & 31, ob = rr * 64 + cc * 2; return st * 1024 + (ob ^ (((ob >> 9) & 1) << 5)); }
__host__ __device__ __forceinline__ void stage_rc(int b, int& R, int& C) { const int st = b / 1024, sb = b % 1024, swz = sb ^ (((sb >> 9) & 1) << 5); R = (st >> 1) * 16 + swz / 64; C = (st & 1) * 32 + (swz % 64) / 2; }
__host__ __device__ __forceinline__ int perm32(int rho) { const int n = rho >> 4, i = rho & 15; return 8 * (i >> 2) + 4 * n + (i & 3); }

struct Unit { int pm, pn; };
struct Gemm { const bf16_t* A; const bf16_t* Bt; int M, N, K, lda; };

struct StaticOrder {
    int nM, nN, nwg, G, c;
    __host__ __device__ void init(int M, int N, int G_, int c_) { nM = M / BM; nN = N / BM; nwg = nM * nN; G = G_; c = c_; }
    __host__ __device__ bool next(int i, Unit& u) const {
        const long L = (long)i * G + c; if (L >= nwg) return false;
        int wgid = (int)L; { const int q = nwg / NXCD, r = nwg % NXCD, xcd = wgid % NXCD, off = wgid / NXCD; wgid = (xcd < r ? xcd * (q + 1) : r * (q + 1) + (xcd - r) * q) + off; }
        const int nig = WGM * nN, gid = wgid / nig, fm = gid * WGM, gsz = (nM - fm) < WGM ? (nM - fm) : WGM;
        u.pm = fm + ((wgid % nig) % gsz); u.pn = (wgid % nig) / gsz; return true;
    }
    __device__ __forceinline__ void a_ready(const Unit&) const {}
    __device__ __forceinline__ void done(const Unit&) const {}
};

typedef float f32x2_t __attribute__((ext_vector_type(2))); typedef __bf16 bf16x2_t __attribute__((ext_vector_type(2)));
__device__ __forceinline__ unsigned cvt_pk_bf16(float lo, float hi) { f32x2_t v = {lo, hi}; bf16x2_t b = __builtin_convertvector(v, bf16x2_t); return __builtin_bit_cast(unsigned, b); }
__device__ __forceinline__ float bf_lo(unsigned w) { return __uint_as_float(w << 16); }
__device__ __forceinline__ float bf_hi(unsigned w) { return __uint_as_float(w & 0xffff0000u); }

__device__ __forceinline__ void wave_rstd(const float* part, int Mrows, int rowbase, int lane, float eps, float (&rs)[2]) {
#pragma unroll
    for (int ai = 0; ai < 2; ++ai) { const float* p = part + rowbase + ai * HALF + lane; float s = 0.f;
#pragma unroll
        for (int t = 0; t < 16; ++t) s += p[(size_t)t * Mrows];
        rs[ai] = 1.0f / sqrtf(s * (1.0f / 1024.0f) + eps); }
}

template <int MODE, class CFG> struct EpiB {
    static constexpr bool PERM = true, AFTER_DRAIN = false;
    bf16_t* O;
    const float* part;
    const bf16_t* X1; const bf16_t* X2;
    static constexpr int Mrows = 16384, ldx = 1024; static constexpr float eps = 1e-6f;
    __device__ __forceinline__ void operator()(const f32x4 (&acc)[2][2][4][2], const Unit& u, int wr, int wc, int fr, int fq) const {
        const int lane = fr + 16 * fq;
        long boff = 0; int ldc = CFG::ld0, sst = 0;
        if (u.pn >= CFG::st1) { boff = CFG::off1; ldc = CFG::ld1; sst = CFG::st1; }
        if (u.pn >= CFG::st2) { boff = CFG::off2; sst = CFG::st2; }
        if (u.pn >= CFG::st3) { boff = CFG::off3; sst = CFG::st3; }
        bf16_t* base = (bf16_t*)((char*)O + boff);
        const int col0 = (u.pn - sst) * BM + wc * 32 + 8 * fq;
        const int row0 = u.pm * BM + wr * 64 + fr;
        float rs[2] = {1.f, 1.f};
        if (MODE <= 1) wave_rstd(part, Mrows, u.pm * BM + wr * 64, lane, eps, rs);
#pragma unroll
        for (int ai = 0; ai < 2; ++ai)
#pragma unroll
            for (int m = 0; m < 4; ++m) {
                const int row = row0 + ai * HALF + m * 16;
                float r = 1.f; if (MODE <= 1) r = __shfl(rs[ai], m * 16 + fr);
                bf16_t* rowp = base + (size_t)row * ldc + col0;
#pragma unroll
                for (int bj = 0; bj < 2; ++bj) {
                    f32x4 v0 = acc[ai][bj][m][0], v1 = acc[ai][bj][m][1];
                    if (MODE <= 1) { v0 = v0 * r; v1 = v1 * r; }
                    if (MODE == 1) {
#pragma unroll
                        for (int e = 0; e < 4; ++e) { v0[e] = __builtin_amdgcn_rcpf(1.0f + __expf(-v0[e])); v1[e] = __builtin_amdgcn_rcpf(1.0f + __expf(-v1[e])); }
                    }
                    if (MODE == 2) {
                        const u32x4 x = *(const u32x4*)(X1 + (size_t)row * ldx + col0 + bj * HALF);
                        v0[0] *= bf_lo(x.x); v0[1] *= bf_hi(x.x); v0[2] *= bf_lo(x.y); v0[3] *= bf_hi(x.y);
                        v1[0] *= bf_lo(x.z); v1[1] *= bf_hi(x.z); v1[2] *= bf_lo(x.w); v1[3] *= bf_hi(x.w);
                    }
                    if (MODE == 3) {
                        const u32x4 x = *(const u32x4*)(X1 + (size_t)row * ldx + col0 + bj * HALF);
                        const u32x4 y = *(const u32x4*)(X2 + (size_t)row * ldx + col0 + bj * HALF);
                        v0[0] = bf_lo(x.x) + v0[0] * bf_lo(y.x); v0[1] = bf_hi(x.x) + v0[1] * bf_hi(y.x); v0[2] = bf_lo(x.y) + v0[2] * bf_lo(y.y); v0[3] = bf_hi(x.y) + v0[3] * bf_hi(y.y);
                        v1[0] = bf_lo(x.z) + v1[0] * bf_lo(y.z); v1[1] = bf_hi(x.z) + v1[1] * bf_hi(y.z); v1[2] = bf_lo(x.w) + v1[2] * bf_lo(y.w); v1[3] = bf_hi(x.w) + v1[3] * bf_hi(y.w);
                    }
                    u32x4 w; w.x = cvt_pk_bf16(v0[0], v0[1]); w.y = cvt_pk_bf16(v0[2], v0[3]); w.z = cvt_pk_bf16(v1[0], v1[1]); w.w = cvt_pk_bf16(v1[2], v1[3]);
                    *(u32x4*)(rowp + bj * HALF) = w;
                }
                if (MODE >= 2) asm volatile("" ::: "memory");
            }
    }
};

struct EpiRes {
    static constexpr bool PERM = false, AFTER_DRAIN = false;
    const float* base; float* out; bf16_t* hb; float* part; int Mrows;
    __device__ __forceinline__ void operator()(const f32x4 (&acc)[2][2][4][2], const Unit& u, int wr, int wc, int fr, int fq) const {
        const int col0 = u.pn * BM + wc * 32 + 4 * fq;
#pragma unroll
        for (int ai = 0; ai < 2; ++ai)
#pragma unroll
            for (int m = 0; m < 4; ++m) {
                const int row = u.pm * BM + ai * HALF + wr * 64 + m * 16 + fr; const size_t off = (size_t)row * 1024 + col0;
                float ss = 0.f;
#pragma unroll
                for (int bj = 0; bj < 2; ++bj)
#pragma unroll
                    for (int n = 0; n < 2; ++n) {
                        const f32x4 bs = *(const f32x4*)(base + off + bj * HALF + n * 16);
                        const f32x4 o = bs + acc[ai][bj][m][n];
                        *(f32x4*)(out + off + bj * HALF + n * 16) = o;
                        u32x2 w; w.x = cvt_pk_bf16(o[0], o[1]); w.y = cvt_pk_bf16(o[2], o[3]);
                        *(u32x2*)(hb + off + bj * HALF + n * 16) = w;
                        ss += (o[0] * o[0] + o[1] * o[1]) + (o[2] * o[2] + o[3] * o[3]);
                    }
                ss += __shfl_xor(ss, 16); ss += __shfl_xor(ss, 32);
                if (fq == 0) part[(size_t)(u.pn * 4 + wc) * Mrows + row] = ss;
                asm volatile("" ::: "memory");
            }
    }
};

template <class Epi, int GN, int GK, int GLDA, bool ALIGN_EPI = false, bool SP2 = false>
__device__ __forceinline__ void gemm_phase(PG8_LAS unsigned char* lds, const bf16_t* gA, const bf16_t* gBt, int G_, int c_, const Epi& E) {
    struct { const bf16_t* A; const bf16_t* Bt; int K, lda; } g{gA, gBt, GK, GLDA};
    StaticOrder S; S.nM = 16384 / BM; S.nN = GN / BM; S.nwg = S.nM * S.nN; S.G = G_; S.c = c_;
    int tid_ = threadIdx.x; asm volatile("" : "+v"(tid_));
    const int tid = tid_, wid = __builtin_amdgcn_readfirstlane(tid >> 6), lane = tid & 63, wr = wid >> 2, wc = wid & 3, fr = lane & 15, fq = lane >> 4;
    const int K = g.K, nt = K / BK, lda = g.lda;
    unsigned voffA[2], voffB[2];
#pragma unroll
    for (int i = 0; i < 2; ++i) { int R, C; stage_rc(tid * 16 + i * 8192, R, C); const int Rb = Epi::PERM ? ((R & ~31) + perm32(R & 31)) : R;
        voffA[i] = (unsigned)(R * lda + C) * 2u; voffB[i] = (unsigned)(Rb * K + C) * 2u; }
    const size_t kstep = (size_t)(BK * 2);
    const size_t hstepA = (size_t)HALF * lda * 2, hstepB = (size_t)HALF * K * 2;
    const size_t tstepA = 2 * hstepA, tstepB = 2 * hstepB;
    const unsigned ldsw = (unsigned)wid * 1024u;
    const int aoff = lds_byte(wr * 64 + fr, fq * 8), boff = lds_byte(wc * 32 + fr, fq * 8);
#define PG8_SA(b, h) (((b) * 2 + (h)) * HTB)
#define PG8_SB(b, h) ((4 + (b) * 2 + (h)) * HTB)
#define PG8_STAGE(bufoff, gbase, voff) do { _Pragma("unroll") for (int _i = 0; _i < 2; ++_i) \
        __builtin_amdgcn_global_load_lds((const unsigned*)((const char*)(gbase) + (voff)[_i]), (PG8_LAS unsigned*)(lds + (bufoff) + ldsw + _i * 8192), 16, 0, 0); } while (0)
#define PG8_LDA(dst, b, h) do { _Pragma("unroll") for (int m = 0; m < 4; ++m) _Pragma("unroll") for (int k = 0; k < 2; ++k) dst[m][k] = *(const PG8_LAS bf16x8*)(lds + PG8_SA(b, h) + aoff + m * 2048 + k * 1024); } while (0)
#define PG8_LDB(dst, b, h) do { _Pragma("unroll") for (int n = 0; n < 2; ++n) _Pragma("unroll") for (int k = 0; k < 2; ++k) dst[n][k] = *(const PG8_LAS bf16x8*)(lds + PG8_SB(b, h) + boff + n * 2048 + k * 1024); } while (0)
#define PG8_MMA(ai, bj, At, Bt) do { __builtin_amdgcn_s_setprio(1); _Pragma("unroll") for (int m = 0; m < 4; ++m) _Pragma("unroll") for (int n = 0; n < 2; ++n) _Pragma("unroll") for (int k = 0; k < 2; ++k) \
        acc[ai][bj][m][n] = __builtin_amdgcn_mfma_f32_16x16x32_bf16(Bt[n][k], At[m][k], acc[ai][bj][m][n], 0, 0, 0); __builtin_amdgcn_s_setprio(0); } while (0)
#define PG8_WAIT_V(n) asm volatile("s_waitcnt vmcnt(" #n ")" ::: "memory")
#define PG8_WAIT_L(n) asm volatile("s_waitcnt lgkmcnt(" #n ")" ::: "memory")
#define PG8_BAR __builtin_amdgcn_s_barrier()
#define PG8_SCHED __builtin_amdgcn_sched_barrier(0)
    Unit cur, nxt; int ui = 0;
    if (!S.next(0, cur)) return;
    f32x4 acc[2][2][4][2];
#pragma unroll
    for (int a = 0; a < 2; ++a)
#pragma unroll
        for (int b = 0; b < 2; ++b)
#pragma unroll
            for (int m = 0; m < 4; ++m)
#pragma unroll
                for (int n = 0; n < 2; ++n) acc[a][b][m][n] = (f32x4){0.f, 0.f, 0.f, 0.f};
    bf16x8 At[4][2], B0[2][2], B1[2][2];
    const char* cA = (const char*)g.A + (size_t)cur.pm * tstepA; const char* cB = (const char*)g.Bt + (size_t)cur.pn * tstepB;
    S.a_ready(cur);
    if constexpr (SP2) {
        PG8_STAGE(PG8_SB(0, 0), cB, voffB); PG8_STAGE(PG8_SB(0, 1), cB + hstepB, voffB); PG8_STAGE(PG8_SA(0, 0), cA, voffA); PG8_STAGE(PG8_SA(0, 1), cA + hstepA, voffA);
        if (wr == 1) PG8_BAR;
        PG8_WAIT_V(2); PG8_BAR;
        PG8_STAGE(PG8_SB(1, 0), cB + kstep, voffB); PG8_STAGE(PG8_SA(1, 0), cA + kstep, voffA); PG8_STAGE(PG8_SB(1, 1), cB + hstepB + kstep, voffB);
        PG8_WAIT_V(6); PG8_BAR;
    } else {
        PG8_STAGE(PG8_SB(0, 0), cB, voffB); PG8_STAGE(PG8_SA(0, 0), cA, voffA); PG8_STAGE(PG8_SB(0, 1), cB + hstepB, voffB); PG8_STAGE(PG8_SA(0, 1), cA + hstepA, voffA);
        if (wr == 1) PG8_BAR;
        PG8_WAIT_V(4); PG8_BAR;
        PG8_STAGE(PG8_SB(1, 0), cB + kstep, voffB); PG8_STAGE(PG8_SA(1, 0), cA + kstep, voffA); PG8_STAGE(PG8_SB(1, 1), cB + hstepB + kstep, voffB);
        PG8_WAIT_V(6); PG8_BAR;
    }
    for (;;) {
        const bool has_next = S.next(ui + 1, nxt);
        const char* nA = has_next ? (const char*)g.A + (size_t)nxt.pm * tstepA : cA; const char* nB = has_next ? (const char*)g.Bt + (size_t)nxt.pn * tstepB : cB;
        for (int t = 0; t < nt; t += 2) {
            const bool last = (t == nt - 2);
            const char* a1 = cA + (size_t)(t + 1) * kstep;
            const char* a2 = last ? nA : cA + (size_t)(t + 2) * kstep; const char* b2 = last ? nB : cB + (size_t)(t + 2) * kstep;
            const char* a3 = a2 + kstep; const char* b3 = b2 + kstep;
            if (last && has_next) S.a_ready(nxt);
            if constexpr (SP2) {
            PG8_LDB(B0, 0, 0); PG8_LDB(B1, 0, 1); PG8_SCHED; PG8_LDA(At, 0, 0); PG8_STAGE(PG8_SA(1, 1), a1 + hstepA, voffA);
            PG8_WAIT_V(8); PG8_WAIT_L(0); PG8_BAR; PG8_MMA(0, 0, At, B0); PG8_MMA(0, 1, At, B1); PG8_BAR; PG8_SCHED;
            PG8_LDA(At, 0, 1); PG8_STAGE(PG8_SB(0, 0), b2, voffB); PG8_STAGE(PG8_SB(0, 1), b2 + hstepB, voffB); PG8_STAGE(PG8_SA(0, 0), a2, voffA);
            PG8_WAIT_V(8); PG8_WAIT_L(0); PG8_BAR; PG8_MMA(1, 0, At, B0); PG8_MMA(1, 1, At, B1); PG8_BAR; PG8_SCHED;
            PG8_LDB(B0, 1, 0); PG8_LDB(B1, 1, 1); PG8_SCHED; PG8_LDA(At, 1, 0); PG8_STAGE(PG8_SA(0, 1), a2 + hstepA, voffA);
            PG8_WAIT_V(8); PG8_WAIT_L(0); PG8_BAR; PG8_MMA(0, 0, At, B0); PG8_MMA(0, 1, At, B1); PG8_BAR; PG8_SCHED;
            PG8_LDA(At, 1, 1); PG8_STAGE(PG8_SB(1, 0), b3, voffB); PG8_STAGE(PG8_SB(1, 1), b3 + hstepB, voffB); PG8_STAGE(PG8_SA(1, 0), a3, voffA);
            PG8_WAIT_V(8); PG8_WAIT_L(0); PG8_BAR; PG8_MMA(1, 0, At, B0); PG8_MMA(1, 1, At, B1); PG8_BAR; PG8_SCHED;
            } else {
            PG8_LDB(B0, 0, 0); PG8_SCHED; PG8_LDA(At, 0, 0); PG8_STAGE(PG8_SA(1, 1), a1 + hstepA, voffA);
            PG8_WAIT_L(8); PG8_BAR; PG8_WAIT_L(0); PG8_MMA(0, 0, At, B0); PG8_BAR; PG8_SCHED;
            PG8_LDB(B1, 0, 1); PG8_STAGE(PG8_SB(0, 0), b2, voffB);
            PG8_BAR; PG8_WAIT_L(0); PG8_MMA(0, 1, At, B1); PG8_BAR;
            PG8_LDA(At, 0, 1); PG8_STAGE(PG8_SA(0, 0), a2, voffA);
            PG8_BAR; PG8_WAIT_L(0); PG8_MMA(1, 0, At, B0); PG8_BAR; PG8_SCHED;
            PG8_STAGE(PG8_SB(0, 1), b2 + hstepB, voffB);
            PG8_WAIT_V(6); PG8_BAR; PG8_MMA(1, 1, At, B1); PG8_BAR;
            PG8_LDB(B0, 1, 0); PG8_SCHED; PG8_LDA(At, 1, 0); PG8_STAGE(PG8_SA(0, 1), a2 + hstepA, voffA);
            PG8_WAIT_L(8); PG8_BAR; PG8_WAIT_L(0); PG8_MMA(0, 0, At, B0); PG8_BAR; PG8_SCHED;
            PG8_LDB(B1, 1, 1); PG8_STAGE(PG8_SB(1, 0), b3, voffB);
            PG8_BAR; PG8_WAIT_L(0); PG8_MMA(0, 1, At, B1); PG8_BAR;
            PG8_LDA(At, 1, 1); PG8_STAGE(PG8_SA(1, 0), a3, voffA);
            PG8_BAR; PG8_WAIT_L(0); PG8_MMA(1, 0, At, B0); PG8_BAR; PG8_SCHED;
            PG8_STAGE(PG8_SB(1, 1), b3 + hstepB, voffB);
            PG8_WAIT_V(6); PG8_BAR; PG8_MMA(1, 1, At, B1); PG8_BAR;
            }
        }
        if constexpr (ALIGN_EPI) { if (wr == 0) PG8_BAR; }
        if constexpr (!Epi::AFTER_DRAIN) { E(acc, cur, wr, wc, fr, fq); S.done(cur); }
        if (!has_next) break;
#pragma unroll
        for (int a = 0; a < 2; ++a)
#pragma unroll
            for (int b = 0; b < 2; ++b)
#pragma unroll
                for (int m = 0; m < 4; ++m)
#pragma unroll
                    for (int n = 0; n < 2; ++n) acc[a][b][m][n] = (f32x4){0.f, 0.f, 0.f, 0.f};
        cur = nxt; cA = nA; cB = nB; ++ui;
        if constexpr (ALIGN_EPI) { if (wr == 1) PG8_BAR; }
    }
    PG8_WAIT_V(0);
    if constexpr (!ALIGN_EPI) { if (wr == 0) PG8_BAR; }
    PG8_BAR;
#undef PG8_SA
#undef PG8_SB
#undef PG8_STAGE
#undef PG8_LDA
#undef PG8_LDB
#undef PG8_MMA
#undef PG8_WAIT_V
#undef PG8_WAIT_L
#undef PG8_BAR
#undef PG8_SCHED
}
}

#ifndef PG8_SP2
#define PG8_SP2 true
#endif
#ifndef PG8_ALIGN
#define PG8_ALIGN true
#endif

constexpr int NWAVES = 8;
constexpr int BATCH = 8, S = 2048, D = 1024, DEPTH = 2;
constexpr int M = BATCH * S;
constexpr int NIN = 7680, NUQKV = 5632, NGATE = 2048, AW = 1536, AO = 512, DFF = 2816, NUP = 5632, HD = 128;
constexpr float EPS = 1e-6f;
constexpr int N_PHASES = 2 + 10 * DEPTH;

constexpr size_t MiB = 1u << 20;
constexpr size_t WS_CTL = 0, CTL_ZERO_BYTES = 64 * 1024;
constexpr size_t WS_PART = 1 * MiB;
constexpr size_t WS_LSE = 2 * MiB;
constexpr size_t WS_W = 4 * MiB;
constexpr size_t WO_WIN = 0, WO_WC = 15 * MiB, WO_WB = 17 * MiB, WO_WO = 18 * MiB, WO_WUP = 20 * MiB, WO_WDN = 31 * MiB, WDN_BYTES = (size_t)D * DFF * 2;
constexpr size_t WS_HB = 46 * MiB;
constexpr size_t WS_Y = 78 * MiB;
constexpr size_t Y_U = 0, Y_Q = 32 * MiB, Y_K = 80 * MiB, Y_V = 128 * MiB;
constexpr size_t WS_END = 254 * MiB;
static_assert(WO_WDN + 2 * WDN_BYTES <= 42 * MiB && WS_W + 42 * MiB <= WS_HB && WS_HB + 32 * MiB <= WS_Y && WS_Y + 176 * MiB <= WS_END, "d_ws map");
constexpr int CW_BAR = 1024;

constexpr int RING_OFF = 0, RING_BYTES = 131072;
constexpr int LDSCTL_OFF = RING_BYTES, MISC_OFF = LDSCTL_OFF + 320;
constexpr int LDS_BYTES = 147456;

#define GAS __attribute__((address_space(1)))
#define LAS __attribute__((address_space(3)))
typedef unsigned short bf16;
typedef unsigned v4u __attribute__((ext_vector_type(4)));
typedef unsigned v2u __attribute__((ext_vector_type(2)));
typedef float f32x4 __attribute__((ext_vector_type(4)));
typedef GAS unsigned gu32;
#define RLX_AGENT __ATOMIC_RELAXED, __HIP_MEMORY_SCOPE_AGENT
#define LDS_WAIT() asm volatile("s_waitcnt lgkmcnt(0)" ::: "memory")
#define VM_WAIT() asm volatile("s_waitcnt vmcnt(0)" ::: "memory")
__device__ __forceinline__ unsigned f2bf(float f) { unsigned u = __builtin_bit_cast(unsigned, f); return (u + 0x7fffu + ((u >> 16) & 1u)) >> 16; }
__device__ __forceinline__ unsigned pk2(float lo, float hi) { return f2bf(lo) | (f2bf(hi) << 16); }
__device__ __forceinline__ float bflo(unsigned w) { return __uint_as_float(w << 16); }
__device__ __forceinline__ float bfhi(unsigned w) { return __uint_as_float(w & 0xffff0000u); }

#define XB_TMO      128
#define XB_XCNT(j)  (256  + 64 * (j))
#define XB_XSUB(j)  (1280 + 64 * (j))
#define XB_XGEN(j)  (2304 + 64 * (j))
#define XB_TOP      3328
#define XB_TOPGEN   3392
#define XCD_BAR_WORDS 3456
#define XB_SPIN_CAP (1u << 18)
static_assert((CW_BAR + XCD_BAR_WORDS) * 4 <= (int)CTL_ZERO_BYTES, "barrier words inside the zeroed region");

__device__ __forceinline__ unsigned xb_ld(unsigned* p)              { return __hip_atomic_load(p, __ATOMIC_RELAXED, __HIP_MEMORY_SCOPE_AGENT); }
__device__ __forceinline__ unsigned xb_add(unsigned* p, unsigned v) { return __hip_atomic_fetch_add(p, v, __ATOMIC_RELAXED, __HIP_MEMORY_SCOPE_AGENT); }
__device__ __forceinline__ unsigned xb_xcc_id() { return (unsigned)__builtin_amdgcn_s_getreg((3 << 11) | 20) & 0xFu; }
#define XB_SPIN(cond, bar) do { unsigned _sp = 0; while (cond) { __builtin_amdgcn_s_sleep(1); \
    if ((++_sp & 255u) == 0u) { if (xb_ld(&(bar)[XB_TMO])) break; if (_sp > XB_SPIN_CAP) { atomicAdd(&(bar)[XB_TMO], 1u); break; } } } } while (0)

struct XcdBarrier { unsigned* bar; unsigned x; volatile LAS unsigned* st; };

__device__ __forceinline__ XcdBarrier xcd_barrier_post(unsigned* bar, volatile LAS unsigned* st) {
    XcdBarrier b; b.bar = bar; b.x = xb_xcc_id(); b.st = st;
    if (threadIdx.x == 0) (void)xb_add(&bar[XB_XCNT(b.x)], 1u);
    return b;
}
__device__ __forceinline__ void xcd_barrier_complete(unsigned* bar, unsigned x, unsigned& nloc, unsigned& nx) {
    const unsigned G = gridDim.x * gridDim.y * gridDim.z;
    unsigned sum, cnt, mine, sp = 0u;
    for (;;) {
        sum = 0u; cnt = 0u; mine = 0u;
#pragma unroll
        for (unsigned j = 0; j < 16; ++j) { const unsigned c = xb_ld(&bar[XB_XCNT(j)]); sum += c; cnt += (c > 0u) ? 1u : 0u; mine = (j == x) ? c : mine; }
        if (sum == G) break;
        __builtin_amdgcn_s_sleep(1);
        if ((++sp & 255u) == 0u) { if (xb_ld(&bar[XB_TMO])) break; if (sp > XB_SPIN_CAP) { atomicAdd(&bar[XB_TMO], 1u); break; } }
    }
    nloc = mine > 0u ? mine : 1u; nx = cnt > 0u ? cnt : 1u;
}
__device__ __forceinline__ void xcd_barrier(const XcdBarrier& b) {
    asm volatile("s_waitcnt vmcnt(0)" ::: "memory");
    __syncthreads();
    if (threadIdx.x == 0) {
        unsigned* bar = b.bar; unsigned bx_ = b.x; asm volatile("" : "+s"(bar), "+s"(bx_));
        __builtin_amdgcn_s_waitcnt(0);
        unsigned nloc = b.st[0], nx = b.st[1];
        if (nloc == 0u) { xcd_barrier_complete(bar, bx_, nloc, nx); b.st[0] = nloc; b.st[1] = nx; }
        const unsigned old = xb_add(&bar[XB_XSUB(bx_)], 1u);
        const unsigned gen = old / nloc;
        if (old + 1u == (gen + 1u) * nloc) {
            __builtin_amdgcn_fence(__ATOMIC_RELEASE, "agent");
            asm volatile("s_waitcnt vmcnt(0)" ::: "memory");
            const unsigned og = xb_add(&bar[XB_TOP], 1u);
            const unsigned tg = og / nx;
            if (og + 1u == (tg + 1u) * nx) xb_add(&bar[XB_TOPGEN], 1u);
            else XB_SPIN(xb_ld(&bar[XB_TOPGEN]) == tg, bar);
            __builtin_amdgcn_fence(__ATOMIC_ACQUIRE, "agent");
            xb_add(&bar[XB_XGEN(bx_)], 1u);
            asm volatile("s_waitcnt vmcnt(0)" ::: "memory");
        } else {
            XB_SPIN(xb_ld(&bar[XB_XGEN(bx_)]) == gen, bar);
            __builtin_amdgcn_fence(__ATOMIC_ACQUIRE, "agent");
            asm volatile("s_waitcnt vmcnt(0)" ::: "memory");
        }
    }
    __syncthreads();
}

struct Frame {
    LAS unsigned char* lds;
    volatile LAS unsigned* MISC;
    gu32* ctl;
    int tid, lane, wave;
    int vcu, G;
    int gw, NGW;
    unsigned char* ws;
    const float* const* in; float* out;
};

__device__ __forceinline__ float wave_sum(float v) {
#pragma unroll
    for (int o = 1; o < 64; o <<= 1) v += __shfl_xor(v, o);
    return v;
}
__device__ __forceinline__ float wave_max(float v) {
#pragma unroll
    for (int o = 1; o < 64; o <<= 1) v = fmaxf(v, __shfl_xor(v, o));
    return v;
}

__device__ __forceinline__ void p0_transpose_item(const float* W, const float* gain, int K, int N, bf16* WT, LAS float* scr, int item, int lane) {
    const int nblk = N / 32, kb = item / nblk, nb = item % nblk, k0 = 64 * kb, n0 = 32 * nb;
#pragma unroll 8
    for (int i = 0; i < 32; ++i) { const int kk = 2 * i + (lane >> 5); const float gsc = gain ? gain[k0 + kk] : 1.0f; scr[kk * 33 + (lane & 31)] = W[(size_t)(k0 + kk) * N + n0 + (lane & 31)] * gsc; }
    LDS_WAIT(); asm volatile("" ::: "memory");
    const int c = lane & 7;
#pragma unroll
    for (int j = 0; j < 4; ++j) { const int n = (lane >> 3) + 8 * j; const LAS float* s = scr + (8 * c) * 33 + n;
        v4u o; o.x = pk2(s[0 * 33], s[1 * 33]); o.y = pk2(s[2 * 33], s[3 * 33]); o.z = pk2(s[4 * 33], s[5 * 33]); o.w = pk2(s[6 * 33], s[7 * 33]);
        *(GAS v4u*)(WT + (size_t)(n0 + n) * K + k0 + 8 * c) = o; }
    LDS_WAIT(); asm volatile("" ::: "memory");
}

__device__ __forceinline__ void convert_weights(Frame& F, int l, bool with_down) {
    LAS float* scr = (LAS float*)(F.lds + RING_OFF + F.wave * 16384);
    unsigned char* wb = F.ws + WS_W;
    const float* w_in = F.in[1] + (size_t)l * D * NIN; const float* w_b = F.in[5] + (size_t)l * AO * D; const float* w_o = F.in[6] + (size_t)l * D * D;
    const float* w_up = F.in[9] + (size_t)l * D * NUP; const float* n1 = F.in[7] + (size_t)l * D; const float* n2 = F.in[8] + (size_t)l * D;
    constexpr int I_IN = (D / 64) * (NIN / 32), I_B = (AO / 64) * (D / 32), I_O = (D / 64) * (D / 32), I_UP = (D / 64) * (NUP / 32), I_DN = (DFF / 64) * (D / 32);
    const int nitems = I_IN + I_B + I_O + I_UP + (with_down ? 2 * I_DN : 0);
    for (int it = F.gw; it < nitems; it += F.NGW) {
        int r = it;
        if (r < I_IN) { p0_transpose_item(w_in, n1, D, NIN, (bf16*)(wb + WO_WIN), scr, r, F.lane); continue; } r -= I_IN;
        if (r < I_B) { p0_transpose_item(w_b, nullptr, AO, D, (bf16*)(wb + WO_WB), scr, r, F.lane); continue; } r -= I_B;
        if (r < I_O) { p0_transpose_item(w_o, nullptr, D, D, (bf16*)(wb + WO_WO), scr, r, F.lane); continue; } r -= I_O;
        if (r < I_UP) { p0_transpose_item(w_up, n2, D, NUP, (bf16*)(wb + WO_WUP), scr, r, F.lane); continue; } r -= I_UP;
        const int ll = r / I_DN; r -= ll * I_DN;
        p0_transpose_item(F.in[12] + (size_t)ll * DFF * D, nullptr, DFF, D, (bf16*)(wb + WO_WDN + ll * WDN_BYTES), scr, r, F.lane);
    }
    const float* w_pool = F.in[2] + (size_t)l * 4 * 256 * 256; const float* ps = F.in[3] + (size_t)l * D; const float* w_a = F.in[4] + (size_t)l * D * D;
    bf16* Wc = (bf16*)(wb + WO_WC);
    LAS float* As = (LAS float*)(F.lds + RING_OFF);
    LAS float* Bs = (LAS float*)(F.lds + RING_OFF + 64 * 129 * 4);
    __syncthreads();
    for (int tile = F.vcu; tile < 4 * 4 * 16; tile += F.G) {
        const int g = tile >> 6, cb = (tile >> 4) & 3, nb = tile & 15, c0 = cb * 64, n0 = nb * 64;
        float acc[8];
#pragma unroll
        for (int e = 0; e < 8; ++e) acc[e] = 0.f;
        for (int dc = 0; dc < 2; ++dc) {
            const int d0 = dc * 128;
            for (int i = F.tid; i < 64 * 128; i += NWAVES * 64) { const int c = i >> 7, d = i & 127; As[c * 129 + d] = w_pool[((size_t)g * 256 + c0 + c) * 256 + d0 + d] * ps[g * 256 + d0 + d]; }
            for (int i = F.tid; i < 128 * 64; i += NWAVES * 64) { const int d = i >> 6, n = i & 63; Bs[d * 65 + n] = w_a[(size_t)(g * 256 + d0 + d) * D + n0 + n]; }
            __syncthreads();
            const LAS float* ap = As + (F.wave * 8) * 129; const LAS float* bp = Bs + F.lane;
#pragma unroll 4
            for (int d = 0; d < 128; ++d) { const float bv = bp[d * 65];
#pragma unroll
                for (int e = 0; e < 8; ++e) acc[e] += ap[e * 129 + d] * bv; }
            __syncthreads();
        }
        v4u o; o.x = pk2(acc[0], acc[1]); o.y = pk2(acc[2], acc[3]); o.z = pk2(acc[4], acc[5]); o.w = pk2(acc[6], acc[7]);
        *(GAS v4u*)(Wc + (size_t)(n0 + F.lane) * D + g * 256 + c0 + F.wave * 8) = o;
    }
}

__device__ __forceinline__ void p0_x_rows(Frame& F) {
    const float* x = F.in[0]; bf16* hb = (bf16*)(F.ws + WS_HB); float* part = (float*)(F.ws + WS_PART);
    for (int m = F.gw; m < M; m += F.NGW) {
        const GAS f32x4* xr = (const GAS f32x4*)(x + (size_t)m * D) + F.lane;
        f32x4 v[4]; float s = 0.f;
#pragma unroll
        for (int j = 0; j < 4; ++j) { v[j] = xr[64 * j]; s += (v[j].x * v[j].x + v[j].y * v[j].y) + (v[j].z * v[j].z + v[j].w * v[j].w); }
        s = wave_sum(s);
        GAS unsigned long long* o8 = (GAS unsigned long long*)(hb + (size_t)m * D) + F.lane;
#pragma unroll
        for (int j = 0; j < 4; ++j) o8[64 * j] = (unsigned long long)pk2(v[j].x, v[j].y) | ((unsigned long long)pk2(v[j].z, v[j].w) << 32);
        if (F.lane < 16) part[(size_t)F.lane * M + m] = (F.lane == 0) ? s : 0.f;
    }
}

__device__ __forceinline__ int t5_bucket(int rel) {
    const int ret = rel > 0 ? 16 : 0; const int n = rel < 0 ? -rel : rel;
    int b;
    if (n < 8) b = n; else if (n < 15) b = 8; else if (n < 27) b = 9; else if (n < 50) b = 10; else if (n < 91) b = 11; else if (n < 166) b = 12; else if (n < 305) b = 13; else if (n < 559) b = 14; else b = 15;
    return ret + b;
}

__device__ __forceinline__ void attn_simple(Frame& F) {
    bf16* Q = (bf16*)(F.ws + WS_Y + Y_Q); const bf16* Kb = (const bf16*)(F.ws + WS_Y + Y_K); const bf16* V = (const bf16*)(F.ws + WS_Y + Y_V);
    const float* rel_bias = F.in[13];
    LAS float* qs = (LAS float*)(F.lds + RING_OFF + F.wave * 2048);
    const int lane = F.lane; const float scale = 0.08838834764831845f;
    for (int item = F.gw; item < M * 4; item += F.NGW) {
        const int tok = item >> 2, h = item & 3, b = tok >> 11, s = tok & (S - 1);
#pragma unroll
        for (int g = 0; g < 3; ++g) { const unsigned w = *(const GAS unsigned*)(Q + (size_t)tok * AW + (g * 4 + h) * HD + 2 * lane); qs[g * 128 + 2 * lane] = bflo(w); qs[g * 128 + 2 * lane + 1] = bfhi(w); }
        LDS_WAIT(); asm volatile("" ::: "memory");
        float mrun = -1e30f, lrun = 0.f, o0 = 0.f, o1 = 0.f;
#pragma unroll 1
        for (int g = 0; g < 3; ++g) {
            const int dl = 1 << (2 * g), head = g * 4 + h;
            float sc[3];
#pragma unroll
            for (int p = 0; p < 3; ++p) {
                const int jj = lane + 64 * p, j = jj - 64, pos = s + dl * j;
                const bool valid = (jj <= 128) && pos >= 0 && pos < S;
                float dot = 0.f;
                if (valid) {
                    const bf16* krow = Kb + ((size_t)b * S + pos) * AW + head * HD;
#pragma unroll 4
                    for (int c = 0; c < 16; ++c) { const v4u kv = *(const GAS v4u*)(krow + 8 * c); const LAS float* qq = qs + g * 128 + 8 * c;
                        dot += bflo(kv.x) * qq[0] + bfhi(kv.x) * qq[1] + bflo(kv.y) * qq[2] + bfhi(kv.y) * qq[3] + bflo(kv.z) * qq[4] + bfhi(kv.z) * qq[5] + bflo(kv.w) * qq[6] + bfhi(kv.w) * qq[7]; }
                }
                const float bias = (jj <= 128) ? rel_bias[t5_bucket(dl * j) * 12 + head] : 0.f;
                sc[p] = valid ? dot * scale + bias : -1e30f;
            }
            const float gmax = wave_max(fmaxf(fmaxf(sc[0], sc[1]), sc[2]));
            const float mnew = fmaxf(mrun, gmax);
            const float alpha = __expf(mrun - mnew);
            float pr[3];
#pragma unroll
            for (int p = 0; p < 3; ++p) pr[p] = (sc[p] > -1e29f) ? __expf(sc[p] - mnew) : 0.f;
            const float psum = wave_sum(pr[0] + pr[1] + pr[2]);
            lrun = lrun * alpha + psum; o0 *= alpha; o1 *= alpha; mrun = mnew;
#pragma unroll 1
            for (int jj = 0; jj <= 128; ++jj) {
                const int pos = s + dl * (jj - 64);
                if (pos < 0 || pos >= S) continue;
                const float pj = __shfl(jj < 64 ? pr[0] : (jj < 128 ? pr[1] : pr[2]), jj & 63);
                const unsigned w = *(const GAS unsigned*)(V + ((size_t)b * S + pos) * AW + head * HD + 2 * lane);
                o0 += pj * bflo(w); o1 += pj * bfhi(w);
            }
        }
        const float inv = 1.0f / lrun;
        *(GAS unsigned*)(Q + (size_t)tok * AW + h * HD + 2 * lane) = pk2(o0 * inv, o1 * inv);
        LDS_WAIT(); asm volatile("" ::: "memory");
    }
}

namespace att {
typedef short bf16x8 __attribute__((ext_vector_type(8)));
typedef short s16x4 __attribute__((ext_vector_type(4)));
typedef float f32x16 __attribute__((ext_vector_type(16)));
__device__ __forceinline__ unsigned off_b(unsigned row, unsigned ch) { return 256u * row + 16u * (ch ^ (((row & 3u) << 2) | ((row >> 2) & 3u))); }
__device__ __forceinline__ s16x4 vtr(const LAS unsigned char* p) { return __builtin_bit_cast(s16x4, __builtin_amdgcn_ds_read_tr16_b64_v4i16((LAS s16x4*)p)); }
constexpr int N_UNITS = BATCH * 3 * 2 * 16;
constexpr int BIAS_OFF = RING_BYTES + 2048;
}
__device__ __forceinline__ void attn_mfma(Frame& F) {
    using namespace att;
    bf16* Q = (bf16*)(F.ws + WS_Y + Y_Q); const bf16* Kg = (const bf16*)(F.ws + WS_Y + Y_K); const bf16* Vg = (const bf16*)(F.ws + WS_Y + Y_V);
    float* LSE = (float*)(F.ws + WS_LSE); const float* rel_bias = F.in[13];
    const int lane = F.lane, wave = F.wave, half = wave >> 2, j = wave & 3, ql = lane & 31, hh = lane >> 5, th = F.tid & 255;
    const float LOG2E = 1.4426950408889634f, CS = 0.08838834764831845f * 1.4426950408889634f;
    LAS unsigned char* hb = F.lds + RING_OFF + half * 65536;
    LAS float* bt = (LAS float*)(F.lds + BIAS_OFF + half * 1024);
    const int nper = (N_UNITS + F.G - 1) / F.G;
    const int u_lo = F.vcu * nper, u_hi = (u_lo + nper < N_UNITS) ? u_lo + nper : N_UNITS;
#pragma unroll 1
    for (int u = u_lo; u < u_hi; ++u) {
        const int t16 = u & 15, rest = u >> 4, hp = rest & 1, g = (rest >> 1) % 3, b = rest / 6;
        const int sh = 2 * g, dl = 1 << sh, L = S >> sh;
        const int r = (g == 0) ? 0 : (g == 1 ? (t16 >> 2) : t16), mt = (g == 0) ? t16 : (g == 1 ? (t16 & 3) : 0), m0 = mt * 128;
        const int hl = hp * 2 + half, hd = g * 4 + hl;
        const size_t tokbase = (size_t)b * S + r;
        { const int jrel = th - 128; float v = 0.f; if (jrel >= -64 && jrel <= 64) v = rel_bias[t5_bucket(dl * jrel) * 12 + hd] * LOG2E; bt[th] = v; }
        const int mq = m0 + 32 * j + ql;
        bf16* qrow = Q + (tokbase + (size_t)dl * mq) * AW + hd * HD;
        bf16x8 qf[8];
#pragma unroll
        for (int s2 = 0; s2 < 8; ++s2) qf[s2] = *(const GAS bf16x8*)(qrow + 16 * s2 + 8 * hh);
        const int kb_lo = (m0 == 0) ? 1 : 0; int kb_hi = (L - 1 - m0 + 64) >> 6; kb_hi = kb_hi > 3 ? 3 : kb_hi;
        v4u kreg[4], vreg[4];
        const int srow = th >> 4, sch = th & 15;
#define ATT_STAGE_LOAD(kb_) do { _Pragma("unroll") for (int i = 0; i < 4; ++i) { const int row = srow + 16 * i, mk = m0 - 64 + 64 * (kb_) + row; const bool ok = (unsigned)mk < (unsigned)L; \
                const size_t off = (tokbase + (size_t)dl * (ok ? mk : 0)) * AW + hd * HD + sch * 8; const v4u z = {0u, 0u, 0u, 0u}; \
                kreg[i] = ok ? *(const GAS v4u*)(Kg + off) : z; vreg[i] = ok ? *(const GAS v4u*)(Vg + off) : z; } } while (0)
#define ATT_STAGE_WRITE(buf_) do { _Pragma("unroll") for (int i = 0; i < 4; ++i) { const unsigned o = off_b((unsigned)(srow + 16 * i), (unsigned)sch); \
                *(LAS v4u*)(hb + (buf_) * 16384 + o) = kreg[i]; *(LAS v4u*)(hb + 32768 + (buf_) * 16384 + o) = vreg[i]; } } while (0)
        float m_run = -1e20f, l_run = 0.f;
        f32x16 O[4];
#pragma unroll
        for (int c = 0; c < 4; ++c)
#pragma unroll
            for (int i = 0; i < 16; ++i) O[c][i] = 0.f;
        ATT_STAGE_LOAD(kb_lo); ATT_STAGE_WRITE(0);
        __syncthreads();
#pragma unroll 1
        for (int kb = kb_lo; kb <= kb_hi; ++kb) {
            const int cur = (kb - kb_lo) & 1;
            if (kb < kb_hi) ATT_STAGE_LOAD(kb + 1);
            if (kb >= (j >> 1) && kb <= (j >> 1) + 2) {
                const LAS unsigned char* kbuf = hb + cur * 16384; const LAS unsigned char* vbuf = hb + 32768 + cur * 16384;
                f32x16 s0, s1;
#pragma unroll
                for (int i = 0; i < 16; ++i) { s0[i] = 0.f; s1[i] = 0.f; }
#pragma unroll
                for (int s2 = 0; s2 < 8; ++s2) {
                    const bf16x8 a0 = *(const LAS bf16x8*)(kbuf + off_b((unsigned)ql, (unsigned)(2 * s2 + hh)));
                    const bf16x8 a1 = *(const LAS bf16x8*)(kbuf + off_b((unsigned)(32 + ql), (unsigned)(2 * s2 + hh)));
                    s0 = __builtin_amdgcn_mfma_f32_32x32x16_bf16(a0, qf[s2], s0, 0, 0, 0);
                    s1 = __builtin_amdgcn_mfma_f32_32x32x16_bf16(a1, qf[s2], s1, 0, 0, 0);
                }
                const int jb = 64 * kb - 64 - 32 * j - ql, mkb = m0 - 64 + 64 * kb;
                float bmax = -1e30f;
#pragma unroll
                for (int i = 0; i < 16; ++i) {
                    const int kr = (i & 3) + 8 * (i >> 2) + 4 * hh;
                    { const int jrel = jb + kr, mk = mkb + kr; const bool ok = (unsigned)(jrel + 64) <= 128u && (unsigned)mk < (unsigned)L;
                      const float t = ok ? fmaf(s0[i], CS, bt[jrel + 128]) : -1e30f; s0[i] = t; bmax = fmaxf(bmax, t); }
                    { const int jrel = jb + 32 + kr, mk = mkb + 32 + kr; const bool ok = (unsigned)(jrel + 64) <= 128u && (unsigned)mk < (unsigned)L;
                      const float t = ok ? fmaf(s1[i], CS, bt[jrel + 128]) : -1e30f; s1[i] = t; bmax = fmaxf(bmax, t); }
                }
                bmax = fmaxf(bmax, __shfl_xor(bmax, 32));
                const float m_new = fmaxf(m_run, bmax), alpha = __builtin_amdgcn_exp2f(m_run - m_new);
                m_run = m_new;
                float psum = 0.f;
#pragma unroll
                for (int i = 0; i < 16; ++i) { s0[i] = __builtin_amdgcn_exp2f(s0[i] - m_new); s1[i] = __builtin_amdgcn_exp2f(s1[i] - m_new); psum += s0[i] + s1[i]; }
                l_run = l_run * alpha + psum;
#pragma unroll
                for (int c = 0; c < 4; ++c)
#pragma unroll
                    for (int i = 0; i < 16; ++i) O[c][i] *= alpha;
                v4u pk[4];
#pragma unroll
                for (int s2 = 0; s2 < 2; ++s2) {
                    pk[s2].x = pg8::cvt_pk_bf16(s0[8 * s2 + 0], s0[8 * s2 + 1]); pk[s2].y = pg8::cvt_pk_bf16(s0[8 * s2 + 2], s0[8 * s2 + 3]);
                    pk[s2].z = pg8::cvt_pk_bf16(s0[8 * s2 + 4], s0[8 * s2 + 5]); pk[s2].w = pg8::cvt_pk_bf16(s0[8 * s2 + 6], s0[8 * s2 + 7]);
                    pk[2 + s2].x = pg8::cvt_pk_bf16(s1[8 * s2 + 0], s1[8 * s2 + 1]); pk[2 + s2].y = pg8::cvt_pk_bf16(s1[8 * s2 + 2], s1[8 * s2 + 3]);
                    pk[2 + s2].z = pg8::cvt_pk_bf16(s1[8 * s2 + 4], s1[8 * s2 + 5]); pk[2 + s2].w = pg8::cvt_pk_bf16(s1[8 * s2 + 6], s1[8 * s2 + 7]);
                }
                const unsigned blk = (lane >> 4) & 1, tq = (lane & 15) >> 2, tp = lane & 3;
#pragma unroll
                for (int ks = 0; ks < 4; ++ks) {
                    const bf16x8 pb = __builtin_bit_cast(bf16x8, pk[ks]);
#pragma unroll
                    for (int c = 0; c < 4; ++c) {
                        const unsigned chn = 4 * c + 2 * blk + (tp >> 1);
                        const s16x4 lo = vtr(vbuf + off_b(16 * ks + 4 * hh + tq, chn) + 8 * (tp & 1));
                        const s16x4 hi = vtr(vbuf + off_b(16 * ks + 8 + 4 * hh + tq, chn) + 8 * (tp & 1));
                        const bf16x8 va = {lo[0], lo[1], lo[2], lo[3], hi[0], hi[1], hi[2], hi[3]};
                        O[c] = __builtin_amdgcn_mfma_f32_32x32x16_bf16(va, pb, O[c], 0, 0, 0);
                    }
                }
            }
            if (kb < kb_hi) ATT_STAGE_WRITE(cur ^ 1);
            __syncthreads();
        }
#undef ATT_STAGE_LOAD
#undef ATT_STAGE_WRITE
        const float l_tot = l_run + __shfl_xor(l_run, 32);
        const float inv = 1.0f / l_tot;
#pragma unroll
        for (int c = 0; c < 4; ++c)
#pragma unroll
            for (int i4 = 0; i4 < 4; ++i4) {
                v2u w; w.x = pg8::cvt_pk_bf16(O[c][4 * i4 + 0] * inv, O[c][4 * i4 + 1] * inv); w.y = pg8::cvt_pk_bf16(O[c][4 * i4 + 2] * inv, O[c][4 * i4 + 3] * inv);
                *(GAS v2u*)(qrow + 32 * c + 8 * i4 + 4 * hh) = w;
            }
        if (hh == 0) LSE[((size_t)g * M + tokbase + (size_t)dl * mq) * 4 + hl] = m_run + __log2f(l_tot);
    }
}

__device__ __forceinline__ void attn_combine(Frame& F) {
    bf16* Q = (bf16*)(F.ws + WS_Y + Y_Q); const float* LSE = (const float*)(F.ws + WS_LSE);
    const int total = M * 64;
    for (int it = F.gw * 64 + F.lane; it < total; it += F.NGW * 64) {
        const int tok = it >> 6, h = (it >> 4) & 3, ch = it & 15;
        const float l0 = LSE[((size_t)0 * M + tok) * 4 + h], l1 = LSE[((size_t)1 * M + tok) * 4 + h], l2 = LSE[((size_t)2 * M + tok) * 4 + h];
        const float mx = fmaxf(l0, fmaxf(l1, l2));
        float w0 = __builtin_amdgcn_exp2f(l0 - mx), w1 = __builtin_amdgcn_exp2f(l1 - mx), w2 = __builtin_amdgcn_exp2f(l2 - mx);
        const float inv = 1.0f / (w0 + w1 + w2); w0 *= inv; w1 *= inv; w2 *= inv;
        bf16* p = Q + (size_t)tok * AW + h * HD + ch * 8;
        const v4u a = *(const GAS v4u*)(p), b2 = *(const GAS v4u*)(p + 512), c = *(const GAS v4u*)(p + 1024);
        v4u o;
        o.x = pk2(w0 * bflo(a.x) + w1 * bflo(b2.x) + w2 * bflo(c.x), w0 * bfhi(a.x) + w1 * bfhi(b2.x) + w2 * bfhi(c.x));
        o.y = pk2(w0 * bflo(a.y) + w1 * bflo(b2.y) + w2 * bflo(c.y), w0 * bfhi(a.y) + w1 * bfhi(b2.y) + w2 * bfhi(c.y));
        o.z = pk2(w0 * bflo(a.z) + w1 * bflo(b2.z) + w2 * bflo(c.z), w0 * bfhi(a.z) + w1 * bfhi(b2.z) + w2 * bfhi(c.z));
        o.w = pk2(w0 * bflo(a.w) + w1 * bflo(b2.w) + w2 * bflo(c.w), w0 * bfhi(a.w) + w1 * bfhi(b2.w) + w2 * bfhi(c.w));
        *(GAS v4u*)(p) = o;
    }
}

__device__ __forceinline__ void pool_simple(Frame& F) {
    const bf16* U = (const bf16*)(F.ws + WS_Y + Y_U); bf16* P = (bf16*)(F.ws + WS_Y + Y_K);
    const int total = M * (D / 8);
    for (int it = F.gw * 64 + F.lane; it < total; it += F.NGW * 64) {
        const int tok = it >> 7, ch = it & 127, s = tok & (S - 1), g = ch >> 5, w = 2 << g;
        int lo = s - (w >> 1), hi = lo + w; lo = lo < 0 ? 0 : lo; hi = hi > S ? S : hi;
        const bf16* base = U + (size_t)(tok - s) * D + ch * 8;
        float a[8];
#pragma unroll
        for (int e = 0; e < 8; ++e) a[e] = 0.f;
        for (int r = lo; r < hi; ++r) { const v4u v = *(const GAS v4u*)(base + (size_t)r * D);
            a[0] += bflo(v.x); a[1] += bfhi(v.x); a[2] += bflo(v.y); a[3] += bfhi(v.y); a[4] += bflo(v.z); a[5] += bfhi(v.z); a[6] += bflo(v.w); a[7] += bfhi(v.w); }
        const float inv = 1.0f / (float)(hi - lo);
        const v4u c = *(const GAS v4u*)(base + (size_t)s * D);
        v4u o; o.x = pk2(a[0] * inv - bflo(c.x), a[1] * inv - bfhi(c.x)); o.y = pk2(a[2] * inv - bflo(c.y), a[3] * inv - bfhi(c.y));
        o.z = pk2(a[4] * inv - bflo(c.z), a[5] * inv - bfhi(c.z)); o.w = pk2(a[6] * inv - bflo(c.w), a[7] * inv - bfhi(c.w));
        *(GAS v4u*)(P + (size_t)tok * D + ch * 8) = o;
    }
}

__device__ __forceinline__ void pool_slide(Frame& F) {
    const bf16* U = (const bf16*)(F.ws + WS_Y + Y_U); bf16* P = (bf16*)(F.ws + WS_Y + Y_K);
    constexpr int T = 16; constexpr int NIT = BATCH * 4 * (S / (2 * T));
    for (int it = F.gw; it < NIT; it += F.NGW) {
        const int seg2 = it & 63, g = (it >> 6) & 3, b = it >> 8;
        const int w = 2 << g, hw = w >> 1;
        const int t0 = (seg2 * 2 + (F.lane >> 5)) * T, ch = g * 32 + (F.lane & 31);
        const bf16* base = U + (size_t)b * S * D + ch * 8; bf16* obase = P + (size_t)b * S * D + ch * 8;
        float a[8];
#pragma unroll
        for (int e = 0; e < 8; ++e) a[e] = 0.f;
        { int lo = t0 - hw, hi = lo + w; lo = lo < 0 ? 0 : lo; hi = hi > S ? S : hi;
          for (int r = lo; r < hi; ++r) { const v4u v = *(const GAS v4u*)(base + (size_t)r * D);
              a[0] += bflo(v.x); a[1] += bfhi(v.x); a[2] += bflo(v.y); a[3] += bfhi(v.y); a[4] += bflo(v.z); a[5] += bfhi(v.z); a[6] += bflo(v.w); a[7] += bfhi(v.w); } }
#pragma unroll 4
        for (int i = 0; i < T; ++i) {
            const int t = t0 + i;
            int lo = t - hw, hi = lo + w; lo = lo < 0 ? 0 : lo; hi = hi > S ? S : hi;
            const float inv = 1.0f / (float)(hi - lo);
            const v4u c = *(const GAS v4u*)(base + (size_t)t * D);
            v4u o; o.x = pk2(a[0] * inv - bflo(c.x), a[1] * inv - bfhi(c.x)); o.y = pk2(a[2] * inv - bflo(c.y), a[3] * inv - bfhi(c.y));
            o.z = pk2(a[4] * inv - bflo(c.z), a[5] * inv - bfhi(c.z)); o.w = pk2(a[6] * inv - bflo(c.w), a[7] * inv - bfhi(c.w));
            *(GAS v4u*)(obase + (size_t)t * D) = o;
            const int re = t + hw, rl = t - hw;
            if (re < S) { const v4u v = *(const GAS v4u*)(base + (size_t)re * D);
                a[0] += bflo(v.x); a[1] += bfhi(v.x); a[2] += bflo(v.y); a[3] += bfhi(v.y); a[4] += bflo(v.z); a[5] += bfhi(v.z); a[6] += bflo(v.w); a[7] += bfhi(v.w); }
            if (rl >= 0) { const v4u v = *(const GAS v4u*)(base + (size_t)rl * D);
                a[0] -= bflo(v.x); a[1] -= bfhi(v.x); a[2] -= bflo(v.y); a[3] -= bfhi(v.y); a[4] -= bflo(v.z); a[5] -= bfhi(v.z); a[6] -= bflo(v.w); a[7] -= bfhi(v.w); }
        }
    }
}

__device__ __forceinline__ float gelu_tanh(float x) {
    const float y = 0.7978845608028654f * (x + 0.044715f * x * x * x);
    const float t = 1.0f - 2.0f / (__expf(2.0f * y) + 1.0f);
    return 0.5f * x * (1.0f + t);
}
__device__ __forceinline__ void conv_simple(Frame& F, int l) {
    bf16* AG = (bf16*)(F.ws + WS_Y);
    const float* cw = F.in[10] + (size_t)l * 3 * DFF; const float* cb = F.in[11] + (size_t)l * DFF;
    constexpr int CH = DFF / 8; const int total = M * CH;
    for (int it = F.gw * 64 + F.lane; it < total; it += F.NGW * 64) {
        const int tok = it / CH, ch = it - tok * CH, s = tok & (S - 1), c0 = ch * 8;
        const bf16* ap = AG + (size_t)tok * NUP + c0;
        const v4u z = {0u, 0u, 0u, 0u};
        const v4u am = (s > 0) ? *(const GAS v4u*)(ap - NUP) : z;
        const v4u a0 = *(const GAS v4u*)(ap);
        const v4u ap1 = (s < S - 1) ? *(const GAS v4u*)(ap + NUP) : z;
        const v4u gv = *(const GAS v4u*)(ap + DFF);
        float xm[8] = {bflo(am.x), bfhi(am.x), bflo(am.y), bfhi(am.y), bflo(am.z), bfhi(am.z), bflo(am.w), bfhi(am.w)};
        float x0[8] = {bflo(a0.x), bfhi(a0.x), bflo(a0.y), bfhi(a0.y), bflo(a0.z), bfhi(a0.z), bflo(a0.w), bfhi(a0.w)};
        float xp[8] = {bflo(ap1.x), bfhi(ap1.x), bflo(ap1.y), bfhi(ap1.y), bflo(ap1.z), bfhi(ap1.z), bflo(ap1.w), bfhi(ap1.w)};
        float gg[8] = {bflo(gv.x), bfhi(gv.x), bflo(gv.y), bfhi(gv.y), bflo(gv.z), bfhi(gv.z), bflo(gv.w), bfhi(gv.w)};
        float r[8];
#pragma unroll
        for (int e = 0; e < 8; ++e) { const float v = cw[c0 + e] * xm[e] + cw[DFF + c0 + e] * x0[e] + cw[2 * DFF + c0 + e] * xp[e] + cb[c0 + e]; r[e] = gelu_tanh(v) * gg[e]; }
        v4u o; o.x = pk2(r[0], r[1]); o.y = pk2(r[2], r[3]); o.z = pk2(r[4], r[5]); o.w = pk2(r[6], r[7]);
        *(GAS v4u*)(AG + (size_t)tok * NUP + DFF + c0) = o;
    }
}

__device__ __forceinline__ void conv_slide(Frame& F, int l) {
    bf16* AG = (bf16*)(F.ws + WS_Y);
    const float* cw = F.in[10] + (size_t)l * 3 * DFF; const float* cb = F.in[11] + (size_t)l * DFF;
    constexpr int CH = DFF / 8, CW = (CH + 63) / 64, T = 16, NIT = CW * (M / T);
    const v4u z = {0u, 0u, 0u, 0u};
    for (int it = F.gw; it < NIT; it += F.NGW) {
        const int cwi = it % CW, run = it / CW, ch = cwi * 64 + F.lane;
        if (ch >= CH) continue;
        const int tok0 = run * T, s0 = tok0 & (S - 1), c0 = ch * 8;
        float w0[8], w1[8], w2[8], bb[8];
#pragma unroll
        for (int e = 0; e < 8; ++e) { w0[e] = cw[c0 + e]; w1[e] = cw[DFF + c0 + e]; w2[e] = cw[2 * DFF + c0 + e]; bb[e] = cb[c0 + e]; }
        bf16* ap = AG + (size_t)tok0 * NUP + c0;
        v4u am = (s0 > 0) ? *(const GAS v4u*)(ap - NUP) : z;
        v4u a0 = *(const GAS v4u*)(ap);
#pragma unroll 4
        for (int i = 0; i < T; ++i) {
            const v4u a1 = (s0 + i < S - 1) ? *(const GAS v4u*)(ap + (size_t)(i + 1) * NUP) : z;
            const v4u gv = *(const GAS v4u*)(ap + (size_t)i * NUP + DFF);
            const float xm[8] = {bflo(am.x), bfhi(am.x), bflo(am.y), bfhi(am.y), bflo(am.z), bfhi(am.z), bflo(am.w), bfhi(am.w)};
            const float x0[8] = {bflo(a0.x), bfhi(a0.x), bflo(a0.y), bfhi(a0.y), bflo(a0.z), bfhi(a0.z), bflo(a0.w), bfhi(a0.w)};
            const float xp[8] = {bflo(a1.x), bfhi(a1.x), bflo(a1.y), bfhi(a1.y), bflo(a1.z), bfhi(a1.z), bflo(a1.w), bfhi(a1.w)};
            const float gg[8] = {bflo(gv.x), bfhi(gv.x), bflo(gv.y), bfhi(gv.y), bflo(gv.z), bfhi(gv.z), bflo(gv.w), bfhi(gv.w)};
            float r[8];
#pragma unroll
            for (int e = 0; e < 8; ++e) { const float v = w0[e] * xm[e] + w1[e] * x0[e] + w2[e] * xp[e] + bb[e]; r[e] = gelu_tanh(v) * gg[e]; }
            v4u o; o.x = pk2(r[0], r[1]); o.y = pk2(r[2], r[3]); o.z = pk2(r[4], r[5]); o.w = pk2(r[6], r[7]);
            *(GAS v4u*)(ap + (size_t)i * NUP + DFF) = o;
            am = a0; a0 = a1;
        }
    }
}

__device__ __forceinline__ void final_norm(Frame& F) {
    const float* part = (const float*)(F.ws + WS_PART); const float* nf = F.in[14];
    for (int m = F.gw; m < M; m += F.NGW) {
        float s = 0.f;
#pragma unroll
        for (int t = 0; t < 16; ++t) s += part[(size_t)t * M + m];
        const float rstd = 1.0f / sqrtf(s * (1.0f / 1024.0f) + EPS);
        GAS f32x4* xr = (GAS f32x4*)(F.out + (size_t)m * D) + F.lane; const GAS f32x4* gr = (const GAS f32x4*)nf + F.lane;
#pragma unroll
        for (int j = 0; j < 4; ++j) { const f32x4 v = xr[64 * j]; const f32x4 gq = gr[64 * j]; xr[64 * j] = v * rstd * gq; }
    }
}

struct Args { const float* in[15]; float* out; unsigned char* ws; int ph_lo, ph_hi; int pad0, pad1; };

struct CfgP1 { static constexpr int st1 = 4, st2 = 10, st3 = 16, ld0 = D, ld1 = AW; static constexpr long off1 = (long)(Y_Q - Y_U), off2 = (long)(Y_K - Y_U), off3 = (long)(Y_V - Y_U); };
struct CfgGate { static constexpr int st1 = 4, st2 = 1 << 20, st3 = 1 << 20, ld0 = D, ld1 = D; static constexpr long off1 = (long)Y_U - (long)Y_V, off2 = 0, off3 = 0; };
struct CfgOne { static constexpr int st1 = 1 << 20, st2 = 1 << 20, st3 = 1 << 20, ld0 = D, ld1 = D; static constexpr long off1 = 0, off2 = 0, off3 = 0; };
struct CfgUp { static constexpr int st1 = 1 << 20, st2 = 1 << 20, st3 = 1 << 20, ld0 = NUP, ld1 = NUP; static constexpr long off1 = 0, off2 = 0, off3 = 0; };
template <int MODE, class CFG, int GN, int GK, int GLDA> __device__ __forceinline__ void run_gemm_b(Frame& F, const bf16* A, const bf16* Bt, bf16* O, const bf16* X1, const bf16* X2) {
    pg8::EpiB<MODE, CFG> E; E.O = O; E.part = (const float*)(F.ws + WS_PART); E.X1 = X1; E.X2 = X2;
    pg8::gemm_phase<pg8::EpiB<MODE, CFG>, GN, GK, GLDA, PG8_ALIGN, PG8_SP2>(F.lds + RING_OFF, A, Bt, F.G, (int)blockIdx.x, E);
}
template <int GK, int GLDA> __device__ __forceinline__ void run_gemm_r(Frame& F, const bf16* A, const bf16* Bt, const float* base) {
    pg8::EpiRes E{base, F.out, (bf16*)(F.ws + WS_HB), (float*)(F.ws + WS_PART), M};
    pg8::gemm_phase<pg8::EpiRes, D, GK, GLDA, PG8_ALIGN, PG8_SP2>(F.lds + RING_OFF, A, Bt, F.G, (int)blockIdx.x, E);
}

#define IN(k) (lo <= (k) && (k) < hi)
#define SEAM(k) do { if (IN(k) && IN((k) + 1)) xcd_barrier(bar); } while (0)
template <int L> __device__ __forceinline__ void layer_phases(Frame& F, int lo, int hi, const XcdBarrier& bar) {
    constexpr int pb = 1 + 10 * L;
    unsigned char* ws = F.ws;
    bf16* HB = (bf16*)(ws + WS_HB);
    bf16* YU = (bf16*)(ws + WS_Y + Y_U); bf16* YQ = (bf16*)(ws + WS_Y + Y_Q); bf16* YK = (bf16*)(ws + WS_Y + Y_K); bf16* YV = (bf16*)(ws + WS_Y + Y_V);
    bf16* W_IN = (bf16*)(ws + WS_W + WO_WIN);
    if (IN(pb + 0)) { run_gemm_b<0, CfgP1, NUQKV, D, D>(F, HB, W_IN, YU, nullptr, nullptr); SEAM(pb + 0); }
#if defined(ATTN_ORACLE)
    if (IN(pb + 1)) { attn_simple(F); SEAM(pb + 1); }
#else
    if (IN(pb + 1)) { attn_mfma(F); SEAM(pb + 1); }
#endif
#if defined(ATTN_ORACLE)
    if (IN(pb + 2)) { pool_simple(F); SEAM(pb + 2); }
#else
    if (IN(pb + 2)) { attn_combine(F); pool_slide(F); SEAM(pb + 2); }
#endif
    if (IN(pb + 3)) { run_gemm_b<1, CfgGate, NGATE, D, D>(F, HB, W_IN + (size_t)NUQKV * D, YV, nullptr, nullptr); SEAM(pb + 3); }
    if (IN(pb + 4)) { run_gemm_b<2, CfgOne, D, D, D>(F, YK, (const bf16*)(ws + WS_W + WO_WC), YV, YV, nullptr); SEAM(pb + 4); }
    if (IN(pb + 5)) { run_gemm_b<3, CfgOne, D, AO, AW>(F, YQ, (const bf16*)(ws + WS_W + WO_WB), YV, YV, YU); SEAM(pb + 5); }
    if (IN(pb + 6)) { run_gemm_r<D, D>(F, YV, (const bf16*)(ws + WS_W + WO_WO), L == 0 ? F.in[0] : (const float*)F.out); SEAM(pb + 6); }
    if (IN(pb + 7)) { run_gemm_b<0, CfgUp, NUP, D, D>(F, HB, (const bf16*)(ws + WS_W + WO_WUP), YU, nullptr, nullptr); SEAM(pb + 7); }
    if (IN(pb + 8)) { conv_slide(F, L); if (L + 1 < DEPTH) convert_weights(F, L + 1, false); SEAM(pb + 8); }
    if (IN(pb + 9)) { run_gemm_r<DFF, NUP>(F, YU + DFF, (const bf16*)(ws + WS_W + WO_WDN + L * WDN_BYTES), (const float*)F.out); SEAM(pb + 9); }
}
#undef IN
#undef SEAM

__global__ void __launch_bounds__(NWAVES * 64, 2) fwd_kernel(Args args) {
    extern __shared__ __attribute__((aligned(16))) unsigned char lds[];
    Frame F;
    F.lds = (LAS unsigned char*)lds;
    F.MISC = (volatile LAS unsigned*)(F.lds + MISC_OFF);
    F.tid = threadIdx.x; F.lane = F.tid & 63; F.wave = __builtin_amdgcn_readfirstlane(F.tid >> 6);
    F.G = gridDim.x; { const int bx = blockIdx.x; F.vcu = (F.G % 8 == 0) ? (bx % 8) * (F.G / 8) + bx / 8 : bx; }
    F.gw = F.vcu * NWAVES + F.wave; F.NGW = F.G * NWAVES;
    F.ws = args.ws; F.ctl = (gu32*)(args.ws + WS_CTL); F.out = args.out;
    F.in = args.in;
    for (int u = F.tid; u < (LDS_BYTES - LDSCTL_OFF) / 4; u += NWAVES * 64) ((LAS unsigned*)(F.lds + LDSCTL_OFF))[u] = 0u;
    __syncthreads();
    const int lo = args.ph_lo, hi = args.ph_hi;
    XcdBarrier bar; bar.bar = (unsigned*)(F.ctl + CW_BAR); bar.x = 0; bar.st = nullptr;
    if (hi - lo > 1) bar = xcd_barrier_post((unsigned*)(F.ctl + CW_BAR), F.MISC + 8);

#define IN(k) (lo <= (k) && (k) < hi)
#define SEAM(k) do { if (IN(k) && IN((k) + 1)) xcd_barrier(bar); } while (0)
    if (IN(0)) { convert_weights(F, 0, true); p0_x_rows(F); SEAM(0); }
    layer_phases<0>(F, lo, hi, bar);
    layer_phases<1>(F, lo, hi, bar);
    if (IN(N_PHASES - 1)) final_norm(F);
}
#undef IN
#undef SEAM

#ifdef DBG_STOP
__global__ void dbg_dump(const unsigned char* ws, float* out, size_t o0, size_t o1, size_t o2, size_t o3, int n_off, int is_f32) {
    const size_t n = (size_t)M * D;
    for (size_t i = (size_t)blockIdx.x * blockDim.x + threadIdx.x; i < n; i += (size_t)gridDim.x * blockDim.x) {
        float acc = 0.f; const size_t offs[4] = {o0, o1, o2, o3};
        for (int r = 0; r < n_off; ++r) { if (is_f32) acc += ((const float*)(ws + offs[r]))[i]; else acc += __uint_as_float((unsigned)((const unsigned short*)(ws + offs[r]))[i] << 16); }
        out[i] = acc;
    }
}
#endif
extern "C" void kernel_launch(void* const* d_in, const int* in_sizes, int n_in, void* d_out, int out_size, void* d_ws, size_t ws_size, hipStream_t stream) {
    static int grid = 0;
    if (grid == 0) {
        if (n_in != 15 || in_sizes[0] != M * D || out_size != M * D || ws_size < WS_END) { fprintf(stderr, "kernel_launch: unexpected problem shape (n_in %d, in0 %d, out %d, ws %zu); nothing launched\n", n_in, n_in > 0 ? in_sizes[0] : -1, out_size, ws_size); grid = -1; return; }
        int dev = 0, cus = 0, per_cu = 0;
        if (hipGetDevice(&dev) != hipSuccess || hipDeviceGetAttribute(&cus, hipDeviceAttributeMultiprocessorCount, dev) != hipSuccess) { grid = -1; return; }
        if (hipFuncSetAttribute((const void*)fwd_kernel, hipFuncAttributeMaxDynamicSharedMemorySize, LDS_BYTES) != hipSuccess) { fprintf(stderr, "kernel_launch: hipFuncSetAttribute failed\n"); grid = -1; return; }
        if (hipOccupancyMaxActiveBlocksPerMultiprocessor(&per_cu, (const void*)fwd_kernel, NWAVES * 64, LDS_BYTES) != hipSuccess || per_cu < 1) { fprintf(stderr, "kernel_launch: occupancy query reports %d blocks per CU\n", per_cu); (void)hipGetLastError(); grid = -1; return; }
        grid = cus;
    }
    if (grid < 0) return;
    (void)hipMemsetAsync((char*)d_ws + WS_CTL, 0, CTL_ZERO_BYTES, stream);
    Args a{};
    for (int i = 0; i < 15; ++i) a.in[i] = (const float*)d_in[i];
    a.out = (float*)d_out; a.ws = (unsigned char*)d_ws;
#if MK_N_LAUNCHES == 1
    a.ph_lo = 0; a.ph_hi = N_PHASES;
    hipLaunchKernelGGL(fwd_kernel, dim3(grid), dim3(NWAVES * 64), LDS_BYTES, stream, a);
#else
#ifdef DBG_STOP
    for (int p = 0; p <= DBG_STOP; ++p) { a.ph_lo = p; a.ph_hi = p + 1; hipLaunchKernelGGL(fwd_kernel, dim3(grid), dim3(NWAVES * 64), LDS_BYTES, stream, a); }
    { const size_t offs[4] = {DBG_OFFS}; hipLaunchKernelGGL(dbg_dump, dim3(2048), dim3(256), 0, stream, (const unsigned char*)d_ws, (float*)d_out, offs[0], offs[1], offs[2], offs[3], DBG_NOFF, DBG_F32); }
#else
    for (int p = 0; p < N_PHASES; ++p) { a.ph_lo = p; a.ph_hi = p + 1; hipLaunchKernelGGL(fwd_kernel, dim3(grid), dim3(NWAVES * 64), LDS_BYTES, stream, a); }
#endif
#endif
}
```

```cpp
#include <hip/hip_runtime.h>
#include <cstdio>
#include <cstdint>

#ifndef MK_N_LAUNCHES
#define MK_N_LAUNCHES 1
#endif

namespace pg8 {
#define PG8_LAS __attribute__((address_space(3)))
typedef unsigned short bf16_t;
typedef short bf16x8 __attribute__((ext_vector_type(8)));
typedef float f32x4 __attribute__((ext_vector_type(4)));
typedef unsigned u32x4 __attribute__((ext_vector_type(4)));
typedef unsigned u32x2 __attribute__((ext_vector_type(2)));
constexpr int BM = 256, BK = 64, HALF = 128, HTB = HALF * BK * 2  , STAGE_BYTES = 8 * HTB, NXCD = 8, WGM = 8;

__host__ __device__ __forceinline__ int lds_byte(int r, int c) { const int st = (r >> 4) * 2 + (c >> 5), rr = r & 15, cc = c & 31, ob = rr * 64 + cc * 2; return st * 1024 + (ob ^ (((ob >> 9) & 1) << 5)); }
__host__ __device__ __forceinline__ void stage_rc(int b, int& R, int& C) { const int st = b / 1024, sb = b % 1024, swz = sb ^ (((sb >> 9) & 1) << 5); R = (st >> 1) * 16 + swz / 64; C = (st & 1) * 32 + (swz % 64) / 2; }
__host__ __device__ __forceinline__ int perm32(int rho) { const int n = rho >> 4, i = rho & 15; return 8 * (i >> 2) + 4 * n + (i & 3); }

struct Unit { int pm, pn; };
struct Gemm { const bf16_t* A; const bf16_t* Bt; int M, N, K, lda; };

struct StaticOrder {
    int nM, nN, nwg, G, c;
    __host__ __device__ void init(int M, int N, int G_, int c_) { nM = M / BM; nN = N / BM; nwg = nM * nN; G = G_; c = c_; }
    __host__ __device__ bool next(int i, Unit& u) const {
        const long L = (long)i * G + c; if (L >= nwg) return false;
        int wgid = (int)L; { const int q = nwg / NXCD, r = nwg % NXCD, xcd = wgid % NXCD, off = wgid / NXCD; wgid = (xcd < r ? xcd * (q + 1) : r * (q + 1) + (xcd - r) * q) + off; }
        const int nig = WGM * nN, gid = wgid / nig, fm = gid * WGM, gsz = (nM - fm) < WGM ? (nM - fm) : WGM;
        u.pm = fm + ((wgid % nig) % gsz); u.pn = (wgid % nig) / gsz; return true;
    }
    __device__ __forceinline__ void a_ready(const Unit&) const {}
    __device__ __forceinline__ void done(const Unit&) const {}
};

typedef float f32x2_t __attribute__((ext_vector_type(2))); typedef __bf16 bf16x2_t __attribute__((ext_vector_type(2)));
__device__ __forceinline__ unsigned cvt_pk_bf16(float lo, float hi) { f32x2_t v = {lo, hi}; bf16x2_t b = __builtin_convertvector(v, bf16x2_t); return __builtin_bit_cast(unsigned, b); }
__device__ __forceinline__ float bf_lo(unsigned w) { return __uint_as_float(w << 16); }
__device__ __forceinline__ float bf_hi(unsigned w) { return __uint_as_float(w & 0xffff0000u); }

__device__ __forceinline__ void wave_rstd(const float* part, int Mrows, int rowbase, int lane, float eps, float (&rs)[2]) {
#pragma unroll
    for (int ai = 0; ai < 2; ++ai) { const float* p = part + rowbase + ai * HALF + lane; float s = 0.f;
#pragma unroll
        for (int t = 0; t < 16; ++t) s += p[(size_t)t * Mrows];
        rs[ai] = 1.0f / sqrtf(s * (1.0f / 1024.0f) + eps); }
}

template <int MODE, class CFG> struct EpiB {
    static constexpr bool PERM = true, AFTER_DRAIN = false;
    bf16_t* O;
    const float* part;
    const bf16_t* X1; const bf16_t* X2;
    static constexpr int Mrows = 16384, ldx = 1024; static constexpr float eps = 1e-6f;
    __device__ __forceinline__ void operator()(const f32x4 (&acc)[2][2][4][2], const Unit& u, int wr, int wc, int fr, int fq) const {
        const int lane = fr + 16 * fq;
        long boff = 0; int ldc = CFG::ld0, sst = 0;
        if (u.pn >= CFG::st1) { boff = CFG::off1; ldc = CFG::ld1; sst = CFG::st1; }
        if (u.pn >= CFG::st2) { boff = CFG::off2; sst = CFG::st2; }
        if (u.pn >= CFG::st3) { boff = CFG::off3; sst = CFG::st3; }
        bf16_t* base = (bf16_t*)((char*)O + boff);
        const int col0 = (u.pn - sst) * BM + wc * 32 + 8 * fq;
        const int row0 = u.pm * BM + wr * 64 + fr;
        float rs[2] = {1.f, 1.f};
        if (MODE <= 1) wave_rstd(part, Mrows, u.pm * BM + wr * 64, lane, eps, rs);
#pragma unroll
        for (int ai = 0; ai < 2; ++ai)
#pragma unroll
            for (int m = 0; m < 4; ++m) {
                const int row = row0 + ai * HALF + m * 16;
                float r = 1.f; if (MODE <= 1) r = __shfl(rs[ai], m * 16 + fr);
                bf16_t* rowp = base + (size_t)row * ldc + col0;
#pragma unroll
                for (int bj = 0; bj < 2; ++bj) {
                    f32x4 v0 = acc[ai][bj][m][0], v1 = acc[ai][bj][m][1];
                    if (MODE <= 1) { v0 = v0 * r; v1 = v1 * r; }
                    if (MODE == 1) {
#pragma unroll
                        for (int e = 0; e < 4; ++e) { v0[e] = __builtin_amdgcn_rcpf(1.0f + __expf(-v0[e])); v1[e] = __builtin_amdgcn_rcpf(1.0f + __expf(-v1[e])); }
                    }
                    if (MODE == 2) {
                        const u32x4 x = *(const u32x4*)(X1 + (size_t)row * ldx + col0 + bj * HALF);
                        v0[0] *= bf_lo(x.x); v0[1] *= bf_hi(x.x); v0[2] *= bf_lo(x.y); v0[3] *= bf_hi(x.y);
                        v1[0] *= bf_lo(x.z); v1[1] *= bf_hi(x.z); v1[2] *= bf_lo(x.w); v1[3] *= bf_hi(x.w);
                    }
                    if (MODE == 3) {
                        const u32x4 x = *(const u32x4*)(X1 + (size_t)row * ldx + col0 + bj * HALF);
                        const u32x4 y = *(const u32x4*)(X2 + (size_t)row * ldx + col0 + bj * HALF);
                        v0[0] = bf_lo(x.x) + v0[0] * bf_lo(y.x); v0[1] = bf_hi(x.x) + v0[1] * bf_hi(y.x); v0[2] = bf_lo(x.y) + v0[2] * bf_lo(y.y); v0[3] = bf_hi(x.y) + v0[3] * bf_hi(y.y);
                        v1[0] = bf_lo(x.z) + v1[0] * bf_lo(y.z); v1[1] = bf_hi(x.z) + v1[1] * bf_hi(y.z); v1[2] = bf_lo(x.w) + v1[2] * bf_lo(y.w); v1[3] = bf_hi(x.w) + v1[3] * bf_hi(y.w);
                    }
                    u32x4 w; w.x = cvt_pk_bf16(v0[0], v0[1]); w.y = cvt_pk_bf16(v0[2], v0[3]); w.z = cvt_pk_bf16(v1[0], v1[1]); w.w = cvt_pk_bf16(v1[2], v1[3]);
                    *(u32x4*)(rowp + bj * HALF) = w;
                }
                if (MODE >= 2) asm volatile("" ::: "memory");
            }
    }
};

struct EpiRes {
    static constexpr bool PERM = false, AFTER_DRAIN = false;
    const float* base; float* out; bf16_t* hb; float* part; int Mrows;
    __device__ __forceinline__ void operator()(const f32x4 (&acc)[2][2][4][2], const Unit& u, int wr, int wc, int fr, int fq) const {
        const int col0 = u.pn * BM + wc * 32 + 4 * fq;
#pragma unroll
        for (int ai = 0; ai < 2; ++ai)
#pragma unroll
            for (int m = 0; m < 4; ++m) {
                const int row = u.pm * BM + ai * HALF + wr * 64 + m * 16 + fr; const size_t off = (size_t)row * 1024 + col0;
                float ss = 0.f;
#pragma unroll
                for (int bj = 0; bj < 2; ++bj)
#pragma unroll
                    for (int n = 0; n < 2; ++n) {
                        const f32x4 bs = *(const f32x4*)(base + off + bj * HALF + n * 16);
                        const f32x4 o = bs + acc[ai][bj][m][n];
                        *(f32x4*)(out + off + bj * HALF + n * 16) = o;
                        u32x2 w; w.x = cvt_pk_bf16(o[0], o[1]); w.y = cvt_pk_bf16(o[2], o[3]);
                        *(u32x2*)(hb + off + bj * HALF + n * 16) = w;
                        ss += (o[0] * o[0] + o[1] * o[1]) + (o[2] * o[2] + o[3] * o[3]);
                    }
                ss += __shfl_xor(ss, 16); ss += __shfl_xor(ss, 32);
                if (fq == 0) part[(size_t)(u.pn * 4 + wc) * Mrows + row] = ss;
                asm volatile("" ::: "memory");
            }
    }
};

template <class Epi, int GN, int GK, int GLDA, bool ALIGN_EPI = false, bool SP2 = false>
__device__ __forceinline__ void gemm_phase(PG8_LAS unsigned char* lds, const bf16_t* gA, const bf16_t* gBt, int G_, int c_, const Epi& E) {
    struct { const bf16_t* A; const bf16_t* Bt; int K, lda; } g{gA, gBt, GK, GLDA};
    StaticOrder S; S.nM = 16384 / BM; S.nN = GN / BM; S.nwg = S.nM * S.nN; S.G = G_; S.c = c_;
    int tid_ = threadIdx.x; asm volatile("" : "+v"(tid_));
    const int tid = tid_, wid = __builtin_amdgcn_readfirstlane(tid >> 6), lane = tid & 63, wr = wid >> 2, wc = wid & 3, fr = lane & 15, fq = lane >> 4;
    const int K = g.K, nt = K / BK, lda = g.lda;
    unsigned voffA[2], voffB[2];
#pragma unroll
    for (int i = 0; i < 2; ++i) { int R, C; stage_rc(tid * 16 + i * 8192, R, C); const int Rb = Epi::PERM ? ((R & ~31) + perm32(R & 31)) : R;
        voffA[i] = (unsigned)(R * lda + C) * 2u; voffB[i] = (unsigned)(Rb * K + C) * 2u; }
    const size_t kstep = (size_t)(BK * 2);
    const size_t hstepA = (size_t)HALF * lda * 2, hstepB = (size_t)HALF * K * 2;
    const size_t tstepA = 2 * hstepA, tstepB = 2 * hstepB;
    const unsigned ldsw = (unsigned)wid * 1024u;
    const int aoff = lds_byte(wr * 64 + fr, fq * 8), boff = lds_byte(wc * 32 + fr, fq * 8);
#define PG8_SA(b, h) (((b) * 2 + (h)) * HTB)
#define PG8_SB(b, h) ((4 + (b) * 2 + (h)) * HTB)
#define PG8_STAGE(bufoff, gbase, voff) do { _Pragma("unroll") for (int _i = 0; _i < 2; ++_i) \
        __builtin_amdgcn_global_load_lds((const unsigned*)((const char*)(gbase) + (voff)[_i]), (PG8_LAS unsigned*)(lds + (bufoff) + ldsw + _i * 8192), 16, 0, 0); } while (0)
#define PG8_LDA(dst, b, h) do { _Pragma("unroll") for (int m = 0; m < 4; ++m) _Pragma("unroll") for (int k = 0; k < 2; ++k) dst[m][k] = *(const PG8_LAS bf16x8*)(lds + PG8_SA(b, h) + aoff + m * 2048 + k * 1024); } while (0)
#define PG8_LDB(dst, b, h) do { _Pragma("unroll") for (int n = 0; n < 2; ++n) _Pragma("unroll") for (int k = 0; k < 2; ++k) dst[n][k] = *(const PG8_LAS bf16x8*)(lds + PG8_SB(b, h) + boff + n * 2048 + k * 1024); } while (0)
#define PG8_MMA(ai, bj, At, Bt) do { __builtin_amdgcn_s_setprio(1); _Pragma("unroll") for (int m = 0; m < 4; ++m) _Pragma("unroll") for (int n = 0; n < 2; ++n) _Pragma("unroll") for (int k = 0; k < 2; ++k) \
        acc[ai][bj][m][n] = __builtin_amdgcn_mfma_f32_16x16x32_bf16(Bt[n][k], At[m][k], acc[ai][bj][m][n], 0, 0, 0); __builtin_amdgcn_s_setprio(0); } while (0)
#define PG8_WAIT_V(n) asm volatile("s_waitcnt vmcnt(" #n ")" ::: "memory")
#define PG8_WAIT_L(n) asm volatile("s_waitcnt lgkmcnt(" #n ")" ::: "memory")
#define PG8_BAR __builtin_amdgcn_s_barrier()
#define PG8_SCHED __builtin_amdgcn_sched_barrier(0)
    Unit cur, nxt; int ui = 0;
    if (!S.next(0, cur)) return;
    f32x4 acc[2][2][4][2];
#pragma unroll
    for (int a = 0; a < 2; ++a)
#pragma unroll
        for (int b = 0; b < 2; ++b)
#pragma unroll
            for (int m = 0; m < 4; ++m)
#pragma unroll
                for (int n = 0; n < 2; ++n) acc[a][b][m][n] = (f32x4){0.f, 0.f, 0.f, 0.f};
    bf16x8 At[4][2], B0[2][2], B1[2][2];
    const char* cA = (const char*)g.A + (size_t)cur.pm * tstepA; const char* cB = (const char*)g.Bt + (size_t)cur.pn * tstepB;
    S.a_ready(cur);
    if constexpr (SP2) {
        PG8_STAGE(PG8_SB(0, 0), cB, voffB); PG8_STAGE(PG8_SB(0, 1), cB + hstepB, voffB); PG8_STAGE(PG8_SA(0, 0), cA, voffA); PG8_STAGE(PG8_SA(0, 1), cA + hstepA, voffA);
        if (wr == 1) PG8_BAR;
        PG8_WAIT_V(2); PG8_BAR;
        PG8_STAGE(PG8_SB(1, 0), cB + kstep, voffB); PG8_STAGE(PG8_SA(1, 0), cA + kstep, voffA); PG8_STAGE(PG8_SB(1, 1), cB + hstepB + kstep, voffB);
        PG8_WAIT_V(6); PG8_BAR;
    } else {
        PG8_STAGE(PG8_SB(0, 0), cB, voffB); PG8_STAGE(PG8_SA(0, 0), cA, voffA); PG8_STAGE(PG8_SB(0, 1), cB + hstepB, voffB); PG8_STAGE(PG8_SA(0, 1), cA + hstepA, voffA);
        if (wr == 1) PG8_BAR;
        PG8_WAIT_V(4); PG8_BAR;
        PG8_STAGE(PG8_SB(1, 0), cB + kstep, voffB); PG8_STAGE(PG8_SA(1, 0), cA + kstep, voffA); PG8_STAGE(PG8_SB(1, 1), cB + hstepB + kstep, voffB);
        PG8_WAIT_V(6); PG8_BAR;
    }
    for (;;) {
        const bool has_next = S.next(ui + 1, nxt);
        const char* nA = has_next ? (const char*)g.A + (size_t)nxt.pm * tstepA : cA; const char* nB = has_next ? (const char*)g.Bt + (size_t)nxt.pn * tstepB : cB;
        for (int t = 0; t < nt; t += 2) {
            const bool last = (t == nt - 2);
            const char* a1 = cA + (size_t)(t + 1) * kstep;
            const char* a2 = last ? nA : cA + (size_t)(t + 2) * kstep; const char* b2 = last ? nB : cB + (size_t)(t + 2) * kstep;
            const char* a3 = a2 + kstep; const char* b3 = b2 + kstep;
            if (last && has_next) S.a_ready(nxt);
            if constexpr (SP2) {
            PG8_LDB(B0, 0, 0); PG8_LDB(B1, 0, 1); PG8_SCHED; PG8_LDA(At, 0, 0); PG8_STAGE(PG8_SA(1, 1), a1 + hstepA, voffA);
            PG8_WAIT_V(8); PG8_WAIT_L(0); PG8_BAR; PG8_MMA(0, 0, At, B0); PG8_MMA(0, 1, At, B1); PG8_BAR; PG8_SCHED;
            PG8_LDA(At, 0, 1); PG8_STAGE(PG8_SB(0, 0), b2, voffB); PG8_STAGE(PG8_SB(0, 1), b2 + hstepB, voffB); PG8_STAGE(PG8_SA(0, 0), a2, voffA);
            PG8_WAIT_V(8); PG8_WAIT_L(0); PG8_BAR; PG8_MMA(1, 0, At, B0); PG8_MMA(1, 1, At, B1); PG8_BAR; PG8_SCHED;
            PG8_LDB(B0, 1, 0); PG8_LDB(B1, 1, 1); PG8_SCHED; PG8_LDA(At, 1, 0); PG8_STAGE(PG8_SA(0, 1), a2 + hstepA, voffA);
            PG8_WAIT_V(8); PG8_WAIT_L(0); PG8_BAR; PG8_MMA(0, 0, At, B0); PG8_MMA(0, 1, At, B1); PG8_BAR; PG8_SCHED;
            PG8_LDA(At, 1, 1); PG8_STAGE(PG8_SB(1, 0), b3, voffB); PG8_STAGE(PG8_SB(1, 1), b3 + hstepB, voffB); PG8_STAGE(PG8_SA(1, 0), a3, voffA);
            PG8_WAIT_V(8); PG8_WAIT_L(0); PG8_BAR; PG8_MMA(1, 0, At, B0); PG8_MMA(1, 1, At, B1); PG8_BAR; PG8_SCHED;
            } else {
            PG8_LDB(B0, 0, 0); PG8_SCHED; PG8_LDA(At, 0, 0); PG8_STAGE(PG8_SA(1, 1), a1 + hstepA, voffA);
            PG8_WAIT_L(8); PG8_BAR; PG8_WAIT_L(0); PG8_MMA(0, 0, At, B0); PG8_BAR; PG8_SCHED;
            PG8_LDB(B1, 0, 1); PG8_STAGE(PG8_SB(0, 0), b2, voffB);
            PG8_BAR; PG8_WAIT_L(0); PG8_MMA(0, 1, At, B1); PG8_BAR;
            PG8_LDA(At, 0, 1); PG8_STAGE(PG8_SA(0, 0), a2, voffA);
            PG8_BAR; PG8_WAIT_L(0); PG8_MMA(1, 0, At, B0); PG8_BAR; PG8_SCHED;
            PG8_STAGE(PG8_SB(0, 1), b2 + hstepB, voffB);
            PG8_WAIT_V(6); PG8_BAR; PG8_MMA(1, 1, At, B1); PG8_BAR;
            PG8_LDB(B0, 1, 0); PG8_SCHED; PG8_LDA(At, 1, 0); PG8_STAGE(PG8_SA(0, 1), a2 + hstepA, voffA);
            PG8_WAIT_L(8); PG8_BAR; PG8_WAIT_L(0); PG8_MMA(0, 0, At, B0); PG8_BAR; PG8_SCHED;
            PG8_LDB(B1, 1, 1); PG8_STAGE(PG8_SB(1, 0), b3, voffB);
            PG8_BAR; PG8_WAIT_L(0); PG8_MMA(0, 1, At, B1); PG8_BAR;
            PG8_LDA(At, 1, 1); PG8_STAGE(PG8_SA(1, 0), a3, voffA);
            PG8_BAR; PG8_WAIT_L(0); PG8_MMA(1, 0, At, B0); PG8_BAR; PG8_SCHED;
            PG8_STAGE(PG8_SB(1, 1), b3 + hstepB, voffB);
            PG8_WAIT_V(6); PG8_BAR; PG8_MMA(1, 1, At, B1); PG8_BAR;
            }
        }
        if constexpr (ALIGN_EPI) { if (wr == 0) PG8_BAR; }
        if constexpr (!Epi::AFTER_DRAIN) { E(acc, cur, wr, wc, fr, fq); S.done(cur); }
        if (!has_next) break;
#pragma unroll
        for (int a = 0; a < 2; ++a)
#pragma unroll
            for (int b = 0; b < 2; ++b)
#pragma unroll
                for (int m = 0; m < 4; ++m)
#pragma unroll
                    for (int n = 0; n < 2; ++n) acc[a][b][m][n] = (f32x4){0.f, 0.f, 0.f, 0.f};
        cur = nxt; cA = nA; cB = nB; ++ui;
        if constexpr (ALIGN_EPI) { if (wr == 1) PG8_BAR; }
    }
    PG8_WAIT_V(0);
    if constexpr (!ALIGN_EPI) { if (wr == 0) PG8_BAR; }
    PG8_BAR;
#undef PG8_SA
#undef PG8_SB
#undef PG8_STAGE
#undef PG8_LDA
#undef PG8_LDB
#undef PG8_MMA
#undef PG8_WAIT_V
#undef PG8_WAIT_L
#undef PG8_BAR
#undef PG8_SCHED
}

struct UnitD { const char* A; const char* Bt; int nt, lda, K; int pm, pn, sub; };
template <class Prog>
__device__ __forceinline__ void gemm_stream(PG8_LAS unsigned char* lds, const Prog& P) {
    int tid_ = threadIdx.x; asm volatile("" : "+v"(tid_));
    const int tid = tid_, wid = __builtin_amdgcn_readfirstlane(tid >> 6), lane = tid & 63, wr = wid >> 2, wc = wid & 3, fr = lane & 15, fq = lane >> 4;
    int Rr[2], Cc[2], Rb[2];
#pragma unroll
    for (int i = 0; i < 2; ++i) { int R, C; stage_rc(tid * 16 + i * 8192, R, C); Rr[i] = R; Cc[i] = C; Rb[i] = (R & ~31) + perm32(R & 31); }
    const size_t kstep = (size_t)(BK * 2);
    const unsigned ldsw = (unsigned)wid * 1024u;
    const int aoff = lds_byte(wr * 64 + fr, fq * 8), boff = lds_byte(wc * 32 + fr, fq * 8);
#define PG8_SA(b, h) (((b) * 2 + (h)) * HTB)
#define PG8_SB(b, h) ((4 + (b) * 2 + (h)) * HTB)
#define PG8_STAGE(bufoff, gbase, voff) do { _Pragma("unroll") for (int _i = 0; _i < 2; ++_i) \
        __builtin_amdgcn_global_load_lds((const unsigned*)((const char*)(gbase) + (voff)[_i]), (PG8_LAS unsigned*)(lds + (bufoff) + ldsw + _i * 8192), 16, 0, 0); } while (0)
#define PG8_LDA(dst, b, h) do { _Pragma("unroll") for (int m = 0; m < 4; ++m) _Pragma("unroll") for (int k = 0; k < 2; ++k) dst[m][k] = *(const PG8_LAS bf16x8*)(lds + PG8_SA(b, h) + aoff + m * 2048 + k * 1024); } while (0)
#define PG8_LDB(dst, b, h) do { _Pragma("unroll") for (int n = 0; n < 2; ++n) _Pragma("unroll") for (int k = 0; k < 2; ++k) dst[n][k] = *(const PG8_LAS bf16x8*)(lds + PG8_SB(b, h) + boff + n * 2048 + k * 1024); } while (0)
#define PG8_MMA(ai, bj, At, Bt) do { __builtin_amdgcn_s_setprio(1); _Pragma("unroll") for (int m = 0; m < 4; ++m) _Pragma("unroll") for (int n = 0; n < 2; ++n) _Pragma("unroll") for (int k = 0; k < 2; ++k) \
        acc[ai][bj][m][n] = __builtin_amdgcn_mfma_f32_16x16x32_bf16(Bt[n][k], At[m][k], acc[ai][bj][m][n], 0, 0, 0); __builtin_amdgcn_s_setprio(0); } while (0)
#define PG8_WAIT_V(n) asm volatile("s_waitcnt vmcnt(" #n ")" ::: "memory")
#define PG8_WAIT_L(n) asm volatile("s_waitcnt lgkmcnt(" #n ")" ::: "memory")
#define PG8_BAR __builtin_amdgcn_s_barrier()
#define PG8_SCHED __builtin_amdgcn_sched_barrier(0)
    UnitD cur, nxt; int ui = 0;
    if (!P.get(0, cur)) return;
    f32x4 acc[2][2][4][2];
#pragma unroll
    for (int a = 0; a < 2; ++a)
#pragma unroll
        for (int b = 0; b < 2; ++b)
#pragma unroll
            for (int m = 0; m < 4; ++m)
#pragma unroll
                for (int n = 0; n < 2; ++n) acc[a][b][m][n] = (f32x4){0.f, 0.f, 0.f, 0.f};
    bf16x8 At[4][2], B0[2][2], B1[2][2];
    unsigned cvA[2], cvB[2];
#pragma unroll
    for (int i = 0; i < 2; ++i) { cvA[i] = (unsigned)(Rr[i] * cur.lda + Cc[i]) * 2u; cvB[i] = (unsigned)(Rb[i] * cur.K + Cc[i]) * 2u; }
    const char* cA = cur.A; const char* cB = cur.Bt;
    size_t chA = (size_t)HALF * cur.lda * 2, chB = (size_t)HALF * cur.K * 2;
    PG8_STAGE(PG8_SB(0, 0), cB, cvB); PG8_STAGE(PG8_SB(0, 1), cB + chB, cvB); PG8_STAGE(PG8_SA(0, 0), cA, cvA); PG8_STAGE(PG8_SA(0, 1), cA + chA, cvA);
    if (wr == 1) PG8_BAR;
    PG8_WAIT_V(2); PG8_BAR;
    PG8_STAGE(PG8_SB(1, 0), cB + kstep, cvB); PG8_STAGE(PG8_SA(1, 0), cA + kstep, cvA); PG8_STAGE(PG8_SB(1, 1), cB + chB + kstep, cvB);
    PG8_WAIT_V(6); PG8_BAR;
    for (;;) {
        const bool has_next = P.get(ui + 1, nxt);
        const char* nA = has_next ? nxt.A : cA; const char* nB = has_next ? nxt.Bt : cB;
        unsigned nvA[2], nvB[2];
#pragma unroll
        for (int i = 0; i < 2; ++i) { nvA[i] = has_next ? (unsigned)(Rr[i] * nxt.lda + Cc[i]) * 2u : cvA[i]; nvB[i] = has_next ? (unsigned)(Rb[i] * nxt.K + Cc[i]) * 2u : cvB[i]; }
        const size_t nhA = has_next ? (size_t)HALF * nxt.lda * 2 : chA, nhB = has_next ? (size_t)HALF * nxt.K * 2 : chB;
        const int nt = cur.nt;
        for (int t = 0; t < nt; t += 2) {
            const bool last = (t == nt - 2);
            const char* a1 = cA + (size_t)(t + 1) * kstep;
            const char* a2 = last ? nA : cA + (size_t)(t + 2) * kstep; const char* b2 = last ? nB : cB + (size_t)(t + 2) * kstep;
            const char* a3 = a2 + kstep; const char* b3 = b2 + kstep;
            unsigned vA2[2], vB2[2];
#pragma unroll
            for (int i = 0; i < 2; ++i) { vA2[i] = last ? nvA[i] : cvA[i]; vB2[i] = last ? nvB[i] : cvB[i]; }
            const size_t hA2 = last ? nhA : chA, hB2 = last ? nhB : chB;
            PG8_LDB(B0, 0, 0); PG8_LDB(B1, 0, 1); PG8_SCHED; PG8_LDA(At, 0, 0); PG8_STAGE(PG8_SA(1, 1), a1 + chA, cvA);
            PG8_WAIT_V(8); PG8_WAIT_L(0); PG8_BAR; PG8_MMA(0, 0, At, B0); PG8_MMA(0, 1, At, B1); PG8_BAR; PG8_SCHED;
            PG8_LDA(At, 0, 1); PG8_STAGE(PG8_SB(0, 0), b2, vB2); PG8_STAGE(PG8_SB(0, 1), b2 + hB2, vB2); PG8_STAGE(PG8_SA(0, 0), a2, vA2);
            PG8_WAIT_V(8); PG8_WAIT_L(0); PG8_BAR; PG8_MMA(1, 0, At, B0); PG8_MMA(1, 1, At, B1); PG8_BAR; PG8_SCHED;
            PG8_LDB(B0, 1, 0); PG8_LDB(B1, 1, 1); PG8_SCHED; PG8_LDA(At, 1, 0); PG8_STAGE(PG8_SA(0, 1), a2 + hA2, vA2);
            PG8_WAIT_V(8); PG8_WAIT_L(0); PG8_BAR; PG8_MMA(0, 0, At, B0); PG8_MMA(0, 1, At, B1); PG8_BAR; PG8_SCHED;
            PG8_LDA(At, 1, 1); PG8_STAGE(PG8_SB(1, 0), b3, vB2); PG8_STAGE(PG8_SB(1, 1), b3 + hB2, vB2); PG8_STAGE(PG8_SA(1, 0), a3, vA2);
            PG8_WAIT_V(8); PG8_WAIT_L(0); PG8_BAR; PG8_MMA(1, 0, At, B0); PG8_MMA(1, 1, At, B1); PG8_BAR; PG8_SCHED;
        }
        if (wr == 0) PG8_BAR;
        P.epi(acc, cur, wr, wc, fr, fq);
        if (!has_next) break;
#pragma unroll
        for (int a = 0; a < 2; ++a)
#pragma unroll
            for (int b = 0; b < 2; ++b)
#pragma unroll
                for (int m = 0; m < 4; ++m)
#pragma unroll
                    for (int n = 0; n < 2; ++n) acc[a][b][m][n] = (f32x4){0.f, 0.f, 0.f, 0.f};
        cur = nxt; cA = nA; cB = nB; chA = nhA; chB = nhB; ++ui;
#pragma unroll
        for (int i = 0; i < 2; ++i) { cvA[i] = nvA[i]; cvB[i] = nvB[i]; }
        if (wr == 1) PG8_BAR;
    }
    PG8_WAIT_V(0);
    PG8_BAR;
#undef PG8_SA
#undef PG8_SB
#undef PG8_STAGE
#undef PG8_LDA
#undef PG8_LDB
#undef PG8_MMA
#undef PG8_WAIT_V
#undef PG8_WAIT_L
#undef PG8_BAR
#undef PG8_SCHED
}

template <int MODE> __device__ __forceinline__ void epi_bf16(const f32x4 (&acc)[2][2][4][2], int pm, int col0, int wr, int fr, int lane, bf16_t* O, int ldo, const float* part,
                                                             const bf16_t* X1, int ldx1, const bf16_t* X2, int ldx2) {
    const int row0 = pm * BM + wr * 64 + fr;
    float rs[2] = {1.f, 1.f};
    if (MODE <= 1) wave_rstd(part, 16384, pm * BM + wr * 64, lane, 1e-6f, rs);
#pragma unroll
    for (int ai = 0; ai < 2; ++ai)
#pragma unroll
        for (int m = 0; m < 4; ++m) {
            const int row = row0 + ai * HALF + m * 16;
            float r = 1.f; if (MODE <= 1) r = __shfl(rs[ai], m * 16 + fr);
#pragma unroll
            for (int bj = 0; bj < 2; ++bj) {
                f32x4 v0 = acc[ai][bj][m][0], v1 = acc[ai][bj][m][1];
                if (MODE <= 1) { v0 = v0 * r; v1 = v1 * r; }
                if (MODE == 1) {
#pragma unroll
                    for (int e = 0; e < 4; ++e) { v0[e] = __builtin_amdgcn_rcpf(1.0f + __expf(-v0[e])); v1[e] = __builtin_amdgcn_rcpf(1.0f + __expf(-v1[e])); }
                }
                if (MODE == 2 || MODE == 3) {
                    const u32x4 x = *(const u32x4*)(X1 + (size_t)row * ldx1 + col0 + bj * HALF);
                    if (MODE == 2) {
                        v0[0] *= bf_lo(x.x); v0[1] *= bf_hi(x.x); v0[2] *= bf_lo(x.y); v0[3] *= bf_hi(x.y);
                        v1[0] *= bf_lo(x.z); v1[1] *= bf_hi(x.z); v1[2] *= bf_lo(x.w); v1[3] *= bf_hi(x.w);
                    } else {
                        const u32x4 y = *(const u32x4*)(X2 + (size_t)row * ldx2 + col0 + bj * HALF);
                        v0[0] = bf_lo(x.x) + v0[0] * bf_lo(y.x); v0[1] = bf_hi(x.x) + v0[1] * bf_hi(y.x); v0[2] = bf_lo(x.y) + v0[2] * bf_lo(y.y); v0[3] = bf_hi(x.y) + v0[3] * bf_hi(y.y);
                        v1[0] = bf_lo(x.z) + v1[0] * bf_lo(y.z); v1[1] = bf_hi(x.z) + v1[1] * bf_hi(y.z); v1[2] = bf_lo(x.w) + v1[2] * bf_lo(y.w); v1[3] = bf_hi(x.w) + v1[3] * bf_hi(y.w);
                    }
                }
                u32x4 w; w.x = cvt_pk_bf16(v0[0], v0[1]); w.y = cvt_pk_bf16(v0[2], v0[3]); w.z = cvt_pk_bf16(v1[0], v1[1]); w.w = cvt_pk_bf16(v1[2], v1[3]);
                *(u32x4*)(O + (size_t)row * ldo + col0 + bj * HALF) = w;
            }
            if (MODE >= 2) asm volatile("" ::: "memory");
        }
}
}

#ifndef PG8_SP2
#define PG8_SP2 true
#endif
#ifndef PG8_ALIGN
#define PG8_ALIGN true
#endif

constexpr int NWAVES = 8;
constexpr int BATCH = 8, S = 2048, D = 1024, DEPTH = 2;
constexpr int M = BATCH * S;
constexpr int NIN = 7680, NUQKV = 5632, NGATE = 2048, AW = 1536, AO = 512, DFF = 2816, NUP = 5632, HD = 128;
constexpr float EPS = 1e-6f;
constexpr int N_PHASES = 2 + 10 * DEPTH;

constexpr size_t MiB = 1u << 20;
constexpr size_t WS_CTL = 0, CTL_ZERO_BYTES = 64 * 1024;
constexpr size_t WS_PART = 1 * MiB;
constexpr size_t WS_LSE = 2 * MiB;
constexpr size_t WS_W = 4 * MiB;
constexpr size_t WO_WIN = 0, WO_WC = 15 * MiB, WO_WB = 17 * MiB, WO_WO = 18 * MiB, WO_WUP = 20 * MiB, WO_WDN = 31 * MiB, WDN_BYTES = (size_t)D * DFF * 2;
constexpr size_t WS_HB = 46 * MiB;
constexpr size_t WS_Y = 78 * MiB;
constexpr size_t Y_U = 0, Y_Q = 32 * MiB, Y_K = 80 * MiB, Y_V = 128 * MiB;
constexpr size_t WS_END = 254 * MiB;
static_assert(WO_WDN + 2 * WDN_BYTES <= 42 * MiB && WS_W + 42 * MiB <= WS_HB && WS_HB + 32 * MiB <= WS_Y && WS_Y + 176 * MiB <= WS_END, "d_ws map");
constexpr int CW_BAR = 1024;

constexpr int RING_OFF = 0, RING_BYTES = 131072;
constexpr int LDSCTL_OFF = RING_BYTES, MISC_OFF = LDSCTL_OFF + 320;
constexpr int LDS_BYTES = 147456;

#define GAS __attribute__((address_space(1)))
#define LAS __attribute__((address_space(3)))
typedef unsigned short bf16;
typedef unsigned v4u __attribute__((ext_vector_type(4)));
typedef unsigned v2u __attribute__((ext_vector_type(2)));
typedef float f32x4 __attribute__((ext_vector_type(4)));
typedef GAS unsigned gu32;
#define RLX_AGENT __ATOMIC_RELAXED, __HIP_MEMORY_SCOPE_AGENT
#define LDS_WAIT() asm volatile("s_waitcnt lgkmcnt(0)" ::: "memory")
#define VM_WAIT() asm volatile("s_waitcnt vmcnt(0)" ::: "memory")
__device__ __forceinline__ unsigned f2bf(float f) { unsigned u = __builtin_bit_cast(unsigned, f); return (u + 0x7fffu + ((u >> 16) & 1u)) >> 16; }
__device__ __forceinline__ unsigned pk2(float lo, float hi) { return f2bf(lo) | (f2bf(hi) << 16); }
__device__ __forceinline__ float bflo(unsigned w) { return __uint_as_float(w << 16); }
__device__ __forceinline__ float bfhi(unsigned w) { return __uint_as_float(w & 0xffff0000u); }

#define XB_TMO      128
#define XB_XCNT(j)  (256  + 64 * (j))
#define XB_XSUB(j)  (1280 + 64 * (j))
#define XB_XGEN(j)  (2304 + 64 * (j))
#define XB_TOP      3328
#define XB_TOPGEN   3392
#define XCD_BAR_WORDS 3456
#define XB_SPIN_CAP (1u << 18)
static_assert((CW_BAR + XCD_BAR_WORDS) * 4 <= (int)CTL_ZERO_BYTES, "barrier words inside the zeroed region");

__device__ __forceinline__ unsigned xb_ld(unsigned* p)              { return __hip_atomic_load(p, __ATOMIC_RELAXED, __HIP_MEMORY_SCOPE_AGENT); }
__device__ __forceinline__ unsigned xb_add(unsigned* p, unsigned v) { return __hip_atomic_fetch_add(p, v, __ATOMIC_RELAXED, __HIP_MEMORY_SCOPE_AGENT); }
__device__ __forceinline__ unsigned xb_xcc_id() { return (unsigned)__builtin_amdgcn_s_getreg((3 << 11) | 20) & 0xFu; }
#define XB_SPIN(cond, bar) do { unsigned _sp = 0; while (cond) { __builtin_amdgcn_s_sleep(1); \
    if ((++_sp & 255u) == 0u) { if (xb_ld(&(bar)[XB_TMO])) break; if (_sp > XB_SPIN_CAP) { atomicAdd(&(bar)[XB_TMO], 1u); break; } } } } while (0)

struct XcdBarrier { unsigned* bar; unsigned x; volatile LAS unsigned* st; };

__device__ __forceinline__ XcdBarrier xcd_barrier_post(unsigned* bar, volatile LAS unsigned* st) {
    XcdBarrier b; b.bar = bar; b.x = xb_xcc_id(); b.st = st;
    if (threadIdx.x == 0) (void)xb_add(&bar[XB_XCNT(b.x)], 1u);
    return b;
}
__device__ __forceinline__ void xcd_barrier_complete(unsigned* bar, unsigned x, unsigned& nloc, unsigned& nx) {
    const unsigned G = gridDim.x * gridDim.y * gridDim.z;
    unsigned sum, cnt, mine, sp = 0u;
    for (;;) {
        sum = 0u; cnt = 0u; mine = 0u;
#pragma unroll
        for (unsigned j = 0; j < 16; ++j) { const unsigned c = xb_ld(&bar[XB_XCNT(j)]); sum += c; cnt += (c > 0u) ? 1u : 0u; mine = (j == x) ? c : mine; }
        if (sum == G) break;
        __builtin_amdgcn_s_sleep(1);
        if ((++sp & 255u) == 0u) { if (xb_ld(&bar[XB_TMO])) break; if (sp > XB_SPIN_CAP) { atomicAdd(&bar[XB_TMO], 1u); break; } }
    }
    nloc = mine > 0u ? mine : 1u; nx = cnt > 0u ? cnt : 1u;
}
__device__ __forceinline__ void xcd_barrier(const XcdBarrier& b) {
    asm volatile("s_waitcnt vmcnt(0)" ::: "memory");
    __syncthreads();
    if (threadIdx.x == 0) {
        unsigned* bar = b.bar; unsigned bx_ = b.x; asm volatile("" : "+s"(bar), "+s"(bx_));
        __builtin_amdgcn_s_waitcnt(0);
        unsigned nloc = b.st[0], nx = b.st[1];
        if (nloc == 0u) { xcd_barrier_complete(bar, bx_, nloc, nx); b.st[0] = nloc; b.st[1] = nx; }
        const unsigned old = xb_add(&bar[XB_XSUB(bx_)], 1u);
        const unsigned gen = old / nloc;
        if (old + 1u == (gen + 1u) * nloc) {
            __builtin_amdgcn_fence(__ATOMIC_RELEASE, "agent");
            asm volatile("s_waitcnt vmcnt(0)" ::: "memory");
            const unsigned og = xb_add(&bar[XB_TOP], 1u);
            const unsigned tg = og / nx;
            if (og + 1u == (tg + 1u) * nx) xb_add(&bar[XB_TOPGEN], 1u);
            else XB_SPIN(xb_ld(&bar[XB_TOPGEN]) == tg, bar);
            __builtin_amdgcn_fence(__ATOMIC_ACQUIRE, "agent");
            xb_add(&bar[XB_XGEN(bx_)], 1u);
            asm volatile("s_waitcnt vmcnt(0)" ::: "memory");
        } else {
            XB_SPIN(xb_ld(&bar[XB_XGEN(bx_)]) == gen, bar);
            __builtin_amdgcn_fence(__ATOMIC_ACQUIRE, "agent");
            asm volatile("s_waitcnt vmcnt(0)" ::: "memory");
        }
    }
    __syncthreads();
}

struct Frame {
    LAS unsigned char* lds;
    volatile LAS unsigned* MISC;
    gu32* ctl;
    int tid, lane, wave;
    int vcu, G;
    int gw, NGW;
    unsigned char* ws;
    const float* const* in; float* out;
};

__device__ __forceinline__ float wave_sum(float v) {
#pragma unroll
    for (int o = 1; o < 64; o <<= 1) v += __shfl_xor(v, o);
    return v;
}
__device__ __forceinline__ float wave_max(float v) {
#pragma unroll
    for (int o = 1; o < 64; o <<= 1) v = fmaxf(v, __shfl_xor(v, o));
    return v;
}

__device__ __forceinline__ void p0_transpose_item(const float* W, const float* gain, int K, int N, bf16* WT, LAS float* scr, int item, int lane) {
    const int nblk = N / 32, kb = item / nblk, nb = item % nblk, k0 = 64 * kb, n0 = 32 * nb;
#pragma unroll 8
    for (int i = 0; i < 32; ++i) { const int kk = 2 * i + (lane >> 5); const float gsc = gain ? gain[k0 + kk] : 1.0f; scr[kk * 33 + (lane & 31)] = W[(size_t)(k0 + kk) * N + n0 + (lane & 31)] * gsc; }
    LDS_WAIT(); asm volatile("" ::: "memory");
    const int c = lane & 7;
#pragma unroll
    for (int j = 0; j < 4; ++j) { const int n = (lane >> 3) + 8 * j; const LAS float* s = scr + (8 * c) * 33 + n;
        v4u o; o.x = pk2(s[0 * 33], s[1 * 33]); o.y = pk2(s[2 * 33], s[3 * 33]); o.z = pk2(s[4 * 33], s[5 * 33]); o.w = pk2(s[6 * 33], s[7 * 33]);
        *(GAS v4u*)(WT + (size_t)(n0 + n) * K + k0 + 8 * c) = o; }
    LDS_WAIT(); asm volatile("" ::: "memory");
}

__device__ __forceinline__ void convert_weights(Frame& F, int l, bool with_down) {
    LAS float* scr = (LAS float*)(F.lds + RING_OFF + F.wave * 16384);
    unsigned char* wb = F.ws + WS_W;
    const float* w_in = F.in[1] + (size_t)l * D * NIN; const float* w_b = F.in[5] + (size_t)l * AO * D; const float* w_o = F.in[6] + (size_t)l * D * D;
    const float* w_up = F.in[9] + (size_t)l * D * NUP; const float* n1 = F.in[7] + (size_t)l * D; const float* n2 = F.in[8] + (size_t)l * D;
    constexpr int I_IN = (D / 64) * (NIN / 32), I_B = (AO / 64) * (D / 32), I_O = (D / 64) * (D / 32), I_UP = (D / 64) * (NUP / 32), I_DN = (DFF / 64) * (D / 32);
    const int nitems = I_IN + I_B + I_O + I_UP + (with_down ? 2 * I_DN : 0);
    for (int it = F.gw; it < nitems; it += F.NGW) {
        int r = it;
        if (r < I_IN) { p0_transpose_item(w_in, n1, D, NIN, (bf16*)(wb + WO_WIN), scr, r, F.lane); continue; } r -= I_IN;
        if (r < I_B) { p0_transpose_item(w_b, nullptr, AO, D, (bf16*)(wb + WO_WB), scr, r, F.lane); continue; } r -= I_B;
        if (r < I_O) { p0_transpose_item(w_o, nullptr, D, D, (bf16*)(wb + WO_WO), scr, r, F.lane); continue; } r -= I_O;
        if (r < I_UP) { p0_transpose_item(w_up, n2, D, NUP, (bf16*)(wb + WO_WUP), scr, r, F.lane); continue; } r -= I_UP;
        const int ll = r / I_DN; r -= ll * I_DN;
        p0_transpose_item(F.in[12] + (size_t)ll * DFF * D, nullptr, DFF, D, (bf16*)(wb + WO_WDN + ll * WDN_BYTES), scr, r, F.lane);
    }
    const float* w_pool = F.in[2] + (size_t)l * 4 * 256 * 256; const float* ps = F.in[3] + (size_t)l * D; const float* w_a = F.in[4] + (size_t)l * D * D;
    bf16* Wc = (bf16*)(wb + WO_WC);
    LAS float* As = (LAS float*)(F.lds + RING_OFF);
    LAS float* Bs = (LAS float*)(F.lds + RING_OFF + 64 * 129 * 4);
    __syncthreads();
    for (int tile = F.vcu; tile < 4 * 4 * 16; tile += F.G) {
        const int g = tile >> 6, cb = (tile >> 4) & 3, nb = tile & 15, c0 = cb * 64, n0 = nb * 64;
        float acc[8];
#pragma unroll
        for (int e = 0; e < 8; ++e) acc[e] = 0.f;
        for (int dc = 0; dc < 2; ++dc) {
            const int d0 = dc * 128;
            for (int i = F.tid; i < 64 * 128; i += NWAVES * 64) { const int c = i >> 7, d = i & 127; As[c * 129 + d] = w_pool[((size_t)g * 256 + c0 + c) * 256 + d0 + d] * ps[g * 256 + d0 + d]; }
            for (int i = F.tid; i < 128 * 64; i += NWAVES * 64) { const int d = i >> 6, n = i & 63; Bs[d * 65 + n] = w_a[(size_t)(g * 256 + d0 + d) * D + n0 + n]; }
            __syncthreads();
            const LAS float* ap = As + (F.wave * 8) * 129; const LAS float* bp = Bs + F.lane;
#pragma unroll 4
            for (int d = 0; d < 128; ++d) { const float bv = bp[d * 65];
#pragma unroll
                for (int e = 0; e < 8; ++e) acc[e] += ap[e * 129 + d] * bv; }
            __syncthreads();
        }
        v4u o; o.x = pk2(acc[0], acc[1]); o.y = pk2(acc[2], acc[3]); o.z = pk2(acc[4], acc[5]); o.w = pk2(acc[6], acc[7]);
        *(GAS v4u*)(Wc + (size_t)(n0 + F.lane) * D + g * 256 + c0 + F.wave * 8) = o;
    }
}

__device__ __forceinline__ void p0_x_rows(Frame& F) {
    const float* x = F.in[0]; bf16* hb = (bf16*)(F.ws + WS_HB); float* part = (float*)(F.ws + WS_PART);
    for (int m = F.gw; m < M; m += F.NGW) {
        const GAS f32x4* xr = (const GAS f32x4*)(x + (size_t)m * D) + F.lane;
        f32x4 v[4]; float s = 0.f;
#pragma unroll
        for (int j = 0; j < 4; ++j) { v[j] = xr[64 * j]; s += (v[j].x * v[j].x + v[j].y * v[j].y) + (v[j].z * v[j].z + v[j].w * v[j].w); }
        s = wave_sum(s);
        GAS unsigned long long* o8 = (GAS unsigned long long*)(hb + (size_t)m * D) + F.lane;
#pragma unroll
        for (int j = 0; j < 4; ++j) o8[64 * j] = (unsigned long long)pk2(v[j].x, v[j].y) | ((unsigned long long)pk2(v[j].z, v[j].w) << 32);
        if (F.lane < 16) part[(size_t)F.lane * M + m] = (F.lane == 0) ? s : 0.f;
    }
}

__device__ __forceinline__ int t5_bucket(int rel) {
    const int ret = rel > 0 ? 16 : 0; const int n = rel < 0 ? -rel : rel;
    int b;
    if (n < 8) b = n; else if (n < 15) b = 8; else if (n < 27) b = 9; else if (n < 50) b = 10; else if (n < 91) b = 11; else if (n < 166) b = 12; else if (n < 305) b = 13; else if (n < 559) b = 14; else b = 15;
    return ret + b;
}

__device__ __forceinline__ void attn_simple(Frame& F) {
    bf16* Q = (bf16*)(F.ws + WS_Y + Y_Q); const bf16* Kb = (const bf16*)(F.ws + WS_Y + Y_K); const bf16* V = (const bf16*)(F.ws + WS_Y + Y_V);
    const float* rel_bias = F.in[13];
    LAS float* qs = (LAS float*)(F.lds + RING_OFF + F.wave * 2048);
    const int lane = F.lane; const float scale = 0.08838834764831845f;
    for (int item = F.gw; item < M * 4; item += F.NGW) {
        const int tok = item >> 2, h = item & 3, b = tok >> 11, s = tok & (S - 1);
#pragma unroll
        for (int g = 0; g < 3; ++g) { const unsigned w = *(const GAS unsigned*)(Q + (size_t)tok * AW + (g * 4 + h) * HD + 2 * lane); qs[g * 128 + 2 * lane] = bflo(w); qs[g * 128 + 2 * lane + 1] = bfhi(w); }
        LDS_WAIT(); asm volatile("" ::: "memory");
        float mrun = -1e30f, lrun = 0.f, o0 = 0.f, o1 = 0.f;
#pragma unroll 1
        for (int g = 0; g < 3; ++g) {
            const int dl = 1 << (2 * g), head = g * 4 + h;
            float sc[3];
#pragma unroll
            for (int p = 0; p < 3; ++p) {
                const int jj = lane + 64 * p, j = jj - 64, pos = s + dl * j;
                const bool valid = (jj <= 128) && pos >= 0 && pos < S;
                float dot = 0.f;
                if (valid) {
                    const bf16* krow = Kb + ((size_t)b * S + pos) * AW + head * HD;
#pragma unroll 4
                    for (int c = 0; c < 16; ++c) { const v4u kv = *(const GAS v4u*)(krow + 8 * c); const LAS float* qq = qs + g * 128 + 8 * c;
                        dot += bflo(kv.x) * qq[0] + bfhi(kv.x) * qq[1] + bflo(kv.y) * qq[2] + bfhi(kv.y) * qq[3] + bflo(kv.z) * qq[4] + bfhi(kv.z) * qq[5] + bflo(kv.w) * qq[6] + bfhi(kv.w) * qq[7]; }
                }
                const float bias = (jj <= 128) ? rel_bias[t5_bucket(dl * j) * 12 + head] : 0.f;
                sc[p] = valid ? dot * scale + bias : -1e30f;
            }
            const float gmax = wave_max(fmaxf(fmaxf(sc[0], sc[1]), sc[2]));
            const float mnew = fmaxf(mrun, gmax);
            const float alpha = __expf(mrun - mnew);
            float pr[3];
#pragma unroll
            for (int p = 0; p < 3; ++p) pr[p] = (sc[p] > -1e29f) ? __expf(sc[p] - mnew) : 0.f;
            const float psum = wave_sum(pr[0] + pr[1] + pr[2]);
            lrun = lrun * alpha + psum; o0 *= alpha; o1 *= alpha; mrun = mnew;
#pragma unroll 1
            for (int jj = 0; jj <= 128; ++jj) {
                const int pos = s + dl * (jj - 64);
                if (pos < 0 || pos >= S) continue;
                const float pj = __shfl(jj < 64 ? pr[0] : (jj < 128 ? pr[1] : pr[2]), jj & 63);
                const unsigned w = *(const GAS unsigned*)(V + ((size_t)b * S + pos) * AW + head * HD + 2 * lane);
                o0 += pj * bflo(w); o1 += pj * bfhi(w);
            }
        }
        const float inv = 1.0f / lrun;
        *(GAS unsigned*)(Q + (size_t)tok * AW + h * HD + 2 * lane) = pk2(o0 * inv, o1 * inv);
        LDS_WAIT(); asm volatile("" ::: "memory");
    }
}

namespace att {
typedef short bf16x8 __attribute__((ext_vector_type(8)));
typedef short s16x4 __attribute__((ext_vector_type(4)));
typedef float f32x16 __attribute__((ext_vector_type(16)));
__device__ __forceinline__ unsigned off_b(unsigned row, unsigned ch) { return 256u * row + 16u * (ch ^ (((row & 3u) << 2) | ((row >> 2) & 3u))); }
__device__ __forceinline__ s16x4 vtr(const LAS unsigned char* p) { return __builtin_bit_cast(s16x4, __builtin_amdgcn_ds_read_tr16_b64_v4i16((LAS s16x4*)p)); }
constexpr int N_UNITS = BATCH * 3 * 2 * 16;
constexpr int BIAS_OFF = RING_BYTES + 2048;
}
__device__ __forceinline__ void attn_mfma(Frame& F) {
    using namespace att;
    bf16* Q = (bf16*)(F.ws + WS_Y + Y_Q); const bf16* Kg = (const bf16*)(F.ws + WS_Y + Y_K); const bf16* Vg = (const bf16*)(F.ws + WS_Y + Y_V);
    float* LSE = (float*)(F.ws + WS_LSE); const float* rel_bias = F.in[13];
    const int lane = F.lane, wave = F.wave, half = wave >> 2, j = wave & 3, ql = lane & 31, hh = lane >> 5, th = F.tid & 255;
    const float LOG2E = 1.4426950408889634f, CS = 0.08838834764831845f * 1.4426950408889634f;
    LAS unsigned char* hb = F.lds + RING_OFF + half * 65536;
    LAS float* bt = (LAS float*)(F.lds + BIAS_OFF + half * 1024);
    const int nper = (N_UNITS + F.G - 1) / F.G;
    const int u_lo = F.vcu * nper, u_hi = (u_lo + nper < N_UNITS) ? u_lo + nper : N_UNITS;
#pragma unroll 1
    for (int u = u_lo; u < u_hi; ++u) {
        const int t16 = u & 15, rest = u >> 4, hp = rest & 1, g = (rest >> 1) % 3, b = rest / 6;
        const int sh = 2 * g, dl = 1 << sh, L = S >> sh;
        const int r = (g == 0) ? 0 : (g == 1 ? (t16 >> 2) : t16), mt = (g == 0) ? t16 : (g == 1 ? (t16 & 3) : 0), m0 = mt * 128;
        const int hl = hp * 2 + half, hd = g * 4 + hl;
        const size_t tokbase = (size_t)b * S + r;
        { const int jrel = th - 128; float v = 0.f; if (jrel >= -64 && jrel <= 64) v = rel_bias[t5_bucket(dl * jrel) * 12 + hd] * LOG2E; bt[th] = v; }
        const int mq = m0 + 32 * j + ql;
        bf16* qrow = Q + (tokbase + (size_t)dl * mq) * AW + hd * HD;
        bf16x8 qf[8];
#pragma unroll
        for (int s2 = 0; s2 < 8; ++s2) qf[s2] = *(const GAS bf16x8*)(qrow + 16 * s2 + 8 * hh);
        const int kb_lo = (m0 == 0) ? 1 : 0; int kb_hi = (L - 1 - m0 + 64) >> 6; kb_hi = kb_hi > 3 ? 3 : kb_hi;
        v4u kreg[4], vreg[4];
        const int srow = th >> 4, sch = th & 15;
#define ATT_STAGE_LOAD(kb_) do { _Pragma("unroll") for (int i = 0; i < 4; ++i) { const int row = srow + 16 * i, mk = m0 - 64 + 64 * (kb_) + row; const bool ok = (unsigned)mk < (unsigned)L; \
                const size_t off = (tokbase + (size_t)dl * (ok ? mk : 0)) * AW + hd * HD + sch * 8; const v4u z = {0u, 0u, 0u, 0u}; \
                kreg[i] = ok ? *(const GAS v4u*)(Kg + off) : z; vreg[i] = ok ? *(const GAS v4u*)(Vg + off) : z; } } while (0)
#define ATT_STAGE_WRITE(buf_) do { _Pragma("unroll") for (int i = 0; i < 4; ++i) { const unsigned o = off_b((unsigned)(srow + 16 * i), (unsigned)sch); \
                *(LAS v4u*)(hb + (buf_) * 16384 + o) = kreg[i]; *(LAS v4u*)(hb + 32768 + (buf_) * 16384 + o) = vreg[i]; } } while (0)
        float m_run = -1e20f, l_run = 0.f;
        f32x16 O[4];
#pragma unroll
        for (int c = 0; c < 4; ++c)
#pragma unroll
            for (int i = 0; i < 16; ++i) O[c][i] = 0.f;
        ATT_STAGE_LOAD(kb_lo); ATT_STAGE_WRITE(0);
        __syncthreads();
#pragma unroll 1
        for (int kb = kb_lo; kb <= kb_hi; ++kb) {
            const int cur = (kb - kb_lo) & 1;
            if (kb < kb_hi) ATT_STAGE_LOAD(kb + 1);
            if (kb >= (j >> 1) && kb <= (j >> 1) + 2) {
                const LAS unsigned char* kbuf = hb + cur * 16384; const LAS unsigned char* vbuf = hb + 32768 + cur * 16384;
                f32x16 s0, s1;
#pragma unroll
                for (int i = 0; i < 16; ++i) { s0[i] = 0.f; s1[i] = 0.f; }
#pragma unroll
                for (int s2 = 0; s2 < 8; ++s2) {
                    const bf16x8 a0 = *(const LAS bf16x8*)(kbuf + off_b((unsigned)ql, (unsigned)(2 * s2 + hh)));
                    const bf16x8 a1 = *(const LAS bf16x8*)(kbuf + off_b((unsigned)(32 + ql), (unsigned)(2 * s2 + hh)));
                    s0 = __builtin_amdgcn_mfma_f32_32x32x16_bf16(a0, qf[s2], s0, 0, 0, 0);
                    s1 = __builtin_amdgcn_mfma_f32_32x32x16_bf16(a1, qf[s2], s1, 0, 0, 0);
                }
                const int jb = 64 * kb - 64 - 32 * j - ql, mkb = m0 - 64 + 64 * kb;
                float bmax = -1e30f;
#pragma unroll
                for (int i = 0; i < 16; ++i) {
                    const int kr = (i & 3) + 8 * (i >> 2) + 4 * hh;
                    { const int jrel = jb + kr, mk = mkb + kr; const bool ok = (unsigned)(jrel + 64) <= 128u && (unsigned)mk < (unsigned)L;
                      const float t = ok ? fmaf(s0[i], CS, bt[jrel + 128]) : -1e30f; s0[i] = t; bmax = fmaxf(bmax, t); }
                    { const int jrel = jb + 32 + kr, mk = mkb + 32 + kr; const bool ok = (unsigned)(jrel + 64) <= 128u && (unsigned)mk < (unsigned)L;
                      const float t = ok ? fmaf(s1[i], CS, bt[jrel + 128]) : -1e30f; s1[i] = t; bmax = fmaxf(bmax, t); }
                }
                bmax = fmaxf(bmax, __shfl_xor(bmax, 32));
                const float m_new = fmaxf(m_run, bmax), alpha = __builtin_amdgcn_exp2f(m_run - m_new);
                m_run = m_new;
                float psum = 0.f;
#pragma unroll
                for (int i = 0; i < 16; ++i) { s0[i] = __builtin_amdgcn_exp2f(s0[i] - m_new); s1[i] = __builtin_amdgcn_exp2f(s1[i] - m_new); psum += s0[i] + s1[i]; }
                l_run = l_run * alpha + psum;
#pragma unroll
                for (int c = 0; c < 4; ++c)
#pragma unroll
                    for (int i = 0; i < 16; ++i) O[c][i] *= alpha;
                v4u pk[4];
#pragma unroll
                for (int s2 = 0; s2 < 2; ++s2) {
                    pk[s2].x = pg8::cvt_pk_bf16(s0[8 * s2 + 0], s0[8 * s2 + 1]); pk[s2].y = pg8::cvt_pk_bf16(s0[8 * s2 + 2], s0[8 * s2 + 3]);
                    pk[s2].z = pg8::cvt_pk_bf16(s0[8 * s2 + 4], s0[8 * s2 + 5]); pk[s2].w = pg8::cvt_pk_bf16(s0[8 * s2 + 6], s0[8 * s2 + 7]);
                    pk[2 + s2].x = pg8::cvt_pk_bf16(s1[8 * s2 + 0], s1[8 * s2 + 1]); pk[2 + s2].y = pg8::cvt_pk_bf16(s1[8 * s2 + 2], s1[8 * s2 + 3]);
                    pk[2 + s2].z = pg8::cvt_pk_bf16(s1[8 * s2 + 4], s1[8 * s2 + 5]); pk[2 + s2].w = pg8::cvt_pk_bf16(s1[8 * s2 + 6], s1[8 * s2 + 7]);
                }
                const unsigned blk = (lane >> 4) & 1, tq = (lane & 15) >> 2, tp = lane & 3;
#pragma unroll
                for (int ks = 0; ks < 4; ++ks) {
                    const bf16x8 pb = __builtin_bit_cast(bf16x8, pk[ks]);
#pragma unroll
                    for (int c = 0; c < 4; ++c) {
                        const unsigned chn = 4 * c + 2 * blk + (tp >> 1);
                        const s16x4 lo = vtr(vbuf + off_b(16 * ks + 4 * hh + tq, chn) + 8 * (tp & 1));
                        const s16x4 hi = vtr(vbuf + off_b(16 * ks + 8 + 4 * hh + tq, chn) + 8 * (tp & 1));
                        const bf16x8 va = {lo[0], lo[1], lo[2], lo[3], hi[0], hi[1], hi[2], hi[3]};
                        O[c] = __builtin_amdgcn_mfma_f32_32x32x16_bf16(va, pb, O[c], 0, 0, 0);
                    }
                }
            }
            if (kb < kb_hi) ATT_STAGE_WRITE(cur ^ 1);
            __syncthreads();
        }
#undef ATT_STAGE_LOAD
#undef ATT_STAGE_WRITE
        const float l_tot = l_run + __shfl_xor(l_run, 32);
        const float inv = 1.0f / l_tot;
#pragma unroll
        for (int c = 0; c < 4; ++c)
#pragma unroll
            for (int i4 = 0; i4 < 4; ++i4) {
                v2u w; w.x = pg8::cvt_pk_bf16(O[c][4 * i4 + 0] * inv, O[c][4 * i4 + 1] * inv); w.y = pg8::cvt_pk_bf16(O[c][4 * i4 + 2] * inv, O[c][4 * i4 + 3] * inv);
                *(GAS v2u*)(qrow + 32 * c + 8 * i4 + 4 * hh) = w;
            }
        if (hh == 0) LSE[((size_t)g * M + tokbase + (size_t)dl * mq) * 4 + hl] = m_run + __log2f(l_tot);
    }
}

__device__ __forceinline__ void attn_combine(Frame& F) {
    bf16* Q = (bf16*)(F.ws + WS_Y + Y_Q); const float* LSE = (const float*)(F.ws + WS_LSE);
    const int total = M * 64;
    for (int it = F.gw * 64 + F.lane; it < total; it += F.NGW * 64) {
        const int tok = it >> 6, h = (it >> 4) & 3, ch = it & 15;
        const float l0 = LSE[((size_t)0 * M + tok) * 4 + h], l1 = LSE[((size_t)1 * M + tok) * 4 + h], l2 = LSE[((size_t)2 * M + tok) * 4 + h];
        const float mx = fmaxf(l0, fmaxf(l1, l2));
        float w0 = __builtin_amdgcn_exp2f(l0 - mx), w1 = __builtin_amdgcn_exp2f(l1 - mx), w2 = __builtin_amdgcn_exp2f(l2 - mx);
        const float inv = 1.0f / (w0 + w1 + w2); w0 *= inv; w1 *= inv; w2 *= inv;
        bf16* p = Q + (size_t)tok * AW + h * HD + ch * 8;
        const v4u a = *(const GAS v4u*)(p), b2 = *(const GAS v4u*)(p + 512), c = *(const GAS v4u*)(p + 1024);
        v4u o;
        o.x = pk2(w0 * bflo(a.x) + w1 * bflo(b2.x) + w2 * bflo(c.x), w0 * bfhi(a.x) + w1 * bfhi(b2.x) + w2 * bfhi(c.x));
        o.y = pk2(w0 * bflo(a.y) + w1 * bflo(b2.y) + w2 * bflo(c.y), w0 * bfhi(a.y) + w1 * bfhi(b2.y) + w2 * bfhi(c.y));
        o.z = pk2(w0 * bflo(a.z) + w1 * bflo(b2.z) + w2 * bflo(c.z), w0 * bfhi(a.z) + w1 * bfhi(b2.z) + w2 * bfhi(c.z));
        o.w = pk2(w0 * bflo(a.w) + w1 * bflo(b2.w) + w2 * bflo(c.w), w0 * bfhi(a.w) + w1 * bfhi(b2.w) + w2 * bfhi(c.w));
        *(GAS v4u*)(p) = o;
    }
}

__device__ __forceinline__ void pool_simple(Frame& F) {
    const bf16* U = (const bf16*)(F.ws + WS_Y + Y_U); bf16* P = (bf16*)(F.ws + WS_Y + Y_K);
    const int total = M * (D / 8);
    for (int it = F.gw * 64 + F.lane; it < total; it += F.NGW * 64) {
        const int tok = it >> 7, ch = it & 127, s = tok & (S - 1), g = ch >> 5, w = 2 << g;
        int lo = s - (w >> 1), hi = lo + w; lo = lo < 0 ? 0 : lo; hi = hi > S ? S : hi;
        const bf16* base = U + (size_t)(tok - s) * D + ch * 8;
        float a[8];
#pragma unroll
        for (int e = 0; e < 8; ++e) a[e] = 0.f;
        for (int r = lo; r < hi; ++r) { const v4u v = *(const GAS v4u*)(base + (size_t)r * D);
            a[0] += bflo(v.x); a[1] += bfhi(v.x); a[2] += bflo(v.y); a[3] += bfhi(v.y); a[4] += bflo(v.z); a[5] += bfhi(v.z); a[6] += bflo(v.w); a[7] += bfhi(v.w); }
        const float inv = 1.0f / (float)(hi - lo);
        const v4u c = *(const GAS v4u*)(base + (size_t)s * D);
        v4u o; o.x = pk2(a[0] * inv - bflo(c.x), a[1] * inv - bfhi(c.x)); o.y = pk2(a[2] * inv - bflo(c.y), a[3] * inv - bfhi(c.y));
        o.z = pk2(a[4] * inv - bflo(c.z), a[5] * inv - bfhi(c.z)); o.w = pk2(a[6] * inv - bflo(c.w), a[7] * inv - bfhi(c.w));
        *(GAS v4u*)(P + (size_t)tok * D + ch * 8) = o;
    }
}

__device__ __forceinline__ void pool_slide(Frame& F) {
    const bf16* U = (const bf16*)(F.ws + WS_Y + Y_U); bf16* P = (bf16*)(F.ws + WS_Y + Y_K);
    constexpr int T = 16; constexpr int NIT = BATCH * 4 * (S / (2 * T));
    for (int it = F.gw; it < NIT; it += F.NGW) {
        const int seg2 = it & 63, g = (it >> 6) & 3, b = it >> 8;
        const int w = 2 << g, hw = w >> 1;
        const int t0 = (seg2 * 2 + (F.lane >> 5)) * T, ch = g * 32 + (F.lane & 31);
        const bf16* base = U + (size_t)b * S * D + ch * 8; bf16* obase = P + (size_t)b * S * D + ch * 8;
        float a[8];
#pragma unroll
        for (int e = 0; e < 8; ++e) a[e] = 0.f;
        { int lo = t0 - hw, hi = lo + w; lo = lo < 0 ? 0 : lo; hi = hi > S ? S : hi;
          for (int r = lo; r < hi; ++r) { const v4u v = *(const GAS v4u*)(base + (size_t)r * D);
              a[0] += bflo(v.x); a[1] += bfhi(v.x); a[2] += bflo(v.y); a[3] += bfhi(v.y); a[4] += bflo(v.z); a[5] += bfhi(v.z); a[6] += bflo(v.w); a[7] += bfhi(v.w); } }
#pragma unroll 4
        for (int i = 0; i < T; ++i) {
            const int t = t0 + i;
            int lo = t - hw, hi = lo + w; lo = lo < 0 ? 0 : lo; hi = hi > S ? S : hi;
            const float inv = 1.0f / (float)(hi - lo);
            const v4u c = *(const GAS v4u*)(base + (size_t)t * D);
            v4u o; o.x = pk2(a[0] * inv - bflo(c.x), a[1] * inv - bfhi(c.x)); o.y = pk2(a[2] * inv - bflo(c.y), a[3] * inv - bfhi(c.y));
            o.z = pk2(a[4] * inv - bflo(c.z), a[5] * inv - bfhi(c.z)); o.w = pk2(a[6] * inv - bflo(c.w), a[7] * inv - bfhi(c.w));
            *(GAS v4u*)(obase + (size_t)t * D) = o;
            const int re = t + hw, rl = t - hw;
            if (re < S) { const v4u v = *(const GAS v4u*)(base + (size_t)re * D);
                a[0] += bflo(v.x); a[1] += bfhi(v.x); a[2] += bflo(v.y); a[3] += bfhi(v.y); a[4] += bflo(v.z); a[5] += bfhi(v.z); a[6] += bflo(v.w); a[7] += bfhi(v.w); }
            if (rl >= 0) { const v4u v = *(const GAS v4u*)(base + (size_t)rl * D);
                a[0] -= bflo(v.x); a[1] -= bfhi(v.x); a[2] -= bflo(v.y); a[3] -= bfhi(v.y); a[4] -= bflo(v.z); a[5] -= bfhi(v.z); a[6] -= bflo(v.w); a[7] -= bfhi(v.w); }
        }
    }
}

__device__ __forceinline__ float gelu_tanh(float x) {
    const float y = 0.7978845608028654f * (x + 0.044715f * x * x * x);
    const float t = 1.0f - 2.0f / (__expf(2.0f * y) + 1.0f);
    return 0.5f * x * (1.0f + t);
}
__device__ __forceinline__ void conv_simple(Frame& F, int l) {
    bf16* AG = (bf16*)(F.ws + WS_Y);
    const float* cw = F.in[10] + (size_t)l * 3 * DFF; const float* cb = F.in[11] + (size_t)l * DFF;
    constexpr int CH = DFF / 8; const int total = M * CH;
    for (int it = F.gw * 64 + F.lane; it < total; it += F.NGW * 64) {
        const int tok = it / CH, ch = it - tok * CH, s = tok & (S - 1), c0 = ch * 8;
        const bf16* ap = AG + (size_t)tok * NUP + c0;
        const v4u z = {0u, 0u, 0u, 0u};
        const v4u am = (s > 0) ? *(const GAS v4u*)(ap - NUP) : z;
        const v4u a0 = *(const GAS v4u*)(ap);
        const v4u ap1 = (s < S - 1) ? *(const GAS v4u*)(ap + NUP) : z;
        const v4u gv = *(const GAS v4u*)(ap + DFF);
        float xm[8] = {bflo(am.x), bfhi(am.x), bflo(am.y), bfhi(am.y), bflo(am.z), bfhi(am.z), bflo(am.w), bfhi(am.w)};
        float x0[8] = {bflo(a0.x), bfhi(a0.x), bflo(a0.y), bfhi(a0.y), bflo(a0.z), bfhi(a0.z), bflo(a0.w), bfhi(a0.w)};
        float xp[8] = {bflo(ap1.x), bfhi(ap1.x), bflo(ap1.y), bfhi(ap1.y), bflo(ap1.z), bfhi(ap1.z), bflo(ap1.w), bfhi(ap1.w)};
        float gg[8] = {bflo(gv.x), bfhi(gv.x), bflo(gv.y), bfhi(gv.y), bflo(gv.z), bfhi(gv.z), bflo(gv.w), bfhi(gv.w)};
        float r[8];
#pragma unroll
        for (int e = 0; e < 8; ++e) { const float v = cw[c0 + e] * xm[e] + cw[DFF + c0 + e] * x0[e] + cw[2 * DFF + c0 + e] * xp[e] + cb[c0 + e]; r[e] = gelu_tanh(v) * gg[e]; }
        v4u o; o.x = pk2(r[0], r[1]); o.y = pk2(r[2], r[3]); o.z = pk2(r[4], r[5]); o.w = pk2(r[6], r[7]);
        *(GAS v4u*)(AG + (size_t)tok * NUP + DFF + c0) = o;
    }
}

__device__ __forceinline__ void conv_slide(Frame& F, int l) {
    bf16* AG = (bf16*)(F.ws + WS_Y);
    const float* cw = F.in[10] + (size_t)l * 3 * DFF; const float* cb = F.in[11] + (size_t)l * DFF;
    constexpr int CH = DFF / 8, CW = (CH + 63) / 64, T = 16, NIT = CW * (M / T);
    const v4u z = {0u, 0u, 0u, 0u};
    for (int it = F.gw; it < NIT; it += F.NGW) {
        const int cwi = it % CW, run = it / CW, ch = cwi * 64 + F.lane;
        if (ch >= CH) continue;
        const int tok0 = run * T, s0 = tok0 & (S - 1), c0 = ch * 8;
        float w0[8], w1[8], w2[8], bb[8];
#pragma unroll
        for (int e = 0; e < 8; ++e) { w0[e] = cw[c0 + e]; w1[e] = cw[DFF + c0 + e]; w2[e] = cw[2 * DFF + c0 + e]; bb[e] = cb[c0 + e]; }
        bf16* ap = AG + (size_t)tok0 * NUP + c0;
        v4u am = (s0 > 0) ? *(const GAS v4u*)(ap - NUP) : z;
        v4u a0 = *(const GAS v4u*)(ap);
#pragma unroll 4
        for (int i = 0; i < T; ++i) {
            const v4u a1 = (s0 + i < S - 1) ? *(const GAS v4u*)(ap + (size_t)(i + 1) * NUP) : z;
            const v4u gv = *(const GAS v4u*)(ap + (size_t)i * NUP + DFF);
            const float xm[8] = {bflo(am.x), bfhi(am.x), bflo(am.y), bfhi(am.y), bflo(am.z), bfhi(am.z), bflo(am.w), bfhi(am.w)};
            const float x0[8] = {bflo(a0.x), bfhi(a0.x), bflo(a0.y), bfhi(a0.y), bflo(a0.z), bfhi(a0.z), bflo(a0.w), bfhi(a0.w)};
            const float xp[8] = {bflo(a1.x), bfhi(a1.x), bflo(a1.y), bfhi(a1.y), bflo(a1.z), bfhi(a1.z), bflo(a1.w), bfhi(a1.w)};
            const float gg[8] = {bflo(gv.x), bfhi(gv.x), bflo(gv.y), bfhi(gv.y), bflo(gv.z), bfhi(gv.z), bflo(gv.w), bfhi(gv.w)};
            float r[8];
#pragma unroll
            for (int e = 0; e < 8; ++e) { const float v = w0[e] * xm[e] + w1[e] * x0[e] + w2[e] * xp[e] + bb[e]; r[e] = gelu_tanh(v) * gg[e]; }
            v4u o; o.x = pk2(r[0], r[1]); o.y = pk2(r[2], r[3]); o.z = pk2(r[4], r[5]); o.w = pk2(r[6], r[7]);
            *(GAS v4u*)(ap + (size_t)i * NUP + DFF) = o;
            am = a0; a0 = a1;
        }
    }
}

__device__ __forceinline__ void final_norm(Frame& F) {
    const float* part = (const float*)(F.ws + WS_PART); const float* nf = F.in[14];
    for (int m = F.gw; m < M; m += F.NGW) {
        float s = 0.f;
#pragma unroll
        for (int t = 0; t < 16; ++t) s += part[(size_t)t * M + m];
        const float rstd = 1.0f / sqrtf(s * (1.0f / 1024.0f) + EPS);
        GAS f32x4* xr = (GAS f32x4*)(F.out + (size_t)m * D) + F.lane; const GAS f32x4* gr = (const GAS f32x4*)nf + F.lane;
#pragma unroll
        for (int j = 0; j < 4; ++j) { const f32x4 v = xr[64 * j]; const f32x4 gq = gr[64 * j]; xr[64 * j] = v * rstd * gq; }
    }
}

struct Args { const float* in[15]; float* out; unsigned char* ws; int ph_lo, ph_hi; int pad0, pad1; };

struct CfgP1 { static constexpr int st1 = 4, st2 = 10, st3 = 16, ld0 = D, ld1 = AW; static constexpr long off1 = (long)(Y_Q - Y_U), off2 = (long)(Y_K - Y_U), off3 = (long)(Y_V - Y_U); };
struct CfgGate { static constexpr int st1 = 4, st2 = 1 << 20, st3 = 1 << 20, ld0 = D, ld1 = D; static constexpr long off1 = (long)Y_U - (long)Y_V, off2 = 0, off3 = 0; };
struct CfgOne { static constexpr int st1 = 1 << 20, st2 = 1 << 20, st3 = 1 << 20, ld0 = D, ld1 = D; static constexpr long off1 = 0, off2 = 0, off3 = 0; };
struct CfgUp { static constexpr int st1 = 1 << 20, st2 = 1 << 20, st3 = 1 << 20, ld0 = NUP, ld1 = NUP; static constexpr long off1 = 0, off2 = 0, off3 = 0; };
template <int MODE, class CFG, int GN, int GK, int GLDA> __device__ __forceinline__ void run_gemm_b(Frame& F, const bf16* A, const bf16* Bt, bf16* O, const bf16* X1, const bf16* X2) {
    pg8::EpiB<MODE, CFG> E; E.O = O; E.part = (const float*)(F.ws + WS_PART); E.X1 = X1; E.X2 = X2;
    pg8::gemm_phase<pg8::EpiB<MODE, CFG>, GN, GK, GLDA, PG8_ALIGN, PG8_SP2>(F.lds + RING_OFF, A, Bt, F.G, (int)blockIdx.x, E);
}
template <int GK, int GLDA> __device__ __forceinline__ void run_gemm_r(Frame& F, const bf16* A, const bf16* Bt, const float* base) {
    pg8::EpiRes E{base, F.out, (bf16*)(F.ws + WS_HB), (float*)(F.ws + WS_PART), M};
    pg8::gemm_phase<pg8::EpiRes, D, GK, GLDA, PG8_ALIGN, PG8_SP2>(F.lds + RING_OFF, A, Bt, F.G, (int)blockIdx.x, E);
}

struct P3Prog {
    unsigned char* ws; int G, c;
    __device__ __forceinline__ bool get(int i, pg8::UnitD& u) const {
        const int it = i >> 2, sub = i & 3; const int Lw = it * G + c; if (Lw >= 256) return false;
        const int wgid = (Lw & 7) * 32 + (Lw >> 3);
        const int pm = (wgid >> 5) * 8 + (wgid & 7), pn = (wgid & 31) >> 3;
        u.pm = pm; u.pn = pn; u.sub = sub;
        const unsigned char* A; const unsigned char* Bt; int K = D, lda = D;
        if (sub <= 1) { A = ws + WS_HB; Bt = ws + WS_W + WO_WIN + (size_t)(NUQKV + sub * D) * D * 2; }
        else if (sub == 2) { A = ws + WS_Y + Y_K; Bt = ws + WS_W + WO_WC; }
        else { A = ws + WS_Y + Y_Q; Bt = ws + WS_W + WO_WB; K = AO; lda = AW; }
        u.K = K; u.lda = lda; u.nt = K / 64;
        u.A = (const char*)A + (size_t)pm * 256 * lda * 2; u.Bt = (const char*)Bt + (size_t)pn * 256 * K * 2;
        return true;
    }
    __device__ __forceinline__ void epi(const pg8::f32x4 (&acc)[2][2][4][2], const pg8::UnitD& u, int wr, int wc, int fr, int fq) const {
        const int lane = fr + 16 * fq, col0 = u.pn * 256 + wc * 32 + 8 * fq;
        bf16* SGP = (bf16*)(ws + WS_Y + Y_V); bf16* SGA = (bf16*)(ws + WS_Y + Y_U); bf16* T1 = (bf16*)(ws + WS_Y + Y_Q) + 512; const float* part = (const float*)(ws + WS_PART);
        if (u.sub == 0) pg8::epi_bf16<1>(acc, u.pm, col0, wr, fr, lane, SGP, D, part, nullptr, 0, nullptr, 0);
        else if (u.sub == 1) pg8::epi_bf16<1>(acc, u.pm, col0, wr, fr, lane, SGA, D, part, nullptr, 0, nullptr, 0);
        else if (u.sub == 2) pg8::epi_bf16<2>(acc, u.pm, col0, wr, fr, lane, T1, AW, part, SGP, D, nullptr, 0);
        else pg8::epi_bf16<3>(acc, u.pm, col0, wr, fr, lane, SGP, D, part, T1, AW, SGA, D);
    }
};

#define IN(k) (lo <= (k) && (k) < hi)
#define SEAM(k) do { if (IN(k) && IN((k) + 1)) xcd_barrier(bar); } while (0)
template <int L> __device__ __forceinline__ void layer_phases(Frame& F, int lo, int hi, const XcdBarrier& bar) {
    constexpr int pb = 1 + 10 * L;
    unsigned char* ws = F.ws;
    bf16* HB = (bf16*)(ws + WS_HB);
    bf16* YU = (bf16*)(ws + WS_Y + Y_U); bf16* YQ = (bf16*)(ws + WS_Y + Y_Q); bf16* YK = (bf16*)(ws + WS_Y + Y_K); bf16* YV = (bf16*)(ws + WS_Y + Y_V);
    bf16* W_IN = (bf16*)(ws + WS_W + WO_WIN);
    if (IN(pb + 0)) { run_gemm_b<0, CfgP1, NUQKV, D, D>(F, HB, W_IN, YU, nullptr, nullptr); SEAM(pb + 0); }
#if defined(ATTN_ORACLE)
    if (IN(pb + 1)) { attn_simple(F); SEAM(pb + 1); }
#else
    if (IN(pb + 1)) { attn_mfma(F); SEAM(pb + 1); }
#endif
#if defined(ATTN_ORACLE)
    if (IN(pb + 2)) { pool_simple(F); SEAM(pb + 2); }
#else
    if (IN(pb + 2)) { attn_combine(F); pool_slide(F); SEAM(pb + 2); }
#endif
    if (IN(pb + 3)) { P3Prog P{F.ws, F.G, (int)blockIdx.x}; pg8::gemm_stream<P3Prog>(F.lds + RING_OFF, P); if (IN(pb + 6)) xcd_barrier(bar); }
    if (IN(pb + 6)) { run_gemm_r<D, D>(F, YV, (const bf16*)(ws + WS_W + WO_WO), L == 0 ? F.in[0] : (const float*)F.out); SEAM(pb + 6); }
    if (IN(pb + 7)) { run_gemm_b<0, CfgUp, NUP, D, D>(F, HB, (const bf16*)(ws + WS_W + WO_WUP), YU, nullptr, nullptr); SEAM(pb + 7); }
    if (IN(pb + 8)) { conv_slide(F, L); if (L + 1 < DEPTH) convert_weights(F, L + 1, false); SEAM(pb + 8); }
    if (IN(pb + 9)) { run_gemm_r<DFF, NUP>(F, YU + DFF, (const bf16*)(ws + WS_W + WO_WDN + L * WDN_BYTES), (const float*)F.out); SEAM(pb + 9); }
}
#undef IN
#undef SEAM

__global__ void __launch_bounds__(NWAVES * 64, 2) fwd_kernel(Args args) {
    extern __shared__ __attribute__((aligned(16))) unsigned char lds[];
    Frame F;
    F.lds = (LAS unsigned char*)lds;
    F.MISC = (volatile LAS unsigned*)(F.lds + MISC_OFF);
    F.tid = threadIdx.x; F.lane = F.tid & 63; F.wave = __builtin_amdgcn_readfirstlane(F.tid >> 6);
    F.G = gridDim.x; { const int bx = blockIdx.x; F.vcu = (F.G % 8 == 0) ? (bx % 8) * (F.G / 8) + bx / 8 : bx; }
    F.gw = F.vcu * NWAVES + F.wave; F.NGW = F.G * NWAVES;
    F.ws = args.ws; F.ctl = (gu32*)(args.ws + WS_CTL); F.out = args.out;
    F.in = args.in;
    for (int u = F.tid; u < (LDS_BYTES - LDSCTL_OFF) / 4; u += NWAVES * 64) ((LAS unsigned*)(F.lds + LDSCTL_OFF))[u] = 0u;
    __syncthreads();
    const int lo = args.ph_lo, hi = args.ph_hi;
    XcdBarrier bar; bar.bar = (unsigned*)(F.ctl + CW_BAR); bar.x = 0; bar.st = nullptr;
    if (hi - lo > 1) bar = xcd_barrier_post((unsigned*)(F.ctl + CW_BAR), F.MISC + 8);

#define IN(k) (lo <= (k) && (k) < hi)
#define SEAM(k) do { if (IN(k) && IN((k) + 1)) xcd_barrier(bar); } while (0)
    if (IN(0)) { convert_weights(F, 0, true); p0_x_rows(F); SEAM(0); }
    layer_phases<0>(F, lo, hi, bar);
    layer_phases<1>(F, lo, hi, bar);
    if (IN(N_PHASES - 1)) final_norm(F);
}
#undef IN
#undef SEAM

#ifdef DBG_STOP
__global__ void dbg_dump(const unsigned char* ws, float* out, size_t o0, size_t o1, size_t o2, size_t o3, int n_off, int is_f32) {
    const size_t n = (size_t)M * D;
    for (size_t i = (size_t)blockIdx.x * blockDim.x + threadIdx.x; i < n; i += (size_t)gridDim.x * blockDim.x) {
        float acc = 0.f; const size_t offs[4] = {o0, o1, o2, o3};
        for (int r = 0; r < n_off; ++r) { if (is_f32) acc += ((const float*)(ws + offs[r]))[i]; else acc += __uint_as_float((unsigned)((const unsigned short*)(ws + offs[r]))[i] << 16); }
        out[i] = acc;
    }
}
#endif
extern "C" void kernel_launch(void* const* d_in, const int* in_sizes, int n_in, void* d_out, int out_size, void* d_ws, size_t ws_size, hipStream_t stream) {
    static int grid = 0;
    if (grid == 0) {
        if (n_in != 15 || in_sizes[0] != M * D || out_size != M * D || ws_size < WS_END) { fprintf(stderr, "kernel_launch: unexpected problem shape (n_in %d, in0 %d, out %d, ws %zu); nothing launched\n", n_in, n_in > 0 ? in_sizes[0] : -1, out_size, ws_size); grid = -1; return; }
        int dev = 0, cus = 0, per_cu = 0;
        if (hipGetDevice(&dev) != hipSuccess || hipDeviceGetAttribute(&cus, hipDeviceAttributeMultiprocessorCount, dev) != hipSuccess) { grid = -1; return; }
        if (hipFuncSetAttribute((const void*)fwd_kernel, hipFuncAttributeMaxDynamicSharedMemorySize, LDS_BYTES) != hipSuccess) { fprintf(stderr, "kernel_launch: hipFuncSetAttribute failed\n"); grid = -1; return; }
        if (hipOccupancyMaxActiveBlocksPerMultiprocessor(&per_cu, (const void*)fwd_kernel, NWAVES * 64, LDS_BYTES) != hipSuccess || per_cu < 1) { fprintf(stderr, "kernel_launch: occupancy query reports %d blocks per CU\n", per_cu); (void)hipGetLastError(); grid = -1; return; }
        grid = cus;
    }
    if (grid < 0) return;
    (void)hipMemsetAsync((char*)d_ws + WS_CTL, 0, CTL_ZERO_BYTES, stream);
    Args a{};
    for (int i = 0; i < 15; ++i) a.in[i] = (const float*)d_in[i];
    a.out = (float*)d_out; a.ws = (unsigned char*)d_ws;
#if MK_N_LAUNCHES == 1
    a.ph_lo = 0; a.ph_hi = N_PHASES;
    hipLaunchKernelGGL(fwd_kernel, dim3(grid), dim3(NWAVES * 64), LDS_BYTES, stream, a);
#else
#ifdef DBG_STOP
    for (int p = 0; p <= DBG_STOP; ++p) { a.ph_lo = p; a.ph_hi = p + 1; hipLaunchKernelGGL(fwd_kernel, dim3(grid), dim3(NWAVES * 64), LDS_BYTES, stream, a); }
    { const size_t offs[4] = {DBG_OFFS}; hipLaunchKernelGGL(dbg_dump, dim3(2048), dim3(256), 0, stream, (const unsigned char*)d_ws, (float*)d_out, offs[0], offs[1], offs[2], offs[3], DBG_NOFF, DBG_F32); }
#else
    for (int p = 0; p < N_PHASES; ++p) { a.ph_lo = p; a.ph_hi = p + 1; hipLaunchKernelGGL(fwd_kernel, dim3(grid), dim3(NWAVES * 64), LDS_BYTES, stream, a); }
#endif
#endif
}
```

```cpp
#include <hip/hip_runtime.h>
#include <cstdio>
#include <cstdint>

#ifndef MK_N_LAUNCHES
#define MK_N_LAUNCHES 1
#endif

namespace pg8 {
#define PG8_LAS __attribute__((address_space(3)))
typedef unsigned short bf16_t;
typedef short bf16x8 __attribute__((ext_vector_type(8)));
typedef float f32x4 __attribute__((ext_vector_type(4)));
typedef unsigned u32x4 __attribute__((ext_vector_type(4)));
typedef unsigned u32x2 __attribute__((ext_vector_type(2)));
constexpr int BM = 256, BK = 64, HALF = 128, HTB = HALF * BK * 2  , STAGE_BYTES = 8 * HTB, NXCD = 8, WGM = 8;

__host__ __device__ __forceinline__ int lds_byte(int r, int c) { const int st = (r >> 4) * 2 + (c >> 5), rr = r & 15, cc = c & 31, ob = rr * 64 + cc * 2; return st * 1024 + (ob ^ (((ob >> 9) & 1) << 5)); }
__host__ __device__ __forceinline__ void stage_rc(int b, int& R, int& C) { const int st = b / 1024, sb = b % 1024, swz = sb ^ (((sb >> 9) & 1) << 5); R = (st >> 1) * 16 + swz / 64; C = (st & 1) * 32 + (swz % 64) / 2; }
__host__ __device__ __forceinline__ int perm32(int rho) { const int n = rho >> 4, i = rho & 15; return 8 * (i >> 2) + 4 * n + (i & 3); }

struct Unit { int pm, pn; };
struct Gemm { const bf16_t* A; const bf16_t* Bt; int M, N, K, lda; };

struct StaticOrder {
    int nM, nN, nwg, G, c;
    __host__ __device__ void init(int M, int N, int G_, int c_) { nM = M / BM; nN = N / BM; nwg = nM * nN; G = G_; c = c_; }
    __host__ __device__ bool next(int i, Unit& u) const {
        const long L = (long)i * G + c; if (L >= nwg) return false;
        int wgid = (int)L; { const int q = nwg / NXCD, r = nwg % NXCD, xcd = wgid % NXCD, off = wgid / NXCD; wgid = (xcd < r ? xcd * (q + 1) : r * (q + 1) + (xcd - r) * q) + off; }
        const int nig = WGM * nN, gid = wgid / nig, fm = gid * WGM, gsz = (nM - fm) < WGM ? (nM - fm) : WGM;
        u.pm = fm + ((wgid % nig) % gsz); u.pn = (wgid % nig) / gsz; return true;
    }
    __device__ __forceinline__ void a_ready(const Unit&) const {}
    __device__ __forceinline__ void done(const Unit&) const {}
};

typedef float f32x2_t __attribute__((ext_vector_type(2))); typedef __bf16 bf16x2_t __attribute__((ext_vector_type(2)));
__device__ __forceinline__ unsigned cvt_pk_bf16(float lo, float hi) { f32x2_t v = {lo, hi}; bf16x2_t b = __builtin_convertvector(v, bf16x2_t); return __builtin_bit_cast(unsigned, b); }
__device__ __forceinline__ float bf_lo(unsigned w) { return __uint_as_float(w << 16); }
__device__ __forceinline__ float bf_hi(unsigned w) { return __uint_as_float(w & 0xffff0000u); }

__device__ __forceinline__ void wave_rstd(const float* part, int Mrows, int rowbase, int lane, float eps, float (&rs)[2]) {
#pragma unroll
    for (int ai = 0; ai < 2; ++ai) { const float* p = part + rowbase + ai * HALF + lane; float s = 0.f;
#pragma unroll
        for (int t = 0; t < 16; ++t) s += p[(size_t)t * Mrows];
        rs[ai] = 1.0f / sqrtf(s * (1.0f / 1024.0f) + eps); }
}

template <int MODE, class CFG> struct EpiB {
    static constexpr bool PERM = true, AFTER_DRAIN = false;
    bf16_t* O;
    const float* part;
    const bf16_t* X1; const bf16_t* X2;
    static constexpr int Mrows = 16384, ldx = 1024; static constexpr float eps = 1e-6f;
    __device__ __forceinline__ void operator()(const f32x4 (&acc)[2][2][4][2], const Unit& u, int wr, int wc, int fr, int fq) const {
        const int lane = fr + 16 * fq;
        long boff = 0; int ldc = CFG::ld0, sst = 0;
        if (u.pn >= CFG::st1) { boff = CFG::off1; ldc = CFG::ld1; sst = CFG::st1; }
        if (u.pn >= CFG::st2) { boff = CFG::off2; sst = CFG::st2; }
        if (u.pn >= CFG::st3) { boff = CFG::off3; sst = CFG::st3; }
        bf16_t* base = (bf16_t*)((char*)O + boff);
        const int col0 = (u.pn - sst) * BM + wc * 32 + 8 * fq;
        const int row0 = u.pm * BM + wr * 64 + fr;
        float rs[2] = {1.f, 1.f};
        if (MODE <= 1) wave_rstd(part, Mrows, u.pm * BM + wr * 64, lane, eps, rs);
#pragma unroll
        for (int ai = 0; ai < 2; ++ai)
#pragma unroll
            for (int m = 0; m < 4; ++m) {
                const int row = row0 + ai * HALF + m * 16;
                float r = 1.f; if (MODE <= 1) r = __shfl(rs[ai], m * 16 + fr);
                bf16_t* rowp = base + (size_t)row * ldc + col0;
#pragma unroll
                for (int bj = 0; bj < 2; ++bj) {
                    f32x4 v0 = acc[ai][bj][m][0], v1 = acc[ai][bj][m][1];
                    if (MODE <= 1) { v0 = v0 * r; v1 = v1 * r; }
                    if (MODE == 1) {
#pragma unroll
                        for (int e = 0; e < 4; ++e) { v0[e] = __builtin_amdgcn_rcpf(1.0f + __expf(-v0[e])); v1[e] = __builtin_amdgcn_rcpf(1.0f + __expf(-v1[e])); }
                    }
                    if (MODE == 2) {
                        const u32x4 x = *(const u32x4*)(X1 + (size_t)row * ldx + col0 + bj * HALF);
                        v0[0] *= bf_lo(x.x); v0[1] *= bf_hi(x.x); v0[2] *= bf_lo(x.y); v0[3] *= bf_hi(x.y);
                        v1[0] *= bf_lo(x.z); v1[1] *= bf_hi(x.z); v1[2] *= bf_lo(x.w); v1[3] *= bf_hi(x.w);
                    }
                    if (MODE == 3) {
                        const u32x4 x = *(const u32x4*)(X1 + (size_t)row * ldx + col0 + bj * HALF);
                        const u32x4 y = *(const u32x4*)(X2 + (size_t)row * ldx + col0 + bj * HALF);
                        v0[0] = bf_lo(x.x) + v0[0] * bf_lo(y.x); v0[1] = bf_hi(x.x) + v0[1] * bf_hi(y.x); v0[2] = bf_lo(x.y) + v0[2] * bf_lo(y.y); v0[3] = bf_hi(x.y) + v0[3] * bf_hi(y.y);
                        v1[0] = bf_lo(x.z) + v1[0] * bf_lo(y.z); v1[1] = bf_hi(x.z) + v1[1] * bf_hi(y.z); v1[2] = bf_lo(x.w) + v1[2] * bf_lo(y.w); v1[3] = bf_hi(x.w) + v1[3] * bf_hi(y.w);
                    }
                    u32x4 w; w.x = cvt_pk_bf16(v0[0], v0[1]); w.y = cvt_pk_bf16(v0[2], v0[3]); w.z = cvt_pk_bf16(v1[0], v1[1]); w.w = cvt_pk_bf16(v1[2], v1[3]);
                    *(u32x4*)(rowp + bj * HALF) = w;
                }
                if (MODE >= 2) asm volatile("" ::: "memory");
            }
    }
};

struct EpiRes {
    static constexpr bool PERM = false, AFTER_DRAIN = false;
    const float* base; float* out; bf16_t* hb; float* part; int Mrows;
    __device__ __forceinline__ void operator()(const f32x4 (&acc)[2][2][4][2], const Unit& u, int wr, int wc, int fr, int fq) const {
        const int col0 = u.pn * BM + wc * 32 + 4 * fq;
#pragma unroll
        for (int ai = 0; ai < 2; ++ai)
#pragma unroll
            for (int m = 0; m < 4; ++m) {
                const int row = u.pm * BM + ai * HALF + wr * 64 + m * 16 + fr; const size_t off = (size_t)row * 1024 + col0;
                float ss = 0.f;
#pragma unroll
                for (int bj = 0; bj < 2; ++bj)
#pragma unroll
                    for (int n = 0; n < 2; ++n) {
                        const f32x4 bs = *(const f32x4*)(base + off + bj * HALF + n * 16);
                        const f32x4 o = bs + acc[ai][bj][m][n];
                        *(f32x4*)(out + off + bj * HALF + n * 16) = o;
                        u32x2 w; w.x = cvt_pk_bf16(o[0], o[1]); w.y = cvt_pk_bf16(o[2], o[3]);
                        *(u32x2*)(hb + off + bj * HALF + n * 16) = w;
                        ss += (o[0] * o[0] + o[1] * o[1]) + (o[2] * o[2] + o[3] * o[3]);
                    }
                ss += __shfl_xor(ss, 16); ss += __shfl_xor(ss, 32);
                if (fq == 0) part[(size_t)(u.pn * 4 + wc) * Mrows + row] = ss;
                asm volatile("" ::: "memory");
            }
    }
};

template <class Epi, int GN, int GK, int GLDA, bool ALIGN_EPI = false, bool SP2 = false>
__device__ __forceinline__ void gemm_phase(PG8_LAS unsigned char* lds, const bf16_t* gA, const bf16_t* gBt, int G_, int c_, const Epi& E) {
    struct { const bf16_t* A; const bf16_t* Bt; int K, lda; } g{gA, gBt, GK, GLDA};
    StaticOrder S; S.nM = 16384 / BM; S.nN = GN / BM; S.nwg = S.nM * S.nN; S.G = G_; S.c = c_;
    int tid_ = threadIdx.x; asm volatile("" : "+v"(tid_));
    const int tid = tid_, wid = __builtin_amdgcn_readfirstlane(tid >> 6), lane = tid & 63, wr = wid >> 2, wc = wid & 3, fr = lane & 15, fq = lane >> 4;
    const int K = g.K, nt = K / BK, lda = g.lda;
    unsigned voffA[2], voffB[2];
#pragma unroll
    for (int i = 0; i < 2; ++i) { int R, C; stage_rc(tid * 16 + i * 8192, R, C); const int Rb = Epi::PERM ? ((R & ~31) + perm32(R & 31)) : R;
        voffA[i] = (unsigned)(R * lda + C) * 2u; voffB[i] = (unsigned)(Rb * K + C) * 2u; }
    const size_t kstep = (size_t)(BK * 2);
    const size_t hstepA = (size_t)HALF * lda * 2, hstepB = (size_t)HALF * K * 2;
    const size_t tstepA = 2 * hstepA, tstepB = 2 * hstepB;
    const unsigned ldsw = (unsigned)wid * 1024u;
    const int aoff = lds_byte(wr * 64 + fr, fq * 8), boff = lds_byte(wc * 32 + fr, fq * 8);
#define PG8_SA(b, h) (((b) * 2 + (h)) * HTB)
#define PG8_SB(b, h) ((4 + (b) * 2 + (h)) * HTB)
#define PG8_STAGE(bufoff, gbase, voff) do { _Pragma("unroll") for (int _i = 0; _i < 2; ++_i) \
        __builtin_amdgcn_global_load_lds((const unsigned*)((const char*)(gbase) + (voff)[_i]), (PG8_LAS unsigned*)(lds + (bufoff) + ldsw + _i * 8192), 16, 0, 0); } while (0)
#define PG8_LDA(dst, b, h) do { _Pragma("unroll") for (int m = 0; m < 4; ++m) _Pragma("unroll") for (int k = 0; k < 2; ++k) dst[m][k] = *(const PG8_LAS bf16x8*)(lds + PG8_SA(b, h) + aoff + m * 2048 + k * 1024); } while (0)
#define PG8_LDB(dst, b, h) do { _Pragma("unroll") for (int n = 0; n < 2; ++n) _Pragma("unroll") for (int k = 0; k < 2; ++k) dst[n][k] = *(const PG8_LAS bf16x8*)(lds + PG8_SB(b, h) + boff + n * 2048 + k * 1024); } while (0)
#define PG8_MMA(ai, bj, At, Bt) do { __builtin_amdgcn_s_setprio(1); _Pragma("unroll") for (int m = 0; m < 4; ++m) _Pragma("unroll") for (int n = 0; n < 2; ++n) _Pragma("unroll") for (int k = 0; k < 2; ++k) \
        acc[ai][bj][m][n] = __builtin_amdgcn_mfma_f32_16x16x32_bf16(Bt[n][k], At[m][k], acc[ai][bj][m][n], 0, 0, 0); __builtin_amdgcn_s_setprio(0); } while (0)
#define PG8_WAIT_V(n) asm volatile("s_waitcnt vmcnt(" #n ")" ::: "memory")
#define PG8_WAIT_L(n) asm volatile("s_waitcnt lgkmcnt(" #n ")" ::: "memory")
#define PG8_BAR __builtin_amdgcn_s_barrier()
#define PG8_SCHED __builtin_amdgcn_sched_barrier(0)
    Unit cur, nxt; int ui = 0;
    if (!S.next(0, cur)) return;
    f32x4 acc[2][2][4][2];
#pragma unroll
    for (int a = 0; a < 2; ++a)
#pragma unroll
        for (int b = 0; b < 2; ++b)
#pragma unroll
            for (int m = 0; m < 4; ++m)
#pragma unroll
                for (int n = 0; n < 2; ++n) acc[a][b][m][n] = (f32x4){0.f, 0.f, 0.f, 0.f};
    bf16x8 At[4][2], B0[2][2], B1[2][2];
    const char* cA = (const char*)g.A + (size_t)cur.pm * tstepA; const char* cB = (const char*)g.Bt + (size_t)cur.pn * tstepB;
    S.a_ready(cur);
    if constexpr (SP2) {
        PG8_STAGE(PG8_SB(0, 0), cB, voffB); PG8_STAGE(PG8_SB(0, 1), cB + hstepB, voffB); PG8_STAGE(PG8_SA(0, 0), cA, voffA); PG8_STAGE(PG8_SA(0, 1), cA + hstepA, voffA);
        if (wr == 1) PG8_BAR;
        PG8_WAIT_V(2); PG8_BAR;
        PG8_STAGE(PG8_SB(1, 0), cB + kstep, voffB); PG8_STAGE(PG8_SA(1, 0), cA + kstep, voffA); PG8_STAGE(PG8_SB(1, 1), cB + hstepB + kstep, voffB);
        PG8_WAIT_V(6); PG8_BAR;
    } else {
        PG8_STAGE(PG8_SB(0, 0), cB, voffB); PG8_STAGE(PG8_SA(0, 0), cA, voffA); PG8_STAGE(PG8_SB(0, 1), cB + hstepB, voffB); PG8_STAGE(PG8_SA(0, 1), cA + hstepA, voffA);
        if (wr == 1) PG8_BAR;
        PG8_WAIT_V(4); PG8_BAR;
        PG8_STAGE(PG8_SB(1, 0), cB + kstep, voffB); PG8_STAGE(PG8_SA(1, 0), cA + kstep, voffA); PG8_STAGE(PG8_SB(1, 1), cB + hstepB + kstep, voffB);
        PG8_WAIT_V(6); PG8_BAR;
    }
    for (;;) {
        const bool has_next = S.next(ui + 1, nxt);
        const char* nA = has_next ? (const char*)g.A + (size_t)nxt.pm * tstepA : cA; const char* nB = has_next ? (const char*)g.Bt + (size_t)nxt.pn * tstepB : cB;
        for (int t = 0; t < nt; t += 2) {
            const bool last = (t == nt - 2);
            const char* a1 = cA + (size_t)(t + 1) * kstep;
            const char* a2 = last ? nA : cA + (size_t)(t + 2) * kstep; const char* b2 = last ? nB : cB + (size_t)(t + 2) * kstep;
            const char* a3 = a2 + kstep; const char* b3 = b2 + kstep;
            if (last && has_next) S.a_ready(nxt);
            if constexpr (SP2) {
            PG8_LDB(B0, 0, 0); PG8_LDB(B1, 0, 1); PG8_SCHED; PG8_LDA(At, 0, 0); PG8_STAGE(PG8_SA(1, 1), a1 + hstepA, voffA);
            PG8_WAIT_V(8); PG8_WAIT_L(0); PG8_BAR; PG8_MMA(0, 0, At, B0); PG8_MMA(0, 1, At, B1); PG8_BAR; PG8_SCHED;
            PG8_LDA(At, 0, 1); PG8_STAGE(PG8_SB(0, 0), b2, voffB); PG8_STAGE(PG8_SB(0, 1), b2 + hstepB, voffB); PG8_STAGE(PG8_SA(0, 0), a2, voffA);
            PG8_WAIT_V(8); PG8_WAIT_L(0); PG8_BAR; PG8_MMA(1, 0, At, B0); PG8_MMA(1, 1, At, B1); PG8_BAR; PG8_SCHED;
            PG8_LDB(B0, 1, 0); PG8_LDB(B1, 1, 1); PG8_SCHED; PG8_LDA(At, 1, 0); PG8_STAGE(PG8_SA(0, 1), a2 + hstepA, voffA);
            PG8_WAIT_V(8); PG8_WAIT_L(0); PG8_BAR; PG8_MMA(0, 0, At, B0); PG8_MMA(0, 1, At, B1); PG8_BAR; PG8_SCHED;
            PG8_LDA(At, 1, 1); PG8_STAGE(PG8_SB(1, 0), b3, voffB); PG8_STAGE(PG8_SB(1, 1), b3 + hstepB, voffB); PG8_STAGE(PG8_SA(1, 0), a3, voffA);
            PG8_WAIT_V(8); PG8_WAIT_L(0); PG8_BAR; PG8_MMA(1, 0, At, B0); PG8_MMA(1, 1, At, B1); PG8_BAR; PG8_SCHED;
            } else {
            PG8_LDB(B0, 0, 0); PG8_SCHED; PG8_LDA(At, 0, 0); PG8_STAGE(PG8_SA(1, 1), a1 + hstepA, voffA);
            PG8_WAIT_L(8); PG8_BAR; PG8_WAIT_L(0); PG8_MMA(0, 0, At, B0); PG8_BAR; PG8_SCHED;
            PG8_LDB(B1, 0, 1); PG8_STAGE(PG8_SB(0, 0), b2, voffB);
            PG8_BAR; PG8_WAIT_L(0); PG8_MMA(0, 1, At, B1); PG8_BAR;
            PG8_LDA(At, 0, 1); PG8_STAGE(PG8_SA(0, 0), a2, voffA);
            PG8_BAR; PG8_WAIT_L(0); PG8_MMA(1, 0, At, B0); PG8_BAR; PG8_SCHED;
            PG8_STAGE(PG8_SB(0, 1), b2 + hstepB, voffB);
            PG8_WAIT_V(6); PG8_BAR; PG8_MMA(1, 1, At, B1); PG8_BAR;
            PG8_LDB(B0, 1, 0); PG8_SCHED; PG8_LDA(At, 1, 0); PG8_STAGE(PG8_SA(0, 1), a2 + hstepA, voffA);
            PG8_WAIT_L(8); PG8_BAR; PG8_WAIT_L(0); PG8_MMA(0, 0, At, B0); PG8_BAR; PG8_SCHED;
            PG8_LDB(B1, 1, 1); PG8_STAGE(PG8_SB(1, 0), b3, voffB);
            PG8_BAR; PG8_WAIT_L(0); PG8_MMA(0, 1, At, B1); PG8_BAR;
            PG8_LDA(At, 1, 1); PG8_STAGE(PG8_SA(1, 0), a3, voffA);
            PG8_BAR; PG8_WAIT_L(0); PG8_MMA(1, 0, At, B0); PG8_BAR; PG8_SCHED;
            PG8_STAGE(PG8_SB(1, 1), b3 + hstepB, voffB);
            PG8_WAIT_V(6); PG8_BAR; PG8_MMA(1, 1, At, B1); PG8_BAR;
            }
        }
        if constexpr (ALIGN_EPI) { if (wr == 0) PG8_BAR; }
        if constexpr (!Epi::AFTER_DRAIN) { E(acc, cur, wr, wc, fr, fq); S.done(cur); }
        if (!has_next) break;
#pragma unroll
        for (int a = 0; a < 2; ++a)
#pragma unroll
            for (int b = 0; b < 2; ++b)
#pragma unroll
                for (int m = 0; m < 4; ++m)
#pragma unroll
                    for (int n = 0; n < 2; ++n) acc[a][b][m][n] = (f32x4){0.f, 0.f, 0.f, 0.f};
        cur = nxt; cA = nA; cB = nB; ++ui;
        if constexpr (ALIGN_EPI) { if (wr == 1) PG8_BAR; }
    }
    PG8_WAIT_V(0);
    if constexpr (!ALIGN_EPI) { if (wr == 0) PG8_BAR; }
    PG8_BAR;
#undef PG8_SA
#undef PG8_SB
#undef PG8_STAGE
#undef PG8_LDA
#undef PG8_LDB
#undef PG8_MMA
#undef PG8_WAIT_V
#undef PG8_WAIT_L
#undef PG8_BAR
#undef PG8_SCHED
}

struct UnitD { const char* A; const char* Bt; int nt, lda, K; int pm, pn, sub; };
template <class Prog>
__device__ __forceinline__ void gemm_stream(PG8_LAS unsigned char* lds, const Prog& P) {
    int tid_ = threadIdx.x; asm volatile("" : "+v"(tid_));
    const int tid = tid_, wid = __builtin_amdgcn_readfirstlane(tid >> 6), lane = tid & 63, wr = wid >> 2, wc = wid & 3, fr = lane & 15, fq = lane >> 4;
    int Rr[2], Cc[2], Rb[2];
#pragma unroll
    for (int i = 0; i < 2; ++i) { int R, C; stage_rc(tid * 16 + i * 8192, R, C); Rr[i] = R; Cc[i] = C; Rb[i] = (R & ~31) + perm32(R & 31); }
    const size_t kstep = (size_t)(BK * 2);
    const unsigned ldsw = (unsigned)wid * 1024u;
    const int aoff = lds_byte(wr * 64 + fr, fq * 8), boff = lds_byte(wc * 32 + fr, fq * 8);
#define PG8_SA(b, h) (((b) * 2 + (h)) * HTB)
#define PG8_SB(b, h) ((4 + (b) * 2 + (h)) * HTB)
#define PG8_STAGE(bufoff, gbase, voff) do { _Pragma("unroll") for (int _i = 0; _i < 2; ++_i) \
        __builtin_amdgcn_global_load_lds((const unsigned*)((const char*)(gbase) + (voff)[_i]), (PG8_LAS unsigned*)(lds + (bufoff) + ldsw + _i * 8192), 16, 0, 0); } while (0)
#define PG8_LDA(dst, b, h) do { _Pragma("unroll") for (int m = 0; m < 4; ++m) _Pragma("unroll") for (int k = 0; k < 2; ++k) dst[m][k] = *(const PG8_LAS bf16x8*)(lds + PG8_SA(b, h) + aoff + m * 2048 + k * 1024); } while (0)
#define PG8_LDB(dst, b, h) do { _Pragma("unroll") for (int n = 0; n < 2; ++n) _Pragma("unroll") for (int k = 0; k < 2; ++k) dst[n][k] = *(const PG8_LAS bf16x8*)(lds + PG8_SB(b, h) + boff + n * 2048 + k * 1024); } while (0)
#define PG8_MMA(ai, bj, At, Bt) do { __builtin_amdgcn_s_setprio(1); _Pragma("unroll") for (int m = 0; m < 4; ++m) _Pragma("unroll") for (int n = 0; n < 2; ++n) _Pragma("unroll") for (int k = 0; k < 2; ++k) \
        acc[ai][bj][m][n] = __builtin_amdgcn_mfma_f32_16x16x32_bf16(Bt[n][k], At[m][k], acc[ai][bj][m][n], 0, 0, 0); __builtin_amdgcn_s_setprio(0); } while (0)
#define PG8_WAIT_V(n) asm volatile("s_waitcnt vmcnt(" #n ")" ::: "memory")
#define PG8_WAIT_L(n) asm volatile("s_waitcnt lgkmcnt(" #n ")" ::: "memory")
#define PG8_BAR __builtin_amdgcn_s_barrier()
#define PG8_SCHED __builtin_amdgcn_sched_barrier(0)
    UnitD cur, nxt; int ui = 0;
    if (!P.get(0, cur)) return;
    f32x4 acc[2][2][4][2];
#pragma unroll
    for (int a = 0; a < 2; ++a)
#pragma unroll
        for (int b = 0; b < 2; ++b)
#pragma unroll
            for (int m = 0; m < 4; ++m)
#pragma unroll
                for (int n = 0; n < 2; ++n) acc[a][b][m][n] = (f32x4){0.f, 0.f, 0.f, 0.f};
    bf16x8 At[4][2], B0[2][2], B1[2][2];
    unsigned cvA[2], cvB[2];
#pragma unroll
    for (int i = 0; i < 2; ++i) { cvA[i] = (unsigned)(Rr[i] * cur.lda + Cc[i]) * 2u; cvB[i] = (unsigned)(Rb[i] * cur.K + Cc[i]) * 2u; }
    const char* cA = cur.A; const char* cB = cur.Bt;
    size_t chA = (size_t)HALF * cur.lda * 2, chB = (size_t)HALF * cur.K * 2;
    PG8_STAGE(PG8_SB(0, 0), cB, cvB); PG8_STAGE(PG8_SB(0, 1), cB + chB, cvB); PG8_STAGE(PG8_SA(0, 0), cA, cvA); PG8_STAGE(PG8_SA(0, 1), cA + chA, cvA);
    if (wr == 1) PG8_BAR;
    PG8_WAIT_V(2); PG8_BAR;
    PG8_STAGE(PG8_SB(1, 0), cB + kstep, cvB); PG8_STAGE(PG8_SA(1, 0), cA + kstep, cvA); PG8_STAGE(PG8_SB(1, 1), cB + chB + kstep, cvB);
    PG8_WAIT_V(6); PG8_BAR;
    for (;;) {
        const bool has_next = P.get(ui + 1, nxt);
        const char* nA = has_next ? nxt.A : cA; const char* nB = has_next ? nxt.Bt : cB;
        unsigned nvA[2], nvB[2];
#pragma unroll
        for (int i = 0; i < 2; ++i) { nvA[i] = has_next ? (unsigned)(Rr[i] * nxt.lda + Cc[i]) * 2u : cvA[i]; nvB[i] = has_next ? (unsigned)(Rb[i] * nxt.K + Cc[i]) * 2u : cvB[i]; }
        const size_t nhA = has_next ? (size_t)HALF * nxt.lda * 2 : chA, nhB = has_next ? (size_t)HALF * nxt.K * 2 : chB;
        const int nt = cur.nt;
        for (int t = 0; t < nt; t += 2) {
            const bool last = (t == nt - 2);
            const char* a1 = cA + (size_t)(t + 1) * kstep;
            const char* a2 = last ? nA : cA + (size_t)(t + 2) * kstep; const char* b2 = last ? nB : cB + (size_t)(t + 2) * kstep;
            const char* a3 = a2 + kstep; const char* b3 = b2 + kstep;
            unsigned vA2[2], vB2[2];
#pragma unroll
            for (int i = 0; i < 2; ++i) { vA2[i] = last ? nvA[i] : cvA[i]; vB2[i] = last ? nvB[i] : cvB[i]; }
            const size_t hA2 = last ? nhA : chA, hB2 = last ? nhB : chB;
            PG8_LDB(B0, 0, 0); PG8_LDB(B1, 0, 1); PG8_SCHED; PG8_LDA(At, 0, 0); PG8_STAGE(PG8_SA(1, 1), a1 + chA, cvA);
            PG8_WAIT_V(8); PG8_WAIT_L(0); PG8_BAR; PG8_MMA(0, 0, At, B0); PG8_MMA(0, 1, At, B1); PG8_BAR; PG8_SCHED;
            PG8_LDA(At, 0, 1); PG8_STAGE(PG8_SB(0, 0), b2, vB2); PG8_STAGE(PG8_SB(0, 1), b2 + hB2, vB2); PG8_STAGE(PG8_SA(0, 0), a2, vA2);
            PG8_WAIT_V(8); PG8_WAIT_L(0); PG8_BAR; PG8_MMA(1, 0, At, B0); PG8_MMA(1, 1, At, B1); PG8_BAR; PG8_SCHED;
            PG8_LDB(B0, 1, 0); PG8_LDB(B1, 1, 1); PG8_SCHED; PG8_LDA(At, 1, 0); PG8_STAGE(PG8_SA(0, 1), a2 + hA2, vA2);
            PG8_WAIT_V(8); PG8_WAIT_L(0); PG8_BAR; PG8_MMA(0, 0, At, B0); PG8_MMA(0, 1, At, B1); PG8_BAR; PG8_SCHED;
            PG8_LDA(At, 1, 1); PG8_STAGE(PG8_SB(1, 0), b3, vB2); PG8_STAGE(PG8_SB(1, 1), b3 + hB2, vB2); PG8_STAGE(PG8_SA(1, 0), a3, vA2);
            PG8_WAIT_V(8); PG8_WAIT_L(0); PG8_BAR; PG8_MMA(1, 0, At, B0); PG8_MMA(1, 1, At, B1); PG8_BAR; PG8_SCHED;
        }
        if (wr == 0) PG8_BAR;
        P.epi(acc, cur, wr, wc, fr, fq);
        if (!has_next) break;
#pragma unroll
        for (int a = 0; a < 2; ++a)
#pragma unroll
            for (int b = 0; b < 2; ++b)
#pragma unroll
                for (int m = 0; m < 4; ++m)
#pragma unroll
                    for (int n = 0; n < 2; ++n) acc[a][b][m][n] = (f32x4){0.f, 0.f, 0.f, 0.f};
        cur = nxt; cA = nA; cB = nB; chA = nhA; chB = nhB; ++ui;
#pragma unroll
        for (int i = 0; i < 2; ++i) { cvA[i] = nvA[i]; cvB[i] = nvB[i]; }
        if (wr == 1) PG8_BAR;
    }
    PG8_WAIT_V(0);
    PG8_BAR;
#undef PG8_SA
#undef PG8_SB
#undef PG8_STAGE
#undef PG8_LDA
#undef PG8_LDB
#undef PG8_MMA
#undef PG8_WAIT_V
#undef PG8_WAIT_L
#undef PG8_BAR
#undef PG8_SCHED
}

template <int MODE> __device__ __forceinline__ void epi_bf16(const f32x4 (&acc)[2][2][4][2], int pm, int col0, int wr, int fr, int lane, bf16_t* O, int ldo, const float* part,
                                                             const bf16_t* X1, int ldx1, const bf16_t* X2, int ldx2) {
    const int row0 = pm * BM + wr * 64 + fr;
    float rs[2] = {1.f, 1.f};
    if (MODE <= 1) wave_rstd(part, 16384, pm * BM + wr * 64, lane, 1e-6f, rs);
#pragma unroll
    for (int ai = 0; ai < 2; ++ai)
#pragma unroll
        for (int m = 0; m < 4; ++m) {
            const int row = row0 + ai * HALF + m * 16;
            float r = 1.f; if (MODE <= 1) r = __shfl(rs[ai], m * 16 + fr);
#pragma unroll
            for (int bj = 0; bj < 2; ++bj) {
                f32x4 v0 = acc[ai][bj][m][0], v1 = acc[ai][bj][m][1];
                if (MODE <= 1) { v0 = v0 * r; v1 = v1 * r; }
                if (MODE == 1) {
#pragma unroll
                    for (int e = 0; e < 4; ++e) { v0[e] = __builtin_amdgcn_rcpf(1.0f + __expf(-v0[e])); v1[e] = __builtin_amdgcn_rcpf(1.0f + __expf(-v1[e])); }
                }
                if (MODE == 2 || MODE == 3) {
                    const u32x4 x = *(const u32x4*)(X1 + (size_t)row * ldx1 + col0 + bj * HALF);
                    if (MODE == 2) {
                        v0[0] *= bf_lo(x.x); v0[1] *= bf_hi(x.x); v0[2] *= bf_lo(x.y); v0[3] *= bf_hi(x.y);
                        v1[0] *= bf_lo(x.z); v1[1] *= bf_hi(x.z); v1[2] *= bf_lo(x.w); v1[3] *= bf_hi(x.w);
                    } else {
                        const u32x4 y = *(const u32x4*)(X2 + (size_t)row * ldx2 + col0 + bj * HALF);
                        v0[0] = bf_lo(x.x) + v0[0] * bf_lo(y.x); v0[1] = bf_hi(x.x) + v0[1] * bf_hi(y.x); v0[2] = bf_lo(x.y) + v0[2] * bf_lo(y.y); v0[3] = bf_hi(x.y) + v0[3] * bf_hi(y.y);
                        v1[0] = bf_lo(x.z) + v1[0] * bf_lo(y.z); v1[1] = bf_hi(x.z) + v1[1] * bf_hi(y.z); v1[2] = bf_lo(x.w) + v1[2] * bf_lo(y.w); v1[3] = bf_hi(x.w) + v1[3] * bf_hi(y.w);
                    }
                }
                u32x4 w; w.x = cvt_pk_bf16(v0[0], v0[1]); w.y = cvt_pk_bf16(v0[2], v0[3]); w.z = cvt_pk_bf16(v1[0], v1[1]); w.w = cvt_pk_bf16(v1[2], v1[3]);
                *(u32x4*)(O + (size_t)row * ldo + col0 + bj * HALF) = w;
            }
            if (MODE >= 2) asm volatile("" ::: "memory");
        }
}
}

#ifndef PG8_SP2
#define PG8_SP2 true
#endif
#ifndef PG8_ALIGN
#define PG8_ALIGN true
#endif

constexpr int NWAVES = 8;
constexpr int BATCH = 8, S = 2048, D = 1024, DEPTH = 2;
constexpr int M = BATCH * S;
constexpr int NIN = 7680, NUQKV = 5632, NGATE = 2048, AW = 1536, AO = 512, DFF = 2816, NUP = 5632, HD = 128;
constexpr float EPS = 1e-6f;
constexpr int N_PHASES = 2 + 10 * DEPTH;

constexpr size_t MiB = 1u << 20;
constexpr size_t WS_CTL = 0, CTL_ZERO_BYTES = 64 * 1024;
constexpr size_t WS_PART = 1 * MiB;
constexpr size_t WS_LSE = 2 * MiB;
constexpr size_t WS_W = 4 * MiB;
constexpr size_t WO_WIN = 0, WO_WC = 15 * MiB, WO_WB = 17 * MiB, WO_WO = 18 * MiB, WO_WUP = 20 * MiB, WO_WDN = 31 * MiB, WDN_BYTES = (size_t)D * DFF * 2;
constexpr size_t WS_HB = 46 * MiB;
constexpr size_t WS_Y = 78 * MiB;
constexpr size_t Y_U = 0, Y_Q = 32 * MiB, Y_K = 80 * MiB, Y_V = 128 * MiB;
constexpr size_t WS_END = 254 * MiB;
static_assert(WO_WDN + 2 * WDN_BYTES <= 42 * MiB && WS_W + 42 * MiB <= WS_HB && WS_HB + 32 * MiB <= WS_Y && WS_Y + 176 * MiB <= WS_END, "d_ws map");
constexpr int CW_BAR = 1024;

constexpr int RING_OFF = 0, RING_BYTES = 131072;
constexpr int LDSCTL_OFF = RING_BYTES, MISC_OFF = LDSCTL_OFF + 320;
constexpr int LDS_BYTES = 147456;

#define GAS __attribute__((address_space(1)))
#define LAS __attribute__((address_space(3)))
typedef unsigned short bf16;
typedef unsigned v4u __attribute__((ext_vector_type(4)));
typedef unsigned v2u __attribute__((ext_vector_type(2)));
typedef float f32x4 __attribute__((ext_vector_type(4)));
typedef GAS unsigned gu32;
#define RLX_AGENT __ATOMIC_RELAXED, __HIP_MEMORY_SCOPE_AGENT
#define LDS_WAIT() asm volatile("s_waitcnt lgkmcnt(0)" ::: "memory")
#define VM_WAIT() asm volatile("s_waitcnt vmcnt(0)" ::: "memory")
__device__ __forceinline__ unsigned f2bf(float f) { unsigned u = __builtin_bit_cast(unsigned, f); return (u + 0x7fffu + ((u >> 16) & 1u)) >> 16; }
__device__ __forceinline__ unsigned pk2(float lo, float hi) { return f2bf(lo) | (f2bf(hi) << 16); }
__device__ __forceinline__ float bflo(unsigned w) { return __uint_as_float(w << 16); }
__device__ __forceinline__ float bfhi(unsigned w) { return __uint_as_float(w & 0xffff0000u); }

#define XB_TMO      128
#define XB_XCNT(j)  (256  + 64 * (j))
#define XB_XSUB(j)  (1280 + 64 * (j))
#define XB_XGEN(j)  (2304 + 64 * (j))
#define XB_TOP      3328
#define XB_TOPGEN   3392
#define XCD_BAR_WORDS 3456
#define XB_SPIN_CAP (1u << 18)
static_assert((CW_BAR + XCD_BAR_WORDS) * 4 <= (int)CTL_ZERO_BYTES, "barrier words inside the zeroed region");

__device__ __forceinline__ unsigned xb_ld(unsigned* p)              { return __hip_atomic_load(p, __ATOMIC_RELAXED, __HIP_MEMORY_SCOPE_AGENT); }
__device__ __forceinline__ unsigned xb_add(unsigned* p, unsigned v) { return __hip_atomic_fetch_add(p, v, __ATOMIC_RELAXED, __HIP_MEMORY_SCOPE_AGENT); }
__device__ __forceinline__ unsigned xb_xcc_id() { return (unsigned)__builtin_amdgcn_s_getreg((3 << 11) | 20) & 0xFu; }
#define XB_SPIN(cond, bar) do { unsigned _sp = 0; while (cond) { __builtin_amdgcn_s_sleep(1); \
    if ((++_sp & 255u) == 0u) { if (xb_ld(&(bar)[XB_TMO])) break; if (_sp > XB_SPIN_CAP) { atomicAdd(&(bar)[XB_TMO], 1u); break; } } } } while (0)

struct XcdBarrier { unsigned* bar; unsigned x; volatile LAS unsigned* st; };

__device__ __forceinline__ XcdBarrier xcd_barrier_post(unsigned* bar, volatile LAS unsigned* st) {
    XcdBarrier b; b.bar = bar; b.x = xb_xcc_id(); b.st = st;
    if (threadIdx.x == 0) (void)xb_add(&bar[XB_XCNT(b.x)], 1u);
    return b;
}
__device__ __forceinline__ void xcd_barrier_complete(unsigned* bar, unsigned x, unsigned& nloc, unsigned& nx) {
    const unsigned G = gridDim.x * gridDim.y * gridDim.z;
    unsigned sum, cnt, mine, sp = 0u;
    for (;;) {
        sum = 0u; cnt = 0u; mine = 0u;
#pragma unroll
        for (unsigned j = 0; j < 16; ++j) { const unsigned c = xb_ld(&bar[XB_XCNT(j)]); sum += c; cnt += (c > 0u) ? 1u : 0u; mine = (j == x) ? c : mine; }
        if (sum == G) break;
        __builtin_amdgcn_s_sleep(1);
        if ((++sp & 255u) == 0u) { if (xb_ld(&bar[XB_TMO])) break; if (sp > XB_SPIN_CAP) { atomicAdd(&bar[XB_TMO], 1u); break; } }
    }
    nloc = mine > 0u ? mine : 1u; nx = cnt > 0u ? cnt : 1u;
}
__device__ __forceinline__ void xcd_barrier(const XcdBarrier& b) {
    asm volatile("s_waitcnt vmcnt(0)" ::: "memory");
    __syncthreads();
    if (threadIdx.x == 0) {
        unsigned* bar = b.bar; unsigned bx_ = b.x; asm volatile("" : "+s"(bar), "+s"(bx_));
        __builtin_amdgcn_s_waitcnt(0);
        unsigned nloc = b.st[0], nx = b.st[1];
        if (nloc == 0u) { xcd_barrier_complete(bar, bx_, nloc, nx); b.st[0] = nloc; b.st[1] = nx; }
        const unsigned old = xb_add(&bar[XB_XSUB(bx_)], 1u);
        const unsigned gen = old / nloc;
        if (old + 1u == (gen + 1u) * nloc) {
            __builtin_amdgcn_fence(__ATOMIC_RELEASE, "agent");
            asm volatile("s_waitcnt vmcnt(0)" ::: "memory");
            const unsigned og = xb_add(&bar[XB_TOP], 1u);
            const unsigned tg = og / nx;
            if (og + 1u == (tg + 1u) * nx) xb_add(&bar[XB_TOPGEN], 1u);
            else XB_SPIN(xb_ld(&bar[XB_TOPGEN]) == tg, bar);
            __builtin_amdgcn_fence(__ATOMIC_ACQUIRE, "agent");
            xb_add(&bar[XB_XGEN(bx_)], 1u);
            asm volatile("s_waitcnt vmcnt(0)" ::: "memory");
        } else {
            XB_SPIN(xb_ld(&bar[XB_XGEN(bx_)]) == gen, bar);
            __builtin_amdgcn_fence(__ATOMIC_ACQUIRE, "agent");
            asm volatile("s_waitcnt vmcnt(0)" ::: "memory");
        }
    }
    __syncthreads();
}

struct Frame {
    LAS unsigned char* lds;
    volatile LAS unsigned* MISC;
    gu32* ctl;
    int tid, lane, wave;
    int vcu, G;
    int gw, NGW;
    unsigned char* ws;
    const float* const* in; float* out;
};

__device__ __forceinline__ float wave_sum(float v) {
#pragma unroll
    for (int o = 1; o < 64; o <<= 1) v += __shfl_xor(v, o);
    return v;
}
__device__ __forceinline__ float wave_max(float v) {
#pragma unroll
    for (int o = 1; o < 64; o <<= 1) v = fmaxf(v, __shfl_xor(v, o));
    return v;
}

__device__ __forceinline__ void p0_transpose_item(const float* W, const float* gain, int K, int N, bf16* WT, LAS float* scr, int item, int lane) {
    const int nblk = N / 32, kb = item / nblk, nb = item % nblk, k0 = 64 * kb, n0 = 32 * nb;
    const int kr = lane >> 3, nq = lane & 7;
    f32x4 v[8]; float gs[8];
#pragma unroll
    for (int i = 0; i < 8; ++i) { v[i] = *(const GAS f32x4*)(W + (size_t)(k0 + 8 * i + kr) * N + n0 + 4 * nq); gs[i] = gain ? gain[k0 + 8 * i + kr] : 1.0f; }
#pragma unroll
    for (int i = 0; i < 8; ++i) { LAS float* d = scr + (8 * i + kr) * 33 + 4 * nq; d[0] = v[i].x * gs[i]; d[1] = v[i].y * gs[i]; d[2] = v[i].z * gs[i]; d[3] = v[i].w * gs[i]; }
    LDS_WAIT(); asm volatile("" ::: "memory");
    const int c = lane & 7;
#pragma unroll
    for (int j = 0; j < 4; ++j) { const int n = (lane >> 3) + 8 * j; const LAS float* s = scr + (8 * c) * 33 + n;
        v4u o; o.x = pk2(s[0 * 33], s[1 * 33]); o.y = pk2(s[2 * 33], s[3 * 33]); o.z = pk2(s[4 * 33], s[5 * 33]); o.w = pk2(s[6 * 33], s[7 * 33]);
        *(GAS v4u*)(WT + (size_t)(n0 + n) * K + k0 + 8 * c) = o; }
    LDS_WAIT(); asm volatile("" ::: "memory");
}

__device__ __forceinline__ void convert_weights(Frame& F, int l, bool with_down) {
    LAS float* scr = (LAS float*)(F.lds + RING_OFF + F.wave * 16384);
    unsigned char* wb = F.ws + WS_W;
    const float* w_in = F.in[1] + (size_t)l * D * NIN; const float* w_b = F.in[5] + (size_t)l * AO * D; const float* w_o = F.in[6] + (size_t)l * D * D;
    const float* w_up = F.in[9] + (size_t)l * D * NUP; const float* n1 = F.in[7] + (size_t)l * D; const float* n2 = F.in[8] + (size_t)l * D;
    constexpr int I_IN = (D / 64) * (NIN / 32), I_B = (AO / 64) * (D / 32), I_O = (D / 64) * (D / 32), I_UP = (D / 64) * (NUP / 32), I_DN = (DFF / 64) * (D / 32);
    const int nitems = I_IN + I_B + I_O + I_UP + (with_down ? 2 * I_DN : 0);
    for (int it = F.gw; it < nitems; it += F.NGW) {
        int r = it;
        if (r < I_IN) { p0_transpose_item(w_in, n1, D, NIN, (bf16*)(wb + WO_WIN), scr, r, F.lane); continue; } r -= I_IN;
        if (r < I_B) { p0_transpose_item(w_b, nullptr, AO, D, (bf16*)(wb + WO_WB), scr, r, F.lane); continue; } r -= I_B;
        if (r < I_O) { p0_transpose_item(w_o, nullptr, D, D, (bf16*)(wb + WO_WO), scr, r, F.lane); continue; } r -= I_O;
        if (r < I_UP) { p0_transpose_item(w_up, n2, D, NUP, (bf16*)(wb + WO_WUP), scr, r, F.lane); continue; } r -= I_UP;
        const int ll = r / I_DN; r -= ll * I_DN;
        p0_transpose_item(F.in[12] + (size_t)ll * DFF * D, nullptr, DFF, D, (bf16*)(wb + WO_WDN + ll * WDN_BYTES), scr, r, F.lane);
    }
    const float* w_pool = F.in[2] + (size_t)l * 4 * 256 * 256; const float* ps = F.in[3] + (size_t)l * D; const float* w_a = F.in[4] + (size_t)l * D * D;
    bf16* Wc = (bf16*)(wb + WO_WC);
    LAS float* As = (LAS float*)(F.lds + RING_OFF);
    LAS float* Bs = (LAS float*)(F.lds + RING_OFF + 64 * 129 * 4);
    __syncthreads();
    for (int tile = F.vcu; tile < 4 * 4 * 16; tile += F.G) {
        const int g = tile >> 6, cb = (tile >> 4) & 3, nb = tile & 15, c0 = cb * 64, n0 = nb * 64;
        float acc[8];
#pragma unroll
        for (int e = 0; e < 8; ++e) acc[e] = 0.f;
        for (int dc = 0; dc < 2; ++dc) {
            const int d0 = dc * 128;
            for (int i = F.tid; i < 64 * 128; i += NWAVES * 64) { const int c = i >> 7, d = i & 127; As[c * 129 + d] = w_pool[((size_t)g * 256 + c0 + c) * 256 + d0 + d] * ps[g * 256 + d0 + d]; }
            for (int i = F.tid; i < 128 * 64; i += NWAVES * 64) { const int d = i >> 6, n = i & 63; Bs[d * 65 + n] = w_a[(size_t)(g * 256 + d0 + d) * D + n0 + n]; }
            __syncthreads();
            const LAS float* ap = As + (F.wave * 8) * 129; const LAS float* bp = Bs + F.lane;
#pragma unroll 4
            for (int d = 0; d < 128; ++d) { const float bv = bp[d * 65];
#pragma unroll
                for (int e = 0; e < 8; ++e) acc[e] += ap[e * 129 + d] * bv; }
            __syncthreads();
        }
        v4u o; o.x = pk2(acc[0], acc[1]); o.y = pk2(acc[2], acc[3]); o.z = pk2(acc[4], acc[5]); o.w = pk2(acc[6], acc[7]);
        *(GAS v4u*)(Wc + (size_t)(n0 + F.lane) * D + g * 256 + c0 + F.wave * 8) = o;
    }
}

__device__ __forceinline__ void p0_x_rows(Frame& F) {
    const float* x = F.in[0]; bf16* hb = (bf16*)(F.ws + WS_HB); float* part = (float*)(F.ws + WS_PART);
    for (int m = F.gw; m < M; m += F.NGW) {
        const GAS f32x4* xr = (const GAS f32x4*)(x + (size_t)m * D) + F.lane;
        f32x4 v[4]; float s = 0.f;
#pragma unroll
        for (int j = 0; j < 4; ++j) { v[j] = xr[64 * j]; s += (v[j].x * v[j].x + v[j].y * v[j].y) + (v[j].z * v[j].z + v[j].w * v[j].w); }
        s = wave_sum(s);
        GAS unsigned long long* o8 = (GAS unsigned long long*)(hb + (size_t)m * D) + F.lane;
#pragma unroll
        for (int j = 0; j < 4; ++j) o8[64 * j] = (unsigned long long)pk2(v[j].x, v[j].y) | ((unsigned long long)pk2(v[j].z, v[j].w) << 32);
        if (F.lane < 16) part[(size_t)F.lane * M + m] = (F.lane == 0) ? s : 0.f;
    }
}

__device__ __forceinline__ int t5_bucket(int rel) {
    const int ret = rel > 0 ? 16 : 0; const int n = rel < 0 ? -rel : rel;
    int b;
    if (n < 8) b = n; else if (n < 15) b = 8; else if (n < 27) b = 9; else if (n < 50) b = 10; else if (n < 91) b = 11; else if (n < 166) b = 12; else if (n < 305) b = 13; else if (n < 559) b = 14; else b = 15;
    return ret + b;
}

__device__ __forceinline__ void attn_simple(Frame& F) {
    bf16* Q = (bf16*)(F.ws + WS_Y + Y_Q); const bf16* Kb = (const bf16*)(F.ws + WS_Y + Y_K); const bf16* V = (const bf16*)(F.ws + WS_Y + Y_V);
    const float* rel_bias = F.in[13];
    LAS float* qs = (LAS float*)(F.lds + RING_OFF + F.wave * 2048);
    const int lane = F.lane; const float scale = 0.08838834764831845f;
    for (int item = F.gw; item < M * 4; item += F.NGW) {
        const int tok = item >> 2, h = item & 3, b = tok >> 11, s = tok & (S - 1);
#pragma unroll
        for (int g = 0; g < 3; ++g) { const unsigned w = *(const GAS unsigned*)(Q + (size_t)tok * AW + (g * 4 + h) * HD + 2 * lane); qs[g * 128 + 2 * lane] = bflo(w); qs[g * 128 + 2 * lane + 1] = bfhi(w); }
        LDS_WAIT(); asm volatile("" ::: "memory");
        float mrun = -1e30f, lrun = 0.f, o0 = 0.f, o1 = 0.f;
#pragma unroll 1
        for (int g = 0; g < 3; ++g) {
            const int dl = 1 << (2 * g), head = g * 4 + h;
            float sc[3];
#pragma unroll
            for (int p = 0; p < 3; ++p) {
                const int jj = lane + 64 * p, j = jj - 64, pos = s + dl * j;
                const bool valid = (jj <= 128) && pos >= 0 && pos < S;
                float dot = 0.f;
                if (valid) {
                    const bf16* krow = Kb + ((size_t)b * S + pos) * AW + head * HD;
#pragma unroll 4
                    for (int c = 0; c < 16; ++c) { const v4u kv = *(const GAS v4u*)(krow + 8 * c); const LAS float* qq = qs + g * 128 + 8 * c;
                        dot += bflo(kv.x) * qq[0] + bfhi(kv.x) * qq[1] + bflo(kv.y) * qq[2] + bfhi(kv.y) * qq[3] + bflo(kv.z) * qq[4] + bfhi(kv.z) * qq[5] + bflo(kv.w) * qq[6] + bfhi(kv.w) * qq[7]; }
                }
                const float bias = (jj <= 128) ? rel_bias[t5_bucket(dl * j) * 12 + head] : 0.f;
                sc[p] = valid ? dot * scale + bias : -1e30f;
            }
            const float gmax = wave_max(fmaxf(fmaxf(sc[0], sc[1]), sc[2]));
            const float mnew = fmaxf(mrun, gmax);
            const float alpha = __expf(mrun - mnew);
            float pr[3];
#pragma unroll
            for (int p = 0; p < 3; ++p) pr[p] = (sc[p] > -1e29f) ? __expf(sc[p] - mnew) : 0.f;
            const float psum = wave_sum(pr[0] + pr[1] + pr[2]);
            lrun = lrun * alpha + psum; o0 *= alpha; o1 *= alpha; mrun = mnew;
#pragma unroll 1
            for (int jj = 0; jj <= 128; ++jj) {
                const int pos = s + dl * (jj - 64);
                if (pos < 0 || pos >= S) continue;
                const float pj = __shfl(jj < 64 ? pr[0] : (jj < 128 ? pr[1] : pr[2]), jj & 63);
                const unsigned w = *(const GAS unsigned*)(V + ((size_t)b * S + pos) * AW + head * HD + 2 * lane);
                o0 += pj * bflo(w); o1 += pj * bfhi(w);
            }
        }
        const float inv = 1.0f / lrun;
        *(GAS unsigned*)(Q + (size_t)tok * AW + h * HD + 2 * lane) = pk2(o0 * inv, o1 * inv);
        LDS_WAIT(); asm volatile("" ::: "memory");
    }
}

namespace att {
typedef short bf16x8 __attribute__((ext_vector_type(8)));
typedef short s16x4 __attribute__((ext_vector_type(4)));
typedef float f32x16 __attribute__((ext_vector_type(16)));
__device__ __forceinline__ unsigned off_b(unsigned row, unsigned ch) { return 256u * row + 16u * (ch ^ (((row & 3u) << 2) | ((row >> 2) & 3u))); }
__device__ __forceinline__ s16x4 vtr(const LAS unsigned char* p) { return __builtin_bit_cast(s16x4, __builtin_amdgcn_ds_read_tr16_b64_v4i16((LAS s16x4*)p)); }
constexpr int N_UNITS = BATCH * 3 * 2 * 16;
constexpr int BIAS_OFF = RING_BYTES + 2048;
}
__device__ __forceinline__ void attn_mfma(Frame& F) {
    using namespace att;
    bf16* Q = (bf16*)(F.ws + WS_Y + Y_Q); const bf16* Kg = (const bf16*)(F.ws + WS_Y + Y_K); const bf16* Vg = (const bf16*)(F.ws + WS_Y + Y_V);
    float* LSE = (float*)(F.ws + WS_LSE); const float* rel_bias = F.in[13];
    const int lane = F.lane, wave = F.wave, half = wave >> 2, j = wave & 3, ql = lane & 31, hh = lane >> 5, th = F.tid & 255;
    const float LOG2E = 1.4426950408889634f, CS = 0.08838834764831845f * 1.4426950408889634f;
    LAS unsigned char* hb = F.lds + RING_OFF + half * 65536;
    LAS float* bt = (LAS float*)(F.lds + BIAS_OFF + half * 1024);
    const int nper = (N_UNITS + F.G - 1) / F.G;
    const int u_lo = F.vcu * nper, u_hi = (u_lo + nper < N_UNITS) ? u_lo + nper : N_UNITS;
#pragma unroll 1
    for (int u = u_lo; u < u_hi; ++u) {
        const int t16 = u & 15, rest = u >> 4, hp = rest & 1, g = (rest >> 1) % 3, b = rest / 6;
        const int sh = 2 * g, dl = 1 << sh, L = S >> sh;
        const int r = (g == 0) ? 0 : (g == 1 ? (t16 >> 2) : t16), mt = (g == 0) ? t16 : (g == 1 ? (t16 & 3) : 0), m0 = mt * 128;
        const int hl = hp * 2 + half, hd = g * 4 + hl;
        const size_t tokbase = (size_t)b * S + r;
        { const int jrel = th - 128; float v = -1e30f; if (jrel >= -64 && jrel <= 64) v = rel_bias[t5_bucket(dl * jrel) * 12 + hd] * LOG2E; bt[th] = v; }
        const int mq = m0 + 32 * j + ql;
        bf16* qrow = Q + (tokbase + (size_t)dl * mq) * AW + hd * HD;
        bf16x8 qf[8];
#pragma unroll
        for (int s2 = 0; s2 < 8; ++s2) qf[s2] = *(const GAS bf16x8*)(qrow + 16 * s2 + 8 * hh);
        const int kb_lo = (m0 == 0) ? 1 : 0; int kb_hi = (L - 1 - m0 + 64) >> 6; kb_hi = kb_hi > 3 ? 3 : kb_hi;
        v4u kreg[4], vreg[4];
        const int srow = th >> 4, sch = th & 15;
#define ATT_STAGE_LOAD(kb_) do { _Pragma("unroll") for (int i = 0; i < 4; ++i) { const int mk = m0 - 64 + 64 * (kb_) + srow + 16 * i; \
                const size_t off = (tokbase + (size_t)dl * mk) * AW + hd * HD + sch * 8; \
                kreg[i] = *(const GAS v4u*)(Kg + off); vreg[i] = *(const GAS v4u*)(Vg + off); } } while (0)
#define ATT_STAGE_WRITE(buf_) do { _Pragma("unroll") for (int i = 0; i < 4; ++i) { const unsigned o = off_b((unsigned)(srow + 16 * i), (unsigned)sch); \
                *(LAS v4u*)(hb + (buf_) * 16384 + o) = kreg[i]; *(LAS v4u*)(hb + 32768 + (buf_) * 16384 + o) = vreg[i]; } } while (0)
        float m_run = -1e20f, l_run = 0.f;
        f32x16 O[4];
#pragma unroll
        for (int c = 0; c < 4; ++c)
#pragma unroll
            for (int i = 0; i < 16; ++i) O[c][i] = 0.f;
        ATT_STAGE_LOAD(kb_lo); ATT_STAGE_WRITE(0);
        __syncthreads();
#pragma unroll 1
        for (int kb = kb_lo; kb <= kb_hi; ++kb) {
            const int cur = (kb - kb_lo) & 1;
            if (kb < kb_hi) ATT_STAGE_LOAD(kb + 1);
            if (kb >= (j >> 1) && kb <= (j >> 1) + 2) {
                const LAS unsigned char* kbuf = hb + cur * 16384; const LAS unsigned char* vbuf = hb + 32768 + cur * 16384;
                f32x16 s0, s1;
#pragma unroll
                for (int i = 0; i < 16; ++i) { s0[i] = 0.f; s1[i] = 0.f; }
#pragma unroll
                for (int s2 = 0; s2 < 8; ++s2) {
                    const bf16x8 a0 = *(const LAS bf16x8*)(kbuf + off_b((unsigned)ql, (unsigned)(2 * s2 + hh)));
                    const bf16x8 a1 = *(const LAS bf16x8*)(kbuf + off_b((unsigned)(32 + ql), (unsigned)(2 * s2 + hh)));
                    s0 = __builtin_amdgcn_mfma_f32_32x32x16_bf16(a0, qf[s2], s0, 0, 0, 0);
                    s1 = __builtin_amdgcn_mfma_f32_32x32x16_bf16(a1, qf[s2], s1, 0, 0, 0);
                }
                const LAS float* btl = bt + (64 * kb + 64 - 32 * j - ql + 4 * hh);
                float bmax = -1e30f;
#pragma unroll
                for (int i = 0; i < 16; ++i) {
                    const int kr = (i & 3) + 8 * (i >> 2);
                    s0[i] = fmaf(s0[i], CS, btl[kr]); s1[i] = fmaf(s1[i], CS, btl[32 + kr]);
                    bmax = fmaxf(bmax, fmaxf(s0[i], s1[i]));
                }
                bmax = fmaxf(bmax, __shfl_xor(bmax, 32));
                if (__any(bmax > m_run + 8.0f)) {
                    const float m_new = fmaxf(m_run, bmax), alpha = __builtin_amdgcn_exp2f(m_run - m_new);
                    m_run = m_new; l_run *= alpha;
#pragma unroll
                    for (int c = 0; c < 4; ++c)
#pragma unroll
                        for (int i = 0; i < 16; ++i) O[c][i] *= alpha;
                }
                float psum = 0.f;
#pragma unroll
                for (int i = 0; i < 16; ++i) { s0[i] = __builtin_amdgcn_exp2f(s0[i] - m_run); s1[i] = __builtin_amdgcn_exp2f(s1[i] - m_run); psum += s0[i] + s1[i]; }
                l_run += psum;
                v4u pk[4];
#pragma unroll
                for (int s2 = 0; s2 < 2; ++s2) {
                    pk[s2].x = pg8::cvt_pk_bf16(s0[8 * s2 + 0], s0[8 * s2 + 1]); pk[s2].y = pg8::cvt_pk_bf16(s0[8 * s2 + 2], s0[8 * s2 + 3]);
                    pk[s2].z = pg8::cvt_pk_bf16(s0[8 * s2 + 4], s0[8 * s2 + 5]); pk[s2].w = pg8::cvt_pk_bf16(s0[8 * s2 + 6], s0[8 * s2 + 7]);
                    pk[2 + s2].x = pg8::cvt_pk_bf16(s1[8 * s2 + 0], s1[8 * s2 + 1]); pk[2 + s2].y = pg8::cvt_pk_bf16(s1[8 * s2 + 2], s1[8 * s2 + 3]);
                    pk[2 + s2].z = pg8::cvt_pk_bf16(s1[8 * s2 + 4], s1[8 * s2 + 5]); pk[2 + s2].w = pg8::cvt_pk_bf16(s1[8 * s2 + 6], s1[8 * s2 + 7]);
                }
                const unsigned blk = (lane >> 4) & 1, tq = (lane & 15) >> 2, tp = lane & 3;
#pragma unroll
                for (int ks = 0; ks < 4; ++ks) {
                    const bf16x8 pb = __builtin_bit_cast(bf16x8, pk[ks]);
#pragma unroll
                    for (int c = 0; c < 4; ++c) {
                        const unsigned chn = 4 * c + 2 * blk + (tp >> 1);
                        const s16x4 lo = vtr(vbuf + off_b(16 * ks + 4 * hh + tq, chn) + 8 * (tp & 1));
                        const s16x4 hi = vtr(vbuf + off_b(16 * ks + 8 + 4 * hh + tq, chn) + 8 * (tp & 1));
                        const bf16x8 va = {lo[0], lo[1], lo[2], lo[3], hi[0], hi[1], hi[2], hi[3]};
                        O[c] = __builtin_amdgcn_mfma_f32_32x32x16_bf16(va, pb, O[c], 0, 0, 0);
                    }
                }
            }
            if (kb < kb_hi) ATT_STAGE_WRITE(cur ^ 1);
            __syncthreads();
        }
#undef ATT_STAGE_LOAD
#undef ATT_STAGE_WRITE
        const float l_tot = l_run + __shfl_xor(l_run, 32);
        const float inv = 1.0f / l_tot;
#pragma unroll
        for (int c = 0; c < 4; ++c)
#pragma unroll
            for (int i4 = 0; i4 < 4; ++i4) {
                v2u w; w.x = pg8::cvt_pk_bf16(O[c][4 * i4 + 0] * inv, O[c][4 * i4 + 1] * inv); w.y = pg8::cvt_pk_bf16(O[c][4 * i4 + 2] * inv, O[c][4 * i4 + 3] * inv);
                *(GAS v2u*)(qrow + 32 * c + 8 * i4 + 4 * hh) = w;
            }
        if (hh == 0) LSE[((size_t)g * M + tokbase + (size_t)dl * mq) * 4 + hl] = m_run + __log2f(l_tot);
    }
}

__device__ __forceinline__ void attn_combine(Frame& F) {
    bf16* Q = (bf16*)(F.ws + WS_Y + Y_Q); const float* LSE = (const float*)(F.ws + WS_LSE);
    const int total = M * 64;
    for (int it = F.gw * 64 + F.lane; it < total; it += F.NGW * 64) {
        const int tok = it >> 6, h = (it >> 4) & 3, ch = it & 15;
        const float l0 = LSE[((size_t)0 * M + tok) * 4 + h], l1 = LSE[((size_t)1 * M + tok) * 4 + h], l2 = LSE[((size_t)2 * M + tok) * 4 + h];
        const float mx = fmaxf(l0, fmaxf(l1, l2));
        float w0 = __builtin_amdgcn_exp2f(l0 - mx), w1 = __builtin_amdgcn_exp2f(l1 - mx), w2 = __builtin_amdgcn_exp2f(l2 - mx);
        const float inv = 1.0f / (w0 + w1 + w2); w0 *= inv; w1 *= inv; w2 *= inv;
        bf16* p = Q + (size_t)tok * AW + h * HD + ch * 8;
        const v4u a = *(const GAS v4u*)(p), b2 = *(const GAS v4u*)(p + 512), c = *(const GAS v4u*)(p + 1024);
        v4u o;
        o.x = pk2(w0 * bflo(a.x) + w1 * bflo(b2.x) + w2 * bflo(c.x), w0 * bfhi(a.x) + w1 * bfhi(b2.x) + w2 * bfhi(c.x));
        o.y = pk2(w0 * bflo(a.y) + w1 * bflo(b2.y) + w2 * bflo(c.y), w0 * bfhi(a.y) + w1 * bfhi(b2.y) + w2 * bfhi(c.y));
        o.z = pk2(w0 * bflo(a.z) + w1 * bflo(b2.z) + w2 * bflo(c.z), w0 * bfhi(a.z) + w1 * bfhi(b2.z) + w2 * bfhi(c.z));
        o.w = pk2(w0 * bflo(a.w) + w1 * bflo(b2.w) + w2 * bflo(c.w), w0 * bfhi(a.w) + w1 * bfhi(b2.w) + w2 * bfhi(c.w));
        *(GAS v4u*)(p) = o;
    }
}

__device__ __forceinline__ void pool_simple(Frame& F) {
    const bf16* U = (const bf16*)(F.ws + WS_Y + Y_U); bf16* P = (bf16*)(F.ws + WS_Y + Y_K);
    const int total = M * (D / 8);
    for (int it = F.gw * 64 + F.lane; it < total; it += F.NGW * 64) {
        const int tok = it >> 7, ch = it & 127, s = tok & (S - 1), g = ch >> 5, w = 2 << g;
        int lo = s - (w >> 1), hi = lo + w; lo = lo < 0 ? 0 : lo; hi = hi > S ? S : hi;
        const bf16* base = U + (size_t)(tok - s) * D + ch * 8;
        float a[8];
#pragma unroll
        for (int e = 0; e < 8; ++e) a[e] = 0.f;
        for (int r = lo; r < hi; ++r) { const v4u v = *(const GAS v4u*)(base + (size_t)r * D);
            a[0] += bflo(v.x); a[1] += bfhi(v.x); a[2] += bflo(v.y); a[3] += bfhi(v.y); a[4] += bflo(v.z); a[5] += bfhi(v.z); a[6] += bflo(v.w); a[7] += bfhi(v.w); }
        const float inv = 1.0f / (float)(hi - lo);
        const v4u c = *(const GAS v4u*)(base + (size_t)s * D);
        v4u o; o.x = pk2(a[0] * inv - bflo(c.x), a[1] * inv - bfhi(c.x)); o.y = pk2(a[2] * inv - bflo(c.y), a[3] * inv - bfhi(c.y));
        o.z = pk2(a[4] * inv - bflo(c.z), a[5] * inv - bfhi(c.z)); o.w = pk2(a[6] * inv - bflo(c.w), a[7] * inv - bfhi(c.w));
        *(GAS v4u*)(P + (size_t)tok * D + ch * 8) = o;
    }
}

__device__ __forceinline__ void pool_slide(Frame& F) {
    const bf16* U = (const bf16*)(F.ws + WS_Y + Y_U); bf16* P = (bf16*)(F.ws + WS_Y + Y_K);
    constexpr int T = 16; constexpr int NIT = BATCH * 4 * (S / (2 * T));
    for (int it = F.gw; it < NIT; it += F.NGW) {
        const int seg2 = it & 63, g = (it >> 6) & 3, b = it >> 8;
        const int w = 2 << g, hw = w >> 1;
        const int t0 = (seg2 * 2 + (F.lane >> 5)) * T, ch = g * 32 + (F.lane & 31);
        const bf16* base = U + (size_t)b * S * D + ch * 8; bf16* obase = P + (size_t)b * S * D + ch * 8;
        float a[8];
#pragma unroll
        for (int e = 0; e < 8; ++e) a[e] = 0.f;
        { int lo = t0 - hw, hi = lo + w; lo = lo < 0 ? 0 : lo; hi = hi > S ? S : hi;
          for (int r = lo; r < hi; ++r) { const v4u v = *(const GAS v4u*)(base + (size_t)r * D);
              a[0] += bflo(v.x); a[1] += bfhi(v.x); a[2] += bflo(v.y); a[3] += bfhi(v.y); a[4] += bflo(v.z); a[5] += bfhi(v.z); a[6] += bflo(v.w); a[7] += bfhi(v.w); } }
#pragma unroll 4
        for (int i = 0; i < T; ++i) {
            const int t = t0 + i;
            int lo = t - hw, hi = lo + w; lo = lo < 0 ? 0 : lo; hi = hi > S ? S : hi;
            const float inv = 1.0f / (float)(hi - lo);
            const v4u c = *(const GAS v4u*)(base + (size_t)t * D);
            v4u o; o.x = pk2(a[0] * inv - bflo(c.x), a[1] * inv - bfhi(c.x)); o.y = pk2(a[2] * inv - bflo(c.y), a[3] * inv - bfhi(c.y));
            o.z = pk2(a[4] * inv - bflo(c.z), a[5] * inv - bfhi(c.z)); o.w = pk2(a[6] * inv - bflo(c.w), a[7] * inv - bfhi(c.w));
            *(GAS v4u*)(obase + (size_t)t * D) = o;
            const int re = t + hw, rl = t - hw;
            if (re < S) { const v4u v = *(const GAS v4u*)(base + (size_t)re * D);
                a[0] += bflo(v.x); a[1] += bfhi(v.x); a[2] += bflo(v.y); a[3] += bfhi(v.y); a[4] += bflo(v.z); a[5] += bfhi(v.z); a[6] += bflo(v.w); a[7] += bfhi(v.w); }
            if (rl >= 0) { const v4u v = *(const GAS v4u*)(base + (size_t)rl * D);
                a[0] -= bflo(v.x); a[1] -= bfhi(v.x); a[2] -= bflo(v.y); a[3] -= bfhi(v.y); a[4] -= bflo(v.z); a[5] -= bfhi(v.z); a[6] -= bflo(v.w); a[7] -= bfhi(v.w); }
        }
    }
}

__device__ __forceinline__ float gelu_tanh(float x) {
    const float y = 0.7978845608028654f * (x + 0.044715f * x * x * x);
    const float t = 1.0f - 2.0f / (__expf(2.0f * y) + 1.0f);
    return 0.5f * x * (1.0f + t);
}
__device__ __forceinline__ void conv_simple(Frame& F, int l) {
    bf16* AG = (bf16*)(F.ws + WS_Y);
    const float* cw = F.in[10] + (size_t)l * 3 * DFF; const float* cb = F.in[11] + (size_t)l * DFF;
    constexpr int CH = DFF / 8; const int total = M * CH;
    for (int it = F.gw * 64 + F.lane; it < total; it += F.NGW * 64) {
        const int tok = it / CH, ch = it - tok * CH, s = tok & (S - 1), c0 = ch * 8;
        const bf16* ap = AG + (size_t)tok * NUP + c0;
        const v4u z = {0u, 0u, 0u, 0u};
        const v4u am = (s > 0) ? *(const GAS v4u*)(ap - NUP) : z;
        const v4u a0 = *(const GAS v4u*)(ap);
        const v4u ap1 = (s < S - 1) ? *(const GAS v4u*)(ap + NUP) : z;
        const v4u gv = *(const GAS v4u*)(ap + DFF);
        float xm[8] = {bflo(am.x), bfhi(am.x), bflo(am.y), bfhi(am.y), bflo(am.z), bfhi(am.z), bflo(am.w), bfhi(am.w)};
        float x0[8] = {bflo(a0.x), bfhi(a0.x), bflo(a0.y), bfhi(a0.y), bflo(a0.z), bfhi(a0.z), bflo(a0.w), bfhi(a0.w)};
        float xp[8] = {bflo(ap1.x), bfhi(ap1.x), bflo(ap1.y), bfhi(ap1.y), bflo(ap1.z), bfhi(ap1.z), bflo(ap1.w), bfhi(ap1.w)};
        float gg[8] = {bflo(gv.x), bfhi(gv.x), bflo(gv.y), bfhi(gv.y), bflo(gv.z), bfhi(gv.z), bflo(gv.w), bfhi(gv.w)};
        float r[8];
#pragma unroll
        for (int e = 0; e < 8; ++e) { const float v = cw[c0 + e] * xm[e] + cw[DFF + c0 + e] * x0[e] + cw[2 * DFF + c0 + e] * xp[e] + cb[c0 + e]; r[e] = gelu_tanh(v) * gg[e]; }
        v4u o; o.x = pk2(r[0], r[1]); o.y = pk2(r[2], r[3]); o.z = pk2(r[4], r[5]); o.w = pk2(r[6], r[7]);
        *(GAS v4u*)(AG + (size_t)tok * NUP + DFF + c0) = o;
    }
}

__device__ __forceinline__ void conv_slide(Frame& F, int l) {
    bf16* AG = (bf16*)(F.ws + WS_Y);
    const float* cw = F.in[10] + (size_t)l * 3 * DFF; const float* cb = F.in[11] + (size_t)l * DFF;
    constexpr int CH = DFF / 8, CW = (CH + 63) / 64, T = 16, NIT = CW * (M / T);
    const v4u z = {0u, 0u, 0u, 0u};
    for (int it = F.gw; it < NIT; it += F.NGW) {
        const int cwi = it % CW, run = it / CW, ch = cwi * 64 + F.lane;
        if (ch >= CH) continue;
        const int tok0 = run * T, s0 = tok0 & (S - 1), c0 = ch * 8;
        float w0[8], w1[8], w2[8], bb[8];
#pragma unroll
        for (int e = 0; e < 8; ++e) { w0[e] = cw[c0 + e]; w1[e] = cw[DFF + c0 + e]; w2[e] = cw[2 * DFF + c0 + e]; bb[e] = cb[c0 + e]; }
        bf16* ap = AG + (size_t)tok0 * NUP + c0;
        v4u am = (s0 > 0) ? *(const GAS v4u*)(ap - NUP) : z;
        v4u a0 = *(const GAS v4u*)(ap);
#pragma unroll 4
        for (int i = 0; i < T; ++i) {
            const v4u a1 = (s0 + i < S - 1) ? *(const GAS v4u*)(ap + (size_t)(i + 1) * NUP) : z;
            const v4u gv = *(const GAS v4u*)(ap + (size_t)i * NUP + DFF);
            const float xm[8] = {bflo(am.x), bfhi(am.x), bflo(am.y), bfhi(am.y), bflo(am.z), bfhi(am.z), bflo(am.w), bfhi(am.w)};
            const float x0[8] = {bflo(a0.x), bfhi(a0.x), bflo(a0.y), bfhi(a0.y), bflo(a0.z), bfhi(a0.z), bflo(a0.w), bfhi(a0.w)};
            const float xp[8] = {bflo(a1.x), bfhi(a1.x), bflo(a1.y), bfhi(a1.y), bflo(a1.z), bfhi(a1.z), bflo(a1.w), bfhi(a1.w)};
            const float gg[8] = {bflo(gv.x), bfhi(gv.x), bflo(gv.y), bfhi(gv.y), bflo(gv.z), bfhi(gv.z), bflo(gv.w), bfhi(gv.w)};
            float r[8];
#pragma unroll
            for (int e = 0; e < 8; ++e) { const float v = w0[e] * xm[e] + w1[e] * x0[e] + w2[e] * xp[e] + bb[e]; r[e] = gelu_tanh(v) * gg[e]; }
            v4u o; o.x = pk2(r[0], r[1]); o.y = pk2(r[2], r[3]); o.z = pk2(r[4], r[5]); o.w = pk2(r[6], r[7]);
            *(GAS v4u*)(ap + (size_t)i * NUP + DFF) = o;
            am = a0; a0 = a1;
        }
    }
}

__device__ __forceinline__ void final_norm(Frame& F) {
    const float* part = (const float*)(F.ws + WS_PART); const float* nf = F.in[14];
    for (int m = F.gw; m < M; m += F.NGW) {
        float s = 0.f;
#pragma unroll
        for (int t = 0; t < 16; ++t) s += part[(size_t)t * M + m];
        const float rstd = 1.0f / sqrtf(s * (1.0f / 1024.0f) + EPS);
        GAS f32x4* xr = (GAS f32x4*)(F.out + (size_t)m * D) + F.lane; const GAS f32x4* gr = (const GAS f32x4*)nf + F.lane;
#pragma unroll
        for (int j = 0; j < 4; ++j) { const f32x4 v = xr[64 * j]; const f32x4 gq = gr[64 * j]; xr[64 * j] = v * rstd * gq; }
    }
}

struct Args { const float* in[15]; float* out; unsigned char* ws; int ph_lo, ph_hi; int pad0, pad1; };

struct CfgP1 { static constexpr int st1 = 4, st2 = 10, st3 = 16, ld0 = D, ld1 = AW; static constexpr long off1 = (long)(Y_Q - Y_U), off2 = (long)(Y_K - Y_U), off3 = (long)(Y_V - Y_U); };
struct CfgGate { static constexpr int st1 = 4, st2 = 1 << 20, st3 = 1 << 20, ld0 = D, ld1 = D; static constexpr long off1 = (long)Y_U - (long)Y_V, off2 = 0, off3 = 0; };
struct CfgOne { static constexpr int st1 = 1 << 20, st2 = 1 << 20, st3 = 1 << 20, ld0 = D, ld1 = D; static constexpr long off1 = 0, off2 = 0, off3 = 0; };
struct CfgUp { static constexpr int st1 = 1 << 20, st2 = 1 << 20, st3 = 1 << 20, ld0 = NUP, ld1 = NUP; static constexpr long off1 = 0, off2 = 0, off3 = 0; };
template <int MODE, class CFG, int GN, int GK, int GLDA> __device__ __forceinline__ void run_gemm_b(Frame& F, const bf16* A, const bf16* Bt, bf16* O, const bf16* X1, const bf16* X2) {
    pg8::EpiB<MODE, CFG> E; E.O = O; E.part = (const float*)(F.ws + WS_PART); E.X1 = X1; E.X2 = X2;
    pg8::gemm_phase<pg8::EpiB<MODE, CFG>, GN, GK, GLDA, PG8_ALIGN, PG8_SP2>(F.lds + RING_OFF, A, Bt, F.G, (int)blockIdx.x, E);
}
template <int GK, int GLDA> __device__ __forceinline__ void run_gemm_r(Frame& F, const bf16* A, const bf16* Bt, const float* base) {
    pg8::EpiRes E{base, F.out, (bf16*)(F.ws + WS_HB), (float*)(F.ws + WS_PART), M};
    pg8::gemm_phase<pg8::EpiRes, D, GK, GLDA, PG8_ALIGN, PG8_SP2>(F.lds + RING_OFF, A, Bt, F.G, (int)blockIdx.x, E);
}

struct P3Prog {
    unsigned char* ws; int G, c;
    __device__ __forceinline__ bool get(int i, pg8::UnitD& u) const {
        const int it = i >> 2, sub = i & 3; const int Lw = it * G + c; if (Lw >= 256) return false;
        const int wgid = (Lw & 7) * 32 + (Lw >> 3);
        const int pm = (wgid >> 5) * 8 + (wgid & 7), pn = (wgid & 31) >> 3;
        u.pm = pm; u.pn = pn; u.sub = sub;
        const unsigned char* A; const unsigned char* Bt; int K = D, lda = D;
        if (sub <= 1) { A = ws + WS_HB; Bt = ws + WS_W + WO_WIN + (size_t)(NUQKV + sub * D) * D * 2; }
        else if (sub == 2) { A = ws + WS_Y + Y_K; Bt = ws + WS_W + WO_WC; }
        else { A = ws + WS_Y + Y_Q; Bt = ws + WS_W + WO_WB; K = AO; lda = AW; }
        u.K = K; u.lda = lda; u.nt = K / 64;
        u.A = (const char*)A + (size_t)pm * 256 * lda * 2; u.Bt = (const char*)Bt + (size_t)pn * 256 * K * 2;
        return true;
    }
    __device__ __forceinline__ void epi(const pg8::f32x4 (&acc)[2][2][4][2], const pg8::UnitD& u, int wr, int wc, int fr, int fq) const {
        const int lane = fr + 16 * fq, col0 = u.pn * 256 + wc * 32 + 8 * fq;
        bf16* SGP = (bf16*)(ws + WS_Y + Y_V); bf16* SGA = (bf16*)(ws + WS_Y + Y_U); bf16* T1 = (bf16*)(ws + WS_Y + Y_Q) + 512; const float* part = (const float*)(ws + WS_PART);
        if (u.sub == 0) pg8::epi_bf16<1>(acc, u.pm, col0, wr, fr, lane, SGP, D, part, nullptr, 0, nullptr, 0);
        else if (u.sub == 1) pg8::epi_bf16<1>(acc, u.pm, col0, wr, fr, lane, SGA, D, part, nullptr, 0, nullptr, 0);
        else if (u.sub == 2) pg8::epi_bf16<2>(acc, u.pm, col0, wr, fr, lane, T1, AW, part, SGP, D, nullptr, 0);
        else pg8::epi_bf16<3>(acc, u.pm, col0, wr, fr, lane, SGP, D, part, T1, AW, SGA, D);
    }
};

#define IN(k) (lo <= (k) && (k) < hi)
#define SEAM(k) do { if (IN(k) && IN((k) + 1)) xcd_barrier(bar); } while (0)
template <int L> __device__ __forceinline__ void layer_phases(Frame& F, int lo, int hi, const XcdBarrier& bar) {
    constexpr int pb = 1 + 10 * L;
    unsigned char* ws = F.ws;
    bf16* HB = (bf16*)(ws + WS_HB);
    bf16* YU = (bf16*)(ws + WS_Y + Y_U); bf16* YQ = (bf16*)(ws + WS_Y + Y_Q); bf16* YK = (bf16*)(ws + WS_Y + Y_K); bf16* YV = (bf16*)(ws + WS_Y + Y_V);
    bf16* W_IN = (bf16*)(ws + WS_W + WO_WIN);
    if (IN(pb + 0)) { run_gemm_b<0, CfgP1, NUQKV, D, D>(F, HB, W_IN, YU, nullptr, nullptr); SEAM(pb + 0); }
#if defined(ATTN_ORACLE)
    if (IN(pb + 1)) { attn_simple(F); SEAM(pb + 1); }
#else
    if (IN(pb + 1)) { attn_mfma(F); SEAM(pb + 1); }
#endif
#if defined(ATTN_ORACLE)
    if (IN(pb + 2)) { pool_simple(F); SEAM(pb + 2); }
#else
    if (IN(pb + 2)) { attn_combine(F); pool_slide(F); SEAM(pb + 2); }
#endif
    if (IN(pb + 3)) { P3Prog P{F.ws, F.G, (int)blockIdx.x}; pg8::gemm_stream<P3Prog>(F.lds + RING_OFF, P); if (IN(pb + 6)) xcd_barrier(bar); }
    if (IN(pb + 6)) { run_gemm_r<D, D>(F, YV, (const bf16*)(ws + WS_W + WO_WO), L == 0 ? F.in[0] : (const float*)F.out); SEAM(pb + 6); }
    if (IN(pb + 7)) { run_gemm_b<0, CfgUp, NUP, D, D>(F, HB, (const bf16*)(ws + WS_W + WO_WUP), YU, nullptr, nullptr); SEAM(pb + 7); }
    if (IN(pb + 8)) { conv_slide(F, L); if (L + 1 < DEPTH) convert_weights(F, L + 1, false); SEAM(pb + 8); }
    if (IN(pb + 9)) { run_gemm_r<DFF, NUP>(F, YU + DFF, (const bf16*)(ws + WS_W + WO_WDN + L * WDN_BYTES), (const float*)F.out); SEAM(pb + 9); }
}
#undef IN
#undef SEAM

__global__ void __launch_bounds__(NWAVES * 64, 2) fwd_kernel(Args args) {
    extern __shared__ __attribute__((aligned(16))) unsigned char lds[];
    Frame F;
    F.lds = (LAS unsigned char*)lds;
    F.MISC = (volatile LAS unsigned*)(F.lds + MISC_OFF);
    F.tid = threadIdx.x; F.lane = F.tid & 63; F.wave = __builtin_amdgcn_readfirstlane(F.tid >> 6);
    F.G = gridDim.x; { const int bx = blockIdx.x; F.vcu = (F.G % 8 == 0) ? (bx % 8) * (F.G / 8) + bx / 8 : bx; }
    F.gw = F.vcu * NWAVES + F.wave; F.NGW = F.G * NWAVES;
    F.ws = args.ws; F.ctl = (gu32*)(args.ws + WS_CTL); F.out = args.out;
    F.in = args.in;
    for (int u = F.tid; u < (LDS_BYTES - LDSCTL_OFF) / 4; u += NWAVES * 64) ((LAS unsigned*)(F.lds + LDSCTL_OFF))[u] = 0u;
    __syncthreads();
    const int lo = args.ph_lo, hi = args.ph_hi;
    XcdBarrier bar; bar.bar = (unsigned*)(F.ctl + CW_BAR); bar.x = 0; bar.st = nullptr;
    if (hi - lo > 1) bar = xcd_barrier_post((unsigned*)(F.ctl + CW_BAR), F.MISC + 8);

#define IN(k) (lo <= (k) && (k) < hi)
#define SEAM(k) do { if (IN(k) && IN((k) + 1)) xcd_barrier(bar); } while (0)
    if (IN(0)) { convert_weights(F, 0, true); p0_x_rows(F); SEAM(0); }
    layer_phases<0>(F, lo, hi, bar);
    layer_phases<1>(F, lo, hi, bar);
    if (IN(N_PHASES - 1)) final_norm(F);
}
#undef IN
#undef SEAM

#ifdef DBG_STOP
__global__ void dbg_dump(const unsigned char* ws, float* out, size_t o0, size_t o1, size_t o2, size_t o3, int n_off, int is_f32) {
    const size_t n = (size_t)M * D;
    for (size_t i = (size_t)blockIdx.x * blockDim.x + threadIdx.x; i < n; i += (size_t)gridDim.x * blockDim.x) {
        float acc = 0.f; const size_t offs[4] = {o0, o1, o2, o3};
        for (int r = 0; r < n_off; ++r) { if (is_f32) acc += ((const float*)(ws + offs[r]))[i]; else acc += __uint_as_float((unsigned)((const unsigned short*)(ws + offs[r]))[i] << 16); }
        out[i] = acc;
    }
}
#endif
extern "C" void kernel_launch(void* const* d_in, const int* in_sizes, int n_in, void* d_out, int out_size, void* d_ws, size_t ws_size, hipStream_t stream) {
    static int grid = 0;
    if (grid == 0) {
        if (n_in != 15 || in_sizes[0] != M * D || out_size != M * D || ws_size < WS_END) { fprintf(stderr, "kernel_launch: unexpected problem shape (n_in %d, in0 %d, out %d, ws %zu); nothing launched\n", n_in, n_in > 0 ? in_sizes[0] : -1, out_size, ws_size); grid = -1; return; }
        int dev = 0, cus = 0, per_cu = 0;
        if (hipGetDevice(&dev) != hipSuccess || hipDeviceGetAttribute(&cus, hipDeviceAttributeMultiprocessorCount, dev) != hipSuccess) { grid = -1; return; }
        if (hipFuncSetAttribute((const void*)fwd_kernel, hipFuncAttributeMaxDynamicSharedMemorySize, LDS_BYTES) != hipSuccess) { fprintf(stderr, "kernel_launch: hipFuncSetAttribute failed\n"); grid = -1; return; }
        if (hipOccupancyMaxActiveBlocksPerMultiprocessor(&per_cu, (const void*)fwd_kernel, NWAVES * 64, LDS_BYTES) != hipSuccess || per_cu < 1) { fprintf(stderr, "kernel_launch: occupancy query reports %d blocks per CU\n", per_cu); (void)hipGetLastError(); grid = -1; return; }
        grid = cus;
    }
    if (grid < 0) return;
    (void)hipMemsetAsync((char*)d_ws + WS_CTL, 0, CTL_ZERO_BYTES, stream);
    Args a{};
    for (int i = 0; i < 15; ++i) a.in[i] = (const float*)d_in[i];
    a.out = (float*)d_out; a.ws = (unsigned char*)d_ws;
#if MK_N_LAUNCHES == 1
    a.ph_lo = 0; a.ph_hi = N_PHASES;
    hipLaunchKernelGGL(fwd_kernel, dim3(grid), dim3(NWAVES * 64), LDS_BYTES, stream, a);
#else
#ifdef DBG_STOP
    for (int p = 0; p <= DBG_STOP; ++p) { a.ph_lo = p; a.ph_hi = p + 1; hipLaunchKernelGGL(fwd_kernel, dim3(grid), dim3(NWAVES * 64), LDS_BYTES, stream, a); }
    { const size_t offs[4] = {DBG_OFFS}; hipLaunchKernelGGL(dbg_dump, dim3(2048), dim3(256), 0, stream, (const unsigned char*)d_ws, (float*)d_out, offs[0], offs[1], offs[2], offs[3], DBG_NOFF, DBG_F32); }
#else
    for (int p = 0; p < N_PHASES; ++p) { a.ph_lo = p; a.ph_hi = p + 1; hipLaunchKernelGGL(fwd_kernel, dim3(grid), dim3(NWAVES * 64), LDS_BYTES, stream, a); }
#endif
#endif
}
```

```cpp
#include <hip/hip_runtime.h>
#include <cstdio>
#include <cstdint>

#ifndef MK_N_LAUNCHES
#define MK_N_LAUNCHES 1
#endif

namespace pg8 {
#define PG8_LAS __attribute__((address_space(3)))
typedef unsigned short bf16_t;
typedef short bf16x8 __attribute__((ext_vector_type(8)));
typedef float f32x4 __attribute__((ext_vector_type(4)));
typedef unsigned u32x4 __attribute__((ext_vector_type(4)));
typedef unsigned u32x2 __attribute__((ext_vector_type(2)));
constexpr int BM = 256, BK = 64, HALF = 128, HTB = HALF * BK * 2  , STAGE_BYTES = 8 * HTB, NXCD = 8, WGM = 8;

__host__ __device__ __forceinline__ int lds_byte(int r, int c) { const int st = (r >> 4) * 2 + (c >> 5), rr = r & 15, cc = c & 31, ob = rr * 64 + cc * 2; return st * 1024 + (ob ^ (((ob >> 9) & 1) << 5)); }
__host__ __device__ __forceinline__ void stage_rc(int b, int& R, int& C) { const int st = b / 1024, sb = b % 1024, swz = sb ^ (((sb >> 9) & 1) << 5); R = (st >> 1) * 16 + swz / 64; C = (st & 1) * 32 + (swz % 64) / 2; }
__host__ __device__ __forceinline__ int perm32(int rho) { const int n = rho >> 4, i = rho & 15; return 8 * (i >> 2) + 4 * n + (i & 3); }

struct Unit { int pm, pn; };
struct Gemm { const bf16_t* A; const bf16_t* Bt; int M, N, K, lda; };

struct StaticOrder {
    int nM, nN, nwg, G, c;
    __host__ __device__ void init(int M, int N, int G_, int c_) { nM = M / BM; nN = N / BM; nwg = nM * nN; G = G_; c = c_; }
    __host__ __device__ bool next(int i, Unit& u) const {
        const long L = (long)i * G + c; if (L >= nwg) return false;
        int wgid = (int)L; { const int q = nwg / NXCD, r = nwg % NXCD, xcd = wgid % NXCD, off = wgid / NXCD; wgid = (xcd < r ? xcd * (q + 1) : r * (q + 1) + (xcd - r) * q) + off; }
        const int nig = WGM * nN, gid = wgid / nig, fm = gid * WGM, gsz = (nM - fm) < WGM ? (nM - fm) : WGM;
        u.pm = fm + ((wgid % nig) % gsz); u.pn = (wgid % nig) / gsz; return true;
    }
    __device__ __forceinline__ void a_ready(const Unit&) const {}
    __device__ __forceinline__ void done(const Unit&) const {}
};

typedef float f32x2_t __attribute__((ext_vector_type(2))); typedef __bf16 bf16x2_t __attribute__((ext_vector_type(2)));
__device__ __forceinline__ unsigned cvt_pk_bf16(float lo, float hi) { f32x2_t v = {lo, hi}; bf16x2_t b = __builtin_convertvector(v, bf16x2_t); return __builtin_bit_cast(unsigned, b); }
__device__ __forceinline__ float bf_lo(unsigned w) { return __uint_as_float(w << 16); }
__device__ __forceinline__ float bf_hi(unsigned w) { return __uint_as_float(w & 0xffff0000u); }

__device__ __forceinline__ void wave_rstd(const float* part, int Mrows, int rowbase, int lane, float eps, float (&rs)[2]) {
#pragma unroll
    for (int ai = 0; ai < 2; ++ai) { const float* p = part + rowbase + ai * HALF + lane; float s = 0.f;
#pragma unroll
        for (int t = 0; t < 16; ++t) s += p[(size_t)t * Mrows];
        rs[ai] = 1.0f / sqrtf(s * (1.0f / 1024.0f) + eps); }
}

template <int MODE, class CFG> struct EpiB {
    static constexpr bool PERM = true, AFTER_DRAIN = false;
    bf16_t* O;
    const float* part;
    const bf16_t* X1; const bf16_t* X2;
    static constexpr int Mrows = 16384, ldx = 1024; static constexpr float eps = 1e-6f;
    __device__ __forceinline__ void operator()(const f32x4 (&acc)[2][2][4][2], const Unit& u, int wr, int wc, int fr, int fq) const {
        const int lane = fr + 16 * fq;
        long boff = 0; int ldc = CFG::ld0, sst = 0;
        if (u.pn >= CFG::st1) { boff = CFG::off1; ldc = CFG::ld1; sst = CFG::st1; }
        if (u.pn >= CFG::st2) { boff = CFG::off2; sst = CFG::st2; }
        if (u.pn >= CFG::st3) { boff = CFG::off3; sst = CFG::st3; }
        bf16_t* base = (bf16_t*)((char*)O + boff);
        const int col0 = (u.pn - sst) * BM + wc * 32 + 8 * fq;
        const int row0 = u.pm * BM + wr * 64 + fr;
        float rs[2] = {1.f, 1.f};
        if (MODE <= 1) wave_rstd(part, Mrows, u.pm * BM + wr * 64, lane, eps, rs);
#pragma unroll
        for (int ai = 0; ai < 2; ++ai)
#pragma unroll
            for (int m = 0; m < 4; ++m) {
                const int row = row0 + ai * HALF + m * 16;
                float r = 1.f; if (MODE <= 1) r = __shfl(rs[ai], m * 16 + fr);
                bf16_t* rowp = base + (size_t)row * ldc + col0;
#pragma unroll
                for (int bj = 0; bj < 2; ++bj) {
                    f32x4 v0 = acc[ai][bj][m][0], v1 = acc[ai][bj][m][1];
                    if (MODE <= 1) { v0 = v0 * r; v1 = v1 * r; }
                    if (MODE == 1) {
#pragma unroll
                        for (int e = 0; e < 4; ++e) { v0[e] = __builtin_amdgcn_rcpf(1.0f + __expf(-v0[e])); v1[e] = __builtin_amdgcn_rcpf(1.0f + __expf(-v1[e])); }
                    }
                    if (MODE == 2) {
                        const u32x4 x = *(const u32x4*)(X1 + (size_t)row * ldx + col0 + bj * HALF);
                        v0[0] *= bf_lo(x.x); v0[1] *= bf_hi(x.x); v0[2] *= bf_lo(x.y); v0[3] *= bf_hi(x.y);
                        v1[0] *= bf_lo(x.z); v1[1] *= bf_hi(x.z); v1[2] *= bf_lo(x.w); v1[3] *= bf_hi(x.w);
                    }
                    if (MODE == 3) {
                        const u32x4 x = *(const u32x4*)(X1 + (size_t)row * ldx + col0 + bj * HALF);
                        const u32x4 y = *(const u32x4*)(X2 + (size_t)row * ldx + col0 + bj * HALF);
                        v0[0] = bf_lo(x.x) + v0[0] * bf_lo(y.x); v0[1] = bf_hi(x.x) + v0[1] * bf_hi(y.x); v0[2] = bf_lo(x.y) + v0[2] * bf_lo(y.y); v0[3] = bf_hi(x.y) + v0[3] * bf_hi(y.y);
                        v1[0] = bf_lo(x.z) + v1[0] * bf_lo(y.z); v1[1] = bf_hi(x.z) + v1[1] * bf_hi(y.z); v1[2] = bf_lo(x.w) + v1[2] * bf_lo(y.w); v1[3] = bf_hi(x.w) + v1[3] * bf_hi(y.w);
                    }
                    u32x4 w; w.x = cvt_pk_bf16(v0[0], v0[1]); w.y = cvt_pk_bf16(v0[2], v0[3]); w.z = cvt_pk_bf16(v1[0], v1[1]); w.w = cvt_pk_bf16(v1[2], v1[3]);
                    *(u32x4*)(rowp + bj * HALF) = w;
                }
                if (MODE >= 2) asm volatile("" ::: "memory");
            }
    }
};

struct EpiRes {
    static constexpr bool PERM = false, AFTER_DRAIN = false;
    bf16_t* hb; float* part; int Mrows;
    __device__ __forceinline__ void operator()(const f32x4 (&acc)[2][2][4][2], const Unit& u, int wr, int wc, int fr, int fq) const {
        const int col0 = u.pn * BM + wc * 32 + 4 * fq;
        bf16_t* p0 = hb + (size_t)(u.pm * BM + wr * 64 + fr) * 1024 + col0;
        u32x2 pre[2][4][2][2];
#pragma unroll
        for (int ai = 0; ai < 2; ++ai)
#pragma unroll
            for (int m = 0; m < 4; ++m)
#pragma unroll
                for (int bj = 0; bj < 2; ++bj)
#pragma unroll
                    for (int n = 0; n < 2; ++n) pre[ai][m][bj][n] = *(const u32x2*)(p0 + (size_t)(ai * HALF + m * 16) * 1024 + bj * HALF + n * 16);
#pragma unroll
        for (int ai = 0; ai < 2; ++ai)
#pragma unroll
            for (int m = 0; m < 4; ++m) {
                const int row = u.pm * BM + ai * HALF + wr * 64 + m * 16 + fr;
                float ss = 0.f;
#pragma unroll
                for (int bj = 0; bj < 2; ++bj)
#pragma unroll
                    for (int n = 0; n < 2; ++n) {
                        const u32x2 b = pre[ai][m][bj][n]; const f32x4 a = acc[ai][bj][m][n];
                        const float o0 = bf_lo(b.x) + a[0], o1 = bf_hi(b.x) + a[1], o2 = bf_lo(b.y) + a[2], o3 = bf_hi(b.y) + a[3];
                        u32x2 w; w.x = cvt_pk_bf16(o0, o1); w.y = cvt_pk_bf16(o2, o3);
                        *(u32x2*)(p0 + (size_t)(ai * HALF + m * 16) * 1024 + bj * HALF + n * 16) = w;
                        ss += (o0 * o0 + o1 * o1) + (o2 * o2 + o3 * o3);
                    }
                ss += __shfl_xor(ss, 16); ss += __shfl_xor(ss, 32);
                if (fq == 0) part[(size_t)(u.pn * 4 + wc) * Mrows + row] = ss;
            }
    }
};

template <class Epi, int GN, int GK, int GLDA, bool ALIGN_EPI = false, bool SP2 = false>
__device__ __forceinline__ void gemm_phase(PG8_LAS unsigned char* lds, const bf16_t* gA, const bf16_t* gBt, int G_, int c_, const Epi& E) {
    struct { const bf16_t* A; const bf16_t* Bt; int K, lda; } g{gA, gBt, GK, GLDA};
    StaticOrder S; S.nM = 16384 / BM; S.nN = GN / BM; S.nwg = S.nM * S.nN; S.G = G_; S.c = c_;
    int tid_ = threadIdx.x; asm volatile("" : "+v"(tid_));
    const int tid = tid_, wid = __builtin_amdgcn_readfirstlane(tid >> 6), lane = tid & 63, wr = wid >> 2, wc = wid & 3, fr = lane & 15, fq = lane >> 4;
    const int K = g.K, nt = K / BK, lda = g.lda;
    unsigned voffA[2], voffB[2];
#pragma unroll
    for (int i = 0; i < 2; ++i) { int R, C; stage_rc(tid * 16 + i * 8192, R, C); const int Rb = Epi::PERM ? ((R & ~31) + perm32(R & 31)) : R;
        voffA[i] = (unsigned)(R * lda + C) * 2u; voffB[i] = (unsigned)(Rb * K + C) * 2u; }
    const size_t kstep = (size_t)(BK * 2);
    const size_t hstepA = (size_t)HALF * lda * 2, hstepB = (size_t)HALF * K * 2;
    const size_t tstepA = 2 * hstepA, tstepB = 2 * hstepB;
    const unsigned ldsw = (unsigned)wid * 1024u;
    const int aoff = lds_byte(wr * 64 + fr, fq * 8), boff = lds_byte(wc * 32 + fr, fq * 8);
#define PG8_SA(b, h) (((b) * 2 + (h)) * HTB)
#define PG8_SB(b, h) ((4 + (b) * 2 + (h)) * HTB)
#define PG8_STAGE(bufoff, gbase, voff) do { _Pragma("unroll") for (int _i = 0; _i < 2; ++_i) \
        __builtin_amdgcn_global_load_lds((const unsigned*)((const char*)(gbase) + (voff)[_i]), (PG8_LAS unsigned*)(lds + (bufoff) + ldsw + _i * 8192), 16, 0, 0); } while (0)
#define PG8_LDA(dst, b, h) do { _Pragma("unroll") for (int m = 0; m < 4; ++m) _Pragma("unroll") for (int k = 0; k < 2; ++k) dst[m][k] = *(const PG8_LAS bf16x8*)(lds + PG8_SA(b, h) + aoff + m * 2048 + k * 1024); } while (0)
#define PG8_LDB(dst, b, h) do { _Pragma("unroll") for (int n = 0; n < 2; ++n) _Pragma("unroll") for (int k = 0; k < 2; ++k) dst[n][k] = *(const PG8_LAS bf16x8*)(lds + PG8_SB(b, h) + boff + n * 2048 + k * 1024); } while (0)
#define PG8_MMA(ai, bj, At, Bt) do { __builtin_amdgcn_s_setprio(1); _Pragma("unroll") for (int m = 0; m < 4; ++m) _Pragma("unroll") for (int n = 0; n < 2; ++n) _Pragma("unroll") for (int k = 0; k < 2; ++k) \
        acc[ai][bj][m][n] = __builtin_amdgcn_mfma_f32_16x16x32_bf16(Bt[n][k], At[m][k], acc[ai][bj][m][n], 0, 0, 0); __builtin_amdgcn_s_setprio(0); } while (0)
#define PG8_WAIT_V(n) asm volatile("s_waitcnt vmcnt(" #n ")" ::: "memory")
#define PG8_WAIT_L(n) asm volatile("s_waitcnt lgkmcnt(" #n ")" ::: "memory")
#define PG8_BAR __builtin_amdgcn_s_barrier()
#define PG8_SCHED __builtin_amdgcn_sched_barrier(0)
    Unit cur, nxt; int ui = 0;
    if (!S.next(0, cur)) return;
    f32x4 acc[2][2][4][2];
#pragma unroll
    for (int a = 0; a < 2; ++a)
#pragma unroll
        for (int b = 0; b < 2; ++b)
#pragma unroll
            for (int m = 0; m < 4; ++m)
#pragma unroll
                for (int n = 0; n < 2; ++n) acc[a][b][m][n] = (f32x4){0.f, 0.f, 0.f, 0.f};
    bf16x8 At[4][2], B0[2][2], B1[2][2];
    const char* cA = (const char*)g.A + (size_t)cur.pm * tstepA; const char* cB = (const char*)g.Bt + (size_t)cur.pn * tstepB;
    S.a_ready(cur);
    if constexpr (SP2) {
        PG8_STAGE(PG8_SB(0, 0), cB, voffB); PG8_STAGE(PG8_SB(0, 1), cB + hstepB, voffB); PG8_STAGE(PG8_SA(0, 0), cA, voffA); PG8_STAGE(PG8_SA(0, 1), cA + hstepA, voffA);
        if (wr == 1) PG8_BAR;
        PG8_WAIT_V(2); PG8_BAR;
        PG8_STAGE(PG8_SB(1, 0), cB + kstep, voffB); PG8_STAGE(PG8_SA(1, 0), cA + kstep, voffA); PG8_STAGE(PG8_SB(1, 1), cB + hstepB + kstep, voffB);
        PG8_WAIT_V(6); PG8_BAR;
    } else {
        PG8_STAGE(PG8_SB(0, 0), cB, voffB); PG8_STAGE(PG8_SA(0, 0), cA, voffA); PG8_STAGE(PG8_SB(0, 1), cB + hstepB, voffB); PG8_STAGE(PG8_SA(0, 1), cA + hstepA, voffA);
        if (wr == 1) PG8_BAR;
        PG8_WAIT_V(4); PG8_BAR;
        PG8_STAGE(PG8_SB(1, 0), cB + kstep, voffB); PG8_STAGE(PG8_SA(1, 0), cA + kstep, voffA); PG8_STAGE(PG8_SB(1, 1), cB + hstepB + kstep, voffB);
        PG8_WAIT_V(6); PG8_BAR;
    }
    for (;;) {
        const bool has_next = S.next(ui + 1, nxt);
        const char* nA = has_next ? (const char*)g.A + (size_t)nxt.pm * tstepA : cA; const char* nB = has_next ? (const char*)g.Bt + (size_t)nxt.pn * tstepB : cB;
        for (int t = 0; t < nt; t += 2) {
            const bool last = (t == nt - 2);
            const char* a1 = cA + (size_t)(t + 1) * kstep;
            const char* a2 = last ? nA : cA + (size_t)(t + 2) * kstep; const char* b2 = last ? nB : cB + (size_t)(t + 2) * kstep;
            const char* a3 = a2 + kstep; const char* b3 = b2 + kstep;
            if (last && has_next) S.a_ready(nxt);
            if constexpr (SP2) {
            PG8_LDB(B0, 0, 0); PG8_LDB(B1, 0, 1); PG8_SCHED; PG8_LDA(At, 0, 0); PG8_STAGE(PG8_SA(1, 1), a1 + hstepA, voffA);
            PG8_WAIT_V(8); PG8_WAIT_L(0); PG8_BAR; PG8_MMA(0, 0, At, B0); PG8_MMA(0, 1, At, B1); PG8_BAR; PG8_SCHED;
            PG8_LDA(At, 0, 1); PG8_STAGE(PG8_SB(0, 0), b2, voffB); PG8_STAGE(PG8_SB(0, 1), b2 + hstepB, voffB); PG8_STAGE(PG8_SA(0, 0), a2, voffA);
            PG8_WAIT_V(8); PG8_WAIT_L(0); PG8_BAR; PG8_MMA(1, 0, At, B0); PG8_MMA(1, 1, At, B1); PG8_BAR; PG8_SCHED;
            PG8_LDB(B0, 1, 0); PG8_LDB(B1, 1, 1); PG8_SCHED; PG8_LDA(At, 1, 0); PG8_STAGE(PG8_SA(0, 1), a2 + hstepA, voffA);
            PG8_WAIT_V(8); PG8_WAIT_L(0); PG8_BAR; PG8_MMA(0, 0, At, B0); PG8_MMA(0, 1, At, B1); PG8_BAR; PG8_SCHED;
            PG8_LDA(At, 1, 1); PG8_STAGE(PG8_SB(1, 0), b3, voffB); PG8_STAGE(PG8_SB(1, 1), b3 + hstepB, voffB); PG8_STAGE(PG8_SA(1, 0), a3, voffA);
            PG8_WAIT_V(8); PG8_WAIT_L(0); PG8_BAR; PG8_MMA(1, 0, At, B0); PG8_MMA(1, 1, At, B1); PG8_BAR; PG8_SCHED;
            } else {
            PG8_LDB(B0, 0, 0); PG8_SCHED; PG8_LDA(At, 0, 0); PG8_STAGE(PG8_SA(1, 1), a1 + hstepA, voffA);
            PG8_WAIT_L(8); PG8_BAR; PG8_WAIT_L(0); PG8_MMA(0, 0, At, B0); PG8_BAR; PG8_SCHED;
            PG8_LDB(B1, 0, 1); PG8_STAGE(PG8_SB(0, 0), b2, voffB);
            PG8_BAR; PG8_WAIT_L(0); PG8_MMA(0, 1, At, B1); PG8_BAR;
            PG8_LDA(At, 0, 1); PG8_STAGE(PG8_SA(0, 0), a2, voffA);
            PG8_BAR; PG8_WAIT_L(0); PG8_MMA(1, 0, At, B0); PG8_BAR; PG8_SCHED;
            PG8_STAGE(PG8_SB(0, 1), b2 + hstepB, voffB);
            PG8_WAIT_V(6); PG8_BAR; PG8_MMA(1, 1, At, B1); PG8_BAR;
            PG8_LDB(B0, 1, 0); PG8_SCHED; PG8_LDA(At, 1, 0); PG8_STAGE(PG8_SA(0, 1), a2 + hstepA, voffA);
            PG8_WAIT_L(8); PG8_BAR; PG8_WAIT_L(0); PG8_MMA(0, 0, At, B0); PG8_BAR; PG8_SCHED;
            PG8_LDB(B1, 1, 1); PG8_STAGE(PG8_SB(1, 0), b3, voffB);
            PG8_BAR; PG8_WAIT_L(0); PG8_MMA(0, 1, At, B1); PG8_BAR;
            PG8_LDA(At, 1, 1); PG8_STAGE(PG8_SA(1, 0), a3, voffA);
            PG8_BAR; PG8_WAIT_L(0); PG8_MMA(1, 0, At, B0); PG8_BAR; PG8_SCHED;
            PG8_STAGE(PG8_SB(1, 1), b3 + hstepB, voffB);
            PG8_WAIT_V(6); PG8_BAR; PG8_MMA(1, 1, At, B1); PG8_BAR;
            }
        }
        if constexpr (ALIGN_EPI) { if (wr == 0) PG8_BAR; }
        if constexpr (!Epi::AFTER_DRAIN) { E(acc, cur, wr, wc, fr, fq); S.done(cur); }
        if (!has_next) break;
#pragma unroll
        for (int a = 0; a < 2; ++a)
#pragma unroll
            for (int b = 0; b < 2; ++b)
#pragma unroll
                for (int m = 0; m < 4; ++m)
#pragma unroll
                    for (int n = 0; n < 2; ++n) acc[a][b][m][n] = (f32x4){0.f, 0.f, 0.f, 0.f};
        cur = nxt; cA = nA; cB = nB; ++ui;
        if constexpr (ALIGN_EPI) { if (wr == 1) PG8_BAR; }
    }
    PG8_WAIT_V(0);
    if constexpr (!ALIGN_EPI) { if (wr == 0) PG8_BAR; }
    PG8_BAR;
#undef PG8_SA
#undef PG8_SB
#undef PG8_STAGE
#undef PG8_LDA
#undef PG8_LDB
#undef PG8_MMA
#undef PG8_WAIT_V
#undef PG8_WAIT_L
#undef PG8_BAR
#undef PG8_SCHED
}

struct UnitD { const char* A; const char* Bt; int nt, lda, K; int pm, pn, sub; };
template <class Prog>
__device__ __forceinline__ void gemm_stream(PG8_LAS unsigned char* lds, const Prog& P) {
    int tid_ = threadIdx.x; asm volatile("" : "+v"(tid_));
    const int tid = tid_, wid = __builtin_amdgcn_readfirstlane(tid >> 6), lane = tid & 63, wr = wid >> 2, wc = wid & 3, fr = lane & 15, fq = lane >> 4;
    int Rr[2], Cc[2], Rb[2];
#pragma unroll
    for (int i = 0; i < 2; ++i) { int R, C; stage_rc(tid * 16 + i * 8192, R, C); Rr[i] = R; Cc[i] = C; Rb[i] = (R & ~31) + perm32(R & 31); }
    const size_t kstep = (size_t)(BK * 2);
    const unsigned ldsw = (unsigned)wid * 1024u;
    const int aoff = lds_byte(wr * 64 + fr, fq * 8), boff = lds_byte(wc * 32 + fr, fq * 8);
#define PG8_SA(b, h) (((b) * 2 + (h)) * HTB)
#define PG8_SB(b, h) ((4 + (b) * 2 + (h)) * HTB)
#define PG8_STAGE(bufoff, gbase, voff) do { _Pragma("unroll") for (int _i = 0; _i < 2; ++_i) \
        __builtin_amdgcn_global_load_lds((const unsigned*)((const char*)(gbase) + (voff)[_i]), (PG8_LAS unsigned*)(lds + (bufoff) + ldsw + _i * 8192), 16, 0, 0); } while (0)
#define PG8_LDA(dst, b, h) do { _Pragma("unroll") for (int m = 0; m < 4; ++m) _Pragma("unroll") for (int k = 0; k < 2; ++k) dst[m][k] = *(const PG8_LAS bf16x8*)(lds + PG8_SA(b, h) + aoff + m * 2048 + k * 1024); } while (0)
#define PG8_LDB(dst, b, h) do { _Pragma("unroll") for (int n = 0; n < 2; ++n) _Pragma("unroll") for (int k = 0; k < 2; ++k) dst[n][k] = *(const PG8_LAS bf16x8*)(lds + PG8_SB(b, h) + boff + n * 2048 + k * 1024); } while (0)
#define PG8_MMA(ai, bj, At, Bt) do { __builtin_amdgcn_s_setprio(1); _Pragma("unroll") for (int m = 0; m < 4; ++m) _Pragma("unroll") for (int n = 0; n < 2; ++n) _Pragma("unroll") for (int k = 0; k < 2; ++k) \
        acc[ai][bj][m][n] = __builtin_amdgcn_mfma_f32_16x16x32_bf16(Bt[n][k], At[m][k], acc[ai][bj][m][n], 0, 0, 0); __builtin_amdgcn_s_setprio(0); } while (0)
#define PG8_WAIT_V(n) asm volatile("s_waitcnt vmcnt(" #n ")" ::: "memory")
#define PG8_WAIT_L(n) asm volatile("s_waitcnt lgkmcnt(" #n ")" ::: "memory")
#define PG8_BAR __builtin_amdgcn_s_barrier()
#define PG8_SCHED __builtin_amdgcn_sched_barrier(0)
    UnitD cur, nxt; int ui = 0;
    if (!P.get(0, cur)) return;
    f32x4 acc[2][2][4][2];
#pragma unroll
    for (int a = 0; a < 2; ++a)
#pragma unroll
        for (int b = 0; b < 2; ++b)
#pragma unroll
            for (int m = 0; m < 4; ++m)
#pragma unroll
                for (int n = 0; n < 2; ++n) acc[a][b][m][n] = (f32x4){0.f, 0.f, 0.f, 0.f};
    bf16x8 At[4][2], B0[2][2], B1[2][2];
    unsigned cvA[2], cvB[2];
#pragma unroll
    for (int i = 0; i < 2; ++i) { cvA[i] = (unsigned)(Rr[i] * cur.lda + Cc[i]) * 2u; cvB[i] = (unsigned)(Rb[i] * cur.K + Cc[i]) * 2u; }
    const char* cA = cur.A; const char* cB = cur.Bt;
    size_t chA = (size_t)HALF * cur.lda * 2, chB = (size_t)HALF * cur.K * 2;
    PG8_STAGE(PG8_SB(0, 0), cB, cvB); PG8_STAGE(PG8_SB(0, 1), cB + chB, cvB); PG8_STAGE(PG8_SA(0, 0), cA, cvA); PG8_STAGE(PG8_SA(0, 1), cA + chA, cvA);
    if (wr == 1) PG8_BAR;
    PG8_WAIT_V(2); PG8_BAR;
    PG8_STAGE(PG8_SB(1, 0), cB + kstep, cvB); PG8_STAGE(PG8_SA(1, 0), cA + kstep, cvA); PG8_STAGE(PG8_SB(1, 1), cB + chB + kstep, cvB);
    PG8_WAIT_V(6); PG8_BAR;
    for (;;) {
        const bool has_next = P.get(ui + 1, nxt);
        const char* nA = has_next ? nxt.A : cA; const char* nB = has_next ? nxt.Bt : cB;
        unsigned nvA[2], nvB[2];
#pragma unroll
        for (int i = 0; i < 2; ++i) { nvA[i] = has_next ? (unsigned)(Rr[i] * nxt.lda + Cc[i]) * 2u : cvA[i]; nvB[i] = has_next ? (unsigned)(Rb[i] * nxt.K + Cc[i]) * 2u : cvB[i]; }
        const size_t nhA = has_next ? (size_t)HALF * nxt.lda * 2 : chA, nhB = has_next ? (size_t)HALF * nxt.K * 2 : chB;
        const int nt = cur.nt;
        for (int t = 0; t < nt; t += 2) {
            const bool last = (t == nt - 2);
            const char* a1 = cA + (size_t)(t + 1) * kstep;
            const char* a2 = last ? nA : cA + (size_t)(t + 2) * kstep; const char* b2 = last ? nB : cB + (size_t)(t + 2) * kstep;
            const char* a3 = a2 + kstep; const char* b3 = b2 + kstep;
            unsigned vA2[2], vB2[2];
#pragma unroll
            for (int i = 0; i < 2; ++i) { vA2[i] = last ? nvA[i] : cvA[i]; vB2[i] = last ? nvB[i] : cvB[i]; }
            const size_t hA2 = last ? nhA : chA, hB2 = last ? nhB : chB;
            PG8_LDB(B0, 0, 0); PG8_LDB(B1, 0, 1); PG8_SCHED; PG8_LDA(At, 0, 0); PG8_STAGE(PG8_SA(1, 1), a1 + chA, cvA);
            PG8_WAIT_V(8); PG8_WAIT_L(0); PG8_BAR; PG8_MMA(0, 0, At, B0); PG8_MMA(0, 1, At, B1); PG8_BAR; PG8_SCHED;
            PG8_LDA(At, 0, 1); PG8_STAGE(PG8_SB(0, 0), b2, vB2); PG8_STAGE(PG8_SB(0, 1), b2 + hB2, vB2); PG8_STAGE(PG8_SA(0, 0), a2, vA2);
            PG8_WAIT_V(8); PG8_WAIT_L(0); PG8_BAR; PG8_MMA(1, 0, At, B0); PG8_MMA(1, 1, At, B1); PG8_BAR; PG8_SCHED;
            PG8_LDB(B0, 1, 0); PG8_LDB(B1, 1, 1); PG8_SCHED; PG8_LDA(At, 1, 0); PG8_STAGE(PG8_SA(0, 1), a2 + hA2, vA2);
            PG8_WAIT_V(8); PG8_WAIT_L(0); PG8_BAR; PG8_MMA(0, 0, At, B0); PG8_MMA(0, 1, At, B1); PG8_BAR; PG8_SCHED;
            PG8_LDA(At, 1, 1); PG8_STAGE(PG8_SB(1, 0), b3, vB2); PG8_STAGE(PG8_SB(1, 1), b3 + hB2, vB2); PG8_STAGE(PG8_SA(1, 0), a3, vA2);
            PG8_WAIT_V(8); PG8_WAIT_L(0); PG8_BAR; PG8_MMA(1, 0, At, B0); PG8_MMA(1, 1, At, B1); PG8_BAR; PG8_SCHED;
        }
        if (wr == 0) PG8_BAR;
        P.epi(acc, cur, wr, wc, fr, fq);
        if (!has_next) break;
#pragma unroll
        for (int a = 0; a < 2; ++a)
#pragma unroll
            for (int b = 0; b < 2; ++b)
#pragma unroll
                for (int m = 0; m < 4; ++m)
#pragma unroll
                    for (int n = 0; n < 2; ++n) acc[a][b][m][n] = (f32x4){0.f, 0.f, 0.f, 0.f};
        cur = nxt; cA = nA; cB = nB; chA = nhA; chB = nhB; ++ui;
#pragma unroll
        for (int i = 0; i < 2; ++i) { cvA[i] = nvA[i]; cvB[i] = nvB[i]; }
        if (wr == 1) PG8_BAR;
    }
    PG8_WAIT_V(0);
    PG8_BAR;
#undef PG8_SA
#undef PG8_SB
#undef PG8_STAGE
#undef PG8_LDA
#undef PG8_LDB
#undef PG8_MMA
#undef PG8_WAIT_V
#undef PG8_WAIT_L
#undef PG8_BAR
#undef PG8_SCHED
}

template <int MODE> __device__ __forceinline__ void epi_bf16(const f32x4 (&acc)[2][2][4][2], int pm, int col0, int wr, int fr, int lane, bf16_t* O, int ldo, const float* part,
                                                             const bf16_t* X1, int ldx1, const bf16_t* X2, int ldx2) {
    const int row0 = pm * BM + wr * 64 + fr;
    float rs[2] = {1.f, 1.f};
    if (MODE <= 1) wave_rstd(part, 16384, pm * BM + wr * 64, lane, 1e-6f, rs);
#pragma unroll
    for (int ai = 0; ai < 2; ++ai)
#pragma unroll
        for (int m = 0; m < 4; ++m) {
            const int row = row0 + ai * HALF + m * 16;
            float r = 1.f; if (MODE <= 1) r = __shfl(rs[ai], m * 16 + fr);
#pragma unroll
            for (int bj = 0; bj < 2; ++bj) {
                f32x4 v0 = acc[ai][bj][m][0], v1 = acc[ai][bj][m][1];
                if (MODE <= 1) { v0 = v0 * r; v1 = v1 * r; }
                if (MODE == 1) {
#pragma unroll
                    for (int e = 0; e < 4; ++e) { v0[e] = __builtin_amdgcn_rcpf(1.0f + __expf(-v0[e])); v1[e] = __builtin_amdgcn_rcpf(1.0f + __expf(-v1[e])); }
                }
                if (MODE == 2 || MODE == 3) {
                    const u32x4 x = *(const u32x4*)(X1 + (size_t)row * ldx1 + col0 + bj * HALF);
                    if (MODE == 2) {
                        v0[0] *= bf_lo(x.x); v0[1] *= bf_hi(x.x); v0[2] *= bf_lo(x.y); v0[3] *= bf_hi(x.y);
                        v1[0] *= bf_lo(x.z); v1[1] *= bf_hi(x.z); v1[2] *= bf_lo(x.w); v1[3] *= bf_hi(x.w);
                    } else {
                        const u32x4 y = *(const u32x4*)(X2 + (size_t)row * ldx2 + col0 + bj * HALF);
                        v0[0] = bf_lo(x.x) + v0[0] * bf_lo(y.x); v0[1] = bf_hi(x.x) + v0[1] * bf_hi(y.x); v0[2] = bf_lo(x.y) + v0[2] * bf_lo(y.y); v0[3] = bf_hi(x.y) + v0[3] * bf_hi(y.y);
                        v1[0] = bf_lo(x.z) + v1[0] * bf_lo(y.z); v1[1] = bf_hi(x.z) + v1[1] * bf_hi(y.z); v1[2] = bf_lo(x.w) + v1[2] * bf_lo(y.w); v1[3] = bf_hi(x.w) + v1[3] * bf_hi(y.w);
                    }
                }
                u32x4 w; w.x = cvt_pk_bf16(v0[0], v0[1]); w.y = cvt_pk_bf16(v0[2], v0[3]); w.z = cvt_pk_bf16(v1[0], v1[1]); w.w = cvt_pk_bf16(v1[2], v1[3]);
                *(u32x4*)(O + (size_t)row * ldo + col0 + bj * HALF) = w;
            }
            if (MODE >= 2) asm volatile("" ::: "memory");
        }
}
}

#ifndef PG8_SP2
#define PG8_SP2 true
#endif
#ifndef PG8_ALIGN
#define PG8_ALIGN true
#endif

constexpr int NWAVES = 8;
constexpr int BATCH = 8, S = 2048, D = 1024, DEPTH = 2;
constexpr int M = BATCH * S;
constexpr int NIN = 7680, NUQKV = 5632, NGATE = 2048, AW = 1536, AO = 512, DFF = 2816, NUP = 5632, HD = 128;
constexpr float EPS = 1e-6f;
constexpr int N_PHASES = 2 + 10 * DEPTH;

constexpr size_t MiB = 1u << 20;
constexpr size_t WS_CTL = 0, CTL_ZERO_BYTES = 64 * 1024;
constexpr size_t WS_PART = 1 * MiB;
constexpr size_t WS_LSE = 2 * MiB;
constexpr size_t WS_W = 4 * MiB;
constexpr size_t WO_WIN = 0, WO_WC = 15 * MiB, WO_WB = 17 * MiB, WO_WO = 18 * MiB, WO_WUP = 20 * MiB, WO_WDN = 31 * MiB, WDN_BYTES = (size_t)D * DFF * 2;
constexpr size_t WS_HB = 46 * MiB;
constexpr size_t WS_Y = 78 * MiB;
constexpr size_t Y_U = 0, Y_Q = 32 * MiB, Y_K = 80 * MiB, Y_V = 128 * MiB;
constexpr size_t WS_END = 254 * MiB;
static_assert(WO_WDN + 2 * WDN_BYTES <= 42 * MiB && WS_W + 42 * MiB <= WS_HB && WS_HB + 32 * MiB <= WS_Y && WS_Y + 176 * MiB <= WS_END, "d_ws map");
constexpr int CW_BAR = 1024;

constexpr int RING_OFF = 0, RING_BYTES = 131072;
constexpr int LDSCTL_OFF = RING_BYTES, MISC_OFF = LDSCTL_OFF + 320;
constexpr int LDS_BYTES = 147456;

#define GAS __attribute__((address_space(1)))
#define LAS __attribute__((address_space(3)))
typedef unsigned short bf16;
typedef unsigned v4u __attribute__((ext_vector_type(4)));
typedef unsigned v2u __attribute__((ext_vector_type(2)));
typedef float f32x4 __attribute__((ext_vector_type(4)));
typedef GAS unsigned gu32;
#define RLX_AGENT __ATOMIC_RELAXED, __HIP_MEMORY_SCOPE_AGENT
#define LDS_WAIT() asm volatile("s_waitcnt lgkmcnt(0)" ::: "memory")
#define VM_WAIT() asm volatile("s_waitcnt vmcnt(0)" ::: "memory")
__device__ __forceinline__ unsigned f2bf(float f) { unsigned u = __builtin_bit_cast(unsigned, f); return (u + 0x7fffu + ((u >> 16) & 1u)) >> 16; }
__device__ __forceinline__ unsigned pk2(float lo, float hi) { return f2bf(lo) | (f2bf(hi) << 16); }
__device__ __forceinline__ float bflo(unsigned w) { return __uint_as_float(w << 16); }
__device__ __forceinline__ float bfhi(unsigned w) { return __uint_as_float(w & 0xffff0000u); }

#define XB_TMO      128
#define XB_XCNT(j)  (256  + 64 * (j))
#define XB_XSUB(j)  (1280 + 64 * (j))
#define XB_XGEN(j)  (2304 + 64 * (j))
#define XB_TOP      3328
#define XB_TOPGEN   3392
#define XCD_BAR_WORDS 3456
#define XB_SPIN_CAP (1u << 18)
static_assert((CW_BAR + XCD_BAR_WORDS) * 4 <= (int)CTL_ZERO_BYTES, "barrier words inside the zeroed region");

__device__ __forceinline__ unsigned xb_ld(unsigned* p)              { return __hip_atomic_load(p, __ATOMIC_RELAXED, __HIP_MEMORY_SCOPE_AGENT); }
__device__ __forceinline__ unsigned xb_add(unsigned* p, unsigned v) { return __hip_atomic_fetch_add(p, v, __ATOMIC_RELAXED, __HIP_MEMORY_SCOPE_AGENT); }
__device__ __forceinline__ unsigned xb_xcc_id() { return (unsigned)__builtin_amdgcn_s_getreg((3 << 11) | 20) & 0xFu; }
#define XB_SPIN(cond, bar) do { unsigned _sp = 0; while (cond) { __builtin_amdgcn_s_sleep(1); \
    if ((++_sp & 255u) == 0u) { if (xb_ld(&(bar)[XB_TMO])) break; if (_sp > XB_SPIN_CAP) { atomicAdd(&(bar)[XB_TMO], 1u); break; } } } } while (0)

struct XcdBarrier { unsigned* bar; unsigned x; volatile LAS unsigned* st; };

__device__ __forceinline__ XcdBarrier xcd_barrier_post(unsigned* bar, volatile LAS unsigned* st) {
    XcdBarrier b; b.bar = bar; b.x = xb_xcc_id(); b.st = st;
    if (threadIdx.x == 0) (void)xb_add(&bar[XB_XCNT(b.x)], 1u);
    return b;
}
__device__ __forceinline__ void xcd_barrier_complete(unsigned* bar, unsigned x, unsigned& nloc, unsigned& nx) {
    const unsigned G = gridDim.x * gridDim.y * gridDim.z;
    unsigned sum, cnt, mine, sp = 0u;
    for (;;) {
        sum = 0u; cnt = 0u; mine = 0u;
#pragma unroll
        for (unsigned j = 0; j < 16; ++j) { const unsigned c = xb_ld(&bar[XB_XCNT(j)]); sum += c; cnt += (c > 0u) ? 1u : 0u; mine = (j == x) ? c : mine; }
        if (sum == G) break;
        __builtin_amdgcn_s_sleep(1);
        if ((++sp & 255u) == 0u) { if (xb_ld(&bar[XB_TMO])) break; if (sp > XB_SPIN_CAP) { atomicAdd(&bar[XB_TMO], 1u); break; } }
    }
    nloc = mine > 0u ? mine : 1u; nx = cnt > 0u ? cnt : 1u;
}
__device__ __forceinline__ void xcd_barrier(const XcdBarrier& b) {
    asm volatile("s_waitcnt vmcnt(0)" ::: "memory");
    __syncthreads();
    if (threadIdx.x == 0) {
        unsigned* bar = b.bar; unsigned bx_ = b.x; asm volatile("" : "+s"(bar), "+s"(bx_));
        __builtin_amdgcn_s_waitcnt(0);
        unsigned nloc = b.st[0], nx = b.st[1];
        if (nloc == 0u) { xcd_barrier_complete(bar, bx_, nloc, nx); b.st[0] = nloc; b.st[1] = nx; }
        const unsigned old = xb_add(&bar[XB_XSUB(bx_)], 1u);
        const unsigned gen = old / nloc;
        if (old + 1u == (gen + 1u) * nloc) {
            __builtin_amdgcn_fence(__ATOMIC_RELEASE, "agent");
            asm volatile("s_waitcnt vmcnt(0)" ::: "memory");
            const unsigned og = xb_add(&bar[XB_TOP], 1u);
            const unsigned tg = og / nx;
            if (og + 1u == (tg + 1u) * nx) xb_add(&bar[XB_TOPGEN], 1u);
            else XB_SPIN(xb_ld(&bar[XB_TOPGEN]) == tg, bar);
            __builtin_amdgcn_fence(__ATOMIC_ACQUIRE, "agent");
            xb_add(&bar[XB_XGEN(bx_)], 1u);
            asm volatile("s_waitcnt vmcnt(0)" ::: "memory");
        } else {
            XB_SPIN(xb_ld(&bar[XB_XGEN(bx_)]) == gen, bar);
            __builtin_amdgcn_fence(__ATOMIC_ACQUIRE, "agent");
            asm volatile("s_waitcnt vmcnt(0)" ::: "memory");
        }
    }
    __syncthreads();
}

struct Frame {
    LAS unsigned char* lds;
    volatile LAS unsigned* MISC;
    gu32* ctl;
    int tid, lane, wave;
    int vcu, G;
    int gw, NGW;
    unsigned char* ws;
    const float* const* in; float* out;
};

__device__ __forceinline__ float wave_sum(float v) {
#pragma unroll
    for (int o = 1; o < 64; o <<= 1) v += __shfl_xor(v, o);
    return v;
}
__device__ __forceinline__ float wave_max(float v) {
#pragma unroll
    for (int o = 1; o < 64; o <<= 1) v = fmaxf(v, __shfl_xor(v, o));
    return v;
}

__device__ __forceinline__ void p0_transpose_item(const float* W, const float* gain, int K, int N, bf16* WT, LAS float* scr, int item, int lane) {
    const int nblk = N / 32, kb = item / nblk, nb = item % nblk, k0 = 64 * kb, n0 = 32 * nb;
    const int kr = lane >> 3, nq = lane & 7;
    f32x4 v[8]; float gs[8];
#pragma unroll
    for (int i = 0; i < 8; ++i) { v[i] = *(const GAS f32x4*)(W + (size_t)(k0 + 8 * i + kr) * N + n0 + 4 * nq); gs[i] = gain ? gain[k0 + 8 * i + kr] : 1.0f; }
#pragma unroll
    for (int i = 0; i < 8; ++i) { LAS float* d = scr + (8 * i + kr) * 33 + 4 * nq; d[0] = v[i].x * gs[i]; d[1] = v[i].y * gs[i]; d[2] = v[i].z * gs[i]; d[3] = v[i].w * gs[i]; }
    LDS_WAIT(); asm volatile("" ::: "memory");
    const int c = lane & 7;
#pragma unroll
    for (int j = 0; j < 4; ++j) { const int n = (lane >> 3) + 8 * j; const LAS float* s = scr + (8 * c) * 33 + n;
        v4u o; o.x = pk2(s[0 * 33], s[1 * 33]); o.y = pk2(s[2 * 33], s[3 * 33]); o.z = pk2(s[4 * 33], s[5 * 33]); o.w = pk2(s[6 * 33], s[7 * 33]);
        *(GAS v4u*)(WT + (size_t)(n0 + n) * K + k0 + 8 * c) = o; }
    LDS_WAIT(); asm volatile("" ::: "memory");
}

__device__ __forceinline__ void convert_weights(Frame& F, int l, bool with_down) {
    LAS float* scr = (LAS float*)(F.lds + RING_OFF + F.wave * 16384);
    unsigned char* wb = F.ws + WS_W;
    const float* w_in = F.in[1] + (size_t)l * D * NIN; const float* w_b = F.in[5] + (size_t)l * AO * D; const float* w_o = F.in[6] + (size_t)l * D * D;
    const float* w_up = F.in[9] + (size_t)l * D * NUP; const float* n1 = F.in[7] + (size_t)l * D; const float* n2 = F.in[8] + (size_t)l * D;
    constexpr int I_IN = (D / 64) * (NIN / 32), I_B = (AO / 64) * (D / 32), I_O = (D / 64) * (D / 32), I_UP = (D / 64) * (NUP / 32), I_DN = (DFF / 64) * (D / 32);
    const int nitems = I_IN + I_B + I_O + I_UP + (with_down ? 2 * I_DN : 0);
    for (int it = F.gw; it < nitems; it += F.NGW) {
        int r = it;
        if (r < I_IN) { p0_transpose_item(w_in, n1, D, NIN, (bf16*)(wb + WO_WIN), scr, r, F.lane); continue; } r -= I_IN;
        if (r < I_B) { p0_transpose_item(w_b, nullptr, AO, D, (bf16*)(wb + WO_WB), scr, r, F.lane); continue; } r -= I_B;
        if (r < I_O) { p0_transpose_item(w_o, nullptr, D, D, (bf16*)(wb + WO_WO), scr, r, F.lane); continue; } r -= I_O;
        if (r < I_UP) { p0_transpose_item(w_up, n2, D, NUP, (bf16*)(wb + WO_WUP), scr, r, F.lane); continue; } r -= I_UP;
        const int ll = r / I_DN; r -= ll * I_DN;
        p0_transpose_item(F.in[12] + (size_t)ll * DFF * D, nullptr, DFF, D, (bf16*)(wb + WO_WDN + ll * WDN_BYTES), scr, r, F.lane);
    }
    const float* w_pool = F.in[2] + (size_t)l * 4 * 256 * 256; const float* ps = F.in[3] + (size_t)l * D; const float* w_a = F.in[4] + (size_t)l * D * D;
    bf16* Wc = (bf16*)(wb + WO_WC);
    LAS float* As = (LAS float*)(F.lds + RING_OFF);
    LAS float* Bs = (LAS float*)(F.lds + RING_OFF + 64 * 129 * 4);
    __syncthreads();
    for (int tile = F.vcu; tile < 4 * 4 * 16; tile += F.G) {
        const int g = tile >> 6, cb = (tile >> 4) & 3, nb = tile & 15, c0 = cb * 64, n0 = nb * 64;
        float acc[8];
#pragma unroll
        for (int e = 0; e < 8; ++e) acc[e] = 0.f;
        for (int dc = 0; dc < 2; ++dc) {
            const int d0 = dc * 128;
            for (int i = F.tid; i < 64 * 128; i += NWAVES * 64) { const int c = i >> 7, d = i & 127; As[c * 129 + d] = w_pool[((size_t)g * 256 + c0 + c) * 256 + d0 + d] * ps[g * 256 + d0 + d]; }
            for (int i = F.tid; i < 128 * 64; i += NWAVES * 64) { const int d = i >> 6, n = i & 63; Bs[d * 65 + n] = w_a[(size_t)(g * 256 + d0 + d) * D + n0 + n]; }
            __syncthreads();
            const LAS float* ap = As + (F.wave * 8) * 129; const LAS float* bp = Bs + F.lane;
#pragma unroll 4
            for (int d = 0; d < 128; ++d) { const float bv = bp[d * 65];
#pragma unroll
                for (int e = 0; e < 8; ++e) acc[e] += ap[e * 129 + d] * bv; }
            __syncthreads();
        }
        v4u o; o.x = pk2(acc[0], acc[1]); o.y = pk2(acc[2], acc[3]); o.z = pk2(acc[4], acc[5]); o.w = pk2(acc[6], acc[7]);
        *(GAS v4u*)(Wc + (size_t)(n0 + F.lane) * D + g * 256 + c0 + F.wave * 8) = o;
    }
}

__device__ __forceinline__ void p0_x_rows(Frame& F) {
    const float* x = F.in[0]; bf16* hb = (bf16*)(F.ws + WS_HB); float* part = (float*)(F.ws + WS_PART);
    for (int m = F.gw; m < M; m += F.NGW) {
        const GAS f32x4* xr = (const GAS f32x4*)(x + (size_t)m * D) + F.lane;
        f32x4 v[4]; float s = 0.f;
#pragma unroll
        for (int j = 0; j < 4; ++j) { v[j] = xr[64 * j]; s += (v[j].x * v[j].x + v[j].y * v[j].y) + (v[j].z * v[j].z + v[j].w * v[j].w); }
        s = wave_sum(s);
        GAS unsigned long long* o8 = (GAS unsigned long long*)(hb + (size_t)m * D) + F.lane;
#pragma unroll
        for (int j = 0; j < 4; ++j) o8[64 * j] = (unsigned long long)pk2(v[j].x, v[j].y) | ((unsigned long long)pk2(v[j].z, v[j].w) << 32);
        if (F.lane < 16) part[(size_t)F.lane * M + m] = (F.lane == 0) ? s : 0.f;
    }
}

__device__ __forceinline__ int t5_bucket(int rel) {
    const int ret = rel > 0 ? 16 : 0; const int n = rel < 0 ? -rel : rel;
    int b;
    if (n < 8) b = n; else if (n < 15) b = 8; else if (n < 27) b = 9; else if (n < 50) b = 10; else if (n < 91) b = 11; else if (n < 166) b = 12; else if (n < 305) b = 13; else if (n < 559) b = 14; else b = 15;
    return ret + b;
}

__device__ __forceinline__ void attn_simple(Frame& F) {
    bf16* Q = (bf16*)(F.ws + WS_Y + Y_Q); const bf16* Kb = (const bf16*)(F.ws + WS_Y + Y_K); const bf16* V = (const bf16*)(F.ws + WS_Y + Y_V);
    const float* rel_bias = F.in[13];
    LAS float* qs = (LAS float*)(F.lds + RING_OFF + F.wave * 2048);
    const int lane = F.lane; const float scale = 0.08838834764831845f;
    for (int item = F.gw; item < M * 4; item += F.NGW) {
        const int tok = item >> 2, h = item & 3, b = tok >> 11, s = tok & (S - 1);
#pragma unroll
        for (int g = 0; g < 3; ++g) { const unsigned w = *(const GAS unsigned*)(Q + (size_t)tok * AW + (g * 4 + h) * HD + 2 * lane); qs[g * 128 + 2 * lane] = bflo(w); qs[g * 128 + 2 * lane + 1] = bfhi(w); }
        LDS_WAIT(); asm volatile("" ::: "memory");
        float mrun = -1e30f, lrun = 0.f, o0 = 0.f, o1 = 0.f;
#pragma unroll 1
        for (int g = 0; g < 3; ++g) {
            const int dl = 1 << (2 * g), head = g * 4 + h;
            float sc[3];
#pragma unroll
            for (int p = 0; p < 3; ++p) {
                const int jj = lane + 64 * p, j = jj - 64, pos = s + dl * j;
                const bool valid = (jj <= 128) && pos >= 0 && pos < S;
                float dot = 0.f;
                if (valid) {
                    const bf16* krow = Kb + ((size_t)b * S + pos) * AW + head * HD;
#pragma unroll 4
                    for (int c = 0; c < 16; ++c) { const v4u kv = *(const GAS v4u*)(krow + 8 * c); const LAS float* qq = qs + g * 128 + 8 * c;
                        dot += bflo(kv.x) * qq[0] + bfhi(kv.x) * qq[1] + bflo(kv.y) * qq[2] + bfhi(kv.y) * qq[3] + bflo(kv.z) * qq[4] + bfhi(kv.z) * qq[5] + bflo(kv.w) * qq[6] + bfhi(kv.w) * qq[7]; }
                }
                const float bias = (jj <= 128) ? rel_bias[t5_bucket(dl * j) * 12 + head] : 0.f;
                sc[p] = valid ? dot * scale + bias : -1e30f;
            }
            const float gmax = wave_max(fmaxf(fmaxf(sc[0], sc[1]), sc[2]));
            const float mnew = fmaxf(mrun, gmax);
            const float alpha = __expf(mrun - mnew);
            float pr[3];
#pragma unroll
            for (int p = 0; p < 3; ++p) pr[p] = (sc[p] > -1e29f) ? __expf(sc[p] - mnew) : 0.f;
            const float psum = wave_sum(pr[0] + pr[1] + pr[2]);
            lrun = lrun * alpha + psum; o0 *= alpha; o1 *= alpha; mrun = mnew;
#pragma unroll 1
            for (int jj = 0; jj <= 128; ++jj) {
                const int pos = s + dl * (jj - 64);
                if (pos < 0 || pos >= S) continue;
                const float pj = __shfl(jj < 64 ? pr[0] : (jj < 128 ? pr[1] : pr[2]), jj & 63);
                const unsigned w = *(const GAS unsigned*)(V + ((size_t)b * S + pos) * AW + head * HD + 2 * lane);
                o0 += pj * bflo(w); o1 += pj * bfhi(w);
            }
        }
        const float inv = 1.0f / lrun;
        *(GAS unsigned*)(Q + (size_t)tok * AW + h * HD + 2 * lane) = pk2(o0 * inv, o1 * inv);
        LDS_WAIT(); asm volatile("" ::: "memory");
    }
}

namespace att {
typedef short bf16x8 __attribute__((ext_vector_type(8)));
typedef short s16x4 __attribute__((ext_vector_type(4)));
typedef float f32x16 __attribute__((ext_vector_type(16)));
__device__ __forceinline__ unsigned off_b(unsigned row, unsigned ch) { return 256u * row + 16u * (ch ^ (((row & 3u) << 2) | ((row >> 2) & 3u))); }
__device__ __forceinline__ s16x4 vtr(const LAS unsigned char* p) { return __builtin_bit_cast(s16x4, __builtin_amdgcn_ds_read_tr16_b64_v4i16((LAS s16x4*)p)); }
constexpr int N_UNITS = BATCH * 3 * 2 * 16;
constexpr int BIAS_OFF = RING_BYTES + 2048;
}
__device__ __forceinline__ void attn_mfma(Frame& F) {
    using namespace att;
    bf16* Q = (bf16*)(F.ws + WS_Y + Y_Q); const bf16* Kg = (const bf16*)(F.ws + WS_Y + Y_K); const bf16* Vg = (const bf16*)(F.ws + WS_Y + Y_V);
    float* LSE = (float*)(F.ws + WS_LSE); const float* rel_bias = F.in[13];
    const int lane = F.lane, wave = F.wave, half = wave >> 2, j = wave & 3, ql = lane & 31, hh = lane >> 5, th = F.tid & 255;
    const float LOG2E = 1.4426950408889634f, CS = 0.08838834764831845f * 1.4426950408889634f;
    LAS unsigned char* hb = F.lds + RING_OFF + half * 65536;
    LAS float* bt = (LAS float*)(F.lds + BIAS_OFF + half * 1024);
    const int nper = (N_UNITS + F.G - 1) / F.G;
    const int u_lo = F.vcu * nper, u_hi = (u_lo + nper < N_UNITS) ? u_lo + nper : N_UNITS;
#pragma unroll 1
    for (int u = u_lo; u < u_hi; ++u) {
        const int t16 = u & 15, rest = u >> 4, hp = rest & 1, g = (rest >> 1) % 3, b = rest / 6;
        const int sh = 2 * g, dl = 1 << sh, L = S >> sh;
        const int r = (g == 0) ? 0 : (g == 1 ? (t16 >> 2) : t16), mt = (g == 0) ? t16 : (g == 1 ? (t16 & 3) : 0), m0 = mt * 128;
        const int hl = hp * 2 + half, hd = g * 4 + hl;
        const size_t tokbase = (size_t)b * S + r;
        { const int jrel = th - 128; float v = -1e30f; if (jrel >= -64 && jrel <= 64) v = rel_bias[t5_bucket(dl * jrel) * 12 + hd] * LOG2E; bt[th] = v; }
        const int mq = m0 + 32 * j + ql;
        bf16* qrow = Q + (tokbase + (size_t)dl * mq) * AW + hd * HD;
        bf16x8 qf[8];
#pragma unroll
        for (int s2 = 0; s2 < 8; ++s2) qf[s2] = *(const GAS bf16x8*)(qrow + 16 * s2 + 8 * hh);
        const int kb_lo = (m0 == 0) ? 1 : 0; int kb_hi = (L - 1 - m0 + 64) >> 6; kb_hi = kb_hi > 3 ? 3 : kb_hi;
        v4u kreg[4], vreg[4];
        const int srow = th >> 4, sch = th & 15;
#define ATT_STAGE_LOAD(kb_) do { _Pragma("unroll") for (int i = 0; i < 4; ++i) { const int mk = m0 - 64 + 64 * (kb_) + srow + 16 * i; \
                const size_t off = (tokbase + (size_t)dl * mk) * AW + hd * HD + sch * 8; \
                kreg[i] = *(const GAS v4u*)(Kg + off); vreg[i] = *(const GAS v4u*)(Vg + off); } } while (0)
#define ATT_STAGE_WRITE(buf_) do { _Pragma("unroll") for (int i = 0; i < 4; ++i) { const unsigned o = off_b((unsigned)(srow + 16 * i), (unsigned)sch); \
                *(LAS v4u*)(hb + (buf_) * 16384 + o) = kreg[i]; *(LAS v4u*)(hb + 32768 + (buf_) * 16384 + o) = vreg[i]; } } while (0)
        float m_run = -1e20f, l_run = 0.f;
        f32x16 O[4];
#pragma unroll
        for (int c = 0; c < 4; ++c)
#pragma unroll
            for (int i = 0; i < 16; ++i) O[c][i] = 0.f;
        ATT_STAGE_LOAD(kb_lo); ATT_STAGE_WRITE(0);
        __syncthreads();
#pragma unroll 1
        for (int kb = kb_lo; kb <= kb_hi; ++kb) {
            const int cur = (kb - kb_lo) & 1;
            if (kb < kb_hi) ATT_STAGE_LOAD(kb + 1);
            if (kb >= (j >> 1) && kb <= (j >> 1) + 2) {
                const LAS unsigned char* kbuf = hb + cur * 16384; const LAS unsigned char* vbuf = hb + 32768 + cur * 16384;
                f32x16 s0, s1;
#pragma unroll
                for (int i = 0; i < 16; ++i) { s0[i] = 0.f; s1[i] = 0.f; }
#pragma unroll
                for (int s2 = 0; s2 < 8; ++s2) {
                    const bf16x8 a0 = *(const LAS bf16x8*)(kbuf + off_b((unsigned)ql, (unsigned)(2 * s2 + hh)));
                    const bf16x8 a1 = *(const LAS bf16x8*)(kbuf + off_b((unsigned)(32 + ql), (unsigned)(2 * s2 + hh)));
                    s0 = __builtin_amdgcn_mfma_f32_32x32x16_bf16(a0, qf[s2], s0, 0, 0, 0);
                    s1 = __builtin_amdgcn_mfma_f32_32x32x16_bf16(a1, qf[s2], s1, 0, 0, 0);
                }
                const LAS float* btl = bt + (64 * kb + 64 - 32 * j - ql + 4 * hh);
                float bmax = -1e30f;
#pragma unroll
                for (int i = 0; i < 16; ++i) {
                    const int kr = (i & 3) + 8 * (i >> 2);
                    s0[i] = fmaf(s0[i], CS, btl[kr]); s1[i] = fmaf(s1[i], CS, btl[32 + kr]);
                    bmax = fmaxf(bmax, fmaxf(s0[i], s1[i]));
                }
                bmax = fmaxf(bmax, __shfl_xor(bmax, 32));
                if (__any(bmax > m_run + 8.0f)) {
                    const float m_new = fmaxf(m_run, bmax), alpha = __builtin_amdgcn_exp2f(m_run - m_new);
                    m_run = m_new; l_run *= alpha;
#pragma unroll
                    for (int c = 0; c < 4; ++c)
#pragma unroll
                        for (int i = 0; i < 16; ++i) O[c][i] *= alpha;
                }
                float psum = 0.f;
#pragma unroll
                for (int i = 0; i < 16; ++i) { s0[i] = __builtin_amdgcn_exp2f(s0[i] - m_run); s1[i] = __builtin_amdgcn_exp2f(s1[i] - m_run); psum += s0[i] + s1[i]; }
                l_run += psum;
                v4u pk[4];
#pragma unroll
                for (int s2 = 0; s2 < 2; ++s2) {
                    pk[s2].x = pg8::cvt_pk_bf16(s0[8 * s2 + 0], s0[8 * s2 + 1]); pk[s2].y = pg8::cvt_pk_bf16(s0[8 * s2 + 2], s0[8 * s2 + 3]);
                    pk[s2].z = pg8::cvt_pk_bf16(s0[8 * s2 + 4], s0[8 * s2 + 5]); pk[s2].w = pg8::cvt_pk_bf16(s0[8 * s2 + 6], s0[8 * s2 + 7]);
                    pk[2 + s2].x = pg8::cvt_pk_bf16(s1[8 * s2 + 0], s1[8 * s2 + 1]); pk[2 + s2].y = pg8::cvt_pk_bf16(s1[8 * s2 + 2], s1[8 * s2 + 3]);
                    pk[2 + s2].z = pg8::cvt_pk_bf16(s1[8 * s2 + 4], s1[8 * s2 + 5]); pk[2 + s2].w = pg8::cvt_pk_bf16(s1[8 * s2 + 6], s1[8 * s2 + 7]);
                }
                const unsigned blk = (lane >> 4) & 1, tq = (lane & 15) >> 2, tp = lane & 3;
#pragma unroll
                for (int ks = 0; ks < 4; ++ks) {
                    const bf16x8 pb = __builtin_bit_cast(bf16x8, pk[ks]);
#pragma unroll
                    for (int c = 0; c < 4; ++c) {
                        const unsigned chn = 4 * c + 2 * blk + (tp >> 1);
                        const s16x4 lo = vtr(vbuf + off_b(16 * ks + 4 * hh + tq, chn) + 8 * (tp & 1));
                        const s16x4 hi = vtr(vbuf + off_b(16 * ks + 8 + 4 * hh + tq, chn) + 8 * (tp & 1));
                        const bf16x8 va = {lo[0], lo[1], lo[2], lo[3], hi[0], hi[1], hi[2], hi[3]};
                        O[c] = __builtin_amdgcn_mfma_f32_32x32x16_bf16(va, pb, O[c], 0, 0, 0);
                    }
                }
            }
            if (kb < kb_hi) ATT_STAGE_WRITE(cur ^ 1);
            __syncthreads();
        }
#undef ATT_STAGE_LOAD
#undef ATT_STAGE_WRITE
        const float l_tot = l_run + __shfl_xor(l_run, 32);
        const float inv = 1.0f / l_tot;
#pragma unroll
        for (int c = 0; c < 4; ++c)
#pragma unroll
            for (int i4 = 0; i4 < 4; ++i4) {
                v2u w; w.x = pg8::cvt_pk_bf16(O[c][4 * i4 + 0] * inv, O[c][4 * i4 + 1] * inv); w.y = pg8::cvt_pk_bf16(O[c][4 * i4 + 2] * inv, O[c][4 * i4 + 3] * inv);
                *(GAS v2u*)(qrow + 32 * c + 8 * i4 + 4 * hh) = w;
            }
        if (hh == 0) LSE[((size_t)g * M + tokbase + (size_t)dl * mq) * 4 + hl] = m_run + __log2f(l_tot);
    }
}

__device__ __forceinline__ void attn_combine(Frame& F) {
    bf16* Q = (bf16*)(F.ws + WS_Y + Y_Q); const float* LSE = (const float*)(F.ws + WS_LSE);
    const int total = M * 64;
    for (int it = F.gw * 64 + F.lane; it < total; it += F.NGW * 64) {
        const int tok = it >> 6, h = (it >> 4) & 3, ch = it & 15;
        const float l0 = LSE[((size_t)0 * M + tok) * 4 + h], l1 = LSE[((size_t)1 * M + tok) * 4 + h], l2 = LSE[((size_t)2 * M + tok) * 4 + h];
        const float mx = fmaxf(l0, fmaxf(l1, l2));
        float w0 = __builtin_amdgcn_exp2f(l0 - mx), w1 = __builtin_amdgcn_exp2f(l1 - mx), w2 = __builtin_amdgcn_exp2f(l2 - mx);
        const float inv = 1.0f / (w0 + w1 + w2); w0 *= inv; w1 *= inv; w2 *= inv;
        bf16* p = Q + (size_t)tok * AW + h * HD + ch * 8;
        const v4u a = *(const GAS v4u*)(p), b2 = *(const GAS v4u*)(p + 512), c = *(const GAS v4u*)(p + 1024);
        v4u o;
        o.x = pk2(w0 * bflo(a.x) + w1 * bflo(b2.x) + w2 * bflo(c.x), w0 * bfhi(a.x) + w1 * bfhi(b2.x) + w2 * bfhi(c.x));
        o.y = pk2(w0 * bflo(a.y) + w1 * bflo(b2.y) + w2 * bflo(c.y), w0 * bfhi(a.y) + w1 * bfhi(b2.y) + w2 * bfhi(c.y));
        o.z = pk2(w0 * bflo(a.z) + w1 * bflo(b2.z) + w2 * bflo(c.z), w0 * bfhi(a.z) + w1 * bfhi(b2.z) + w2 * bfhi(c.z));
        o.w = pk2(w0 * bflo(a.w) + w1 * bflo(b2.w) + w2 * bflo(c.w), w0 * bfhi(a.w) + w1 * bfhi(b2.w) + w2 * bfhi(c.w));
        *(GAS v4u*)(p) = o;
    }
}

__device__ __forceinline__ void pool_simple(Frame& F) {
    const bf16* U = (const bf16*)(F.ws + WS_Y + Y_U); bf16* P = (bf16*)(F.ws + WS_Y + Y_K);
    const int total = M * (D / 8);
    for (int it = F.gw * 64 + F.lane; it < total; it += F.NGW * 64) {
        const int tok = it >> 7, ch = it & 127, s = tok & (S - 1), g = ch >> 5, w = 2 << g;
        int lo = s - (w >> 1), hi = lo + w; lo = lo < 0 ? 0 : lo; hi = hi > S ? S : hi;
        const bf16* base = U + (size_t)(tok - s) * D + ch * 8;
        float a[8];
#pragma unroll
        for (int e = 0; e < 8; ++e) a[e] = 0.f;
        for (int r = lo; r < hi; ++r) { const v4u v = *(const GAS v4u*)(base + (size_t)r * D);
            a[0] += bflo(v.x); a[1] += bfhi(v.x); a[2] += bflo(v.y); a[3] += bfhi(v.y); a[4] += bflo(v.z); a[5] += bfhi(v.z); a[6] += bflo(v.w); a[7] += bfhi(v.w); }
        const float inv = 1.0f / (float)(hi - lo);
        const v4u c = *(const GAS v4u*)(base + (size_t)s * D);
        v4u o; o.x = pk2(a[0] * inv - bflo(c.x), a[1] * inv - bfhi(c.x)); o.y = pk2(a[2] * inv - bflo(c.y), a[3] * inv - bfhi(c.y));
        o.z = pk2(a[4] * inv - bflo(c.z), a[5] * inv - bfhi(c.z)); o.w = pk2(a[6] * inv - bflo(c.w), a[7] * inv - bfhi(c.w));
        *(GAS v4u*)(P + (size_t)tok * D + ch * 8) = o;
    }
}

__device__ __forceinline__ void pool_slide(Frame& F) {
    const bf16* U = (const bf16*)(F.ws + WS_Y + Y_U); bf16* P = (bf16*)(F.ws + WS_Y + Y_K);
    constexpr int T = 16; constexpr int NIT = BATCH * 4 * (S / (2 * T));
    for (int it = F.gw; it < NIT; it += F.NGW) {
        const int seg2 = it & 63, g = (it >> 6) & 3, b = it >> 8;
        const int w = 2 << g, hw = w >> 1;
        const int t0 = (seg2 * 2 + (F.lane >> 5)) * T, ch = g * 32 + (F.lane & 31);
        const bf16* base = U + (size_t)b * S * D + ch * 8; bf16* obase = P + (size_t)b * S * D + ch * 8;
        float a[8];
#pragma unroll
        for (int e = 0; e < 8; ++e) a[e] = 0.f;
        { int lo = t0 - hw, hi = lo + w; lo = lo < 0 ? 0 : lo; hi = hi > S ? S : hi;
          for (int r = lo; r < hi; ++r) { const v4u v = *(const GAS v4u*)(base + (size_t)r * D);
              a[0] += bflo(v.x); a[1] += bfhi(v.x); a[2] += bflo(v.y); a[3] += bfhi(v.y); a[4] += bflo(v.z); a[5] += bfhi(v.z); a[6] += bflo(v.w); a[7] += bfhi(v.w); } }
#pragma unroll 4
        for (int i = 0; i < T; ++i) {
            const int t = t0 + i;
            int lo = t - hw, hi = lo + w; lo = lo < 0 ? 0 : lo; hi = hi > S ? S : hi;
            const float inv = 1.0f / (float)(hi - lo);
            const v4u c = *(const GAS v4u*)(base + (size_t)t * D);
            v4u o; o.x = pk2(a[0] * inv - bflo(c.x), a[1] * inv - bfhi(c.x)); o.y = pk2(a[2] * inv - bflo(c.y), a[3] * inv - bfhi(c.y));
            o.z = pk2(a[4] * inv - bflo(c.z), a[5] * inv - bfhi(c.z)); o.w = pk2(a[6] * inv - bflo(c.w), a[7] * inv - bfhi(c.w));
            *(GAS v4u*)(obase + (size_t)t * D) = o;
            const int re = t + hw, rl = t - hw;
            if (re < S) { const v4u v = *(const GAS v4u*)(base + (size_t)re * D);
                a[0] += bflo(v.x); a[1] += bfhi(v.x); a[2] += bflo(v.y); a[3] += bfhi(v.y); a[4] += bflo(v.z); a[5] += bfhi(v.z); a[6] += bflo(v.w); a[7] += bfhi(v.w); }
            if (rl >= 0) { const v4u v = *(const GAS v4u*)(base + (size_t)rl * D);
                a[0] -= bflo(v.x); a[1] -= bfhi(v.x); a[2] -= bflo(v.y); a[3] -= bfhi(v.y); a[4] -= bflo(v.z); a[5] -= bfhi(v.z); a[6] -= bflo(v.w); a[7] -= bfhi(v.w); }
        }
    }
}

__device__ __forceinline__ float gelu_tanh(float x) {
    const float y = 0.7978845608028654f * (x + 0.044715f * x * x * x);
    const float t = 1.0f - 2.0f / (__expf(2.0f * y) + 1.0f);
    return 0.5f * x * (1.0f + t);
}
__device__ __forceinline__ void conv_simple(Frame& F, int l) {
    bf16* AG = (bf16*)(F.ws + WS_Y);
    const float* cw = F.in[10] + (size_t)l * 3 * DFF; const float* cb = F.in[11] + (size_t)l * DFF;
    constexpr int CH = DFF / 8; const int total = M * CH;
    for (int it = F.gw * 64 + F.lane; it < total; it += F.NGW * 64) {
        const int tok = it / CH, ch = it - tok * CH, s = tok & (S - 1), c0 = ch * 8;
        const bf16* ap = AG + (size_t)tok * NUP + c0;
        const v4u z = {0u, 0u, 0u, 0u};
        const v4u am = (s > 0) ? *(const GAS v4u*)(ap - NUP) : z;
        const v4u a0 = *(const GAS v4u*)(ap);
        const v4u ap1 = (s < S - 1) ? *(const GAS v4u*)(ap + NUP) : z;
        const v4u gv = *(const GAS v4u*)(ap + DFF);
        float xm[8] = {bflo(am.x), bfhi(am.x), bflo(am.y), bfhi(am.y), bflo(am.z), bfhi(am.z), bflo(am.w), bfhi(am.w)};
        float x0[8] = {bflo(a0.x), bfhi(a0.x), bflo(a0.y), bfhi(a0.y), bflo(a0.z), bfhi(a0.z), bflo(a0.w), bfhi(a0.w)};
        float xp[8] = {bflo(ap1.x), bfhi(ap1.x), bflo(ap1.y), bfhi(ap1.y), bflo(ap1.z), bfhi(ap1.z), bflo(ap1.w), bfhi(ap1.w)};
        float gg[8] = {bflo(gv.x), bfhi(gv.x), bflo(gv.y), bfhi(gv.y), bflo(gv.z), bfhi(gv.z), bflo(gv.w), bfhi(gv.w)};
        float r[8];
#pragma unroll
        for (int e = 0; e < 8; ++e) { const float v = cw[c0 + e] * xm[e] + cw[DFF + c0 + e] * x0[e] + cw[2 * DFF + c0 + e] * xp[e] + cb[c0 + e]; r[e] = gelu_tanh(v) * gg[e]; }
        v4u o; o.x = pk2(r[0], r[1]); o.y = pk2(r[2], r[3]); o.z = pk2(r[4], r[5]); o.w = pk2(r[6], r[7]);
        *(GAS v4u*)(AG + (size_t)tok * NUP + DFF + c0) = o;
    }
}

__device__ __forceinline__ void conv_slide(Frame& F, int l) {
    bf16* AG = (bf16*)(F.ws + WS_Y);
    const float* cw = F.in[10] + (size_t)l * 3 * DFF; const float* cb = F.in[11] + (size_t)l * DFF;
    constexpr int CH = DFF / 8, CW = (CH + 63) / 64, T = 16, NIT = CW * (M / T);
    const v4u z = {0u, 0u, 0u, 0u};
    for (int it = F.gw; it < NIT; it += F.NGW) {
        const int cwi = it % CW, run = it / CW, ch = cwi * 64 + F.lane;
        if (ch >= CH) continue;
        const int tok0 = run * T, s0 = tok0 & (S - 1), c0 = ch * 8;
        float w0[8], w1[8], w2[8], bb[8];
#pragma unroll
        for (int e = 0; e < 8; ++e) { w0[e] = cw[c0 + e]; w1[e] = cw[DFF + c0 + e]; w2[e] = cw[2 * DFF + c0 + e]; bb[e] = cb[c0 + e]; }
        bf16* ap = AG + (size_t)tok0 * NUP + c0;
        v4u am = (s0 > 0) ? *(const GAS v4u*)(ap - NUP) : z;
        v4u a0 = *(const GAS v4u*)(ap);
#pragma unroll 4
        for (int i = 0; i < T; ++i) {
            const v4u a1 = (s0 + i < S - 1) ? *(const GAS v4u*)(ap + (size_t)(i + 1) * NUP) : z;
            const v4u gv = *(const GAS v4u*)(ap + (size_t)i * NUP + DFF);
            const float xm[8] = {bflo(am.x), bfhi(am.x), bflo(am.y), bfhi(am.y), bflo(am.z), bfhi(am.z), bflo(am.w), bfhi(am.w)};
            const float x0[8] = {bflo(a0.x), bfhi(a0.x), bflo(a0.y), bfhi(a0.y), bflo(a0.z), bfhi(a0.z), bflo(a0.w), bfhi(a0.w)};
            const float xp[8] = {bflo(a1.x), bfhi(a1.x), bflo(a1.y), bfhi(a1.y), bflo(a1.z), bfhi(a1.z), bflo(a1.w), bfhi(a1.w)};
            const float gg[8] = {bflo(gv.x), bfhi(gv.x), bflo(gv.y), bfhi(gv.y), bflo(gv.z), bfhi(gv.z), bflo(gv.w), bfhi(gv.w)};
            float r[8];
#pragma unroll
            for (int e = 0; e < 8; ++e) { const float v = w0[e] * xm[e] + w1[e] * x0[e] + w2[e] * xp[e] + bb[e]; r[e] = gelu_tanh(v) * gg[e]; }
            v4u o; o.x = pk2(r[0], r[1]); o.y = pk2(r[2], r[3]); o.z = pk2(r[4], r[5]); o.w = pk2(r[6], r[7]);
            *(GAS v4u*)(ap + (size_t)i * NUP + DFF) = o;
            am = a0; a0 = a1;
        }
    }
}

__device__ __forceinline__ void final_norm(Frame& F) {
    const float* part = (const float*)(F.ws + WS_PART); const float* nf = F.in[14]; const bf16* hb = (const bf16*)(F.ws + WS_HB);
    for (int m = F.gw; m < M; m += F.NGW) {
        float s = 0.f;
#pragma unroll
        for (int t = 0; t < 16; ++t) s += part[(size_t)t * M + m];
        const float rstd = 1.0f / sqrtf(s * (1.0f / 1024.0f) + EPS);
        GAS f32x4* xr = (GAS f32x4*)(F.out + (size_t)m * D) + F.lane; const GAS f32x4* gr = (const GAS f32x4*)nf + F.lane; const GAS v2u* hr = (const GAS v2u*)(hb + (size_t)m * D) + F.lane;
#pragma unroll
        for (int j = 0; j < 4; ++j) { const v2u h = hr[64 * j]; const f32x4 gq = gr[64 * j]; f32x4 v = {bflo(h.x), bfhi(h.x), bflo(h.y), bfhi(h.y)}; xr[64 * j] = v * rstd * gq; }
    }
}

struct Args { const float* in[15]; float* out; unsigned char* ws; int ph_lo, ph_hi; int pad0, pad1; };

struct CfgP1 { static constexpr int st1 = 4, st2 = 10, st3 = 16, ld0 = D, ld1 = AW; static constexpr long off1 = (long)(Y_Q - Y_U), off2 = (long)(Y_K - Y_U), off3 = (long)(Y_V - Y_U); };
struct CfgGate { static constexpr int st1 = 4, st2 = 1 << 20, st3 = 1 << 20, ld0 = D, ld1 = D; static constexpr long off1 = (long)Y_U - (long)Y_V, off2 = 0, off3 = 0; };
struct CfgOne { static constexpr int st1 = 1 << 20, st2 = 1 << 20, st3 = 1 << 20, ld0 = D, ld1 = D; static constexpr long off1 = 0, off2 = 0, off3 = 0; };
struct CfgUp { static constexpr int st1 = 1 << 20, st2 = 1 << 20, st3 = 1 << 20, ld0 = NUP, ld1 = NUP; static constexpr long off1 = 0, off2 = 0, off3 = 0; };
template <int MODE, class CFG, int GN, int GK, int GLDA> __device__ __forceinline__ void run_gemm_b(Frame& F, const bf16* A, const bf16* Bt, bf16* O, const bf16* X1, const bf16* X2) {
    pg8::EpiB<MODE, CFG> E; E.O = O; E.part = (const float*)(F.ws + WS_PART); E.X1 = X1; E.X2 = X2;
    pg8::gemm_phase<pg8::EpiB<MODE, CFG>, GN, GK, GLDA, PG8_ALIGN, PG8_SP2>(F.lds + RING_OFF, A, Bt, F.G, (int)blockIdx.x, E);
}
template <int GK, int GLDA> __device__ __forceinline__ void run_gemm_r(Frame& F, const bf16* A, const bf16* Bt) {
    pg8::EpiRes E{(bf16*)(F.ws + WS_HB), (float*)(F.ws + WS_PART), M};
    pg8::gemm_phase<pg8::EpiRes, D, GK, GLDA, PG8_ALIGN, PG8_SP2>(F.lds + RING_OFF, A, Bt, F.G, (int)blockIdx.x, E);
}

struct P3Prog {
    unsigned char* ws; int G, c;
    __device__ __forceinline__ bool get(int i, pg8::UnitD& u) const {
        const int it = i >> 2, sub = i & 3; const int Lw = it * G + c; if (Lw >= 256) return false;
        const int wgid = (Lw & 7) * 32 + (Lw >> 3);
        const int pm = (wgid >> 5) * 8 + (wgid & 7), pn = (wgid & 31) >> 3;
        u.pm = pm; u.pn = pn; u.sub = sub;
        const unsigned char* A; const unsigned char* Bt; int K = D, lda = D;
        if (sub <= 1) { A = ws + WS_HB; Bt = ws + WS_W + WO_WIN + (size_t)(NUQKV + sub * D) * D * 2; }
        else if (sub == 2) { A = ws + WS_Y + Y_K; Bt = ws + WS_W + WO_WC; }
        else { A = ws + WS_Y + Y_Q; Bt = ws + WS_W + WO_WB; K = AO; lda = AW; }
        u.K = K; u.lda = lda; u.nt = K / 64;
        u.A = (const char*)A + (size_t)pm * 256 * lda * 2; u.Bt = (const char*)Bt + (size_t)pn * 256 * K * 2;
        return true;
    }
    __device__ __forceinline__ void epi(const pg8::f32x4 (&acc)[2][2][4][2], const pg8::UnitD& u, int wr, int wc, int fr, int fq) const {
        const int lane = fr + 16 * fq, col0 = u.pn * 256 + wc * 32 + 8 * fq;
        bf16* SGP = (bf16*)(ws + WS_Y + Y_V); bf16* SGA = (bf16*)(ws + WS_Y + Y_U); bf16* T1 = (bf16*)(ws + WS_Y + Y_Q) + 512; const float* part = (const float*)(ws + WS_PART);
        if (u.sub == 0) pg8::epi_bf16<1>(acc, u.pm, col0, wr, fr, lane, SGP, D, part, nullptr, 0, nullptr, 0);
        else if (u.sub == 1) pg8::epi_bf16<1>(acc, u.pm, col0, wr, fr, lane, SGA, D, part, nullptr, 0, nullptr, 0);
        else if (u.sub == 2) pg8::epi_bf16<2>(acc, u.pm, col0, wr, fr, lane, T1, AW, part, SGP, D, nullptr, 0);
        else pg8::epi_bf16<3>(acc, u.pm, col0, wr, fr, lane, SGP, D, part, T1, AW, SGA, D);
    }
};

#define IN(k) (lo <= (k) && (k) < hi)
#define SEAM(k) do { if (IN(k) && IN((k) + 1)) xcd_barrier(bar); } while (0)
template <int L> __device__ __forceinline__ void layer_phases(Frame& F, int lo, int hi, const XcdBarrier& bar) {
    constexpr int pb = 1 + 10 * L;
    unsigned char* ws = F.ws;
    bf16* HB = (bf16*)(ws + WS_HB);
    bf16* YU = (bf16*)(ws + WS_Y + Y_U); bf16* YQ = (bf16*)(ws + WS_Y + Y_Q); bf16* YK = (bf16*)(ws + WS_Y + Y_K); bf16* YV = (bf16*)(ws + WS_Y + Y_V);
    bf16* W_IN = (bf16*)(ws + WS_W + WO_WIN);
    if (IN(pb + 0)) { run_gemm_b<0, CfgP1, NUQKV, D, D>(F, HB, W_IN, YU, nullptr, nullptr); SEAM(pb + 0); }
#if defined(ATTN_ORACLE)
    if (IN(pb + 1)) { attn_simple(F); SEAM(pb + 1); }
#else
    if (IN(pb + 1)) { attn_mfma(F); SEAM(pb + 1); }
#endif
#if defined(ATTN_ORACLE)
    if (IN(pb + 2)) { pool_simple(F); SEAM(pb + 2); }
#else
    if (IN(pb + 2)) { attn_combine(F); pool_slide(F); SEAM(pb + 2); }
#endif
    if (IN(pb + 3)) { P3Prog P{F.ws, F.G, (int)blockIdx.x}; pg8::gemm_stream<P3Prog>(F.lds + RING_OFF, P); if (IN(pb + 6)) xcd_barrier(bar); }
    if (IN(pb + 6)) { run_gemm_r<D, D>(F, YV, (const bf16*)(ws + WS_W + WO_WO)); SEAM(pb + 6); }
    if (IN(pb + 7)) { run_gemm_b<0, CfgUp, NUP, D, D>(F, HB, (const bf16*)(ws + WS_W + WO_WUP), YU, nullptr, nullptr); SEAM(pb + 7); }
    if (IN(pb + 8)) { conv_slide(F, L); if (L + 1 < DEPTH) convert_weights(F, L + 1, false); SEAM(pb + 8); }
    if (IN(pb + 9)) { run_gemm_r<DFF, NUP>(F, YU + DFF, (const bf16*)(ws + WS_W + WO_WDN + L * WDN_BYTES)); SEAM(pb + 9); }
}
#undef IN
#undef SEAM

__global__ void __launch_bounds__(NWAVES * 64, 2) fwd_kernel(Args args) {
    extern __shared__ __attribute__((aligned(16))) unsigned char lds[];
    Frame F;
    F.lds = (LAS unsigned char*)lds;
    F.MISC = (volatile LAS unsigned*)(F.lds + MISC_OFF);
    F.tid = threadIdx.x; F.lane = F.tid & 63; F.wave = __builtin_amdgcn_readfirstlane(F.tid >> 6);
    F.G = gridDim.x; { const int bx = blockIdx.x; F.vcu = (F.G % 8 == 0) ? (bx % 8) * (F.G / 8) + bx / 8 : bx; }
    F.gw = F.vcu * NWAVES + F.wave; F.NGW = F.G * NWAVES;
    F.ws = args.ws; F.ctl = (gu32*)(args.ws + WS_CTL); F.out = args.out;
    F.in = args.in;
    for (int u = F.tid; u < (LDS_BYTES - LDSCTL_OFF) / 4; u += NWAVES * 64) ((LAS unsigned*)(F.lds + LDSCTL_OFF))[u] = 0u;
    __syncthreads();
    const int lo = args.ph_lo, hi = args.ph_hi;
    XcdBarrier bar; bar.bar = (unsigned*)(F.ctl + CW_BAR); bar.x = 0; bar.st = nullptr;
    if (hi - lo > 1) bar = xcd_barrier_post((unsigned*)(F.ctl + CW_BAR), F.MISC + 8);

#define IN(k) (lo <= (k) && (k) < hi)
#define SEAM(k) do { if (IN(k) && IN((k) + 1)) xcd_barrier(bar); } while (0)
    if (IN(0)) { convert_weights(F, 0, true); p0_x_rows(F); SEAM(0); }
    layer_phases<0>(F, lo, hi, bar);
    layer_phases<1>(F, lo, hi, bar);
    if (IN(N_PHASES - 1)) final_norm(F);
}
#undef IN
#undef SEAM

#ifdef DBG_STOP
__global__ void dbg_dump(const unsigned char* ws, float* out, size_t o0, size_t o1, size_t o2, size_t o3, int n_off, int is_f32) {
    const size_t n = (size_t)M * D;
    for (size_t i = (size_t)blockIdx.x * blockDim.x + threadIdx.x; i < n; i += (size_t)gridDim.x * blockDim.x) {
        float acc = 0.f; const size_t offs[4] = {o0, o1, o2, o3};
        for (int r = 0; r < n_off; ++r) { if (is_f32) acc += ((const float*)(ws + offs[r]))[i]; else acc += __uint_as_float((unsigned)((const unsigned short*)(ws + offs[r]))[i] << 16); }
        out[i] = acc;
    }
}
#endif
extern "C" void kernel_launch(void* const* d_in, const int* in_sizes, int n_in, void* d_out, int out_size, void* d_ws, size_t ws_size, hipStream_t stream) {
    static int grid = 0;
    if (grid == 0) {
        if (n_in != 15 || in_sizes[0] != M * D || out_size != M * D || ws_size < WS_END) { fprintf(stderr, "kernel_launch: unexpected problem shape (n_in %d, in0 %d, out %d, ws %zu); nothing launched\n", n_in, n_in > 0 ? in_sizes[0] : -1, out_size, ws_size); grid = -1; return; }
        int dev = 0, cus = 0, per_cu = 0;
        if (hipGetDevice(&dev) != hipSuccess || hipDeviceGetAttribute(&cus, hipDeviceAttributeMultiprocessorCount, dev) != hipSuccess) { grid = -1; return; }
        if (hipFuncSetAttribute((const void*)fwd_kernel, hipFuncAttributeMaxDynamicSharedMemorySize, LDS_BYTES) != hipSuccess) { fprintf(stderr, "kernel_launch: hipFuncSetAttribute failed\n"); grid = -1; return; }
        if (hipOccupancyMaxActiveBlocksPerMultiprocessor(&per_cu, (const void*)fwd_kernel, NWAVES * 64, LDS_BYTES) != hipSuccess || per_cu < 1) { fprintf(stderr, "kernel_launch: occupancy query reports %d blocks per CU\n", per_cu); (void)hipGetLastError(); grid = -1; return; }
        grid = cus;
    }
    if (grid < 0) return;
    (void)hipMemsetAsync((char*)d_ws + WS_CTL, 0, CTL_ZERO_BYTES, stream);
    Args a{};
    for (int i = 0; i < 15; ++i) a.in[i] = (const float*)d_in[i];
    a.out = (float*)d_out; a.ws = (unsigned char*)d_ws;
#if MK_N_LAUNCHES == 1
    a.ph_lo = 0; a.ph_hi = N_PHASES;
    hipLaunchKernelGGL(fwd_kernel, dim3(grid), dim3(NWAVES * 64), LDS_BYTES, stream, a);
#else
#ifdef DBG_STOP
    for (int p = 0; p <= DBG_STOP; ++p) { a.ph_lo = p; a.ph_hi = p + 1; hipLaunchKernelGGL(fwd_kernel, dim3(grid), dim3(NWAVES * 64), LDS_BYTES, stream, a); }
    { const size_t offs[4] = {DBG_OFFS}; hipLaunchKernelGGL(dbg_dump, dim3(2048), dim3(256), 0, stream, (const unsigned char*)d_ws, (float*)d_out, offs[0], offs[1], offs[2], offs[3], DBG_NOFF, DBG_F32); }
#else
    for (int p = 0; p < N_PHASES; ++p) { a.ph_lo = p; a.ph_hi = p + 1; hipLaunchKernelGGL(fwd_kernel, dim3(grid), dim3(NWAVES * 64), LDS_BYTES, stream, a); }
#endif
#endif
}
```

```cpp
#include <hip/hip_runtime.h>
#include <cstdio>
#include <cstdint>

#ifndef MK_N_LAUNCHES
#define MK_N_LAUNCHES 1
#endif

namespace pg8 {
#define PG8_LAS __attribute__((address_space(3)))
typedef unsigned short bf16_t;
typedef short bf16x8 __attribute__((ext_vector_type(8)));
typedef float f32x4 __attribute__((ext_vector_type(4)));
typedef unsigned u32x4 __attribute__((ext_vector_type(4)));
typedef unsigned u32x2 __attribute__((ext_vector_type(2)));
constexpr int BM = 256, BK = 64, HALF = 128, HTB = HALF * BK * 2  , STAGE_BYTES = 8 * HTB, NXCD = 8, WGM = 8;

__host__ __device__ __forceinline__ int lds_byte(int r, int c) { const int st = (r >> 4) * 2 + (c >> 5), rr = r & 15, cc = c & 31, ob = rr * 64 + cc * 2; return st * 1024 + (ob ^ (((ob >> 9) & 1) << 5)); }
__host__ __device__ __forceinline__ void stage_rc(int b, int& R, int& C) { const int st = b / 1024, sb = b % 1024, swz = sb ^ (((sb >> 9) & 1) << 5); R = (st >> 1) * 16 + swz / 64; C = (st & 1) * 32 + (swz % 64) / 2; }
__host__ __device__ __forceinline__ int perm32(int rho) { const int n = rho >> 4, i = rho & 15; return 8 * (i >> 2) + 4 * n + (i & 3); }

struct Unit { int pm, pn; };
struct Gemm { const bf16_t* A; const bf16_t* Bt; int M, N, K, lda; };

struct StaticOrder {
    int nM, nN, nwg, G, c;
    __host__ __device__ void init(int M, int N, int G_, int c_) { nM = M / BM; nN = N / BM; nwg = nM * nN; G = G_; c = c_; }
    __host__ __device__ bool next(int i, Unit& u) const {
        const long L = (long)i * G + c; if (L >= nwg) return false;
        int wgid = (int)L; { const int q = nwg / NXCD, r = nwg % NXCD, xcd = wgid % NXCD, off = wgid / NXCD; wgid = (xcd < r ? xcd * (q + 1) : r * (q + 1) + (xcd - r) * q) + off; }
        const int nig = WGM * nN, gid = wgid / nig, fm = gid * WGM, gsz = (nM - fm) < WGM ? (nM - fm) : WGM;
        u.pm = fm + ((wgid % nig) % gsz); u.pn = (wgid % nig) / gsz; return true;
    }
    __device__ __forceinline__ void a_ready(const Unit&) const {}
    __device__ __forceinline__ void done(const Unit&) const {}
};

typedef float f32x2_t __attribute__((ext_vector_type(2))); typedef __bf16 bf16x2_t __attribute__((ext_vector_type(2)));
__device__ __forceinline__ unsigned cvt_pk_bf16(float lo, float hi) { f32x2_t v = {lo, hi}; bf16x2_t b = __builtin_convertvector(v, bf16x2_t); return __builtin_bit_cast(unsigned, b); }
__device__ __forceinline__ float bf_lo(unsigned w) { return __uint_as_float(w << 16); }
__device__ __forceinline__ float bf_hi(unsigned w) { return __uint_as_float(w & 0xffff0000u); }

__device__ __forceinline__ void wave_rstd(const float* part, int Mrows, int rowbase, int lane, float eps, float (&rs)[2]) {
#pragma unroll
    for (int ai = 0; ai < 2; ++ai) { const float* p = part + rowbase + ai * HALF + lane; float s = 0.f;
#pragma unroll
        for (int t = 0; t < 16; ++t) s += p[(size_t)t * Mrows];
        rs[ai] = 1.0f / sqrtf(s * (1.0f / 1024.0f) + eps); }
}

template <int MODE, class CFG> struct EpiB {
    static constexpr bool PERM = true, APERM = false, AFTER_DRAIN = false;
    bf16_t* O;
    const float* part;
    const bf16_t* X1; const bf16_t* X2;
    static constexpr int Mrows = 16384, ldx = 1024; static constexpr float eps = 1e-6f;
    __device__ __forceinline__ void operator()(const f32x4 (&acc)[2][2][4][2], const Unit& u, int wr, int wc, int fr, int fq) const {
        const int lane = fr + 16 * fq;
        long boff = 0; int ldc = CFG::ld0, sst = 0;
        if (u.pn >= CFG::st1) { boff = CFG::off1; ldc = CFG::ld1; sst = CFG::st1; }
        if (u.pn >= CFG::st2) { boff = CFG::off2; sst = CFG::st2; }
        if (u.pn >= CFG::st3) { boff = CFG::off3; sst = CFG::st3; }
        bf16_t* base = (bf16_t*)((char*)O + boff);
        const int col0 = (u.pn - sst) * BM + wc * 32 + 8 * fq;
        const int row0 = u.pm * BM + wr * 64 + fr;
        float rs[2] = {1.f, 1.f};
        if (MODE <= 1) wave_rstd(part, Mrows, u.pm * BM + wr * 64, lane, eps, rs);
#pragma unroll
        for (int ai = 0; ai < 2; ++ai)
#pragma unroll
            for (int m = 0; m < 4; ++m) {
                const int row = row0 + ai * HALF + m * 16;
                float r = 1.f; if (MODE <= 1) r = __shfl(rs[ai], m * 16 + fr);
                bf16_t* rowp = base + (size_t)row * ldc + col0;
#pragma unroll
                for (int bj = 0; bj < 2; ++bj) {
                    f32x4 v0 = acc[ai][bj][m][0], v1 = acc[ai][bj][m][1];
                    if (MODE <= 1) { v0 = v0 * r; v1 = v1 * r; }
                    if (MODE == 1) {
#pragma unroll
                        for (int e = 0; e < 4; ++e) { v0[e] = __builtin_amdgcn_rcpf(1.0f + __expf(-v0[e])); v1[e] = __builtin_amdgcn_rcpf(1.0f + __expf(-v1[e])); }
                    }
                    if (MODE == 2) {
                        const u32x4 x = *(const u32x4*)(X1 + (size_t)row * ldx + col0 + bj * HALF);
                        v0[0] *= bf_lo(x.x); v0[1] *= bf_hi(x.x); v0[2] *= bf_lo(x.y); v0[3] *= bf_hi(x.y);
                        v1[0] *= bf_lo(x.z); v1[1] *= bf_hi(x.z); v1[2] *= bf_lo(x.w); v1[3] *= bf_hi(x.w);
                    }
                    if (MODE == 3) {
                        const u32x4 x = *(const u32x4*)(X1 + (size_t)row * ldx + col0 + bj * HALF);
                        const u32x4 y = *(const u32x4*)(X2 + (size_t)row * ldx + col0 + bj * HALF);
                        v0[0] = bf_lo(x.x) + v0[0] * bf_lo(y.x); v0[1] = bf_hi(x.x) + v0[1] * bf_hi(y.x); v0[2] = bf_lo(x.y) + v0[2] * bf_lo(y.y); v0[3] = bf_hi(x.y) + v0[3] * bf_hi(y.y);
                        v1[0] = bf_lo(x.z) + v1[0] * bf_lo(y.z); v1[1] = bf_hi(x.z) + v1[1] * bf_hi(y.z); v1[2] = bf_lo(x.w) + v1[2] * bf_lo(y.w); v1[3] = bf_hi(x.w) + v1[3] * bf_hi(y.w);
                    }
                    u32x4 w; w.x = cvt_pk_bf16(v0[0], v0[1]); w.y = cvt_pk_bf16(v0[2], v0[3]); w.z = cvt_pk_bf16(v1[0], v1[1]); w.w = cvt_pk_bf16(v1[2], v1[3]);
                    *(u32x4*)(rowp + bj * HALF) = w;
                }
                if (MODE >= 2) asm volatile("" ::: "memory");
            }
    }
};

struct EpiRes {
    static constexpr bool PERM = false, APERM = false, AFTER_DRAIN = false;
    bf16_t* hb; float* part; int Mrows;
    __device__ __forceinline__ void operator()(const f32x4 (&acc)[2][2][4][2], const Unit& u, int wr, int wc, int fr, int fq) const {
        const int col0 = u.pn * BM + wc * 32 + 4 * fq;
        bf16_t* p0 = hb + (size_t)(u.pm * BM + wr * 64 + fr) * 1024 + col0;
        u32x2 pre[2][4][2][2];
#pragma unroll
        for (int ai = 0; ai < 2; ++ai)
#pragma unroll
            for (int m = 0; m < 4; ++m)
#pragma unroll
                for (int bj = 0; bj < 2; ++bj)
#pragma unroll
                    for (int n = 0; n < 2; ++n) pre[ai][m][bj][n] = *(const u32x2*)(p0 + (size_t)(ai * HALF + m * 16) * 1024 + bj * HALF + n * 16);
#pragma unroll
        for (int ai = 0; ai < 2; ++ai)
#pragma unroll
            for (int m = 0; m < 4; ++m) {
                const int row = u.pm * BM + ai * HALF + wr * 64 + m * 16 + fr;
                float ss = 0.f;
#pragma unroll
                for (int bj = 0; bj < 2; ++bj)
#pragma unroll
                    for (int n = 0; n < 2; ++n) {
                        const u32x2 b = pre[ai][m][bj][n]; const f32x4 a = acc[ai][bj][m][n];
                        const float o0 = bf_lo(b.x) + a[0], o1 = bf_hi(b.x) + a[1], o2 = bf_lo(b.y) + a[2], o3 = bf_hi(b.y) + a[3];
                        u32x2 w; w.x = cvt_pk_bf16(o0, o1); w.y = cvt_pk_bf16(o2, o3);
                        *(u32x2*)(p0 + (size_t)(ai * HALF + m * 16) * 1024 + bj * HALF + n * 16) = w;
                        ss += (o0 * o0 + o1 * o1) + (o2 * o2 + o3 * o3);
                    }
                ss += __shfl_xor(ss, 16); ss += __shfl_xor(ss, 32);
                if (fq == 0) part[(size_t)(u.pn * 4 + wc) * Mrows + row] = ss;
            }
    }
};

struct EpiConv {
    static constexpr bool PERM = true, APERM = true, AFTER_DRAIN = false;
    bf16_t* ACT; const float* part; const float* cw; const float* cb; float* side; PG8_LAS float* xbuf;
    static constexpr int FF = 2816, SIDE_STRIDE = 64 * 2816;
    __device__ __forceinline__ void operator()(f32x4 (&acc)[2][2][4][2], const Unit& u, int wr, int wc, int fr, int fq) const {
        const int lane = fr + 16 * fq, c0 = u.pn * 128 + wc * 32 + 8 * fq;
        float rs[2]; wave_rstd(part, 16384, u.pm * BM + wr * 64, lane, 1e-6f, rs);
#pragma unroll
        for (int ai = 0; ai < 2; ++ai)
#pragma unroll
            for (int m = 0; m < 4; ++m) { const float r = __shfl(rs[ai], 4 * fr + m);
#pragma unroll
                for (int bj = 0; bj < 2; ++bj)
#pragma unroll
                    for (int n = 0; n < 2; ++n) acc[ai][bj][m][n] = acc[ai][bj][m][n] * r; }
        PG8_LAS float* xw = xbuf + (wr * 4 + wc) * 128 + fq * 8;
        if (fr == 0) {
#pragma unroll
            for (int ai = 0; ai < 2; ++ai) { *(PG8_LAS f32x4*)(xw + (ai * 2 + 0) * 32) = acc[ai][0][0][0]; *(PG8_LAS f32x4*)(xw + (ai * 2 + 0) * 32 + 4) = acc[ai][0][0][1]; } }
        if (fr == 15) {
#pragma unroll
            for (int ai = 0; ai < 2; ++ai) { *(PG8_LAS f32x4*)(xw + (ai * 2 + 1) * 32) = acc[ai][0][3][0]; *(PG8_LAS f32x4*)(xw + (ai * 2 + 1) * 32 + 4) = acc[ai][0][3][1]; } }
        asm volatile("s_waitcnt lgkmcnt(0)" ::: "memory"); __builtin_amdgcn_s_barrier(); asm volatile("" ::: "memory");
        const PG8_LAS float* xp = xbuf + ((wr ^ 1) * 4 + wc) * 128 + fq * 8;
        f32x4 w0[2], w1[2], w2[2], bb[2];
#pragma unroll
        for (int n = 0; n < 2; ++n) { w0[n] = *(const f32x4*)(cw + c0 + 4 * n); w1[n] = *(const f32x4*)(cw + FF + c0 + 4 * n); w2[n] = *(const f32x4*)(cw + 2 * FF + c0 + 4 * n); bb[n] = *(const f32x4*)(cb + c0 + 4 * n); }
        const bool seq_first = (u.pm & 7) == 0, seq_last = (u.pm & 7) == 7;
#pragma unroll
        for (int ai = 0; ai < 2; ++ai) {
            f32x4 xprev[2], xnext[2];
#pragma unroll
            for (int n = 0; n < 2; ++n) {
                const f32x4 z = {0.f, 0.f, 0.f, 0.f};
                const f32x4 pl_same = *(const PG8_LAS f32x4*)(xp + (ai * 2 + 1) * 32 + 4 * n);
                const f32x4 pl_low = *(const PG8_LAS f32x4*)(xp + (0 * 2 + 1) * 32 + 4 * n);
                const f32x4 pf_same = *(const PG8_LAS f32x4*)(xp + (ai * 2 + 0) * 32 + 4 * n);
                const f32x4 pf_high = *(const PG8_LAS f32x4*)(xp + (1 * 2 + 0) * 32 + 4 * n);
                xprev[n] = (wr == 1) ? pl_same : (ai == 1 ? pl_low : z);
                xnext[n] = (wr == 0) ? pf_same : (ai == 0 ? pf_high : z);
            }
            f32x4 up[2], dn[2];
#pragma unroll
            for (int n = 0; n < 2; ++n)
#pragma unroll
                for (int e = 0; e < 4; ++e) { up[n][e] = __shfl_up(acc[ai][0][3][n][e], 1, 16); dn[n][e] = __shfl_down(acc[ai][0][0][n][e], 1, 16);
                    if (fr == 0) up[n][e] = xprev[n][e]; if (fr == 15) dn[n][e] = xnext[n][e]; }
#pragma unroll
            for (int m = 0; m < 4; ++m) {
                const int tok = ai * HALF + wr * 64 + 4 * fr + m;
                u32x4 wout; unsigned wtmp[4];
#pragma unroll
                for (int n = 0; n < 2; ++n) {
                    const f32x4 a = acc[ai][0][m][n], g = acc[ai][1][m][n];
                    const f32x4 pv = (m == 0) ? up[n] : acc[ai][0][m == 0 ? 0 : m - 1][n];
                    const f32x4 nv = (m == 3) ? dn[n] : acc[ai][0][m == 3 ? 3 : m + 1][n];
                    f32x4 v = w0[n] * pv + w1[n] * a + w2[n] * nv + bb[n];
                    if (tok == 0 && !seq_first) {
                        float* sp = side + (size_t)u.pm * FF + c0 + 4 * n; *(f32x4*)(sp + 2 * SIDE_STRIDE) = v; *(f32x4*)(sp + 3 * SIDE_STRIDE) = g; }
                    if (tok == 255 && !seq_last) {
                        float* sp = side + (size_t)u.pm * FF + c0 + 4 * n; *(f32x4*)(sp + 4 * SIDE_STRIDE) = v; *(f32x4*)(sp + 5 * SIDE_STRIDE) = g; }
                    if (tok == 0) *(f32x4*)(side + (size_t)u.pm * FF + c0 + 4 * n) = a;
                    if (tok == 255) *(f32x4*)(side + SIDE_STRIDE + (size_t)u.pm * FF + c0 + 4 * n) = a;
                    float o[4];
#pragma unroll
                    for (int e = 0; e < 4; ++e) { const float x = v[e]; o[e] = x * __builtin_amdgcn_rcpf(1.0f + __builtin_amdgcn_exp2f(x * (-2.3022082f + -0.10294324f * x * x))) * g[e]; }
                    wtmp[2 * n] = cvt_pk_bf16(o[0], o[1]); wtmp[2 * n + 1] = cvt_pk_bf16(o[2], o[3]);
                }
                wout.x = wtmp[0]; wout.y = wtmp[1]; wout.z = wtmp[2]; wout.w = wtmp[3];
                *(u32x4*)(ACT + (size_t)(u.pm * BM + tok) * FF + c0) = wout;
            }
        }
    }
};

template <class Epi, int GN, int GK, int GLDA, bool ALIGN_EPI = false, bool SP2 = false>
__device__ __forceinline__ void gemm_phase(PG8_LAS unsigned char* lds, const bf16_t* gA, const bf16_t* gBt, int G_, int c_, const Epi& E) {
    struct { const bf16_t* A; const bf16_t* Bt; int K, lda; } g{gA, gBt, GK, GLDA};
    StaticOrder S; S.nM = 16384 / BM; S.nN = GN / BM; S.nwg = S.nM * S.nN; S.G = G_; S.c = c_;
    int tid_ = threadIdx.x; asm volatile("" : "+v"(tid_));
    const int tid = tid_, wid = __builtin_amdgcn_readfirstlane(tid >> 6), lane = tid & 63, wr = wid >> 2, wc = wid & 3, fr = lane & 15, fq = lane >> 4;
    const int K = g.K, nt = K / BK, lda = g.lda;
    unsigned voffA[2], voffB[2];
#pragma unroll
    for (int i = 0; i < 2; ++i) { int R, C; stage_rc(tid * 16 + i * 8192, R, C); const int Rb = Epi::PERM ? ((R & ~31) + perm32(R & 31)) : R;
        const int Ra = Epi::APERM ? ((R & 64) + 4 * (R & 15) + ((R >> 4) & 3)) : R;
        voffA[i] = (unsigned)(Ra * lda + C) * 2u; voffB[i] = (unsigned)(Rb * K + C) * 2u; }
    const size_t kstep = (size_t)(BK * 2);
    const size_t hstepA = (size_t)HALF * lda * 2, hstepB = (size_t)HALF * K * 2;
    const size_t tstepA = 2 * hstepA, tstepB = 2 * hstepB;
    const unsigned ldsw = (unsigned)wid * 1024u;
    const int aoff = lds_byte(wr * 64 + fr, fq * 8), boff = lds_byte(wc * 32 + fr, fq * 8);
#define PG8_SA(b, h) (((b) * 2 + (h)) * HTB)
#define PG8_SB(b, h) ((4 + (b) * 2 + (h)) * HTB)
#define PG8_STAGE(bufoff, gbase, voff) do { _Pragma("unroll") for (int _i = 0; _i < 2; ++_i) \
        __builtin_amdgcn_global_load_lds((const unsigned*)((const char*)(gbase) + (voff)[_i]), (PG8_LAS unsigned*)(lds + (bufoff) + ldsw + _i * 8192), 16, 0, 0); } while (0)
#define PG8_LDA(dst, b, h) do { _Pragma("unroll") for (int m = 0; m < 4; ++m) _Pragma("unroll") for (int k = 0; k < 2; ++k) dst[m][k] = *(const PG8_LAS bf16x8*)(lds + PG8_SA(b, h) + aoff + m * 2048 + k * 1024); } while (0)
#define PG8_LDB(dst, b, h) do { _Pragma("unroll") for (int n = 0; n < 2; ++n) _Pragma("unroll") for (int k = 0; k < 2; ++k) dst[n][k] = *(const PG8_LAS bf16x8*)(lds + PG8_SB(b, h) + boff + n * 2048 + k * 1024); } while (0)
#define PG8_MMA(ai, bj, At, Bt) do { __builtin_amdgcn_s_setprio(1); _Pragma("unroll") for (int m = 0; m < 4; ++m) _Pragma("unroll") for (int n = 0; n < 2; ++n) _Pragma("unroll") for (int k = 0; k < 2; ++k) \
        acc[ai][bj][m][n] = __builtin_amdgcn_mfma_f32_16x16x32_bf16(Bt[n][k], At[m][k], acc[ai][bj][m][n], 0, 0, 0); __builtin_amdgcn_s_setprio(0); } while (0)
#define PG8_WAIT_V(n) asm volatile("s_waitcnt vmcnt(" #n ")" ::: "memory")
#define PG8_WAIT_L(n) asm volatile("s_waitcnt lgkmcnt(" #n ")" ::: "memory")
#define PG8_BAR __builtin_amdgcn_s_barrier()
#define PG8_SCHED __builtin_amdgcn_sched_barrier(0)
    Unit cur, nxt; int ui = 0;
    if (!S.next(0, cur)) return;
    f32x4 acc[2][2][4][2];
#pragma unroll
    for (int a = 0; a < 2; ++a)
#pragma unroll
        for (int b = 0; b < 2; ++b)
#pragma unroll
            for (int m = 0; m < 4; ++m)
#pragma unroll
                for (int n = 0; n < 2; ++n) acc[a][b][m][n] = (f32x4){0.f, 0.f, 0.f, 0.f};
    bf16x8 At[4][2], B0[2][2], B1[2][2];
    const char* cA = (const char*)g.A + (size_t)cur.pm * tstepA; const char* cB = (const char*)g.Bt + (size_t)cur.pn * tstepB;
    S.a_ready(cur);
    if constexpr (SP2) {
        PG8_STAGE(PG8_SB(0, 0), cB, voffB); PG8_STAGE(PG8_SB(0, 1), cB + hstepB, voffB); PG8_STAGE(PG8_SA(0, 0), cA, voffA); PG8_STAGE(PG8_SA(0, 1), cA + hstepA, voffA);
        if (wr == 1) PG8_BAR;
        PG8_WAIT_V(2); PG8_BAR;
        PG8_STAGE(PG8_SB(1, 0), cB + kstep, voffB); PG8_STAGE(PG8_SA(1, 0), cA + kstep, voffA); PG8_STAGE(PG8_SB(1, 1), cB + hstepB + kstep, voffB);
        PG8_WAIT_V(6); PG8_BAR;
    } else {
        PG8_STAGE(PG8_SB(0, 0), cB, voffB); PG8_STAGE(PG8_SA(0, 0), cA, voffA); PG8_STAGE(PG8_SB(0, 1), cB + hstepB, voffB); PG8_STAGE(PG8_SA(0, 1), cA + hstepA, voffA);
        if (wr == 1) PG8_BAR;
        PG8_WAIT_V(4); PG8_BAR;
        PG8_STAGE(PG8_SB(1, 0), cB + kstep, voffB); PG8_STAGE(PG8_SA(1, 0), cA + kstep, voffA); PG8_STAGE(PG8_SB(1, 1), cB + hstepB + kstep, voffB);
        PG8_WAIT_V(6); PG8_BAR;
    }
    for (;;) {
        const bool has_next = S.next(ui + 1, nxt);
        const char* nA = has_next ? (const char*)g.A + (size_t)nxt.pm * tstepA : cA; const char* nB = has_next ? (const char*)g.Bt + (size_t)nxt.pn * tstepB : cB;
        for (int t = 0; t < nt; t += 2) {
            const bool last = (t == nt - 2);
            const char* a1 = cA + (size_t)(t + 1) * kstep;
            const char* a2 = last ? nA : cA + (size_t)(t + 2) * kstep; const char* b2 = last ? nB : cB + (size_t)(t + 2) * kstep;
            const char* a3 = a2 + kstep; const char* b3 = b2 + kstep;
            if (last && has_next) S.a_ready(nxt);
            if constexpr (SP2) {
            PG8_LDB(B0, 0, 0); PG8_LDB(B1, 0, 1); PG8_SCHED; PG8_LDA(At, 0, 0); PG8_STAGE(PG8_SA(1, 1), a1 + hstepA, voffA);
            PG8_WAIT_V(8); PG8_WAIT_L(0); PG8_BAR; PG8_MMA(0, 0, At, B0); PG8_MMA(0, 1, At, B1); PG8_BAR; PG8_SCHED;
            PG8_LDA(At, 0, 1); PG8_STAGE(PG8_SB(0, 0), b2, voffB); PG8_STAGE(PG8_SB(0, 1), b2 + hstepB, voffB); PG8_STAGE(PG8_SA(0, 0), a2, voffA);
            PG8_WAIT_V(8); PG8_WAIT_L(0); PG8_BAR; PG8_MMA(1, 0, At, B0); PG8_MMA(1, 1, At, B1); PG8_BAR; PG8_SCHED;
            PG8_LDB(B0, 1, 0); PG8_LDB(B1, 1, 1); PG8_SCHED; PG8_LDA(At, 1, 0); PG8_STAGE(PG8_SA(0, 1), a2 + hstepA, voffA);
            PG8_WAIT_V(8); PG8_WAIT_L(0); PG8_BAR; PG8_MMA(0, 0, At, B0); PG8_MMA(0, 1, At, B1); PG8_BAR; PG8_SCHED;
            PG8_LDA(At, 1, 1); PG8_STAGE(PG8_SB(1, 0), b3, voffB); PG8_STAGE(PG8_SB(1, 1), b3 + hstepB, voffB); PG8_STAGE(PG8_SA(1, 0), a3, voffA);
            PG8_WAIT_V(8); PG8_WAIT_L(0); PG8_BAR; PG8_MMA(1, 0, At, B0); PG8_MMA(1, 1, At, B1); PG8_BAR; PG8_SCHED;
            } else {
            PG8_LDB(B0, 0, 0); PG8_SCHED; PG8_LDA(At, 0, 0); PG8_STAGE(PG8_SA(1, 1), a1 + hstepA, voffA);
            PG8_WAIT_L(8); PG8_BAR; PG8_WAIT_L(0); PG8_MMA(0, 0, At, B0); PG8_BAR; PG8_SCHED;
            PG8_LDB(B1, 0, 1); PG8_STAGE(PG8_SB(0, 0), b2, voffB);
            PG8_BAR; PG8_WAIT_L(0); PG8_MMA(0, 1, At, B1); PG8_BAR;
            PG8_LDA(At, 0, 1); PG8_STAGE(PG8_SA(0, 0), a2, voffA);
            PG8_BAR; PG8_WAIT_L(0); PG8_MMA(1, 0, At, B0); PG8_BAR; PG8_SCHED;
            PG8_STAGE(PG8_SB(0, 1), b2 + hstepB, voffB);
            PG8_WAIT_V(6); PG8_BAR; PG8_MMA(1, 1, At, B1); PG8_BAR;
            PG8_LDB(B0, 1, 0); PG8_SCHED; PG8_LDA(At, 1, 0); PG8_STAGE(PG8_SA(0, 1), a2 + hstepA, voffA);
            PG8_WAIT_L(8); PG8_BAR; PG8_WAIT_L(0); PG8_MMA(0, 0, At, B0); PG8_BAR; PG8_SCHED;
            PG8_LDB(B1, 1, 1); PG8_STAGE(PG8_SB(1, 0), b3, voffB);
            PG8_BAR; PG8_WAIT_L(0); PG8_MMA(0, 1, At, B1); PG8_BAR;
            PG8_LDA(At, 1, 1); PG8_STAGE(PG8_SA(1, 0), a3, voffA);
            PG8_BAR; PG8_WAIT_L(0); PG8_MMA(1, 0, At, B0); PG8_BAR; PG8_SCHED;
            PG8_STAGE(PG8_SB(1, 1), b3 + hstepB, voffB);
            PG8_WAIT_V(6); PG8_BAR; PG8_MMA(1, 1, At, B1); PG8_BAR;
            }
        }
        if constexpr (ALIGN_EPI) { if (wr == 0) PG8_BAR; }
        if constexpr (!Epi::AFTER_DRAIN) { E(acc, cur, wr, wc, fr, fq); S.done(cur); }
        if (!has_next) break;
#pragma unroll
        for (int a = 0; a < 2; ++a)
#pragma unroll
            for (int b = 0; b < 2; ++b)
#pragma unroll
                for (int m = 0; m < 4; ++m)
#pragma unroll
                    for (int n = 0; n < 2; ++n) acc[a][b][m][n] = (f32x4){0.f, 0.f, 0.f, 0.f};
        cur = nxt; cA = nA; cB = nB; ++ui;
        if constexpr (ALIGN_EPI) { if (wr == 1) PG8_BAR; }
    }
    PG8_WAIT_V(0);
    if constexpr (!ALIGN_EPI) { if (wr == 0) PG8_BAR; }
    PG8_BAR;
#undef PG8_SA
#undef PG8_SB
#undef PG8_STAGE
#undef PG8_LDA
#undef PG8_LDB
#undef PG8_MMA
#undef PG8_WAIT_V
#undef PG8_WAIT_L
#undef PG8_BAR
#undef PG8_SCHED
}

struct UnitD { const char* A; const char* Bt; int nt, lda, K; int pm, pn, sub; };
template <class Prog>
__device__ __forceinline__ void gemm_stream(PG8_LAS unsigned char* lds, const Prog& P) {
    int tid_ = threadIdx.x; asm volatile("" : "+v"(tid_));
    const int tid = tid_, wid = __builtin_amdgcn_readfirstlane(tid >> 6), lane = tid & 63, wr = wid >> 2, wc = wid & 3, fr = lane & 15, fq = lane >> 4;
    int Rr[2], Cc[2], Rb[2];
#pragma unroll
    for (int i = 0; i < 2; ++i) { int R, C; stage_rc(tid * 16 + i * 8192, R, C); Rr[i] = R; Cc[i] = C; Rb[i] = (R & ~31) + perm32(R & 31); }
    const size_t kstep = (size_t)(BK * 2);
    const unsigned ldsw = (unsigned)wid * 1024u;
    const int aoff = lds_byte(wr * 64 + fr, fq * 8), boff = lds_byte(wc * 32 + fr, fq * 8);
#define PG8_SA(b, h) (((b) * 2 + (h)) * HTB)
#define PG8_SB(b, h) ((4 + (b) * 2 + (h)) * HTB)
#define PG8_STAGE(bufoff, gbase, voff) do { _Pragma("unroll") for (int _i = 0; _i < 2; ++_i) \
        __builtin_amdgcn_global_load_lds((const unsigned*)((const char*)(gbase) + (voff)[_i]), (PG8_LAS unsigned*)(lds + (bufoff) + ldsw + _i * 8192), 16, 0, 0); } while (0)
#define PG8_LDA(dst, b, h) do { _Pragma("unroll") for (int m = 0; m < 4; ++m) _Pragma("unroll") for (int k = 0; k < 2; ++k) dst[m][k] = *(const PG8_LAS bf16x8*)(lds + PG8_SA(b, h) + aoff + m * 2048 + k * 1024); } while (0)
#define PG8_LDB(dst, b, h) do { _Pragma("unroll") for (int n = 0; n < 2; ++n) _Pragma("unroll") for (int k = 0; k < 2; ++k) dst[n][k] = *(const PG8_LAS bf16x8*)(lds + PG8_SB(b, h) + boff + n * 2048 + k * 1024); } while (0)
#define PG8_MMA(ai, bj, At, Bt) do { __builtin_amdgcn_s_setprio(1); _Pragma("unroll") for (int m = 0; m < 4; ++m) _Pragma("unroll") for (int n = 0; n < 2; ++n) _Pragma("unroll") for (int k = 0; k < 2; ++k) \
        acc[ai][bj][m][n] = __builtin_amdgcn_mfma_f32_16x16x32_bf16(Bt[n][k], At[m][k], acc[ai][bj][m][n], 0, 0, 0); __builtin_amdgcn_s_setprio(0); } while (0)
#define PG8_WAIT_V(n) asm volatile("s_waitcnt vmcnt(" #n ")" ::: "memory")
#define PG8_WAIT_L(n) asm volatile("s_waitcnt lgkmcnt(" #n ")" ::: "memory")
#define PG8_BAR __builtin_amdgcn_s_barrier()
#define PG8_SCHED __builtin_amdgcn_sched_barrier(0)
    UnitD cur, nxt; int ui = 0;
    if (!P.get(0, cur)) return;
    f32x4 acc[2][2][4][2];
#pragma unroll
    for (int a = 0; a < 2; ++a)
#pragma unroll
        for (int b = 0; b < 2; ++b)
#pragma unroll
            for (int m = 0; m < 4; ++m)
#pragma unroll
                for (int n = 0; n < 2; ++n) acc[a][b][m][n] = (f32x4){0.f, 0.f, 0.f, 0.f};
    bf16x8 At[4][2], B0[2][2], B1[2][2];
    unsigned cvA[2], cvB[2];
#pragma unroll
    for (int i = 0; i < 2; ++i) { cvA[i] = (unsigned)(Rr[i] * cur.lda + Cc[i]) * 2u; cvB[i] = (unsigned)(Rb[i] * cur.K + Cc[i]) * 2u; }
    const char* cA = cur.A; const char* cB = cur.Bt;
    size_t chA = (size_t)HALF * cur.lda * 2, chB = (size_t)HALF * cur.K * 2;
    PG8_STAGE(PG8_SB(0, 0), cB, cvB); PG8_STAGE(PG8_SB(0, 1), cB + chB, cvB); PG8_STAGE(PG8_SA(0, 0), cA, cvA); PG8_STAGE(PG8_SA(0, 1), cA + chA, cvA);
    if (wr == 1) PG8_BAR;
    PG8_WAIT_V(2); PG8_BAR;
    PG8_STAGE(PG8_SB(1, 0), cB + kstep, cvB); PG8_STAGE(PG8_SA(1, 0), cA + kstep, cvA); PG8_STAGE(PG8_SB(1, 1), cB + chB + kstep, cvB);
    PG8_WAIT_V(6); PG8_BAR;
    for (;;) {
        const bool has_next = P.get(ui + 1, nxt);
        const char* nA = has_next ? nxt.A : cA; const char* nB = has_next ? nxt.Bt : cB;
        unsigned nvA[2], nvB[2];
#pragma unroll
        for (int i = 0; i < 2; ++i) { nvA[i] = has_next ? (unsigned)(Rr[i] * nxt.lda + Cc[i]) * 2u : cvA[i]; nvB[i] = has_next ? (unsigned)(Rb[i] * nxt.K + Cc[i]) * 2u : cvB[i]; }
        const size_t nhA = has_next ? (size_t)HALF * nxt.lda * 2 : chA, nhB = has_next ? (size_t)HALF * nxt.K * 2 : chB;
        const int nt = cur.nt;
        for (int t = 0; t < nt; t += 2) {
            const bool last = (t == nt - 2);
            const char* a1 = cA + (size_t)(t + 1) * kstep;
            const char* a2 = last ? nA : cA + (size_t)(t + 2) * kstep; const char* b2 = last ? nB : cB + (size_t)(t + 2) * kstep;
            const char* a3 = a2 + kstep; const char* b3 = b2 + kstep;
            unsigned vA2[2], vB2[2];
#pragma unroll
            for (int i = 0; i < 2; ++i) { vA2[i] = last ? nvA[i] : cvA[i]; vB2[i] = last ? nvB[i] : cvB[i]; }
            const size_t hA2 = last ? nhA : chA, hB2 = last ? nhB : chB;
            PG8_LDB(B0, 0, 0); PG8_LDB(B1, 0, 1); PG8_SCHED; PG8_LDA(At, 0, 0); PG8_STAGE(PG8_SA(1, 1), a1 + chA, cvA);
            PG8_WAIT_V(8); PG8_WAIT_L(0); PG8_BAR; PG8_MMA(0, 0, At, B0); PG8_MMA(0, 1, At, B1); PG8_BAR; PG8_SCHED;
            PG8_LDA(At, 0, 1); PG8_STAGE(PG8_SB(0, 0), b2, vB2); PG8_STAGE(PG8_SB(0, 1), b2 + hB2, vB2); PG8_STAGE(PG8_SA(0, 0), a2, vA2);
            PG8_WAIT_V(8); PG8_WAIT_L(0); PG8_BAR; PG8_MMA(1, 0, At, B0); PG8_MMA(1, 1, At, B1); PG8_BAR; PG8_SCHED;
            PG8_LDB(B0, 1, 0); PG8_LDB(B1, 1, 1); PG8_SCHED; PG8_LDA(At, 1, 0); PG8_STAGE(PG8_SA(0, 1), a2 + hA2, vA2);
            PG8_WAIT_V(8); PG8_WAIT_L(0); PG8_BAR; PG8_MMA(0, 0, At, B0); PG8_MMA(0, 1, At, B1); PG8_BAR; PG8_SCHED;
            PG8_LDA(At, 1, 1); PG8_STAGE(PG8_SB(1, 0), b3, vB2); PG8_STAGE(PG8_SB(1, 1), b3 + hB2, vB2); PG8_STAGE(PG8_SA(1, 0), a3, vA2);
            PG8_WAIT_V(8); PG8_WAIT_L(0); PG8_BAR; PG8_MMA(1, 0, At, B0); PG8_MMA(1, 1, At, B1); PG8_BAR; PG8_SCHED;
        }
        if (wr == 0) PG8_BAR;
        P.epi(acc, cur, wr, wc, fr, fq);
        if (!has_next) break;
#pragma unroll
        for (int a = 0; a < 2; ++a)
#pragma unroll
            for (int b = 0; b < 2; ++b)
#pragma unroll
                for (int m = 0; m < 4; ++m)
#pragma unroll
                    for (int n = 0; n < 2; ++n) acc[a][b][m][n] = (f32x4){0.f, 0.f, 0.f, 0.f};
        cur = nxt; cA = nA; cB = nB; chA = nhA; chB = nhB; ++ui;
#pragma unroll
        for (int i = 0; i < 2; ++i) { cvA[i] = nvA[i]; cvB[i] = nvB[i]; }
        if (wr == 1) PG8_BAR;
    }
    PG8_WAIT_V(0);
    PG8_BAR;
#undef PG8_SA
#undef PG8_SB
#undef PG8_STAGE
#undef PG8_LDA
#undef PG8_LDB
#undef PG8_MMA
#undef PG8_WAIT_V
#undef PG8_WAIT_L
#undef PG8_BAR
#undef PG8_SCHED
}

template <int MODE> __device__ __forceinline__ void epi_bf16(const f32x4 (&acc)[2][2][4][2], int pm, int col0, int wr, int fr, int lane, bf16_t* O, int ldo, const float* part,
                                                             const bf16_t* X1, int ldx1, const bf16_t* X2, int ldx2) {
    const int row0 = pm * BM + wr * 64 + fr;
    float rs[2] = {1.f, 1.f};
    if (MODE <= 1) wave_rstd(part, 16384, pm * BM + wr * 64, lane, 1e-6f, rs);
#pragma unroll
    for (int ai = 0; ai < 2; ++ai)
#pragma unroll
        for (int m = 0; m < 4; ++m) {
            const int row = row0 + ai * HALF + m * 16;
            float r = 1.f; if (MODE <= 1) r = __shfl(rs[ai], m * 16 + fr);
#pragma unroll
            for (int bj = 0; bj < 2; ++bj) {
                f32x4 v0 = acc[ai][bj][m][0], v1 = acc[ai][bj][m][1];
                if (MODE <= 1) { v0 = v0 * r; v1 = v1 * r; }
                if (MODE == 1) {
#pragma unroll
                    for (int e = 0; e < 4; ++e) { v0[e] = __builtin_amdgcn_rcpf(1.0f + __expf(-v0[e])); v1[e] = __builtin_amdgcn_rcpf(1.0f + __expf(-v1[e])); }
                }
                if (MODE == 2 || MODE == 3) {
                    const u32x4 x = *(const u32x4*)(X1 + (size_t)row * ldx1 + col0 + bj * HALF);
                    if (MODE == 2) {
                        v0[0] *= bf_lo(x.x); v0[1] *= bf_hi(x.x); v0[2] *= bf_lo(x.y); v0[3] *= bf_hi(x.y);
                        v1[0] *= bf_lo(x.z); v1[1] *= bf_hi(x.z); v1[2] *= bf_lo(x.w); v1[3] *= bf_hi(x.w);
                    } else {
                        const u32x4 y = *(const u32x4*)(X2 + (size_t)row * ldx2 + col0 + bj * HALF);
                        v0[0] = bf_lo(x.x) + v0[0] * bf_lo(y.x); v0[1] = bf_hi(x.x) + v0[1] * bf_hi(y.x); v0[2] = bf_lo(x.y) + v0[2] * bf_lo(y.y); v0[3] = bf_hi(x.y) + v0[3] * bf_hi(y.y);
                        v1[0] = bf_lo(x.z) + v1[0] * bf_lo(y.z); v1[1] = bf_hi(x.z) + v1[1] * bf_hi(y.z); v1[2] = bf_lo(x.w) + v1[2] * bf_lo(y.w); v1[3] = bf_hi(x.w) + v1[3] * bf_hi(y.w);
                    }
                }
                u32x4 w; w.x = cvt_pk_bf16(v0[0], v0[1]); w.y = cvt_pk_bf16(v0[2], v0[3]); w.z = cvt_pk_bf16(v1[0], v1[1]); w.w = cvt_pk_bf16(v1[2], v1[3]);
                *(u32x4*)(O + (size_t)row * ldo + col0 + bj * HALF) = w;
            }
            if (MODE >= 2) asm volatile("" ::: "memory");
        }
}
}

#ifndef PG8_SP2
#define PG8_SP2 true
#endif
#ifndef PG8_ALIGN
#define PG8_ALIGN true
#endif

constexpr int NWAVES = 8;
constexpr int BATCH = 8, S = 2048, D = 1024, DEPTH = 2;
constexpr int M = BATCH * S;
constexpr int NIN = 7680, NUQKV = 5632, NGATE = 2048, AW = 1536, AO = 512, DFF = 2816, NUP = 5632, HD = 128;
constexpr float EPS = 1e-6f;
constexpr int N_PHASES = 2 + 10 * DEPTH;

constexpr size_t MiB = 1u << 20;
constexpr size_t WS_CTL = 0, CTL_ZERO_BYTES = 64 * 1024;
constexpr size_t WS_PART = 1 * MiB;
constexpr size_t WS_LSE = 2 * MiB;
constexpr size_t WS_W = 4 * MiB;
constexpr size_t WO_WIN = 0, WO_WC = 15 * MiB, WO_WB = 17 * MiB, WO_WO = 18 * MiB, WO_WUP = 20 * MiB, WO_WDN = 31 * MiB, WDN_BYTES = (size_t)D * DFF * 2;
constexpr size_t WS_HB = 46 * MiB;
constexpr size_t WS_Y = 78 * MiB;
constexpr size_t Y_U = 0, Y_Q = 32 * MiB, Y_K = 80 * MiB, Y_V = 128 * MiB;
constexpr size_t WS_END = 254 * MiB;
static_assert(WO_WDN + 2 * WDN_BYTES <= 42 * MiB && WS_W + 42 * MiB <= WS_HB && WS_HB + 32 * MiB <= WS_Y && WS_Y + 176 * MiB <= WS_END, "d_ws map");
constexpr int CW_BAR = 1024;

constexpr int RING_OFF = 0, RING_BYTES = 131072;
constexpr int LDSCTL_OFF = RING_BYTES, MISC_OFF = LDSCTL_OFF + 320;
constexpr int LDS_BYTES = 147456;

#define GAS __attribute__((address_space(1)))
#define LAS __attribute__((address_space(3)))
typedef unsigned short bf16;
typedef unsigned v4u __attribute__((ext_vector_type(4)));
typedef unsigned v2u __attribute__((ext_vector_type(2)));
typedef float f32x4 __attribute__((ext_vector_type(4)));
typedef GAS unsigned gu32;
#define RLX_AGENT __ATOMIC_RELAXED, __HIP_MEMORY_SCOPE_AGENT
#define LDS_WAIT() asm volatile("s_waitcnt lgkmcnt(0)" ::: "memory")
#define VM_WAIT() asm volatile("s_waitcnt vmcnt(0)" ::: "memory")
__device__ __forceinline__ unsigned f2bf(float f) { unsigned u = __builtin_bit_cast(unsigned, f); return (u + 0x7fffu + ((u >> 16) & 1u)) >> 16; }
__device__ __forceinline__ unsigned pk2(float lo, float hi) { return f2bf(lo) | (f2bf(hi) << 16); }
__device__ __forceinline__ float bflo(unsigned w) { return __uint_as_float(w << 16); }
__device__ __forceinline__ float bfhi(unsigned w) { return __uint_as_float(w & 0xffff0000u); }

#define XB_TMO      128
#define XB_XCNT(j)  (256  + 64 * (j))
#define XB_XSUB(j)  (1280 + 64 * (j))
#define XB_XGEN(j)  (2304 + 64 * (j))
#define XB_TOP      3328
#define XB_TOPGEN   3392
#define XCD_BAR_WORDS 3456
#define XB_SPIN_CAP (1u << 18)
static_assert((CW_BAR + XCD_BAR_WORDS) * 4 <= (int)CTL_ZERO_BYTES, "barrier words inside the zeroed region");

__device__ __forceinline__ unsigned xb_ld(unsigned* p)              { return __hip_atomic_load(p, __ATOMIC_RELAXED, __HIP_MEMORY_SCOPE_AGENT); }
__device__ __forceinline__ unsigned xb_add(unsigned* p, unsigned v) { return __hip_atomic_fetch_add(p, v, __ATOMIC_RELAXED, __HIP_MEMORY_SCOPE_AGENT); }
__device__ __forceinline__ unsigned xb_xcc_id() { return (unsigned)__builtin_amdgcn_s_getreg((3 << 11) | 20) & 0xFu; }
#define XB_SPIN(cond, bar) do { unsigned _sp = 0; while (cond) { __builtin_amdgcn_s_sleep(1); \
    if ((++_sp & 255u) == 0u) { if (xb_ld(&(bar)[XB_TMO])) break; if (_sp > XB_SPIN_CAP) { atomicAdd(&(bar)[XB_TMO], 1u); break; } } } } while (0)

struct XcdBarrier { unsigned* bar; unsigned x; volatile LAS unsigned* st; };

__device__ __forceinline__ XcdBarrier xcd_barrier_post(unsigned* bar, volatile LAS unsigned* st) {
    XcdBarrier b; b.bar = bar; b.x = xb_xcc_id(); b.st = st;
    if (threadIdx.x == 0) (void)xb_add(&bar[XB_XCNT(b.x)], 1u);
    return b;
}
__device__ __forceinline__ void xcd_barrier_complete(unsigned* bar, unsigned x, unsigned& nloc, unsigned& nx) {
    const unsigned G = gridDim.x * gridDim.y * gridDim.z;
    unsigned sum, cnt, mine, sp = 0u;
    for (;;) {
        sum = 0u; cnt = 0u; mine = 0u;
#pragma unroll
        for (unsigned j = 0; j < 16; ++j) { const unsigned c = xb_ld(&bar[XB_XCNT(j)]); sum += c; cnt += (c > 0u) ? 1u : 0u; mine = (j == x) ? c : mine; }
        if (sum == G) break;
        __builtin_amdgcn_s_sleep(1);
        if ((++sp & 255u) == 0u) { if (xb_ld(&bar[XB_TMO])) break; if (sp > XB_SPIN_CAP) { atomicAdd(&bar[XB_TMO], 1u); break; } }
    }
    nloc = mine > 0u ? mine : 1u; nx = cnt > 0u ? cnt : 1u;
}
__device__ __forceinline__ void xcd_barrier(const XcdBarrier& b) {
    asm volatile("s_waitcnt vmcnt(0)" ::: "memory");
    __syncthreads();
    if (threadIdx.x == 0) {
        unsigned* bar = b.bar; unsigned bx_ = b.x; asm volatile("" : "+s"(bar), "+s"(bx_));
        __builtin_amdgcn_s_waitcnt(0);
        unsigned nloc = b.st[0], nx = b.st[1];
        if (nloc == 0u) { xcd_barrier_complete(bar, bx_, nloc, nx); b.st[0] = nloc; b.st[1] = nx; }
        const unsigned old = xb_add(&bar[XB_XSUB(bx_)], 1u);
        const unsigned gen = old / nloc;
        if (old + 1u == (gen + 1u) * nloc) {
            __builtin_amdgcn_fence(__ATOMIC_RELEASE, "agent");
            asm volatile("s_waitcnt vmcnt(0)" ::: "memory");
            const unsigned og = xb_add(&bar[XB_TOP], 1u);
            const unsigned tg = og / nx;
            if (og + 1u == (tg + 1u) * nx) xb_add(&bar[XB_TOPGEN], 1u);
            else XB_SPIN(xb_ld(&bar[XB_TOPGEN]) == tg, bar);
            __builtin_amdgcn_fence(__ATOMIC_ACQUIRE, "agent");
            xb_add(&bar[XB_XGEN(bx_)], 1u);
            asm volatile("s_waitcnt vmcnt(0)" ::: "memory");
        } else {
            XB_SPIN(xb_ld(&bar[XB_XGEN(bx_)]) == gen, bar);
            __builtin_amdgcn_fence(__ATOMIC_ACQUIRE, "agent");
            asm volatile("s_waitcnt vmcnt(0)" ::: "memory");
        }
    }
    __syncthreads();
}

struct Frame {
    LAS unsigned char* lds;
    volatile LAS unsigned* MISC;
    gu32* ctl;
    int tid, lane, wave;
    int vcu, G;
    int gw, NGW;
    unsigned char* ws;
    const float* const* in; float* out;
};

__device__ __forceinline__ float wave_sum(float v) {
#pragma unroll
    for (int o = 1; o < 64; o <<= 1) v += __shfl_xor(v, o);
    return v;
}
__device__ __forceinline__ float wave_max(float v) {
#pragma unroll
    for (int o = 1; o < 64; o <<= 1) v = fmaxf(v, __shfl_xor(v, o));
    return v;
}

template <bool UPDN = false> __device__ __forceinline__ void p0_transpose_item(const float* W, const float* gain, int K, int N, bf16* WT, LAS float* scr, int item, int lane) {
    const int nblk = N / 32, kb = item / nblk, nb = item % nblk, k0 = 64 * kb, n0 = 32 * nb;
    const int d0 = UPDN ? (n0 < DFF ? (n0 >> 7) * 256 + (n0 & 127) : ((n0 - DFF) >> 7) * 256 + 128 + ((n0 - DFF) & 127)) : n0;
    const int kr = lane >> 3, nq = lane & 7;
    f32x4 v[8]; float gs[8];
#pragma unroll
    for (int i = 0; i < 8; ++i) { v[i] = *(const GAS f32x4*)(W + (size_t)(k0 + 8 * i + kr) * N + n0 + 4 * nq); gs[i] = gain ? gain[k0 + 8 * i + kr] : 1.0f; }
#pragma unroll
    for (int i = 0; i < 8; ++i) { LAS float* d = scr + (8 * i + kr) * 33 + 4 * nq; d[0] = v[i].x * gs[i]; d[1] = v[i].y * gs[i]; d[2] = v[i].z * gs[i]; d[3] = v[i].w * gs[i]; }
    LDS_WAIT(); asm volatile("" ::: "memory");
    const int c = lane & 7;
#pragma unroll
    for (int j = 0; j < 4; ++j) { const int n = (lane >> 3) + 8 * j; const LAS float* s = scr + (8 * c) * 33 + n;
        v4u o; o.x = pk2(s[0 * 33], s[1 * 33]); o.y = pk2(s[2 * 33], s[3 * 33]); o.z = pk2(s[4 * 33], s[5 * 33]); o.w = pk2(s[6 * 33], s[7 * 33]);
        *(GAS v4u*)(WT + (size_t)(d0 + n) * K + k0 + 8 * c) = o; }
    LDS_WAIT(); asm volatile("" ::: "memory");
}

__device__ __forceinline__ void convert_weights(Frame& F, int l, bool with_down) {
    LAS float* scr = (LAS float*)(F.lds + RING_OFF + F.wave * 16384);
    unsigned char* wb = F.ws + WS_W;
    const float* w_in = F.in[1] + (size_t)l * D * NIN; const float* w_b = F.in[5] + (size_t)l * AO * D; const float* w_o = F.in[6] + (size_t)l * D * D;
    const float* w_up = F.in[9] + (size_t)l * D * NUP; const float* n1 = F.in[7] + (size_t)l * D; const float* n2 = F.in[8] + (size_t)l * D;
    constexpr int I_IN = (D / 64) * (NIN / 32), I_B = (AO / 64) * (D / 32), I_O = (D / 64) * (D / 32), I_UP = (D / 64) * (NUP / 32), I_DN = (DFF / 64) * (D / 32);
    const int nitems = I_IN + I_B + I_O + I_UP + (with_down ? 2 * I_DN : 0);
    for (int it = F.gw; it < nitems; it += F.NGW) {
        int r = it;
        if (r < I_IN) { p0_transpose_item(w_in, n1, D, NIN, (bf16*)(wb + WO_WIN), scr, r, F.lane); continue; } r -= I_IN;
        if (r < I_B) { p0_transpose_item(w_b, nullptr, AO, D, (bf16*)(wb + WO_WB), scr, r, F.lane); continue; } r -= I_B;
        if (r < I_O) { p0_transpose_item(w_o, nullptr, D, D, (bf16*)(wb + WO_WO), scr, r, F.lane); continue; } r -= I_O;
        if (r < I_UP) { p0_transpose_item<true>(w_up, n2, D, NUP, (bf16*)(wb + WO_WUP), scr, r, F.lane); continue; } r -= I_UP;
        const int ll = r / I_DN; r -= ll * I_DN;
        p0_transpose_item(F.in[12] + (size_t)ll * DFF * D, nullptr, DFF, D, (bf16*)(wb + WO_WDN + ll * WDN_BYTES), scr, r, F.lane);
    }
    const float* w_pool = F.in[2] + (size_t)l * 4 * 256 * 256; const float* ps = F.in[3] + (size_t)l * D; const float* w_a = F.in[4] + (size_t)l * D * D;
    bf16* Wc = (bf16*)(wb + WO_WC);
    LAS float* As = (LAS float*)(F.lds + RING_OFF);
    LAS float* Bs = (LAS float*)(F.lds + RING_OFF + 64 * 129 * 4);
    __syncthreads();
    for (int tile = F.vcu; tile < 4 * 4 * 16; tile += F.G) {
        const int g = tile >> 6, cb = (tile >> 4) & 3, nb = tile & 15, c0 = cb * 64, n0 = nb * 64;
        float acc[8];
#pragma unroll
        for (int e = 0; e < 8; ++e) acc[e] = 0.f;
        for (int dc = 0; dc < 2; ++dc) {
            const int d0 = dc * 128;
            for (int i = F.tid; i < 64 * 128; i += NWAVES * 64) { const int c = i >> 7, d = i & 127; As[c * 129 + d] = w_pool[((size_t)g * 256 + c0 + c) * 256 + d0 + d] * ps[g * 256 + d0 + d]; }
            for (int i = F.tid; i < 128 * 64; i += NWAVES * 64) { const int d = i >> 6, n = i & 63; Bs[d * 65 + n] = w_a[(size_t)(g * 256 + d0 + d) * D + n0 + n]; }
            __syncthreads();
            const LAS float* ap = As + (F.wave * 8) * 129; const LAS float* bp = Bs + F.lane;
#pragma unroll 4
            for (int d = 0; d < 128; ++d) { const float bv = bp[d * 65];
#pragma unroll
                for (int e = 0; e < 8; ++e) acc[e] += ap[e * 129 + d] * bv; }
            __syncthreads();
        }
        v4u o; o.x = pk2(acc[0], acc[1]); o.y = pk2(acc[2], acc[3]); o.z = pk2(acc[4], acc[5]); o.w = pk2(acc[6], acc[7]);
        *(GAS v4u*)(Wc + (size_t)(n0 + F.lane) * D + g * 256 + c0 + F.wave * 8) = o;
    }
}

__device__ __forceinline__ void p0_x_rows(Frame& F) {
    const float* x = F.in[0]; bf16* hb = (bf16*)(F.ws + WS_HB); float* part = (float*)(F.ws + WS_PART);
    for (int m = F.gw; m < M; m += F.NGW) {
        const GAS f32x4* xr = (const GAS f32x4*)(x + (size_t)m * D) + F.lane;
        f32x4 v[4]; float s = 0.f;
#pragma unroll
        for (int j = 0; j < 4; ++j) { v[j] = xr[64 * j]; s += (v[j].x * v[j].x + v[j].y * v[j].y) + (v[j].z * v[j].z + v[j].w * v[j].w); }
        s = wave_sum(s);
        GAS unsigned long long* o8 = (GAS unsigned long long*)(hb + (size_t)m * D) + F.lane;
#pragma unroll
        for (int j = 0; j < 4; ++j) o8[64 * j] = (unsigned long long)pk2(v[j].x, v[j].y) | ((unsigned long long)pk2(v[j].z, v[j].w) << 32);
        if (F.lane < 16) part[(size_t)F.lane * M + m] = (F.lane == 0) ? s : 0.f;
    }
}

__device__ __forceinline__ int t5_bucket(int rel) {
    const int ret = rel > 0 ? 16 : 0; const int n = rel < 0 ? -rel : rel;
    int b;
    if (n < 8) b = n; else if (n < 15) b = 8; else if (n < 27) b = 9; else if (n < 50) b = 10; else if (n < 91) b = 11; else if (n < 166) b = 12; else if (n < 305) b = 13; else if (n < 559) b = 14; else b = 15;
    return ret + b;
}

__device__ __forceinline__ void attn_simple(Frame& F) {
    bf16* Q = (bf16*)(F.ws + WS_Y + Y_Q); const bf16* Kb = (const bf16*)(F.ws + WS_Y + Y_K); const bf16* V = (const bf16*)(F.ws + WS_Y + Y_V);
    const float* rel_bias = F.in[13];
    LAS float* qs = (LAS float*)(F.lds + RING_OFF + F.wave * 2048);
    const int lane = F.lane; const float scale = 0.08838834764831845f;
    for (int item = F.gw; item < M * 4; item += F.NGW) {
        const int tok = item >> 2, h = item & 3, b = tok >> 11, s = tok & (S - 1);
#pragma unroll
        for (int g = 0; g < 3; ++g) { const unsigned w = *(const GAS unsigned*)(Q + (size_t)tok * AW + (g * 4 + h) * HD + 2 * lane); qs[g * 128 + 2 * lane] = bflo(w); qs[g * 128 + 2 * lane + 1] = bfhi(w); }
        LDS_WAIT(); asm volatile("" ::: "memory");
        float mrun = -1e30f, lrun = 0.f, o0 = 0.f, o1 = 0.f;
#pragma unroll 1
        for (int g = 0; g < 3; ++g) {
            const int dl = 1 << (2 * g), head = g * 4 + h;
            float sc[3];
#pragma unroll
            for (int p = 0; p < 3; ++p) {
                const int jj = lane + 64 * p, j = jj - 64, pos = s + dl * j;
                const bool valid = (jj <= 128) && pos >= 0 && pos < S;
                float dot = 0.f;
                if (valid) {
                    const bf16* krow = Kb + ((size_t)b * S + pos) * AW + head * HD;
#pragma unroll 4
                    for (int c = 0; c < 16; ++c) { const v4u kv = *(const GAS v4u*)(krow + 8 * c); const LAS float* qq = qs + g * 128 + 8 * c;
                        dot += bflo(kv.x) * qq[0] + bfhi(kv.x) * qq[1] + bflo(kv.y) * qq[2] + bfhi(kv.y) * qq[3] + bflo(kv.z) * qq[4] + bfhi(kv.z) * qq[5] + bflo(kv.w) * qq[6] + bfhi(kv.w) * qq[7]; }
                }
                const float bias = (jj <= 128) ? rel_bias[t5_bucket(dl * j) * 12 + head] : 0.f;
                sc[p] = valid ? dot * scale + bias : -1e30f;
            }
            const float gmax = wave_max(fmaxf(fmaxf(sc[0], sc[1]), sc[2]));
            const float mnew = fmaxf(mrun, gmax);
            const float alpha = __expf(mrun - mnew);
            float pr[3];
#pragma unroll
            for (int p = 0; p < 3; ++p) pr[p] = (sc[p] > -1e29f) ? __expf(sc[p] - mnew) : 0.f;
            const float psum = wave_sum(pr[0] + pr[1] + pr[2]);
            lrun = lrun * alpha + psum; o0 *= alpha; o1 *= alpha; mrun = mnew;
#pragma unroll 1
            for (int jj = 0; jj <= 128; ++jj) {
                const int pos = s + dl * (jj - 64);
                if (pos < 0 || pos >= S) continue;
                const float pj = __shfl(jj < 64 ? pr[0] : (jj < 128 ? pr[1] : pr[2]), jj & 63);
                const unsigned w = *(const GAS unsigned*)(V + ((size_t)b * S + pos) * AW + head * HD + 2 * lane);
                o0 += pj * bflo(w); o1 += pj * bfhi(w);
            }
        }
        const float inv = 1.0f / lrun;
        *(GAS unsigned*)(Q + (size_t)tok * AW + h * HD + 2 * lane) = pk2(o0 * inv, o1 * inv);
        LDS_WAIT(); asm volatile("" ::: "memory");
    }
}

namespace att {
typedef short bf16x8 __attribute__((ext_vector_type(8)));
typedef short s16x4 __attribute__((ext_vector_type(4)));
typedef float f32x16 __attribute__((ext_vector_type(16)));
__device__ __forceinline__ unsigned off_b(unsigned row, unsigned ch) { return 256u * row + 16u * (ch ^ (((row & 3u) << 2) | ((row >> 2) & 3u))); }
__device__ __forceinline__ s16x4 vtr(const LAS unsigned char* p) { return __builtin_bit_cast(s16x4, __builtin_amdgcn_ds_read_tr16_b64_v4i16((LAS s16x4*)p)); }
constexpr int N_UNITS = BATCH * 3 * 2 * 16;
constexpr int BIAS_OFF = RING_BYTES + 2048;
}
__device__ __forceinline__ void attn_mfma(Frame& F) {
    using namespace att;
    bf16* Q = (bf16*)(F.ws + WS_Y + Y_Q); const bf16* Kg = (const bf16*)(F.ws + WS_Y + Y_K); const bf16* Vg = (const bf16*)(F.ws + WS_Y + Y_V);
    float* LSE = (float*)(F.ws + WS_LSE); const float* rel_bias = F.in[13];
    const int lane = F.lane, wave = F.wave, half = wave >> 2, j = wave & 3, ql = lane & 31, hh = lane >> 5, th = F.tid & 255;
    const float LOG2E = 1.4426950408889634f, CS = 0.08838834764831845f * 1.4426950408889634f;
    LAS unsigned char* hb = F.lds + RING_OFF + half * 65536;
    LAS float* bt = (LAS float*)(F.lds + BIAS_OFF + half * 1024);
    const int nper = (N_UNITS + F.G - 1) / F.G;
    const int u_lo = F.vcu * nper, u_hi = (u_lo + nper < N_UNITS) ? u_lo + nper : N_UNITS;
#pragma unroll 1
    for (int u = u_lo; u < u_hi; ++u) {
        const int t16 = u & 15, rest = u >> 4, hp = rest & 1, g = (rest >> 1) % 3, b = rest / 6;
        const int sh = 2 * g, dl = 1 << sh, L = S >> sh;
        const int r = (g == 0) ? 0 : (g == 1 ? (t16 >> 2) : t16), mt = (g == 0) ? t16 : (g == 1 ? (t16 & 3) : 0), m0 = mt * 128;
        const int hl = hp * 2 + half, hd = g * 4 + hl;
        const size_t tokbase = (size_t)b * S + r;
        { const int jrel = th - 128; float v = -1e30f; if (jrel >= -64 && jrel <= 64) v = rel_bias[t5_bucket(dl * jrel) * 12 + hd] * LOG2E; bt[th] = v; }
        const int mq = m0 + 32 * j + ql;
        bf16* qrow = Q + (tokbase + (size_t)dl * mq) * AW + hd * HD;
        bf16x8 qf[8];
#pragma unroll
        for (int s2 = 0; s2 < 8; ++s2) qf[s2] = *(const GAS bf16x8*)(qrow + 16 * s2 + 8 * hh);
        const int kb_lo = (m0 == 0) ? 1 : 0; int kb_hi = (L - 1 - m0 + 64) >> 6; kb_hi = kb_hi > 3 ? 3 : kb_hi;
        v4u kreg[4], vreg[4];
        const int srow = th >> 4, sch = th & 15;
#define ATT_STAGE_LOAD(kb_) do { _Pragma("unroll") for (int i = 0; i < 4; ++i) { const int mk = m0 - 64 + 64 * (kb_) + srow + 16 * i; \
                const size_t off = (tokbase + (size_t)dl * mk) * AW + hd * HD + sch * 8; \
                kreg[i] = *(const GAS v4u*)(Kg + off); vreg[i] = *(const GAS v4u*)(Vg + off); } } while (0)
#define ATT_STAGE_WRITE(buf_) do { _Pragma("unroll") for (int i = 0; i < 4; ++i) { const unsigned o = off_b((unsigned)(srow + 16 * i), (unsigned)sch); \
                *(LAS v4u*)(hb + (buf_) * 16384 + o) = kreg[i]; *(LAS v4u*)(hb + 32768 + (buf_) * 16384 + o) = vreg[i]; } } while (0)
        float m_run = -1e20f, l_run = 0.f;
        f32x16 O[4];
#pragma unroll
        for (int c = 0; c < 4; ++c)
#pragma unroll
            for (int i = 0; i < 16; ++i) O[c][i] = 0.f;
        ATT_STAGE_LOAD(kb_lo); ATT_STAGE_WRITE(0);
        __syncthreads();
#pragma unroll 1
        for (int kb = kb_lo; kb <= kb_hi; ++kb) {
            const int cur = (kb - kb_lo) & 1;
            if (kb < kb_hi) ATT_STAGE_LOAD(kb + 1);
            if (kb >= (j >> 1) && kb <= (j >> 1) + 2) {
                const LAS unsigned char* kbuf = hb + cur * 16384; const LAS unsigned char* vbuf = hb + 32768 + cur * 16384;
                f32x16 s0, s1;
#pragma unroll
                for (int i = 0; i < 16; ++i) { s0[i] = 0.f; s1[i] = 0.f; }
#pragma unroll
                for (int s2 = 0; s2 < 8; ++s2) {
                    const bf16x8 a0 = *(const LAS bf16x8*)(kbuf + off_b((unsigned)ql, (unsigned)(2 * s2 + hh)));
                    const bf16x8 a1 = *(const LAS bf16x8*)(kbuf + off_b((unsigned)(32 + ql), (unsigned)(2 * s2 + hh)));
                    s0 = __builtin_amdgcn_mfma_f32_32x32x16_bf16(a0, qf[s2], s0, 0, 0, 0);
                    s1 = __builtin_amdgcn_mfma_f32_32x32x16_bf16(a1, qf[s2], s1, 0, 0, 0);
                }
                const LAS float* btl = bt + (64 * kb + 64 - 32 * j - ql + 4 * hh);
                float bmax = -1e30f;
#pragma unroll
                for (int i = 0; i < 16; ++i) {
                    const int kr = (i & 3) + 8 * (i >> 2);
                    s0[i] = fmaf(s0[i], CS, btl[kr]); s1[i] = fmaf(s1[i], CS, btl[32 + kr]);
                    bmax = fmaxf(bmax, fmaxf(s0[i], s1[i]));
                }
                bmax = fmaxf(bmax, __shfl_xor(bmax, 32));
                if (__any(bmax > m_run + 8.0f)) {
                    const float m_new = fmaxf(m_run, bmax), alpha = __builtin_amdgcn_exp2f(m_run - m_new);
                    m_run = m_new; l_run *= alpha;
#pragma unroll
                    for (int c = 0; c < 4; ++c)
#pragma unroll
                        for (int i = 0; i < 16; ++i) O[c][i] *= alpha;
                }
                float psum = 0.f;
#pragma unroll
                for (int i = 0; i < 16; ++i) { s0[i] = __builtin_amdgcn_exp2f(s0[i] - m_run); s1[i] = __builtin_amdgcn_exp2f(s1[i] - m_run); psum += s0[i] + s1[i]; }
                l_run += psum;
                v4u pk[4];
#pragma unroll
                for (int s2 = 0; s2 < 2; ++s2) {
                    pk[s2].x = pg8::cvt_pk_bf16(s0[8 * s2 + 0], s0[8 * s2 + 1]); pk[s2].y = pg8::cvt_pk_bf16(s0[8 * s2 + 2], s0[8 * s2 + 3]);
                    pk[s2].z = pg8::cvt_pk_bf16(s0[8 * s2 + 4], s0[8 * s2 + 5]); pk[s2].w = pg8::cvt_pk_bf16(s0[8 * s2 + 6], s0[8 * s2 + 7]);
                    pk[2 + s2].x = pg8::cvt_pk_bf16(s1[8 * s2 + 0], s1[8 * s2 + 1]); pk[2 + s2].y = pg8::cvt_pk_bf16(s1[8 * s2 + 2], s1[8 * s2 + 3]);
                    pk[2 + s2].z = pg8::cvt_pk_bf16(s1[8 * s2 + 4], s1[8 * s2 + 5]); pk[2 + s2].w = pg8::cvt_pk_bf16(s1[8 * s2 + 6], s1[8 * s2 + 7]);
                }
                const unsigned blk = (lane >> 4) & 1, tq = (lane & 15) >> 2, tp = lane & 3;
#pragma unroll
                for (int ks = 0; ks < 4; ++ks) {
                    const bf16x8 pb = __builtin_bit_cast(bf16x8, pk[ks]);
#pragma unroll
                    for (int c = 0; c < 4; ++c) {
                        const unsigned chn = 4 * c + 2 * blk + (tp >> 1);
                        const s16x4 lo = vtr(vbuf + off_b(16 * ks + 4 * hh + tq, chn) + 8 * (tp & 1));
                        const s16x4 hi = vtr(vbuf + off_b(16 * ks + 8 + 4 * hh + tq, chn) + 8 * (tp & 1));
                        const bf16x8 va = {lo[0], lo[1], lo[2], lo[3], hi[0], hi[1], hi[2], hi[3]};
                        O[c] = __builtin_amdgcn_mfma_f32_32x32x16_bf16(va, pb, O[c], 0, 0, 0);
                    }
                }
            }
            if (kb < kb_hi) ATT_STAGE_WRITE(cur ^ 1);
            __syncthreads();
        }
#undef ATT_STAGE_LOAD
#undef ATT_STAGE_WRITE
        const float l_tot = l_run + __shfl_xor(l_run, 32);
        const float inv = 1.0f / l_tot;
#pragma unroll
        for (int c = 0; c < 4; ++c)
#pragma unroll
            for (int i4 = 0; i4 < 4; ++i4) {
                v2u w; w.x = pg8::cvt_pk_bf16(O[c][4 * i4 + 0] * inv, O[c][4 * i4 + 1] * inv); w.y = pg8::cvt_pk_bf16(O[c][4 * i4 + 2] * inv, O[c][4 * i4 + 3] * inv);
                *(GAS v2u*)(qrow + 32 * c + 8 * i4 + 4 * hh) = w;
            }
        if (hh == 0) LSE[((size_t)g * M + tokbase + (size_t)dl * mq) * 4 + hl] = m_run + __log2f(l_tot);
    }
}

__device__ __forceinline__ void attn_combine(Frame& F) {
    bf16* Q = (bf16*)(F.ws + WS_Y + Y_Q); const float* LSE = (const float*)(F.ws + WS_LSE);
    const int total = M * 64;
    for (int it = F.gw * 64 + F.lane; it < total; it += F.NGW * 64) {
        const int tok = it >> 6, h = (it >> 4) & 3, ch = it & 15;
        const float l0 = LSE[((size_t)0 * M + tok) * 4 + h], l1 = LSE[((size_t)1 * M + tok) * 4 + h], l2 = LSE[((size_t)2 * M + tok) * 4 + h];
        const float mx = fmaxf(l0, fmaxf(l1, l2));
        float w0 = __builtin_amdgcn_exp2f(l0 - mx), w1 = __builtin_amdgcn_exp2f(l1 - mx), w2 = __builtin_amdgcn_exp2f(l2 - mx);
        const float inv = 1.0f / (w0 + w1 + w2); w0 *= inv; w1 *= inv; w2 *= inv;
        bf16* p = Q + (size_t)tok * AW + h * HD + ch * 8;
        const v4u a = *(const GAS v4u*)(p), b2 = *(const GAS v4u*)(p + 512), c = *(const GAS v4u*)(p + 1024);
        v4u o;
        o.x = pk2(w0 * bflo(a.x) + w1 * bflo(b2.x) + w2 * bflo(c.x), w0 * bfhi(a.x) + w1 * bfhi(b2.x) + w2 * bfhi(c.x));
        o.y = pk2(w0 * bflo(a.y) + w1 * bflo(b2.y) + w2 * bflo(c.y), w0 * bfhi(a.y) + w1 * bfhi(b2.y) + w2 * bfhi(c.y));
        o.z = pk2(w0 * bflo(a.z) + w1 * bflo(b2.z) + w2 * bflo(c.z), w0 * bfhi(a.z) + w1 * bfhi(b2.z) + w2 * bfhi(c.z));
        o.w = pk2(w0 * bflo(a.w) + w1 * bflo(b2.w) + w2 * bflo(c.w), w0 * bfhi(a.w) + w1 * bfhi(b2.w) + w2 * bfhi(c.w));
        *(GAS v4u*)(p) = o;
    }
}

__device__ __forceinline__ void pool_simple(Frame& F) {
    const bf16* U = (const bf16*)(F.ws + WS_Y + Y_U); bf16* P = (bf16*)(F.ws + WS_Y + Y_K);
    const int total = M * (D / 8);
    for (int it = F.gw * 64 + F.lane; it < total; it += F.NGW * 64) {
        const int tok = it >> 7, ch = it & 127, s = tok & (S - 1), g = ch >> 5, w = 2 << g;
        int lo = s - (w >> 1), hi = lo + w; lo = lo < 0 ? 0 : lo; hi = hi > S ? S : hi;
        const bf16* base = U + (size_t)(tok - s) * D + ch * 8;
        float a[8];
#pragma unroll
        for (int e = 0; e < 8; ++e) a[e] = 0.f;
        for (int r = lo; r < hi; ++r) { const v4u v = *(const GAS v4u*)(base + (size_t)r * D);
            a[0] += bflo(v.x); a[1] += bfhi(v.x); a[2] += bflo(v.y); a[3] += bfhi(v.y); a[4] += bflo(v.z); a[5] += bfhi(v.z); a[6] += bflo(v.w); a[7] += bfhi(v.w); }
        const float inv = 1.0f / (float)(hi - lo);
        const v4u c = *(const GAS v4u*)(base + (size_t)s * D);
        v4u o; o.x = pk2(a[0] * inv - bflo(c.x), a[1] * inv - bfhi(c.x)); o.y = pk2(a[2] * inv - bflo(c.y), a[3] * inv - bfhi(c.y));
        o.z = pk2(a[4] * inv - bflo(c.z), a[5] * inv - bfhi(c.z)); o.w = pk2(a[6] * inv - bflo(c.w), a[7] * inv - bfhi(c.w));
        *(GAS v4u*)(P + (size_t)tok * D + ch * 8) = o;
    }
}

__device__ __forceinline__ void pool_slide(Frame& F) {
    const bf16* U = (const bf16*)(F.ws + WS_Y + Y_U); bf16* P = (bf16*)(F.ws + WS_Y + Y_K);
    constexpr int T = 16; constexpr int NIT = BATCH * 4 * (S / (2 * T));
    for (int it = F.gw; it < NIT; it += F.NGW) {
        const int seg2 = it & 63, g = (it >> 6) & 3, b = it >> 8;
        const int w = 2 << g, hw = w >> 1;
        const int t0 = (seg2 * 2 + (F.lane >> 5)) * T, ch = g * 32 + (F.lane & 31);
        const bf16* base = U + (size_t)b * S * D + ch * 8; bf16* obase = P + (size_t)b * S * D + ch * 8;
        float a[8];
#pragma unroll
        for (int e = 0; e < 8; ++e) a[e] = 0.f;
        { int lo = t0 - hw, hi = lo + w; lo = lo < 0 ? 0 : lo; hi = hi > S ? S : hi;
          for (int r = lo; r < hi; ++r) { const v4u v = *(const GAS v4u*)(base + (size_t)r * D);
              a[0] += bflo(v.x); a[1] += bfhi(v.x); a[2] += bflo(v.y); a[3] += bfhi(v.y); a[4] += bflo(v.z); a[5] += bfhi(v.z); a[6] += bflo(v.w); a[7] += bfhi(v.w); } }
#pragma unroll 4
        for (int i = 0; i < T; ++i) {
            const int t = t0 + i;
            int lo = t - hw, hi = lo + w; lo = lo < 0 ? 0 : lo; hi = hi > S ? S : hi;
            const float inv = 1.0f / (float)(hi - lo);
            const v4u c = *(const GAS v4u*)(base + (size_t)t * D);
            v4u o; o.x = pk2(a[0] * inv - bflo(c.x), a[1] * inv - bfhi(c.x)); o.y = pk2(a[2] * inv - bflo(c.y), a[3] * inv - bfhi(c.y));
            o.z = pk2(a[4] * inv - bflo(c.z), a[5] * inv - bfhi(c.z)); o.w = pk2(a[6] * inv - bflo(c.w), a[7] * inv - bfhi(c.w));
            *(GAS v4u*)(obase + (size_t)t * D) = o;
            const int re = t + hw, rl = t - hw;
            if (re < S) { const v4u v = *(const GAS v4u*)(base + (size_t)re * D);
                a[0] += bflo(v.x); a[1] += bfhi(v.x); a[2] += bflo(v.y); a[3] += bfhi(v.y); a[4] += bflo(v.z); a[5] += bfhi(v.z); a[6] += bflo(v.w); a[7] += bfhi(v.w); }
            if (rl >= 0) { const v4u v = *(const GAS v4u*)(base + (size_t)rl * D);
                a[0] -= bflo(v.x); a[1] -= bfhi(v.x); a[2] -= bflo(v.y); a[3] -= bfhi(v.y); a[4] -= bflo(v.z); a[5] -= bfhi(v.z); a[6] -= bflo(v.w); a[7] -= bfhi(v.w); }
        }
    }
}

__device__ __forceinline__ float gelu_tanh(float x) {
    const float y = 0.7978845608028654f * (x + 0.044715f * x * x * x);
    const float t = 1.0f - 2.0f / (__expf(2.0f * y) + 1.0f);
    return 0.5f * x * (1.0f + t);
}
__device__ __forceinline__ void conv_simple(Frame& F, int l) {
    bf16* AG = (bf16*)(F.ws + WS_Y);
    const float* cw = F.in[10] + (size_t)l * 3 * DFF; const float* cb = F.in[11] + (size_t)l * DFF;
    constexpr int CH = DFF / 8; const int total = M * CH;
    for (int it = F.gw * 64 + F.lane; it < total; it += F.NGW * 64) {
        const int tok = it / CH, ch = it - tok * CH, s = tok & (S - 1), c0 = ch * 8;
        const bf16* ap = AG + (size_t)tok * NUP + c0;
        const v4u z = {0u, 0u, 0u, 0u};
        const v4u am = (s > 0) ? *(const GAS v4u*)(ap - NUP) : z;
        const v4u a0 = *(const GAS v4u*)(ap);
        const v4u ap1 = (s < S - 1) ? *(const GAS v4u*)(ap + NUP) : z;
        const v4u gv = *(const GAS v4u*)(ap + DFF);
        float xm[8] = {bflo(am.x), bfhi(am.x), bflo(am.y), bfhi(am.y), bflo(am.z), bfhi(am.z), bflo(am.w), bfhi(am.w)};
        float x0[8] = {bflo(a0.x), bfhi(a0.x), bflo(a0.y), bfhi(a0.y), bflo(a0.z), bfhi(a0.z), bflo(a0.w), bfhi(a0.w)};
        float xp[8] = {bflo(ap1.x), bfhi(ap1.x), bflo(ap1.y), bfhi(ap1.y), bflo(ap1.z), bfhi(ap1.z), bflo(ap1.w), bfhi(ap1.w)};
        float gg[8] = {bflo(gv.x), bfhi(gv.x), bflo(gv.y), bfhi(gv.y), bflo(gv.z), bfhi(gv.z), bflo(gv.w), bfhi(gv.w)};
        float r[8];
#pragma unroll
        for (int e = 0; e < 8; ++e) { const float v = cw[c0 + e] * xm[e] + cw[DFF + c0 + e] * x0[e] + cw[2 * DFF + c0 + e] * xp[e] + cb[c0 + e]; r[e] = gelu_tanh(v) * gg[e]; }
        v4u o; o.x = pk2(r[0], r[1]); o.y = pk2(r[2], r[3]); o.z = pk2(r[4], r[5]); o.w = pk2(r[6], r[7]);
        *(GAS v4u*)(AG + (size_t)tok * NUP + DFF + c0) = o;
    }
}

__device__ __forceinline__ void conv_slide(Frame& F, int l) {
    bf16* AG = (bf16*)(F.ws + WS_Y);
    const float* cw = F.in[10] + (size_t)l * 3 * DFF; const float* cb = F.in[11] + (size_t)l * DFF;
    constexpr int CH = DFF / 8, CW = (CH + 63) / 64, T = 16, NIT = CW * (M / T);
    const v4u z = {0u, 0u, 0u, 0u};
    for (int it = F.gw; it < NIT; it += F.NGW) {
        const int cwi = it % CW, run = it / CW, ch = cwi * 64 + F.lane;
        if (ch >= CH) continue;
        const int tok0 = run * T, s0 = tok0 & (S - 1), c0 = ch * 8;
        float w0[8], w1[8], w2[8], bb[8];
#pragma unroll
        for (int e = 0; e < 8; ++e) { w0[e] = cw[c0 + e]; w1[e] = cw[DFF + c0 + e]; w2[e] = cw[2 * DFF + c0 + e]; bb[e] = cb[c0 + e]; }
        bf16* ap = AG + (size_t)tok0 * NUP + c0;
        v4u am = (s0 > 0) ? *(const GAS v4u*)(ap - NUP) : z;
        v4u a0 = *(const GAS v4u*)(ap);
#pragma unroll 4
        for (int i = 0; i < T; ++i) {
            const v4u a1 = (s0 + i < S - 1) ? *(const GAS v4u*)(ap + (size_t)(i + 1) * NUP) : z;
            const v4u gv = *(const GAS v4u*)(ap + (size_t)i * NUP + DFF);
            const float xm[8] = {bflo(am.x), bfhi(am.x), bflo(am.y), bfhi(am.y), bflo(am.z), bfhi(am.z), bflo(am.w), bfhi(am.w)};
            const float x0[8] = {bflo(a0.x), bfhi(a0.x), bflo(a0.y), bfhi(a0.y), bflo(a0.z), bfhi(a0.z), bflo(a0.w), bfhi(a0.w)};
            const float xp[8] = {bflo(a1.x), bfhi(a1.x), bflo(a1.y), bfhi(a1.y), bflo(a1.z), bfhi(a1.z), bflo(a1.w), bfhi(a1.w)};
            const float gg[8] = {bflo(gv.x), bfhi(gv.x), bflo(gv.y), bfhi(gv.y), bflo(gv.z), bfhi(gv.z), bflo(gv.w), bfhi(gv.w)};
            float r[8];
#pragma unroll
            for (int e = 0; e < 8; ++e) { const float v = w0[e] * xm[e] + w1[e] * x0[e] + w2[e] * xp[e] + bb[e]; r[e] = gelu_tanh(v) * gg[e]; }
            v4u o; o.x = pk2(r[0], r[1]); o.y = pk2(r[2], r[3]); o.z = pk2(r[4], r[5]); o.w = pk2(r[6], r[7]);
            *(GAS v4u*)(ap + (size_t)i * NUP + DFF) = o;
            am = a0; a0 = a1;
        }
    }
}

__device__ __forceinline__ void final_norm(Frame& F) {
    const float* part = (const float*)(F.ws + WS_PART); const float* nf = F.in[14]; const bf16* hb = (const bf16*)(F.ws + WS_HB);
    for (int m = F.gw; m < M; m += F.NGW) {
        float s = 0.f;
#pragma unroll
        for (int t = 0; t < 16; ++t) s += part[(size_t)t * M + m];
        const float rstd = 1.0f / sqrtf(s * (1.0f / 1024.0f) + EPS);
        GAS f32x4* xr = (GAS f32x4*)(F.out + (size_t)m * D) + F.lane; const GAS f32x4* gr = (const GAS f32x4*)nf + F.lane; const GAS v2u* hr = (const GAS v2u*)(hb + (size_t)m * D) + F.lane;
#pragma unroll
        for (int j = 0; j < 4; ++j) { const v2u h = hr[64 * j]; const f32x4 gq = gr[64 * j]; f32x4 v = {bflo(h.x), bfhi(h.x), bflo(h.y), bfhi(h.y)}; xr[64 * j] = v * rstd * gq; }
    }
}

struct Args { const float* in[15]; float* out; unsigned char* ws; int ph_lo, ph_hi; int pad0, pad1; };

struct CfgP1 { static constexpr int st1 = 4, st2 = 10, st3 = 16, ld0 = D, ld1 = AW; static constexpr long off1 = (long)(Y_Q - Y_U), off2 = (long)(Y_K - Y_U), off3 = (long)(Y_V - Y_U); };
struct CfgGate { static constexpr int st1 = 4, st2 = 1 << 20, st3 = 1 << 20, ld0 = D, ld1 = D; static constexpr long off1 = (long)Y_U - (long)Y_V, off2 = 0, off3 = 0; };
struct CfgOne { static constexpr int st1 = 1 << 20, st2 = 1 << 20, st3 = 1 << 20, ld0 = D, ld1 = D; static constexpr long off1 = 0, off2 = 0, off3 = 0; };
struct CfgUp { static constexpr int st1 = 1 << 20, st2 = 1 << 20, st3 = 1 << 20, ld0 = NUP, ld1 = NUP; static constexpr long off1 = 0, off2 = 0, off3 = 0; };
template <int MODE, class CFG, int GN, int GK, int GLDA> __device__ __forceinline__ void run_gemm_b(Frame& F, const bf16* A, const bf16* Bt, bf16* O, const bf16* X1, const bf16* X2) {
    pg8::EpiB<MODE, CFG> E; E.O = O; E.part = (const float*)(F.ws + WS_PART); E.X1 = X1; E.X2 = X2;
    pg8::gemm_phase<pg8::EpiB<MODE, CFG>, GN, GK, GLDA, PG8_ALIGN, PG8_SP2>(F.lds + RING_OFF, A, Bt, F.G, (int)blockIdx.x, E);
}
template <int GK, int GLDA> __device__ __forceinline__ void run_gemm_r(Frame& F, const bf16* A, const bf16* Bt) {
    pg8::EpiRes E{(bf16*)(F.ws + WS_HB), (float*)(F.ws + WS_PART), M};
    pg8::gemm_phase<pg8::EpiRes, D, GK, GLDA, PG8_ALIGN, PG8_SP2>(F.lds + RING_OFF, A, Bt, F.G, (int)blockIdx.x, E);
}

constexpr size_t SIDE_OFF = 96 * MiB;
constexpr int XBUF_OFF = RING_BYTES + 4096;
__device__ __forceinline__ void conv_fixup(Frame& F, int l) {
    const float* cw = F.in[10] + (size_t)l * 3 * DFF; const float* side = (const float*)(F.ws + WS_Y + SIDE_OFF); bf16* ACT = (bf16*)(F.ws + WS_Y);
    constexpr int SS = 64 * DFF;
    pg8::StaticOrder So; So.init(M, D, F.G, (int)blockIdx.x); pg8::Unit u;
    for (int i = 0; So.next(i, u); ++i) {
        const int pm = u.pm;
        for (int t = F.tid; t < 2 * (DFF / 4); t += NWAVES * 64) {
            const int which = t / (DFF / 4), c = (t - which * (DFF / 4)) * 4;
            if (which == 0 ? ((pm & 7) == 0) : ((pm & 7) == 7)) continue;
            const f32x4 pre = *(const GAS f32x4*)(side + (size_t)(which ? 4 : 2) * SS + (size_t)pm * DFF + c);
            const f32x4 g = *(const GAS f32x4*)(side + (size_t)(which ? 5 : 3) * SS + (size_t)pm * DFF + c);
            const f32x4 nb = which ? *(const GAS f32x4*)(side + (size_t)(pm + 1) * DFF + c) : *(const GAS f32x4*)(side + SS + (size_t)(pm - 1) * DFF + c);
            const f32x4 w = *(const GAS f32x4*)(cw + (which ? 2 * DFF : 0) + c);
            float o[4];
#pragma unroll
            for (int e = 0; e < 4; ++e) { const float x = pre[e] + w[e] * nb[e]; o[e] = x * __builtin_amdgcn_rcpf(1.0f + __builtin_amdgcn_exp2f(x * (-2.3022082f + -0.10294324f * x * x))) * g[e]; }
            v2u wv; wv.x = pg8::cvt_pk_bf16(o[0], o[1]); wv.y = pg8::cvt_pk_bf16(o[2], o[3]);
            *(GAS v2u*)(ACT + (size_t)(pm * 256 + (which ? 255 : 0)) * DFF + c) = wv;
        }
    }
    VM_WAIT(); __syncthreads();
}

struct P3Prog {
    unsigned char* ws; int G, c;
    __device__ __forceinline__ bool get(int i, pg8::UnitD& u) const {
        const int it = i >> 2, sub = i & 3; const int Lw = it * G + c; if (Lw >= 256) return false;
        const int wgid = (Lw & 7) * 32 + (Lw >> 3);
        const int pm = (wgid >> 5) * 8 + (wgid & 7), pn = (wgid & 31) >> 3;
        u.pm = pm; u.pn = pn; u.sub = sub;
        const unsigned char* A; const unsigned char* Bt; int K = D, lda = D;
        if (sub <= 1) { A = ws + WS_HB; Bt = ws + WS_W + WO_WIN + (size_t)(NUQKV + sub * D) * D * 2; }
        else if (sub == 2) { A = ws + WS_Y + Y_K; Bt = ws + WS_W + WO_WC; }
        else { A = ws + WS_Y + Y_Q; Bt = ws + WS_W + WO_WB; K = AO; lda = AW; }
        u.K = K; u.lda = lda; u.nt = K / 64;
        u.A = (const char*)A + (size_t)pm * 256 * lda * 2; u.Bt = (const char*)Bt + (size_t)pn * 256 * K * 2;
        return true;
    }
    __device__ __forceinline__ void epi(const pg8::f32x4 (&acc)[2][2][4][2], const pg8::UnitD& u, int wr, int wc, int fr, int fq) const {
        const int lane = fr + 16 * fq, col0 = u.pn * 256 + wc * 32 + 8 * fq;
        bf16* SGP = (bf16*)(ws + WS_Y + Y_V); bf16* SGA = (bf16*)(ws + WS_Y + Y_U); bf16* T1 = (bf16*)(ws + WS_Y + Y_Q) + 512; const float* part = (const float*)(ws + WS_PART);
        if (u.sub == 0) pg8::epi_bf16<1>(acc, u.pm, col0, wr, fr, lane, SGP, D, part, nullptr, 0, nullptr, 0);
        else if (u.sub == 1) pg8::epi_bf16<1>(acc, u.pm, col0, wr, fr, lane, SGA, D, part, nullptr, 0, nullptr, 0);
        else if (u.sub == 2) pg8::epi_bf16<2>(acc, u.pm, col0, wr, fr, lane, T1, AW, part, SGP, D, nullptr, 0);
        else pg8::epi_bf16<3>(acc, u.pm, col0, wr, fr, lane, SGP, D, part, T1, AW, SGA, D);
    }
};

#define IN(k) (lo <= (k) && (k) < hi)
#define SEAM(k) do { if (IN(k) && IN((k) + 1)) xcd_barrier(bar); } while (0)
template <int L> __device__ __forceinline__ void layer_phases(Frame& F, int lo, int hi, const XcdBarrier& bar) {
    constexpr int pb = 1 + 10 * L;
    unsigned char* ws = F.ws;
    bf16* HB = (bf16*)(ws + WS_HB);
    bf16* YU = (bf16*)(ws + WS_Y + Y_U); bf16* YQ = (bf16*)(ws + WS_Y + Y_Q); bf16* YK = (bf16*)(ws + WS_Y + Y_K); bf16* YV = (bf16*)(ws + WS_Y + Y_V);
    bf16* W_IN = (bf16*)(ws + WS_W + WO_WIN);
    if (IN(pb + 0)) { run_gemm_b<0, CfgP1, NUQKV, D, D>(F, HB, W_IN, YU, nullptr, nullptr); SEAM(pb + 0); }
#if defined(ATTN_ORACLE)
    if (IN(pb + 1)) { attn_simple(F); SEAM(pb + 1); }
#else
    if (IN(pb + 1)) { attn_mfma(F); SEAM(pb + 1); }
#endif
#if defined(ATTN_ORACLE)
    if (IN(pb + 2)) { pool_simple(F); SEAM(pb + 2); }
#else
    if (IN(pb + 2)) { attn_combine(F); pool_slide(F); SEAM(pb + 2); }
#endif
    if (IN(pb + 3)) { P3Prog P{F.ws, F.G, (int)blockIdx.x}; pg8::gemm_stream<P3Prog>(F.lds + RING_OFF, P); if (IN(pb + 6)) xcd_barrier(bar); }
    if (IN(pb + 6)) { run_gemm_r<D, D>(F, YV, (const bf16*)(ws + WS_W + WO_WO)); SEAM(pb + 6); }
    if (IN(pb + 7)) {
        pg8::EpiConv E{YU, (const float*)(ws + WS_PART), F.in[10] + (size_t)L * 3 * DFF, F.in[11] + (size_t)L * DFF, (float*)(ws + WS_Y + SIDE_OFF), (LAS float*)(F.lds + XBUF_OFF)};
        pg8::gemm_phase<pg8::EpiConv, NUP, D, D, PG8_ALIGN, PG8_SP2>(F.lds + RING_OFF, HB, (const bf16*)(ws + WS_W + WO_WUP), F.G, (int)blockIdx.x, E);
        if (IN(pb + 9)) xcd_barrier(bar);
    }
    if (IN(pb + 9)) {
        conv_fixup(F, L);
        run_gemm_r<DFF, DFF>(F, YU, (const bf16*)(ws + WS_W + WO_WDN + L * WDN_BYTES));
        if (L + 1 < DEPTH) convert_weights(F, L + 1, false);
        SEAM(pb + 9);
    }
}
#undef IN
#undef SEAM

__global__ void __launch_bounds__(NWAVES * 64, 2) fwd_kernel(Args args) {
    extern __shared__ __attribute__((aligned(16))) unsigned char lds[];
    Frame F;
    F.lds = (LAS unsigned char*)lds;
    F.MISC = (volatile LAS unsigned*)(F.lds + MISC_OFF);
    F.tid = threadIdx.x; F.lane = F.tid & 63; F.wave = __builtin_amdgcn_readfirstlane(F.tid >> 6);
    F.G = gridDim.x; { const int bx = blockIdx.x; F.vcu = (F.G % 8 == 0) ? (bx % 8) * (F.G / 8) + bx / 8 : bx; }
    F.gw = F.vcu * NWAVES + F.wave; F.NGW = F.G * NWAVES;
    F.ws = args.ws; F.ctl = (gu32*)(args.ws + WS_CTL); F.out = args.out;
    F.in = args.in;
    for (int u = F.tid; u < (LDS_BYTES - LDSCTL_OFF) / 4; u += NWAVES * 64) ((LAS unsigned*)(F.lds + LDSCTL_OFF))[u] = 0u;
    __syncthreads();
    const int lo = args.ph_lo, hi = args.ph_hi;
    XcdBarrier bar; bar.bar = (unsigned*)(F.ctl + CW_BAR); bar.x = 0; bar.st = nullptr;
    if (hi - lo > 1) bar = xcd_barrier_post((unsigned*)(F.ctl + CW_BAR), F.MISC + 8);

#define IN(k) (lo <= (k) && (k) < hi)
#define SEAM(k) do { if (IN(k) && IN((k) + 1)) xcd_barrier(bar); } while (0)
    if (IN(0)) { convert_weights(F, 0, true); p0_x_rows(F); SEAM(0); }
    layer_phases<0>(F, lo, hi, bar);
    layer_phases<1>(F, lo, hi, bar);
    if (IN(N_PHASES - 1)) final_norm(F);
}
#undef IN
#undef SEAM

#ifdef DBG_STOP
__global__ void dbg_dump(const unsigned char* ws, float* out, size_t o0, size_t o1, size_t o2, size_t o3, int n_off, int is_f32) {
    const size_t n = (size_t)M * D;
    for (size_t i = (size_t)blockIdx.x * blockDim.x + threadIdx.x; i < n; i += (size_t)gridDim.x * blockDim.x) {
        float acc = 0.f; const size_t offs[4] = {o0, o1, o2, o3};
        for (int r = 0; r < n_off; ++r) { if (is_f32) acc += ((const float*)(ws + offs[r]))[i]; else acc += __uint_as_float((unsigned)((const unsigned short*)(ws + offs[r]))[i] << 16); }
        out[i] = acc;
    }
}
#endif
extern "C" void kernel_launch(void* const* d_in, const int* in_sizes, int n_in, void* d_out, int out_size, void* d_ws, size_t ws_size, hipStream_t stream) {
    static int grid = 0;
    if (grid == 0) {
        if (n_in != 15 || in_sizes[0] != M * D || out_size != M * D || ws_size < WS_END) { fprintf(stderr, "kernel_launch: unexpected problem shape (n_in %d, in0 %d, out %d, ws %zu); nothing launched\n", n_in, n_in > 0 ? in_sizes[0] : -1, out_size, ws_size); grid = -1; return; }
        int dev = 0, cus = 0, per_cu = 0;
        if (hipGetDevice(&dev) != hipSuccess || hipDeviceGetAttribute(&cus, hipDeviceAttributeMultiprocessorCount, dev) != hipSuccess) { grid = -1; return; }
        if (hipFuncSetAttribute((const void*)fwd_kernel, hipFuncAttributeMaxDynamicSharedMemorySize, LDS_BYTES) != hipSuccess) { fprintf(stderr, "kernel_launch: hipFuncSetAttribute failed\n"); grid = -1; return; }
        if (hipOccupancyMaxActiveBlocksPerMultiprocessor(&per_cu, (const void*)fwd_kernel, NWAVES * 64, LDS_BYTES) != hipSuccess || per_cu < 1) { fprintf(stderr, "kernel_launch: occupancy query reports %d blocks per CU\n", per_cu); (void)hipGetLastError(); grid = -1; return; }
        grid = cus;
    }
    if (grid < 0) return;
    (void)hipMemsetAsync((char*)d_ws + WS_CTL, 0, CTL_ZERO_BYTES, stream);
    Args a{};
    for (int i = 0; i < 15; ++i) a.in[i] = (const float*)d_in[i];
    a.out = (float*)d_out; a.ws = (unsigned char*)d_ws;
#if MK_N_LAUNCHES == 1
    a.ph_lo = 0; a.ph_hi = N_PHASES;
    hipLaunchKernelGGL(fwd_kernel, dim3(grid), dim3(NWAVES * 64), LDS_BYTES, stream, a);
#else
#ifdef DBG_STOP
    for (int p = 0; p <= DBG_STOP; ++p) { a.ph_lo = p; a.ph_hi = p + 1; hipLaunchKernelGGL(fwd_kernel, dim3(grid), dim3(NWAVES * 64), LDS_BYTES, stream, a); }
    { const size_t offs[4] = {DBG_OFFS}; hipLaunchKernelGGL(dbg_dump, dim3(2048), dim3(256), 0, stream, (const unsigned char*)d_ws, (float*)d_out, offs[0], offs[1], offs[2], offs[3], DBG_NOFF, DBG_F32); }
#else
    for (int p = 0; p < N_PHASES; ++p) { a.ph_lo = p; a.ph_hi = p + 1; hipLaunchKernelGGL(fwd_kernel, dim3(grid), dim3(NWAVES * 64), LDS_BYTES, stream, a); }
#endif
#endif
}
```

```cpp
#include <hip/hip_runtime.h>
#include <cstdio>
#include <cstdint>

#ifndef MK_N_LAUNCHES
#define MK_N_LAUNCHES 1
#endif

namespace pg8 {
#define PG8_LAS __attribute__((address_space(3)))
typedef unsigned short bf16_t;
typedef short bf16x8 __attribute__((ext_vector_type(8)));
typedef float f32x4 __attribute__((ext_vector_type(4)));
typedef unsigned u32x4 __attribute__((ext_vector_type(4)));
typedef unsigned u32x2 __attribute__((ext_vector_type(2)));
constexpr int BM = 256, BK = 64, HALF = 128, HTB = HALF * BK * 2  , STAGE_BYTES = 8 * HTB, NXCD = 8, WGM = 8;

__host__ __device__ __forceinline__ int lds_byte(int r, int c) { const int st = (r >> 4) * 2 + (c >> 5), rr = r & 15, cc = c & 31, ob = rr * 64 + cc * 2; return st * 1024 + (ob ^ (((ob >> 9) & 1) << 5)); }
__host__ __device__ __forceinline__ void stage_rc(int b, int& R, int& C) { const int st = b / 1024, sb = b % 1024, swz = sb ^ (((sb >> 9) & 1) << 5); R = (st >> 1) * 16 + swz / 64; C = (st & 1) * 32 + (swz % 64) / 2; }
__host__ __device__ __forceinline__ int perm32(int rho) { const int n = rho >> 4, i = rho & 15; return 8 * (i >> 2) + 4 * n + (i & 3); }

struct Unit { int pm, pn; };
struct Gemm { const bf16_t* A; const bf16_t* Bt; int M, N, K, lda; };

struct StaticOrder {
    int nM, nN, nwg, G, c;
    __host__ __device__ void init(int M, int N, int G_, int c_) { nM = M / BM; nN = N / BM; nwg = nM * nN; G = G_; c = c_; }
    __host__ __device__ bool next(int i, Unit& u) const {
        const long L = (long)i * G + c; if (L >= nwg) return false;
        int wgid = (int)L; { const int q = nwg / NXCD, r = nwg % NXCD, xcd = wgid % NXCD, off = wgid / NXCD; wgid = (xcd < r ? xcd * (q + 1) : r * (q + 1) + (xcd - r) * q) + off; }
        const int nig = WGM * nN, gid = wgid / nig, fm = gid * WGM, gsz = (nM - fm) < WGM ? (nM - fm) : WGM;
        u.pm = fm + ((wgid % nig) % gsz); u.pn = (wgid % nig) / gsz; return true;
    }
    __device__ __forceinline__ void a_ready(const Unit&) const {}
    __device__ __forceinline__ void done(const Unit&) const {}
};

typedef float f32x2_t __attribute__((ext_vector_type(2))); typedef __bf16 bf16x2_t __attribute__((ext_vector_type(2)));
__device__ __forceinline__ unsigned cvt_pk_bf16(float lo, float hi) { f32x2_t v = {lo, hi}; bf16x2_t b = __builtin_convertvector(v, bf16x2_t); return __builtin_bit_cast(unsigned, b); }
__device__ __forceinline__ float bf_lo(unsigned w) { return __uint_as_float(w << 16); }
__device__ __forceinline__ float bf_hi(unsigned w) { return __uint_as_float(w & 0xffff0000u); }

__device__ __forceinline__ void wave_rstd(const float* part, int Mrows, int rowbase, int lane, float eps, float (&rs)[2]) {
#pragma unroll
    for (int ai = 0; ai < 2; ++ai) { const float* p = part + rowbase + ai * HALF + lane; float s = 0.f;
#pragma unroll
        for (int t = 0; t < 16; ++t) s += p[(size_t)t * Mrows];
        rs[ai] = 1.0f / sqrtf(s * (1.0f / 1024.0f) + eps); }
}

template <int MODE, class CFG> struct EpiB {
    static constexpr bool PERM = true, APERM = false, AFTER_DRAIN = false;
    bf16_t* O;
    const float* part;
    const bf16_t* X1; const bf16_t* X2;
    static constexpr int Mrows = 16384, ldx = 1024; static constexpr float eps = 1e-6f;
    __device__ __forceinline__ void operator()(const f32x4 (&acc)[2][2][4][2], const Unit& u, int wr, int wc, int fr, int fq) const {
        const int lane = fr + 16 * fq;
        long boff = 0; int ldc = CFG::ld0, sst = 0;
        if (u.pn >= CFG::st1) { boff = CFG::off1; ldc = CFG::ld1; sst = CFG::st1; }
        if (u.pn >= CFG::st2) { boff = CFG::off2; sst = CFG::st2; }
        if (u.pn >= CFG::st3) { boff = CFG::off3; sst = CFG::st3; }
        bf16_t* base = (bf16_t*)((char*)O + boff);
        const int col0 = (u.pn - sst) * BM + wc * 32 + 8 * fq;
        const int row0 = u.pm * BM + wr * 64 + fr;
        float rs[2] = {1.f, 1.f};
        if (MODE <= 1) wave_rstd(part, Mrows, u.pm * BM + wr * 64, lane, eps, rs);
#pragma unroll
        for (int ai = 0; ai < 2; ++ai)
#pragma unroll
            for (int m = 0; m < 4; ++m) {
                const int row = row0 + ai * HALF + m * 16;
                float r = 1.f; if (MODE <= 1) r = __shfl(rs[ai], m * 16 + fr);
                bf16_t* rowp = base + (size_t)row * ldc + col0;
#pragma unroll
                for (int bj = 0; bj < 2; ++bj) {
                    f32x4 v0 = acc[ai][bj][m][0], v1 = acc[ai][bj][m][1];
                    if (MODE <= 1) { v0 = v0 * r; v1 = v1 * r; }
                    if (MODE == 1) {
#pragma unroll
                        for (int e = 0; e < 4; ++e) { v0[e] = __builtin_amdgcn_rcpf(1.0f + __expf(-v0[e])); v1[e] = __builtin_amdgcn_rcpf(1.0f + __expf(-v1[e])); }
                    }
                    if (MODE == 2) {
                        const u32x4 x = *(const u32x4*)(X1 + (size_t)row * ldx + col0 + bj * HALF);
                        v0[0] *= bf_lo(x.x); v0[1] *= bf_hi(x.x); v0[2] *= bf_lo(x.y); v0[3] *= bf_hi(x.y);
                        v1[0] *= bf_lo(x.z); v1[1] *= bf_hi(x.z); v1[2] *= bf_lo(x.w); v1[3] *= bf_hi(x.w);
                    }
                    if (MODE == 3) {
                        const u32x4 x = *(const u32x4*)(X1 + (size_t)row * ldx + col0 + bj * HALF);
                        const u32x4 y = *(const u32x4*)(X2 + (size_t)row * ldx + col0 + bj * HALF);
                        v0[0] = bf_lo(x.x) + v0[0] * bf_lo(y.x); v0[1] = bf_hi(x.x) + v0[1] * bf_hi(y.x); v0[2] = bf_lo(x.y) + v0[2] * bf_lo(y.y); v0[3] = bf_hi(x.y) + v0[3] * bf_hi(y.y);
                        v1[0] = bf_lo(x.z) + v1[0] * bf_lo(y.z); v1[1] = bf_hi(x.z) + v1[1] * bf_hi(y.z); v1[2] = bf_lo(x.w) + v1[2] * bf_lo(y.w); v1[3] = bf_hi(x.w) + v1[3] * bf_hi(y.w);
                    }
                    u32x4 w; w.x = cvt_pk_bf16(v0[0], v0[1]); w.y = cvt_pk_bf16(v0[2], v0[3]); w.z = cvt_pk_bf16(v1[0], v1[1]); w.w = cvt_pk_bf16(v1[2], v1[3]);
                    *(u32x4*)(rowp + bj * HALF) = w;
                }
                if (MODE >= 2) asm volatile("" ::: "memory");
            }
    }
};

struct EpiRes {
    static constexpr bool PERM = false, APERM = false, AFTER_DRAIN = false;
    bf16_t* hb; float* part; int Mrows;
    __device__ __forceinline__ void operator()(const f32x4 (&acc)[2][2][4][2], const Unit& u, int wr, int wc, int fr, int fq) const {
        const int col0 = u.pn * BM + wc * 32 + 4 * fq;
        bf16_t* p0 = hb + (size_t)(u.pm * BM + wr * 64 + fr) * 1024 + col0;
        u32x2 pre[2][4][2][2];
#pragma unroll
        for (int ai = 0; ai < 2; ++ai)
#pragma unroll
            for (int m = 0; m < 4; ++m)
#pragma unroll
                for (int bj = 0; bj < 2; ++bj)
#pragma unroll
                    for (int n = 0; n < 2; ++n) pre[ai][m][bj][n] = *(const u32x2*)(p0 + (size_t)(ai * HALF + m * 16) * 1024 + bj * HALF + n * 16);
#pragma unroll
        for (int ai = 0; ai < 2; ++ai)
#pragma unroll
            for (int m = 0; m < 4; ++m) {
                const int row = u.pm * BM + ai * HALF + wr * 64 + m * 16 + fr;
                float ss = 0.f;
#pragma unroll
                for (int bj = 0; bj < 2; ++bj)
#pragma unroll
                    for (int n = 0; n < 2; ++n) {
                        const u32x2 b = pre[ai][m][bj][n]; const f32x4 a = acc[ai][bj][m][n];
                        const float o0 = bf_lo(b.x) + a[0], o1 = bf_hi(b.x) + a[1], o2 = bf_lo(b.y) + a[2], o3 = bf_hi(b.y) + a[3];
                        u32x2 w; w.x = cvt_pk_bf16(o0, o1); w.y = cvt_pk_bf16(o2, o3);
                        *(u32x2*)(p0 + (size_t)(ai * HALF + m * 16) * 1024 + bj * HALF + n * 16) = w;
                        ss += (o0 * o0 + o1 * o1) + (o2 * o2 + o3 * o3);
                    }
                ss += __shfl_xor(ss, 16); ss += __shfl_xor(ss, 32);
                if (fq == 0) part[(size_t)(u.pn * 4 + wc) * Mrows + row] = ss;
            }
    }
};

struct EpiConv {
    static constexpr bool PERM = true, APERM = true, AFTER_DRAIN = false;
    bf16_t* ACT; const float* part; const float* cw; const float* cb; float* side; PG8_LAS float* xbuf;
    static constexpr int FF = 2816, SIDE_STRIDE = 64 * 2816;
    __device__ __forceinline__ void operator()(f32x4 (&acc)[2][2][4][2], const Unit& u, int wr, int wc, int fr, int fq) const {
        const int lane = fr + 16 * fq, c0 = u.pn * 128 + wc * 32 + 8 * fq;
        float rs[2]; wave_rstd(part, 16384, u.pm * BM + wr * 64, lane, 1e-6f, rs);
#pragma unroll
        for (int ai = 0; ai < 2; ++ai)
#pragma unroll
            for (int m = 0; m < 4; ++m) { const float r = __shfl(rs[ai], 4 * fr + m);
#pragma unroll
                for (int bj = 0; bj < 2; ++bj)
#pragma unroll
                    for (int n = 0; n < 2; ++n) acc[ai][bj][m][n] = acc[ai][bj][m][n] * r; }
        PG8_LAS float* xw = xbuf + (wr * 4 + wc) * 128 + fq * 8;
        if (fr == 0) {
#pragma unroll
            for (int ai = 0; ai < 2; ++ai) { *(PG8_LAS f32x4*)(xw + (ai * 2 + 0) * 32) = acc[ai][0][0][0]; *(PG8_LAS f32x4*)(xw + (ai * 2 + 0) * 32 + 4) = acc[ai][0][0][1]; } }
        if (fr == 15) {
#pragma unroll
            for (int ai = 0; ai < 2; ++ai) { *(PG8_LAS f32x4*)(xw + (ai * 2 + 1) * 32) = acc[ai][0][3][0]; *(PG8_LAS f32x4*)(xw + (ai * 2 + 1) * 32 + 4) = acc[ai][0][3][1]; } }
        asm volatile("s_waitcnt lgkmcnt(0)" ::: "memory"); __builtin_amdgcn_s_barrier(); asm volatile("" ::: "memory");
        const PG8_LAS float* xp = xbuf + ((wr ^ 1) * 4 + wc) * 128 + fq * 8;
        f32x4 w0[2], w1[2], w2[2], bb[2];
#pragma unroll
        for (int n = 0; n < 2; ++n) { w0[n] = *(const f32x4*)(cw + c0 + 4 * n); w1[n] = *(const f32x4*)(cw + FF + c0 + 4 * n); w2[n] = *(const f32x4*)(cw + 2 * FF + c0 + 4 * n); bb[n] = *(const f32x4*)(cb + c0 + 4 * n); }
        const bool seq_first = (u.pm & 7) == 0, seq_last = (u.pm & 7) == 7;
#pragma unroll
        for (int ai = 0; ai < 2; ++ai) {
            f32x4 xprev[2], xnext[2];
#pragma unroll
            for (int n = 0; n < 2; ++n) {
                const f32x4 z = {0.f, 0.f, 0.f, 0.f};
                const f32x4 pl_same = *(const PG8_LAS f32x4*)(xp + (ai * 2 + 1) * 32 + 4 * n);
                const f32x4 pl_low = *(const PG8_LAS f32x4*)(xp + (0 * 2 + 1) * 32 + 4 * n);
                const f32x4 pf_same = *(const PG8_LAS f32x4*)(xp + (ai * 2 + 0) * 32 + 4 * n);
                const f32x4 pf_high = *(const PG8_LAS f32x4*)(xp + (1 * 2 + 0) * 32 + 4 * n);
                xprev[n] = (wr == 1) ? pl_same : (ai == 1 ? pl_low : z);
                xnext[n] = (wr == 0) ? pf_same : (ai == 0 ? pf_high : z);
            }
            f32x4 up[2], dn[2];
#pragma unroll
            for (int n = 0; n < 2; ++n)
#pragma unroll
                for (int e = 0; e < 4; ++e) { up[n][e] = __shfl_up(acc[ai][0][3][n][e], 1, 16); dn[n][e] = __shfl_down(acc[ai][0][0][n][e], 1, 16);
                    if (fr == 0) up[n][e] = xprev[n][e]; if (fr == 15) dn[n][e] = xnext[n][e]; }
#pragma unroll
            for (int m = 0; m < 4; ++m) {
                const int tok = ai * HALF + wr * 64 + 4 * fr + m;
                u32x4 wout; unsigned wtmp[4];
#pragma unroll
                for (int n = 0; n < 2; ++n) {
                    const f32x4 a = acc[ai][0][m][n], g = acc[ai][1][m][n];
                    const f32x4 pv = (m == 0) ? up[n] : acc[ai][0][m == 0 ? 0 : m - 1][n];
                    const f32x4 nv = (m == 3) ? dn[n] : acc[ai][0][m == 3 ? 3 : m + 1][n];
                    f32x4 v = w0[n] * pv + w1[n] * a + w2[n] * nv + bb[n];
                    if (tok == 0 && !seq_first) {
                        float* sp = side + (size_t)u.pm * FF + c0 + 4 * n; *(f32x4*)(sp + 2 * SIDE_STRIDE) = v; *(f32x4*)(sp + 3 * SIDE_STRIDE) = g; }
                    if (tok == 255 && !seq_last) {
                        float* sp = side + (size_t)u.pm * FF + c0 + 4 * n; *(f32x4*)(sp + 4 * SIDE_STRIDE) = v; *(f32x4*)(sp + 5 * SIDE_STRIDE) = g; }
                    if (tok == 0) *(f32x4*)(side + (size_t)u.pm * FF + c0 + 4 * n) = a;
                    if (tok == 255) *(f32x4*)(side + SIDE_STRIDE + (size_t)u.pm * FF + c0 + 4 * n) = a;
                    float o[4];
#pragma unroll
                    for (int e = 0; e < 4; ++e) { const float x = v[e]; o[e] = x * __builtin_amdgcn_rcpf(1.0f + __builtin_amdgcn_exp2f(x * (-2.3022082f + -0.10294324f * x * x))) * g[e]; }
                    wtmp[2 * n] = cvt_pk_bf16(o[0], o[1]); wtmp[2 * n + 1] = cvt_pk_bf16(o[2], o[3]);
                }
                wout.x = wtmp[0]; wout.y = wtmp[1]; wout.z = wtmp[2]; wout.w = wtmp[3];
                *(u32x4*)(ACT + (size_t)(u.pm * BM + tok) * FF + c0) = wout;
            }
        }
    }
};

template <class Epi, int GN, int GK, int GLDA, bool ALIGN_EPI = false, bool SP2 = false>
__device__ __forceinline__ void gemm_phase(PG8_LAS unsigned char* lds, const bf16_t* gA, const bf16_t* gBt, int G_, int c_, const Epi& E) {
    struct { const bf16_t* A; const bf16_t* Bt; int K, lda; } g{gA, gBt, GK, GLDA};
    StaticOrder S; S.nM = 16384 / BM; S.nN = GN / BM; S.nwg = S.nM * S.nN; S.G = G_; S.c = c_;
    int tid_ = threadIdx.x; asm volatile("" : "+v"(tid_));
    const int tid = tid_, wid = __builtin_amdgcn_readfirstlane(tid >> 6), lane = tid & 63, wr = wid >> 2, wc = wid & 3, fr = lane & 15, fq = lane >> 4;
    const int K = g.K, nt = K / BK, lda = g.lda;
    unsigned voffA[2], voffB[2];
#pragma unroll
    for (int i = 0; i < 2; ++i) { int R, C; stage_rc(tid * 16 + i * 8192, R, C); const int Rb = Epi::PERM ? ((R & ~31) + perm32(R & 31)) : R;
        const int Ra = Epi::APERM ? ((R & 64) + 4 * (R & 15) + ((R >> 4) & 3)) : R;
        voffA[i] = (unsigned)(Ra * lda + C) * 2u; voffB[i] = (unsigned)(Rb * K + C) * 2u; }
    const size_t kstep = (size_t)(BK * 2);
    const size_t hstepA = (size_t)HALF * lda * 2, hstepB = (size_t)HALF * K * 2;
    const size_t tstepA = 2 * hstepA, tstepB = 2 * hstepB;
    const unsigned ldsw = (unsigned)wid * 1024u;
    const int aoff = lds_byte(wr * 64 + fr, fq * 8), boff = lds_byte(wc * 32 + fr, fq * 8);
#define PG8_SA(b, h) (((b) * 2 + (h)) * HTB)
#define PG8_SB(b, h) ((4 + (b) * 2 + (h)) * HTB)
#define PG8_STAGE(bufoff, gbase, voff) do { _Pragma("unroll") for (int _i = 0; _i < 2; ++_i) \
        __builtin_amdgcn_global_load_lds((const unsigned*)((const char*)(gbase) + (voff)[_i]), (PG8_LAS unsigned*)(lds + (bufoff) + ldsw + _i * 8192), 16, 0, 0); } while (0)
#define PG8_LDA(dst, b, h) do { _Pragma("unroll") for (int m = 0; m < 4; ++m) _Pragma("unroll") for (int k = 0; k < 2; ++k) dst[m][k] = *(const PG8_LAS bf16x8*)(lds + PG8_SA(b, h) + aoff + m * 2048 + k * 1024); } while (0)
#define PG8_LDB(dst, b, h) do { _Pragma("unroll") for (int n = 0; n < 2; ++n) _Pragma("unroll") for (int k = 0; k < 2; ++k) dst[n][k] = *(const PG8_LAS bf16x8*)(lds + PG8_SB(b, h) + boff + n * 2048 + k * 1024); } while (0)
#define PG8_MMA(ai, bj, At, Bt) do { __builtin_amdgcn_s_setprio(1); _Pragma("unroll") for (int m = 0; m < 4; ++m) _Pragma("unroll") for (int n = 0; n < 2; ++n) _Pragma("unroll") for (int k = 0; k < 2; ++k) \
        acc[ai][bj][m][n] = __builtin_amdgcn_mfma_f32_16x16x32_bf16(Bt[n][k], At[m][k], acc[ai][bj][m][n], 0, 0, 0); __builtin_amdgcn_s_setprio(0); } while (0)
#define PG8_WAIT_V(n) asm volatile("s_waitcnt vmcnt(" #n ")" ::: "memory")
#define PG8_WAIT_L(n) asm volatile("s_waitcnt lgkmcnt(" #n ")" ::: "memory")
#define PG8_BAR __builtin_amdgcn_s_barrier()
#define PG8_SCHED __builtin_amdgcn_sched_barrier(0)
    Unit cur, nxt; int ui = 0;
    if (!S.next(0, cur)) return;
    f32x4 acc[2][2][4][2];
#pragma unroll
    for (int a = 0; a < 2; ++a)
#pragma unroll
        for (int b = 0; b < 2; ++b)
#pragma unroll
            for (int m = 0; m < 4; ++m)
#pragma unroll
                for (int n = 0; n < 2; ++n) acc[a][b][m][n] = (f32x4){0.f, 0.f, 0.f, 0.f};
    bf16x8 At[4][2], B0[2][2], B1[2][2];
    const char* cA = (const char*)g.A + (size_t)cur.pm * tstepA; const char* cB = (const char*)g.Bt + (size_t)cur.pn * tstepB;
    S.a_ready(cur);
    if constexpr (SP2) {
        PG8_STAGE(PG8_SB(0, 0), cB, voffB); PG8_STAGE(PG8_SB(0, 1), cB + hstepB, voffB); PG8_STAGE(PG8_SA(0, 0), cA, voffA); PG8_STAGE(PG8_SA(0, 1), cA + hstepA, voffA);
        if (wr == 1) PG8_BAR;
        PG8_WAIT_V(2); PG8_BAR;
        PG8_STAGE(PG8_SB(1, 0), cB + kstep, voffB); PG8_STAGE(PG8_SA(1, 0), cA + kstep, voffA); PG8_STAGE(PG8_SB(1, 1), cB + hstepB + kstep, voffB);
        PG8_WAIT_V(6); PG8_BAR;
    } else {
        PG8_STAGE(PG8_SB(0, 0), cB, voffB); PG8_STAGE(PG8_SA(0, 0), cA, voffA); PG8_STAGE(PG8_SB(0, 1), cB + hstepB, voffB); PG8_STAGE(PG8_SA(0, 1), cA + hstepA, voffA);
        if (wr == 1) PG8_BAR;
        PG8_WAIT_V(4); PG8_BAR;
        PG8_STAGE(PG8_SB(1, 0), cB + kstep, voffB); PG8_STAGE(PG8_SA(1, 0), cA + kstep, voffA); PG8_STAGE(PG8_SB(1, 1), cB + hstepB + kstep, voffB);
        PG8_WAIT_V(6); PG8_BAR;
    }
    for (;;) {
        const bool has_next = S.next(ui + 1, nxt);
        const char* nA = has_next ? (const char*)g.A + (size_t)nxt.pm * tstepA : cA; const char* nB = has_next ? (const char*)g.Bt + (size_t)nxt.pn * tstepB : cB;
        for (int t = 0; t < nt; t += 2) {
            const bool last = (t == nt - 2);
            const char* a1 = cA + (size_t)(t + 1) * kstep;
            const char* a2 = last ? nA : cA + (size_t)(t + 2) * kstep; const char* b2 = last ? nB : cB + (size_t)(t + 2) * kstep;
            const char* a3 = a2 + kstep; const char* b3 = b2 + kstep;
            if (last && has_next) S.a_ready(nxt);
            if constexpr (SP2) {
            PG8_LDB(B0, 0, 0); PG8_LDB(B1, 0, 1); PG8_SCHED; PG8_LDA(At, 0, 0); PG8_STAGE(PG8_SA(1, 1), a1 + hstepA, voffA);
            PG8_WAIT_V(8); PG8_WAIT_L(0); PG8_BAR; PG8_MMA(0, 0, At, B0); PG8_MMA(0, 1, At, B1); PG8_BAR; PG8_SCHED;
            PG8_LDA(At, 0, 1); PG8_STAGE(PG8_SB(0, 0), b2, voffB); PG8_STAGE(PG8_SB(0, 1), b2 + hstepB, voffB); PG8_STAGE(PG8_SA(0, 0), a2, voffA);
            PG8_WAIT_V(8); PG8_WAIT_L(0); PG8_BAR; PG8_MMA(1, 0, At, B0); PG8_MMA(1, 1, At, B1); PG8_BAR; PG8_SCHED;
            PG8_LDB(B0, 1, 0); PG8_LDB(B1, 1, 1); PG8_SCHED; PG8_LDA(At, 1, 0); PG8_STAGE(PG8_SA(0, 1), a2 + hstepA, voffA);
            PG8_WAIT_V(8); PG8_WAIT_L(0); PG8_BAR; PG8_MMA(0, 0, At, B0); PG8_MMA(0, 1, At, B1); PG8_BAR; PG8_SCHED;
            PG8_LDA(At, 1, 1); PG8_STAGE(PG8_SB(1, 0), b3, voffB); PG8_STAGE(PG8_SB(1, 1), b3 + hstepB, voffB); PG8_STAGE(PG8_SA(1, 0), a3, voffA);
            PG8_WAIT_V(8); PG8_WAIT_L(0); PG8_BAR; PG8_MMA(1, 0, At, B0); PG8_MMA(1, 1, At, B1); PG8_BAR; PG8_SCHED;
            } else {
            PG8_LDB(B0, 0, 0); PG8_SCHED; PG8_LDA(At, 0, 0); PG8_STAGE(PG8_SA(1, 1), a1 + hstepA, voffA);
            PG8_WAIT_L(8); PG8_BAR; PG8_WAIT_L(0); PG8_MMA(0, 0, At, B0); PG8_BAR; PG8_SCHED;
            PG8_LDB(B1, 0, 1); PG8_STAGE(PG8_SB(0, 0), b2, voffB);
            PG8_BAR; PG8_WAIT_L(0); PG8_MMA(0, 1, At, B1); PG8_BAR;
            PG8_LDA(At, 0, 1); PG8_STAGE(PG8_SA(0, 0), a2, voffA);
            PG8_BAR; PG8_WAIT_L(0); PG8_MMA(1, 0, At, B0); PG8_BAR; PG8_SCHED;
            PG8_STAGE(PG8_SB(0, 1), b2 + hstepB, voffB);
            PG8_WAIT_V(6); PG8_BAR; PG8_MMA(1, 1, At, B1); PG8_BAR;
            PG8_LDB(B0, 1, 0); PG8_SCHED; PG8_LDA(At, 1, 0); PG8_STAGE(PG8_SA(0, 1), a2 + hstepA, voffA);
            PG8_WAIT_L(8); PG8_BAR; PG8_WAIT_L(0); PG8_MMA(0, 0, At, B0); PG8_BAR; PG8_SCHED;
            PG8_LDB(B1, 1, 1); PG8_STAGE(PG8_SB(1, 0), b3, voffB);
            PG8_BAR; PG8_WAIT_L(0); PG8_MMA(0, 1, At, B1); PG8_BAR;
            PG8_LDA(At, 1, 1); PG8_STAGE(PG8_SA(1, 0), a3, voffA);
            PG8_BAR; PG8_WAIT_L(0); PG8_MMA(1, 0, At, B0); PG8_BAR; PG8_SCHED;
            PG8_STAGE(PG8_SB(1, 1), b3 + hstepB, voffB);
            PG8_WAIT_V(6); PG8_BAR; PG8_MMA(1, 1, At, B1); PG8_BAR;
            }
        }
        if constexpr (ALIGN_EPI) { if (wr == 0) PG8_BAR; }
        if constexpr (!Epi::AFTER_DRAIN) { E(acc, cur, wr, wc, fr, fq); S.done(cur); }
        if (!has_next) break;
#pragma unroll
        for (int a = 0; a < 2; ++a)
#pragma unroll
            for (int b = 0; b < 2; ++b)
#pragma unroll
                for (int m = 0; m < 4; ++m)
#pragma unroll
                    for (int n = 0; n < 2; ++n) acc[a][b][m][n] = (f32x4){0.f, 0.f, 0.f, 0.f};
        cur = nxt; cA = nA; cB = nB; ++ui;
        if constexpr (ALIGN_EPI) { if (wr == 1) PG8_BAR; }
    }
    PG8_WAIT_V(0);
    if constexpr (!ALIGN_EPI) { if (wr == 0) PG8_BAR; }
    PG8_BAR;
#undef PG8_SA
#undef PG8_SB
#undef PG8_STAGE
#undef PG8_LDA
#undef PG8_LDB
#undef PG8_MMA
#undef PG8_WAIT_V
#undef PG8_WAIT_L
#undef PG8_BAR
#undef PG8_SCHED
}

struct UnitD { const char* A; const char* Bt; int nt, lda, K; int pm, pn, sub; };
template <class Prog>
__device__ __forceinline__ void gemm_stream(PG8_LAS unsigned char* lds, const Prog& P) {
    int tid_ = threadIdx.x; asm volatile("" : "+v"(tid_));
    const int tid = tid_, wid = __builtin_amdgcn_readfirstlane(tid >> 6), lane = tid & 63, wr = wid >> 2, wc = wid & 3, fr = lane & 15, fq = lane >> 4;
    int Rr[2], Cc[2], Rb[2];
#pragma unroll
    for (int i = 0; i < 2; ++i) { int R, C; stage_rc(tid * 16 + i * 8192, R, C); Rr[i] = R; Cc[i] = C; Rb[i] = (R & ~31) + perm32(R & 31); }
    const size_t kstep = (size_t)(BK * 2);
    const unsigned ldsw = (unsigned)wid * 1024u;
    const int aoff = lds_byte(wr * 64 + fr, fq * 8), boff = lds_byte(wc * 32 + fr, fq * 8);
#define PG8_SA(b, h) (((b) * 2 + (h)) * HTB)
#define PG8_SB(b, h) ((4 + (b) * 2 + (h)) * HTB)
#define PG8_STAGE(bufoff, gbase, voff) do { _Pragma("unroll") for (int _i = 0; _i < 2; ++_i) \
        __builtin_amdgcn_global_load_lds((const unsigned*)((const char*)(gbase) + (voff)[_i]), (PG8_LAS unsigned*)(lds + (bufoff) + ldsw + _i * 8192), 16, 0, 0); } while (0)
#define PG8_LDA(dst, b, h) do { _Pragma("unroll") for (int m = 0; m < 4; ++m) _Pragma("unroll") for (int k = 0; k < 2; ++k) dst[m][k] = *(const PG8_LAS bf16x8*)(lds + PG8_SA(b, h) + aoff + m * 2048 + k * 1024); } while (0)
#define PG8_LDB(dst, b, h) do { _Pragma("unroll") for (int n = 0; n < 2; ++n) _Pragma("unroll") for (int k = 0; k < 2; ++k) dst[n][k] = *(const PG8_LAS bf16x8*)(lds + PG8_SB(b, h) + boff + n * 2048 + k * 1024); } while (0)
#define PG8_MMA(ai, bj, At, Bt) do { __builtin_amdgcn_s_setprio(1); _Pragma("unroll") for (int m = 0; m < 4; ++m) _Pragma("unroll") for (int n = 0; n < 2; ++n) _Pragma("unroll") for (int k = 0; k < 2; ++k) \
        acc[ai][bj][m][n] = __builtin_amdgcn_mfma_f32_16x16x32_bf16(Bt[n][k], At[m][k], acc[ai][bj][m][n], 0, 0, 0); __builtin_amdgcn_s_setprio(0); } while (0)
#define PG8_WAIT_V(n) asm volatile("s_waitcnt vmcnt(" #n ")" ::: "memory")
#define PG8_WAIT_L(n) asm volatile("s_waitcnt lgkmcnt(" #n ")" ::: "memory")
#define PG8_BAR __builtin_amdgcn_s_barrier()
#define PG8_SCHED __builtin_amdgcn_sched_barrier(0)
    UnitD cur, nxt; int ui = 0;
    if (!P.get(0, cur)) return;
    f32x4 acc[2][2][4][2];
#pragma unroll
    for (int a = 0; a < 2; ++a)
#pragma unroll
        for (int b = 0; b < 2; ++b)
#pragma unroll
            for (int m = 0; m < 4; ++m)
#pragma unroll
                for (int n = 0; n < 2; ++n) acc[a][b][m][n] = (f32x4){0.f, 0.f, 0.f, 0.f};
    bf16x8 At[4][2], B0[2][2], B1[2][2];
    unsigned cvA[2], cvB[2];
#pragma unroll
    for (int i = 0; i < 2; ++i) { cvA[i] = (unsigned)(Rr[i] * cur.lda + Cc[i]) * 2u; cvB[i] = (unsigned)(Rb[i] * cur.K + Cc[i]) * 2u; }
    const char* cA = cur.A; const char* cB = cur.Bt;
    size_t chA = (size_t)HALF * cur.lda * 2, chB = (size_t)HALF * cur.K * 2;
    PG8_STAGE(PG8_SB(0, 0), cB, cvB); PG8_STAGE(PG8_SB(0, 1), cB + chB, cvB); PG8_STAGE(PG8_SA(0, 0), cA, cvA); PG8_STAGE(PG8_SA(0, 1), cA + chA, cvA);
    if (wr == 1) PG8_BAR;
    PG8_WAIT_V(2); PG8_BAR;
    PG8_STAGE(PG8_SB(1, 0), cB + kstep, cvB); PG8_STAGE(PG8_SA(1, 0), cA + kstep, cvA); PG8_STAGE(PG8_SB(1, 1), cB + chB + kstep, cvB);
    PG8_WAIT_V(6); PG8_BAR;
    for (;;) {
        const bool has_next = P.get(ui + 1, nxt);
        const char* nA = has_next ? nxt.A : cA; const char* nB = has_next ? nxt.Bt : cB;
        unsigned nvA[2], nvB[2];
#pragma unroll
        for (int i = 0; i < 2; ++i) { nvA[i] = has_next ? (unsigned)(Rr[i] * nxt.lda + Cc[i]) * 2u : cvA[i]; nvB[i] = has_next ? (unsigned)(Rb[i] * nxt.K + Cc[i]) * 2u : cvB[i]; }
        const size_t nhA = has_next ? (size_t)HALF * nxt.lda * 2 : chA, nhB = has_next ? (size_t)HALF * nxt.K * 2 : chB;
        const int nt = cur.nt;
        for (int t = 0; t < nt; t += 2) {
            const bool last = (t == nt - 2);
            const char* a1 = cA + (size_t)(t + 1) * kstep;
            const char* a2 = last ? nA : cA + (size_t)(t + 2) * kstep; const char* b2 = last ? nB : cB + (size_t)(t + 2) * kstep;
            const char* a3 = a2 + kstep; const char* b3 = b2 + kstep;
            unsigned vA2[2], vB2[2];
#pragma unroll
            for (int i = 0; i < 2; ++i) { vA2[i] = last ? nvA[i] : cvA[i]; vB2[i] = last ? nvB[i] : cvB[i]; }
            const size_t hA2 = last ? nhA : chA, hB2 = last ? nhB : chB;
            PG8_LDB(B0, 0, 0); PG8_LDB(B1, 0, 1); PG8_SCHED; PG8_LDA(At, 0, 0); PG8_STAGE(PG8_SA(1, 1), a1 + chA, cvA);
            PG8_WAIT_V(8); PG8_WAIT_L(0); PG8_BAR; PG8_MMA(0, 0, At, B0); PG8_MMA(0, 1, At, B1); PG8_BAR; PG8_SCHED;
            PG8_LDA(At, 0, 1); PG8_STAGE(PG8_SB(0, 0), b2, vB2); PG8_STAGE(PG8_SB(0, 1), b2 + hB2, vB2); PG8_STAGE(PG8_SA(0, 0), a2, vA2);
            PG8_WAIT_V(8); PG8_WAIT_L(0); PG8_BAR; PG8_MMA(1, 0, At, B0); PG8_MMA(1, 1, At, B1); PG8_BAR; PG8_SCHED;
            PG8_LDB(B0, 1, 0); PG8_LDB(B1, 1, 1); PG8_SCHED; PG8_LDA(At, 1, 0); PG8_STAGE(PG8_SA(0, 1), a2 + hA2, vA2);
            PG8_WAIT_V(8); PG8_WAIT_L(0); PG8_BAR; PG8_MMA(0, 0, At, B0); PG8_MMA(0, 1, At, B1); PG8_BAR; PG8_SCHED;
            PG8_LDA(At, 1, 1); PG8_STAGE(PG8_SB(1, 0), b3, vB2); PG8_STAGE(PG8_SB(1, 1), b3 + hB2, vB2); PG8_STAGE(PG8_SA(1, 0), a3, vA2);
            PG8_WAIT_V(8); PG8_WAIT_L(0); PG8_BAR; PG8_MMA(1, 0, At, B0); PG8_MMA(1, 1, At, B1); PG8_BAR; PG8_SCHED;
        }
        if (wr == 0) PG8_BAR;
        P.epi(acc, cur, wr, wc, fr, fq);
        if (!has_next) break;
#pragma unroll
        for (int a = 0; a < 2; ++a)
#pragma unroll
            for (int b = 0; b < 2; ++b)
#pragma unroll
                for (int m = 0; m < 4; ++m)
#pragma unroll
                    for (int n = 0; n < 2; ++n) acc[a][b][m][n] = (f32x4){0.f, 0.f, 0.f, 0.f};
        cur = nxt; cA = nA; cB = nB; chA = nhA; chB = nhB; ++ui;
#pragma unroll
        for (int i = 0; i < 2; ++i) { cvA[i] = nvA[i]; cvB[i] = nvB[i]; }
        if (wr == 1) PG8_BAR;
    }
    PG8_WAIT_V(0);
    PG8_BAR;
#undef PG8_SA
#undef PG8_SB
#undef PG8_STAGE
#undef PG8_LDA
#undef PG8_LDB
#undef PG8_MMA
#undef PG8_WAIT_V
#undef PG8_WAIT_L
#undef PG8_BAR
#undef PG8_SCHED
}

template <int MODE> __device__ __forceinline__ void epi_bf16(const f32x4 (&acc)[2][2][4][2], int pm, int col0, int wr, int fr, int lane, bf16_t* O, int ldo, const float* part,
                                                             const bf16_t* X1, int ldx1, const bf16_t* X2, int ldx2) {
    const int row0 = pm * BM + wr * 64 + fr;
    float rs[2] = {1.f, 1.f};
    if (MODE <= 1) wave_rstd(part, 16384, pm * BM + wr * 64, lane, 1e-6f, rs);
#pragma unroll
    for (int ai = 0; ai < 2; ++ai)
#pragma unroll
        for (int m = 0; m < 4; ++m) {
            const int row = row0 + ai * HALF + m * 16;
            float r = 1.f; if (MODE <= 1) r = __shfl(rs[ai], m * 16 + fr);
#pragma unroll
            for (int bj = 0; bj < 2; ++bj) {
                f32x4 v0 = acc[ai][bj][m][0], v1 = acc[ai][bj][m][1];
                if (MODE <= 1) { v0 = v0 * r; v1 = v1 * r; }
                if (MODE == 1) {
#pragma unroll
                    for (int e = 0; e < 4; ++e) { v0[e] = __builtin_amdgcn_rcpf(1.0f + __expf(-v0[e])); v1[e] = __builtin_amdgcn_rcpf(1.0f + __expf(-v1[e])); }
                }
                if (MODE == 2 || MODE == 3) {
                    const u32x4 x = *(const u32x4*)(X1 + (size_t)row * ldx1 + col0 + bj * HALF);
                    if (MODE == 2) {
                        v0[0] *= bf_lo(x.x); v0[1] *= bf_hi(x.x); v0[2] *= bf_lo(x.y); v0[3] *= bf_hi(x.y);
                        v1[0] *= bf_lo(x.z); v1[1] *= bf_hi(x.z); v1[2] *= bf_lo(x.w); v1[3] *= bf_hi(x.w);
                    } else {
                        const u32x4 y = *(const u32x4*)(X2 + (size_t)row * ldx2 + col0 + bj * HALF);
                        v0[0] = bf_lo(x.x) + v0[0] * bf_lo(y.x); v0[1] = bf_hi(x.x) + v0[1] * bf_hi(y.x); v0[2] = bf_lo(x.y) + v0[2] * bf_lo(y.y); v0[3] = bf_hi(x.y) + v0[3] * bf_hi(y.y);
                        v1[0] = bf_lo(x.z) + v1[0] * bf_lo(y.z); v1[1] = bf_hi(x.z) + v1[1] * bf_hi(y.z); v1[2] = bf_lo(x.w) + v1[2] * bf_lo(y.w); v1[3] = bf_hi(x.w) + v1[3] * bf_hi(y.w);
                    }
                }
                u32x4 w; w.x = cvt_pk_bf16(v0[0], v0[1]); w.y = cvt_pk_bf16(v0[2], v0[3]); w.z = cvt_pk_bf16(v1[0], v1[1]); w.w = cvt_pk_bf16(v1[2], v1[3]);
                *(u32x4*)(O + (size_t)row * ldo + col0 + bj * HALF) = w;
            }
            if (MODE >= 2) asm volatile("" ::: "memory");
        }
}
}

#ifndef PG8_SP2
#define PG8_SP2 true
#endif
#ifndef PG8_ALIGN
#define PG8_ALIGN true
#endif

constexpr int NWAVES = 8;
constexpr int BATCH = 8, S = 2048, D = 1024, DEPTH = 2;
constexpr int M = BATCH * S;
constexpr int NIN = 7680, NUQKV = 5632, NGATE = 2048, AW = 1536, AO = 512, DFF = 2816, NUP = 5632, HD = 128;
constexpr float EPS = 1e-6f;
constexpr int N_PHASES = 2 + 10 * DEPTH;

constexpr size_t MiB = 1u << 20;
constexpr size_t WS_CTL = 0, CTL_ZERO_BYTES = 64 * 1024;
constexpr size_t WS_PART = 1 * MiB;
constexpr size_t WS_LSE = 2 * MiB;
constexpr size_t WS_W = 4 * MiB;
constexpr size_t WO_WIN = 0, WO_WC = 15 * MiB, WO_WB = 17 * MiB, WO_WO = 18 * MiB, WO_WUP = 20 * MiB, WO_WDN = 31 * MiB, WDN_BYTES = (size_t)D * DFF * 2;
constexpr size_t WS_HB = 46 * MiB;
constexpr size_t WS_Y = 78 * MiB;
constexpr size_t Y_U = 0, Y_Q = 32 * MiB, Y_K = 80 * MiB, Y_V = 128 * MiB;
constexpr size_t WS_END = 254 * MiB;
static_assert(WO_WDN + 2 * WDN_BYTES <= 42 * MiB && WS_W + 42 * MiB <= WS_HB && WS_HB + 32 * MiB <= WS_Y && WS_Y + 176 * MiB <= WS_END, "d_ws map");
constexpr int CW_BAR = 1024;

constexpr int RING_OFF = 0, RING_BYTES = 131072;
constexpr int LDSCTL_OFF = RING_BYTES, MISC_OFF = LDSCTL_OFF + 320;
constexpr int LDS_BYTES = 147456;

#define GAS __attribute__((address_space(1)))
#define LAS __attribute__((address_space(3)))
typedef unsigned short bf16;
typedef unsigned v4u __attribute__((ext_vector_type(4)));
typedef unsigned v2u __attribute__((ext_vector_type(2)));
typedef float f32x4 __attribute__((ext_vector_type(4)));
typedef GAS unsigned gu32;
#define RLX_AGENT __ATOMIC_RELAXED, __HIP_MEMORY_SCOPE_AGENT
#define LDS_WAIT() asm volatile("s_waitcnt lgkmcnt(0)" ::: "memory")
#define VM_WAIT() asm volatile("s_waitcnt vmcnt(0)" ::: "memory")
__device__ __forceinline__ unsigned f2bf(float f) { unsigned u = __builtin_bit_cast(unsigned, f); return (u + 0x7fffu + ((u >> 16) & 1u)) >> 16; }
__device__ __forceinline__ unsigned pk2(float lo, float hi) { return f2bf(lo) | (f2bf(hi) << 16); }
__device__ __forceinline__ float bflo(unsigned w) { return __uint_as_float(w << 16); }
__device__ __forceinline__ float bfhi(unsigned w) { return __uint_as_float(w & 0xffff0000u); }

#define XB_TMO      128
#define XB_XCNT(j)  (256  + 64 * (j))
#define XB_XSUB(j)  (1280 + 64 * (j))
#define XB_XGEN(j)  (2304 + 64 * (j))
#define XB_TOP      3328
#define XB_TOPGEN   3392
#define XCD_BAR_WORDS 3456
#define XB_SPIN_CAP (1u << 18)
static_assert((CW_BAR + XCD_BAR_WORDS) * 4 <= (int)CTL_ZERO_BYTES, "barrier words inside the zeroed region");

__device__ __forceinline__ unsigned xb_ld(unsigned* p)              { return __hip_atomic_load(p, __ATOMIC_RELAXED, __HIP_MEMORY_SCOPE_AGENT); }
__device__ __forceinline__ unsigned xb_add(unsigned* p, unsigned v) { return __hip_atomic_fetch_add(p, v, __ATOMIC_RELAXED, __HIP_MEMORY_SCOPE_AGENT); }
__device__ __forceinline__ unsigned xb_xcc_id() { return (unsigned)__builtin_amdgcn_s_getreg((3 << 11) | 20) & 0xFu; }
#define XB_SPIN(cond, bar) do { unsigned _sp = 0; while (cond) { __builtin_amdgcn_s_sleep(1); \
    if ((++_sp & 255u) == 0u) { if (xb_ld(&(bar)[XB_TMO])) break; if (_sp > XB_SPIN_CAP) { atomicAdd(&(bar)[XB_TMO], 1u); break; } } } } while (0)

struct XcdBarrier { unsigned* bar; unsigned x; volatile LAS unsigned* st; };

__device__ __forceinline__ XcdBarrier xcd_barrier_post(unsigned* bar, volatile LAS unsigned* st) {
    XcdBarrier b; b.bar = bar; b.x = xb_xcc_id(); b.st = st;
    if (threadIdx.x == 0) (void)xb_add(&bar[XB_XCNT(b.x)], 1u);
    return b;
}
__device__ __forceinline__ void xcd_barrier_complete(unsigned* bar, unsigned x, unsigned& nloc, unsigned& nx) {
    const unsigned G = gridDim.x * gridDim.y * gridDim.z;
    unsigned sum, cnt, mine, sp = 0u;
    for (;;) {
        sum = 0u; cnt = 0u; mine = 0u;
#pragma unroll
        for (unsigned j = 0; j < 16; ++j) { const unsigned c = xb_ld(&bar[XB_XCNT(j)]); sum += c; cnt += (c > 0u) ? 1u : 0u; mine = (j == x) ? c : mine; }
        if (sum == G) break;
        __builtin_amdgcn_s_sleep(1);
        if ((++sp & 255u) == 0u) { if (xb_ld(&bar[XB_TMO])) break; if (sp > XB_SPIN_CAP) { atomicAdd(&bar[XB_TMO], 1u); break; } }
    }
    nloc = mine > 0u ? mine : 1u; nx = cnt > 0u ? cnt : 1u;
}
__device__ __forceinline__ void xcd_barrier(const XcdBarrier& b) {
    asm volatile("s_waitcnt vmcnt(0)" ::: "memory");
    __syncthreads();
    if (threadIdx.x == 0) {
        unsigned* bar = b.bar; unsigned bx_ = b.x; asm volatile("" : "+s"(bar), "+s"(bx_));
        __builtin_amdgcn_s_waitcnt(0);
        unsigned nloc = b.st[0], nx = b.st[1];
        if (nloc == 0u) { xcd_barrier_complete(bar, bx_, nloc, nx); b.st[0] = nloc; b.st[1] = nx; }
        const unsigned old = xb_add(&bar[XB_XSUB(bx_)], 1u);
        const unsigned gen = old / nloc;
        if (old + 1u == (gen + 1u) * nloc) {
            __builtin_amdgcn_fence(__ATOMIC_RELEASE, "agent");
            asm volatile("s_waitcnt vmcnt(0)" ::: "memory");
            const unsigned og = xb_add(&bar[XB_TOP], 1u);
            const unsigned tg = og / nx;
            if (og + 1u == (tg + 1u) * nx) xb_add(&bar[XB_TOPGEN], 1u);
            else XB_SPIN(xb_ld(&bar[XB_TOPGEN]) == tg, bar);
            __builtin_amdgcn_fence(__ATOMIC_ACQUIRE, "agent");
            xb_add(&bar[XB_XGEN(bx_)], 1u);
            asm volatile("s_waitcnt vmcnt(0)" ::: "memory");
        } else {
            XB_SPIN(xb_ld(&bar[XB_XGEN(bx_)]) == gen, bar);
            __builtin_amdgcn_fence(__ATOMIC_ACQUIRE, "agent");
            asm volatile("s_waitcnt vmcnt(0)" ::: "memory");
        }
    }
    __syncthreads();
}

struct Frame {
    LAS unsigned char* lds;
    volatile LAS unsigned* MISC;
    gu32* ctl;
    int tid, lane, wave;
    int vcu, G;
    int gw, NGW;
    unsigned char* ws;
    const float* const* in; float* out;
};

__device__ __forceinline__ float wave_sum(float v) {
#pragma unroll
    for (int o = 1; o < 64; o <<= 1) v += __shfl_xor(v, o);
    return v;
}
__device__ __forceinline__ float wave_max(float v) {
#pragma unroll
    for (int o = 1; o < 64; o <<= 1) v = fmaxf(v, __shfl_xor(v, o));
    return v;
}

template <bool UPDN = false> __device__ __forceinline__ void p0_transpose_item(const float* W, const float* gain, int K, int N, bf16* WT, LAS float* scr, int item, int lane) {
    const int nblk = N / 32, kb = item / nblk, nb = item % nblk, k0 = 64 * kb, n0 = 32 * nb;
    const int d0 = UPDN ? (n0 < DFF ? (n0 >> 7) * 256 + (n0 & 127) : ((n0 - DFF) >> 7) * 256 + 128 + ((n0 - DFF) & 127)) : n0;
    const int kr = lane >> 3, nq = lane & 7;
    f32x4 v[8]; float gs[8];
#pragma unroll
    for (int i = 0; i < 8; ++i) { v[i] = *(const GAS f32x4*)(W + (size_t)(k0 + 8 * i + kr) * N + n0 + 4 * nq); gs[i] = gain ? gain[k0 + 8 * i + kr] : 1.0f; }
#pragma unroll
    for (int i = 0; i < 8; ++i) { LAS float* d = scr + (8 * i + kr) * 33 + 4 * nq; d[0] = v[i].x * gs[i]; d[1] = v[i].y * gs[i]; d[2] = v[i].z * gs[i]; d[3] = v[i].w * gs[i]; }
    LDS_WAIT(); asm volatile("" ::: "memory");
    const int c = lane & 7;
#pragma unroll
    for (int j = 0; j < 4; ++j) { const int n = (lane >> 3) + 8 * j; const LAS float* s = scr + (8 * c) * 33 + n;
        v4u o; o.x = pk2(s[0 * 33], s[1 * 33]); o.y = pk2(s[2 * 33], s[3 * 33]); o.z = pk2(s[4 * 33], s[5 * 33]); o.w = pk2(s[6 * 33], s[7 * 33]);
        *(GAS v4u*)(WT + (size_t)(d0 + n) * K + k0 + 8 * c) = o; }
    LDS_WAIT(); asm volatile("" ::: "memory");
}

__device__ __forceinline__ void convert_weights(Frame& F, int l, bool with_down) {
    LAS float* scr = (LAS float*)(F.lds + RING_OFF + F.wave * 16384);
    unsigned char* wb = F.ws + WS_W;
    const float* w_in = F.in[1] + (size_t)l * D * NIN; const float* w_b = F.in[5] + (size_t)l * AO * D; const float* w_o = F.in[6] + (size_t)l * D * D;
    const float* w_up = F.in[9] + (size_t)l * D * NUP; const float* n1 = F.in[7] + (size_t)l * D; const float* n2 = F.in[8] + (size_t)l * D;
    constexpr int I_IN = (D / 64) * (NIN / 32), I_B = (AO / 64) * (D / 32), I_O = (D / 64) * (D / 32), I_UP = (D / 64) * (NUP / 32), I_DN = (DFF / 64) * (D / 32);
    const int nitems = I_IN + I_B + I_O + I_UP + (with_down ? 2 * I_DN : 0);
    for (int it = F.gw; it < nitems; it += F.NGW) {
        int r = it;
        if (r < I_IN) { p0_transpose_item(w_in, n1, D, NIN, (bf16*)(wb + WO_WIN), scr, r, F.lane); continue; } r -= I_IN;
        if (r < I_B) { p0_transpose_item(w_b, nullptr, AO, D, (bf16*)(wb + WO_WB), scr, r, F.lane); continue; } r -= I_B;
        if (r < I_O) { p0_transpose_item(w_o, nullptr, D, D, (bf16*)(wb + WO_WO), scr, r, F.lane); continue; } r -= I_O;
        if (r < I_UP) { p0_transpose_item<true>(w_up, n2, D, NUP, (bf16*)(wb + WO_WUP), scr, r, F.lane); continue; } r -= I_UP;
        const int ll = r / I_DN; r -= ll * I_DN;
        p0_transpose_item(F.in[12] + (size_t)ll * DFF * D, nullptr, DFF, D, (bf16*)(wb + WO_WDN + ll * WDN_BYTES), scr, r, F.lane);
    }
    const float* w_pool = F.in[2] + (size_t)l * 4 * 256 * 256; const float* ps = F.in[3] + (size_t)l * D; const float* w_a = F.in[4] + (size_t)l * D * D;
    bf16* Wc = (bf16*)(wb + WO_WC);
    LAS float* As = (LAS float*)(F.lds + RING_OFF);
    LAS float* Bs = (LAS float*)(F.lds + RING_OFF + 64 * 129 * 4);
    __syncthreads();
    for (int tile = F.vcu; tile < 4 * 4 * 16; tile += F.G) {
        const int g = tile >> 6, cb = (tile >> 4) & 3, nb = tile & 15, c0 = cb * 64, n0 = nb * 64;
        float acc[8];
#pragma unroll
        for (int e = 0; e < 8; ++e) acc[e] = 0.f;
        for (int dc = 0; dc < 2; ++dc) {
            const int d0 = dc * 128;
            for (int i = F.tid; i < 64 * 128; i += NWAVES * 64) { const int c = i >> 7, d = i & 127; As[c * 129 + d] = w_pool[((size_t)g * 256 + c0 + c) * 256 + d0 + d] * ps[g * 256 + d0 + d]; }
            for (int i = F.tid; i < 128 * 64; i += NWAVES * 64) { const int d = i >> 6, n = i & 63; Bs[d * 65 + n] = w_a[(size_t)(g * 256 + d0 + d) * D + n0 + n]; }
            __syncthreads();
            const LAS float* ap = As + (F.wave * 8) * 129; const LAS float* bp = Bs + F.lane;
#pragma unroll 4
            for (int d = 0; d < 128; ++d) { const float bv = bp[d * 65];
#pragma unroll
                for (int e = 0; e < 8; ++e) acc[e] += ap[e * 129 + d] * bv; }
            __syncthreads();
        }
        v4u o; o.x = pk2(acc[0], acc[1]); o.y = pk2(acc[2], acc[3]); o.z = pk2(acc[4], acc[5]); o.w = pk2(acc[6], acc[7]);
        *(GAS v4u*)(Wc + (size_t)(n0 + F.lane) * D + g * 256 + c0 + F.wave * 8) = o;
    }
}

__device__ __forceinline__ void p0_x_rows(Frame& F) {
    const float* x = F.in[0]; bf16* hb = (bf16*)(F.ws + WS_HB); float* part = (float*)(F.ws + WS_PART);
    for (int m = F.gw; m < M; m += F.NGW) {
        const GAS f32x4* xr = (const GAS f32x4*)(x + (size_t)m * D) + F.lane;
        f32x4 v[4]; float s = 0.f;
#pragma unroll
        for (int j = 0; j < 4; ++j) { v[j] = xr[64 * j]; s += (v[j].x * v[j].x + v[j].y * v[j].y) + (v[j].z * v[j].z + v[j].w * v[j].w); }
        s = wave_sum(s);
        GAS unsigned long long* o8 = (GAS unsigned long long*)(hb + (size_t)m * D) + F.lane;
#pragma unroll
        for (int j = 0; j < 4; ++j) o8[64 * j] = (unsigned long long)pk2(v[j].x, v[j].y) | ((unsigned long long)pk2(v[j].z, v[j].w) << 32);
        if (F.lane < 16) part[(size_t)F.lane * M + m] = (F.lane == 0) ? s : 0.f;
    }
}

__device__ __forceinline__ int t5_bucket(int rel) {
    const int ret = rel > 0 ? 16 : 0; const int n = rel < 0 ? -rel : rel;
    int b;
    if (n < 8) b = n; else if (n < 15) b = 8; else if (n < 27) b = 9; else if (n < 50) b = 10; else if (n < 91) b = 11; else if (n < 166) b = 12; else if (n < 305) b = 13; else if (n < 559) b = 14; else b = 15;
    return ret + b;
}

__device__ __forceinline__ void attn_simple(Frame& F) {
    bf16* Q = (bf16*)(F.ws + WS_Y + Y_Q); const bf16* Kb = (const bf16*)(F.ws + WS_Y + Y_K); const bf16* V = (const bf16*)(F.ws + WS_Y + Y_V);
    const float* rel_bias = F.in[13];
    LAS float* qs = (LAS float*)(F.lds + RING_OFF + F.wave * 2048);
    const int lane = F.lane; const float scale = 0.08838834764831845f;
    for (int item = F.gw; item < M * 4; item += F.NGW) {
        const int tok = item >> 2, h = item & 3, b = tok >> 11, s = tok & (S - 1);
#pragma unroll
        for (int g = 0; g < 3; ++g) { const unsigned w = *(const GAS unsigned*)(Q + (size_t)tok * AW + (g * 4 + h) * HD + 2 * lane); qs[g * 128 + 2 * lane] = bflo(w); qs[g * 128 + 2 * lane + 1] = bfhi(w); }
        LDS_WAIT(); asm volatile("" ::: "memory");
        float mrun = -1e30f, lrun = 0.f, o0 = 0.f, o1 = 0.f;
#pragma unroll 1
        for (int g = 0; g < 3; ++g) {
            const int dl = 1 << (2 * g), head = g * 4 + h;
            float sc[3];
#pragma unroll
            for (int p = 0; p < 3; ++p) {
                const int jj = lane + 64 * p, j = jj - 64, pos = s + dl * j;
                const bool valid = (jj <= 128) && pos >= 0 && pos < S;
                float dot = 0.f;
                if (valid) {
                    const bf16* krow = Kb + ((size_t)b * S + pos) * AW + head * HD;
#pragma unroll 4
                    for (int c = 0; c < 16; ++c) { const v4u kv = *(const GAS v4u*)(krow + 8 * c); const LAS float* qq = qs + g * 128 + 8 * c;
                        dot += bflo(kv.x) * qq[0] + bfhi(kv.x) * qq[1] + bflo(kv.y) * qq[2] + bfhi(kv.y) * qq[3] + bflo(kv.z) * qq[4] + bfhi(kv.z) * qq[5] + bflo(kv.w) * qq[6] + bfhi(kv.w) * qq[7]; }
                }
                const float bias = (jj <= 128) ? rel_bias[t5_bucket(dl * j) * 12 + head] : 0.f;
                sc[p] = valid ? dot * scale + bias : -1e30f;
            }
            const float gmax = wave_max(fmaxf(fmaxf(sc[0], sc[1]), sc[2]));
            const float mnew = fmaxf(mrun, gmax);
            const float alpha = __expf(mrun - mnew);
            float pr[3];
#pragma unroll
            for (int p = 0; p < 3; ++p) pr[p] = (sc[p] > -1e29f) ? __expf(sc[p] - mnew) : 0.f;
            const float psum = wave_sum(pr[0] + pr[1] + pr[2]);
            lrun = lrun * alpha + psum; o0 *= alpha; o1 *= alpha; mrun = mnew;
#pragma unroll 1
            for (int jj = 0; jj <= 128; ++jj) {
                const int pos = s + dl * (jj - 64);
                if (pos < 0 || pos >= S) continue;
                const float pj = __shfl(jj < 64 ? pr[0] : (jj < 128 ? pr[1] : pr[2]), jj & 63);
                const unsigned w = *(const GAS unsigned*)(V + ((size_t)b * S + pos) * AW + head * HD + 2 * lane);
                o0 += pj * bflo(w); o1 += pj * bfhi(w);
            }
        }
        const float inv = 1.0f / lrun;
        *(GAS unsigned*)(Q + (size_t)tok * AW + h * HD + 2 * lane) = pk2(o0 * inv, o1 * inv);
        LDS_WAIT(); asm volatile("" ::: "memory");
    }
}

namespace att {
typedef short bf16x8 __attribute__((ext_vector_type(8)));
typedef short s16x4 __attribute__((ext_vector_type(4)));
typedef float f32x16 __attribute__((ext_vector_type(16)));
__device__ __forceinline__ unsigned off_b(unsigned row, unsigned ch) { return 256u * row + 16u * (ch ^ (((row & 3u) << 2) | ((row >> 2) & 3u))); }
__device__ __forceinline__ s16x4 vtr(const LAS unsigned char* p) { return __builtin_bit_cast(s16x4, __builtin_amdgcn_ds_read_tr16_b64_v4i16((LAS s16x4*)p)); }
constexpr int N_UNITS = BATCH * 3 * 2 * 16;
constexpr int BIAS_OFF = RING_BYTES + 8192;
}
__device__ __forceinline__ void attn_mfma(Frame& F) {
    using namespace att;
    bf16* Q = (bf16*)(F.ws + WS_Y + Y_Q); const bf16* Kg = (const bf16*)(F.ws + WS_Y + Y_K); const bf16* Vg = (const bf16*)(F.ws + WS_Y + Y_V);
    float* LSE = (float*)(F.ws + WS_LSE); const float* rel_bias = F.in[13];
    const int lane = F.lane, wave = F.wave, half = wave >> 2, j = wave & 3, ql = lane & 31, hh = lane >> 5, th = F.tid & 255;
    const float LOG2E = 1.4426950408889634f, CS = 0.08838834764831845f * 1.4426950408889634f;
    LAS unsigned char* hb = F.lds + RING_OFF + half * 65536;
    LAS float* btab = (LAS float*)(F.lds + BIAS_OFF + half * 2048);
    const int u_lo = F.vcu, ustep = F.G;
    if (u_lo >= N_UNITS) return;
#define ATT_DECODE(u_, sh_, m0_, hd_, hl_, g_, tb_) do { const int t16_ = (u_) & 15, rest_ = (u_) >> 4, hp_ = rest_ & 1; g_ = (rest_ >> 1) % 3; const int b_ = rest_ / 6; sh_ = 2 * g_; \
        const int r_ = (g_ == 0) ? 0 : (g_ == 1 ? (t16_ >> 2) : t16_), mt_ = (g_ == 0) ? t16_ : (g_ == 1 ? (t16_ & 3) : 0); m0_ = mt_ * 128; hl_ = hp_ * 2 + half; hd_ = g_ * 4 + hl_; tb_ = (size_t)b_ * S + r_; } while (0)
#define ATT_STAGE(tb_, sh_, m0_, hd_, kb_, buf_) do { _Pragma("unroll") for (int i = 0; i < 4; ++i) { const int row = 16 * i + 4 * j + (lane >> 4); const int mk = (m0_) - 64 + 64 * (kb_) + row; \
        const unsigned xs = (((unsigned)row & 3u) << 2) | (((unsigned)row >> 2) & 3u); \
        const size_t off = ((tb_) + ((size_t)mk << (sh_))) * AW + (hd_) * HD + (((unsigned)lane & 15u) ^ xs) * 8; \
        __builtin_amdgcn_global_load_lds((const unsigned*)(Kg + off), (LAS unsigned*)(hb + (buf_) * 16384 + 256 * (16 * i + 4 * j)), 16, 0, 0); \
        __builtin_amdgcn_global_load_lds((const unsigned*)(Vg + off), (LAS unsigned*)(hb + 32768 + (buf_) * 16384 + 256 * (16 * i + 4 * j)), 16, 0, 0); } } while (0)
#define ATT_BIAS(tab_, sh_, hd_) do { const int jrel = th - 128; float v = -1e30f; if (jrel >= -64 && jrel <= 64) v = rel_bias[t5_bucket(jrel << (sh_)) * 12 + (hd_)] * LOG2E; (tab_)[th] = v; } while (0)
    int csh, cm0, chd, chl, cg; size_t ctb;
    ATT_DECODE(u_lo, csh, cm0, chd, chl, cg, ctb);
    ATT_BIAS(btab, csh, chd);
    bf16x8 qf[8];
    { const bf16* qrow = Q + (ctb + ((size_t)(cm0 + 32 * j + ql) << csh)) * AW + chd * HD;
#pragma unroll
      for (int s2 = 0; s2 < 8; ++s2) qf[s2] = *(const GAS bf16x8*)(qrow + 16 * s2 + 8 * hh); }
    { const int kb0 = (cm0 == 0) ? 1 : 0; ATT_STAGE(ctb, csh, cm0, chd, kb0, 0); }
    __syncthreads();
    int par = 0, tbsel = 0;
#pragma unroll 1
    for (int u = u_lo; u < N_UNITS; u += ustep) {
        const bool has_next = (u + ustep < N_UNITS);
        int nsh = csh, nm0 = cm0, nhd = chd, nhl = chl, ng = cg; size_t ntb = ctb;
        if (has_next) ATT_DECODE(u + ustep, nsh, nm0, nhd, nhl, ng, ntb);
        const int L = S >> csh;
        const int kb_lo = (cm0 == 0) ? 1 : 0; int kb_hi = (L - 1 - cm0 + 64) >> 6; kb_hi = kb_hi > 3 ? 3 : kb_hi;
        const LAS float* bt = btab + tbsel * 256;
        float m_run = -1e20f, l_run = 0.f;
        f32x16 O[4];
#pragma unroll
        for (int c = 0; c < 4; ++c)
#pragma unroll
            for (int i = 0; i < 16; ++i) O[c][i] = 0.f;
#pragma unroll 1
        for (int kb = kb_lo; kb <= kb_hi; ++kb) {
            const bool lastb = (kb == kb_hi);
            if (!lastb) { ATT_STAGE(ctb, csh, cm0, chd, kb + 1, par ^ 1); }
            else if (has_next) {
                const int nkb0 = (nm0 == 0) ? 1 : 0; ATT_STAGE(ntb, nsh, nm0, nhd, nkb0, par ^ 1);
                ATT_BIAS(btab + (tbsel ^ 1) * 256, nsh, nhd);
            }
            if (kb >= (j >> 1) && kb <= (j >> 1) + 2) {
                const LAS unsigned char* kbuf = hb + par * 16384; const LAS unsigned char* vbuf = hb + 32768 + par * 16384;
                f32x16 s0, s1;
#pragma unroll
                for (int i = 0; i < 16; ++i) { s0[i] = 0.f; s1[i] = 0.f; }
#pragma unroll
                for (int s2 = 0; s2 < 8; ++s2) {
                    const bf16x8 a0 = *(const LAS bf16x8*)(kbuf + off_b((unsigned)ql, (unsigned)(2 * s2 + hh)));
                    const bf16x8 a1 = *(const LAS bf16x8*)(kbuf + off_b((unsigned)(32 + ql), (unsigned)(2 * s2 + hh)));
                    s0 = __builtin_amdgcn_mfma_f32_32x32x16_bf16(a0, qf[s2], s0, 0, 0, 0);
                    s1 = __builtin_amdgcn_mfma_f32_32x32x16_bf16(a1, qf[s2], s1, 0, 0, 0);
                    if (s2 & 1) __builtin_amdgcn_sched_barrier(0);
                }
                __builtin_amdgcn_sched_barrier(0);
                const LAS float* btl = bt + (64 * kb + 64 - 32 * j - ql + 4 * hh);
                float bmax = -1e30f;
#pragma unroll
                for (int i = 0; i < 16; ++i) {
                    const int kr = (i & 3) + 8 * (i >> 2);
                    s0[i] = fmaf(s0[i], CS, btl[kr]); s1[i] = fmaf(s1[i], CS, btl[32 + kr]);
                    bmax = fmaxf(bmax, fmaxf(s0[i], s1[i]));
                }
                bmax = fmaxf(bmax, __shfl_xor(bmax, 32));
                if (__any(bmax > m_run + 8.0f)) {
                    const float m_new = fmaxf(m_run, bmax), alpha = __builtin_amdgcn_exp2f(m_run - m_new);
                    m_run = m_new; l_run *= alpha;
#pragma unroll
                    for (int c = 0; c < 4; ++c)
#pragma unroll
                        for (int i = 0; i < 16; ++i) O[c][i] *= alpha;
                }
                float psum = 0.f;
#pragma unroll
                for (int i = 0; i < 16; ++i) { s0[i] = __builtin_amdgcn_exp2f(s0[i] - m_run); s1[i] = __builtin_amdgcn_exp2f(s1[i] - m_run); psum += s0[i] + s1[i]; }
                l_run += psum;
                v4u pk[4];
#pragma unroll
                for (int s2 = 0; s2 < 2; ++s2) {
                    pk[s2].x = pg8::cvt_pk_bf16(s0[8 * s2 + 0], s0[8 * s2 + 1]); pk[s2].y = pg8::cvt_pk_bf16(s0[8 * s2 + 2], s0[8 * s2 + 3]);
                    pk[s2].z = pg8::cvt_pk_bf16(s0[8 * s2 + 4], s0[8 * s2 + 5]); pk[s2].w = pg8::cvt_pk_bf16(s0[8 * s2 + 6], s0[8 * s2 + 7]);
                    pk[2 + s2].x = pg8::cvt_pk_bf16(s1[8 * s2 + 0], s1[8 * s2 + 1]); pk[2 + s2].y = pg8::cvt_pk_bf16(s1[8 * s2 + 2], s1[8 * s2 + 3]);
                    pk[2 + s2].z = pg8::cvt_pk_bf16(s1[8 * s2 + 4], s1[8 * s2 + 5]); pk[2 + s2].w = pg8::cvt_pk_bf16(s1[8 * s2 + 6], s1[8 * s2 + 7]);
                }
                const unsigned blk = (lane >> 4) & 1, tq = (lane & 15) >> 2, tp = lane & 3;
#pragma unroll
                for (int ks = 0; ks < 4; ++ks) {
                    const bf16x8 pb = __builtin_bit_cast(bf16x8, pk[ks]);
#pragma unroll
                    for (int c = 0; c < 4; ++c) {
                        const unsigned chn = 4 * c + 2 * blk + (tp >> 1);
                        const s16x4 lo = vtr(vbuf + off_b(16 * ks + 4 * hh + tq, chn) + 8 * (tp & 1));
                        const s16x4 hi = vtr(vbuf + off_b(16 * ks + 8 + 4 * hh + tq, chn) + 8 * (tp & 1));
                        const bf16x8 va = {lo[0], lo[1], lo[2], lo[3], hi[0], hi[1], hi[2], hi[3]};
                        O[c] = __builtin_amdgcn_mfma_f32_32x32x16_bf16(va, pb, O[c], 0, 0, 0);
                    }
                    __builtin_amdgcn_sched_barrier(0);
                }
            }
            __syncthreads();
            par ^= 1;
        }
        {
            const int mq = cm0 + 32 * j + ql; const size_t tok = ctb + ((size_t)mq << csh);
            bf16* qrow = Q + tok * AW + chd * HD;
            const float l_tot = l_run + __shfl_xor(l_run, 32);
            const float inv = 1.0f / l_tot;
#pragma unroll
            for (int c = 0; c < 4; ++c)
#pragma unroll
                for (int ip = 0; ip < 2; ++ip) {
                    unsigned ax = pg8::cvt_pk_bf16(O[c][8 * ip + 0] * inv, O[c][8 * ip + 1] * inv), ay = pg8::cvt_pk_bf16(O[c][8 * ip + 2] * inv, O[c][8 * ip + 3] * inv);
                    unsigned bx = pg8::cvt_pk_bf16(O[c][8 * ip + 4] * inv, O[c][8 * ip + 5] * inv), by = pg8::cvt_pk_bf16(O[c][8 * ip + 6] * inv, O[c][8 * ip + 7] * inv);
                    { auto r2 = __builtin_amdgcn_permlane32_swap(ax, bx, false, false); ax = r2[0]; bx = r2[1]; }
                    { auto r2 = __builtin_amdgcn_permlane32_swap(ay, by, false, false); ay = r2[0]; by = r2[1]; }
                    v4u w; w.x = ax; w.y = ay; w.z = bx; w.w = by;
                    *(GAS v4u*)(qrow + 32 * c + 16 * ip + 8 * hh) = w;
                }
            if (hh == 0) LSE[((size_t)cg * M + tok) * 4 + chl] = m_run + __log2f(l_tot);
        }
        if (has_next) {
            const bf16* qrow = Q + (ntb + ((size_t)(nm0 + 32 * j + ql) << nsh)) * AW + nhd * HD;
#pragma unroll
            for (int s2 = 0; s2 < 8; ++s2) qf[s2] = *(const GAS bf16x8*)(qrow + 16 * s2 + 8 * hh);
        }
        csh = nsh; cm0 = nm0; chd = nhd; chl = nhl; cg = ng; ctb = ntb; tbsel ^= 1;
    }
#undef ATT_DECODE
#undef ATT_STAGE
#undef ATT_BIAS
}

__device__ __forceinline__ void attn_combine(Frame& F) {
    bf16* Q = (bf16*)(F.ws + WS_Y + Y_Q); const float* LSE = (const float*)(F.ws + WS_LSE);
    const int total = M * 64;
    for (int it = F.gw * 64 + F.lane; it < total; it += F.NGW * 64) {
        const int tok = it >> 6, h = (it >> 4) & 3, ch = it & 15;
        const float l0 = LSE[((size_t)0 * M + tok) * 4 + h], l1 = LSE[((size_t)1 * M + tok) * 4 + h], l2 = LSE[((size_t)2 * M + tok) * 4 + h];
        const float mx = fmaxf(l0, fmaxf(l1, l2));
        float w0 = __builtin_amdgcn_exp2f(l0 - mx), w1 = __builtin_amdgcn_exp2f(l1 - mx), w2 = __builtin_amdgcn_exp2f(l2 - mx);
        const float inv = 1.0f / (w0 + w1 + w2); w0 *= inv; w1 *= inv; w2 *= inv;
        bf16* p = Q + (size_t)tok * AW + h * HD + ch * 8;
        const v4u a = *(const GAS v4u*)(p), b2 = *(const GAS v4u*)(p + 512), c = *(const GAS v4u*)(p + 1024);
        v4u o;
        o.x = pk2(w0 * bflo(a.x) + w1 * bflo(b2.x) + w2 * bflo(c.x), w0 * bfhi(a.x) + w1 * bfhi(b2.x) + w2 * bfhi(c.x));
        o.y = pk2(w0 * bflo(a.y) + w1 * bflo(b2.y) + w2 * bflo(c.y), w0 * bfhi(a.y) + w1 * bfhi(b2.y) + w2 * bfhi(c.y));
        o.z = pk2(w0 * bflo(a.z) + w1 * bflo(b2.z) + w2 * bflo(c.z), w0 * bfhi(a.z) + w1 * bfhi(b2.z) + w2 * bfhi(c.z));
        o.w = pk2(w0 * bflo(a.w) + w1 * bflo(b2.w) + w2 * bflo(c.w), w0 * bfhi(a.w) + w1 * bfhi(b2.w) + w2 * bfhi(c.w));
        *(GAS v4u*)(p) = o;
    }
}

__device__ __forceinline__ void pool_simple(Frame& F) {
    const bf16* U = (const bf16*)(F.ws + WS_Y + Y_U); bf16* P = (bf16*)(F.ws + WS_Y + Y_K);
    const int total = M * (D / 8);
    for (int it = F.gw * 64 + F.lane; it < total; it += F.NGW * 64) {
        const int tok = it >> 7, ch = it & 127, s = tok & (S - 1), g = ch >> 5, w = 2 << g;
        int lo = s - (w >> 1), hi = lo + w; lo = lo < 0 ? 0 : lo; hi = hi > S ? S : hi;
        const bf16* base = U + (size_t)(tok - s) * D + ch * 8;
        float a[8];
#pragma unroll
        for (int e = 0; e < 8; ++e) a[e] = 0.f;
        for (int r = lo; r < hi; ++r) { const v4u v = *(const GAS v4u*)(base + (size_t)r * D);
            a[0] += bflo(v.x); a[1] += bfhi(v.x); a[2] += bflo(v.y); a[3] += bfhi(v.y); a[4] += bflo(v.z); a[5] += bfhi(v.z); a[6] += bflo(v.w); a[7] += bfhi(v.w); }
        const float inv = 1.0f / (float)(hi - lo);
        const v4u c = *(const GAS v4u*)(base + (size_t)s * D);
        v4u o; o.x = pk2(a[0] * inv - bflo(c.x), a[1] * inv - bfhi(c.x)); o.y = pk2(a[2] * inv - bflo(c.y), a[3] * inv - bfhi(c.y));
        o.z = pk2(a[4] * inv - bflo(c.z), a[5] * inv - bfhi(c.z)); o.w = pk2(a[6] * inv - bflo(c.w), a[7] * inv - bfhi(c.w));
        *(GAS v4u*)(P + (size_t)tok * D + ch * 8) = o;
    }
}

__device__ __forceinline__ void pool_slide(Frame& F) {
    const bf16* U = (const bf16*)(F.ws + WS_Y + Y_U); bf16* P = (bf16*)(F.ws + WS_Y + Y_K);
    constexpr int T = 16; constexpr int NIT = BATCH * 4 * (S / (2 * T));
    for (int it = F.gw; it < NIT; it += F.NGW) {
        const int seg2 = it & 63, g = (it >> 6) & 3, b = it >> 8;
        const int w = 2 << g, hw = w >> 1;
        const int t0 = (seg2 * 2 + (F.lane >> 5)) * T, ch = g * 32 + (F.lane & 31);
        const bf16* base = U + (size_t)b * S * D + ch * 8; bf16* obase = P + (size_t)b * S * D + ch * 8;
        float a[8];
#pragma unroll
        for (int e = 0; e < 8; ++e) a[e] = 0.f;
        { int lo = t0 - hw, hi = lo + w; lo = lo < 0 ? 0 : lo; hi = hi > S ? S : hi;
          for (int r = lo; r < hi; ++r) { const v4u v = *(const GAS v4u*)(base + (size_t)r * D);
              a[0] += bflo(v.x); a[1] += bfhi(v.x); a[2] += bflo(v.y); a[3] += bfhi(v.y); a[4] += bflo(v.z); a[5] += bfhi(v.z); a[6] += bflo(v.w); a[7] += bfhi(v.w); } }
#pragma unroll 4
        for (int i = 0; i < T; ++i) {
            const int t = t0 + i;
            int lo = t - hw, hi = lo + w; lo = lo < 0 ? 0 : lo; hi = hi > S ? S : hi;
            const float inv = 1.0f / (float)(hi - lo);
            const v4u c = *(const GAS v4u*)(base + (size_t)t * D);
            v4u o; o.x = pk2(a[0] * inv - bflo(c.x), a[1] * inv - bfhi(c.x)); o.y = pk2(a[2] * inv - bflo(c.y), a[3] * inv - bfhi(c.y));
            o.z = pk2(a[4] * inv - bflo(c.z), a[5] * inv - bfhi(c.z)); o.w = pk2(a[6] * inv - bflo(c.w), a[7] * inv - bfhi(c.w));
            *(GAS v4u*)(obase + (size_t)t * D) = o;
            const int re = t + hw, rl = t - hw;
            if (re < S) { const v4u v = *(const GAS v4u*)(base + (size_t)re * D);
                a[0] += bflo(v.x); a[1] += bfhi(v.x); a[2] += bflo(v.y); a[3] += bfhi(v.y); a[4] += bflo(v.z); a[5] += bfhi(v.z); a[6] += bflo(v.w); a[7] += bfhi(v.w); }
            if (rl >= 0) { const v4u v = *(const GAS v4u*)(base + (size_t)rl * D);
                a[0] -= bflo(v.x); a[1] -= bfhi(v.x); a[2] -= bflo(v.y); a[3] -= bfhi(v.y); a[4] -= bflo(v.z); a[5] -= bfhi(v.z); a[6] -= bflo(v.w); a[7] -= bfhi(v.w); }
        }
    }
}

__device__ __forceinline__ float gelu_tanh(float x) {
    const float y = 0.7978845608028654f * (x + 0.044715f * x * x * x);
    const float t = 1.0f - 2.0f / (__expf(2.0f * y) + 1.0f);
    return 0.5f * x * (1.0f + t);
}
__device__ __forceinline__ void conv_simple(Frame& F, int l) {
    bf16* AG = (bf16*)(F.ws + WS_Y);
    const float* cw = F.in[10] + (size_t)l * 3 * DFF; const float* cb = F.in[11] + (size_t)l * DFF;
    constexpr int CH = DFF / 8; const int total = M * CH;
    for (int it = F.gw * 64 + F.lane; it < total; it += F.NGW * 64) {
        const int tok = it / CH, ch = it - tok * CH, s = tok & (S - 1), c0 = ch * 8;
        const bf16* ap = AG + (size_t)tok * NUP + c0;
        const v4u z = {0u, 0u, 0u, 0u};
        const v4u am = (s > 0) ? *(const GAS v4u*)(ap - NUP) : z;
        const v4u a0 = *(const GAS v4u*)(ap);
        const v4u ap1 = (s < S - 1) ? *(const GAS v4u*)(ap + NUP) : z;
        const v4u gv = *(const GAS v4u*)(ap + DFF);
        float xm[8] = {bflo(am.x), bfhi(am.x), bflo(am.y), bfhi(am.y), bflo(am.z), bfhi(am.z), bflo(am.w), bfhi(am.w)};
        float x0[8] = {bflo(a0.x), bfhi(a0.x), bflo(a0.y), bfhi(a0.y), bflo(a0.z), bfhi(a0.z), bflo(a0.w), bfhi(a0.w)};
        float xp[8] = {bflo(ap1.x), bfhi(ap1.x), bflo(ap1.y), bfhi(ap1.y), bflo(ap1.z), bfhi(ap1.z), bflo(ap1.w), bfhi(ap1.w)};
        float gg[8] = {bflo(gv.x), bfhi(gv.x), bflo(gv.y), bfhi(gv.y), bflo(gv.z), bfhi(gv.z), bflo(gv.w), bfhi(gv.w)};
        float r[8];
#pragma unroll
        for (int e = 0; e < 8; ++e) { const float v = cw[c0 + e] * xm[e] + cw[DFF + c0 + e] * x0[e] + cw[2 * DFF + c0 + e] * xp[e] + cb[c0 + e]; r[e] = gelu_tanh(v) * gg[e]; }
        v4u o; o.x = pk2(r[0], r[1]); o.y = pk2(r[2], r[3]); o.z = pk2(r[4], r[5]); o.w = pk2(r[6], r[7]);
        *(GAS v4u*)(AG + (size_t)tok * NUP + DFF + c0) = o;
    }
}

__device__ __forceinline__ void conv_slide(Frame& F, int l) {
    bf16* AG = (bf16*)(F.ws + WS_Y);
    const float* cw = F.in[10] + (size_t)l * 3 * DFF; const float* cb = F.in[11] + (size_t)l * DFF;
    constexpr int CH = DFF / 8, CW = (CH + 63) / 64, T = 16, NIT = CW * (M / T);
    const v4u z = {0u, 0u, 0u, 0u};
    for (int it = F.gw; it < NIT; it += F.NGW) {
        const int cwi = it % CW, run = it / CW, ch = cwi * 64 + F.lane;
        if (ch >= CH) continue;
        const int tok0 = run * T, s0 = tok0 & (S - 1), c0 = ch * 8;
        float w0[8], w1[8], w2[8], bb[8];
#pragma unroll
        for (int e = 0; e < 8; ++e) { w0[e] = cw[c0 + e]; w1[e] = cw[DFF + c0 + e]; w2[e] = cw[2 * DFF + c0 + e]; bb[e] = cb[c0 + e]; }
        bf16* ap = AG + (size_t)tok0 * NUP + c0;
        v4u am = (s0 > 0) ? *(const GAS v4u*)(ap - NUP) : z;
        v4u a0 = *(const GAS v4u*)(ap);
#pragma unroll 4
        for (int i = 0; i < T; ++i) {
            const v4u a1 = (s0 + i < S - 1) ? *(const GAS v4u*)(ap + (size_t)(i + 1) * NUP) : z;
            const v4u gv = *(const GAS v4u*)(ap + (size_t)i * NUP + DFF);
            const float xm[8] = {bflo(am.x), bfhi(am.x), bflo(am.y), bfhi(am.y), bflo(am.z), bfhi(am.z), bflo(am.w), bfhi(am.w)};
            const float x0[8] = {bflo(a0.x), bfhi(a0.x), bflo(a0.y), bfhi(a0.y), bflo(a0.z), bfhi(a0.z), bflo(a0.w), bfhi(a0.w)};
            const float xp[8] = {bflo(a1.x), bfhi(a1.x), bflo(a1.y), bfhi(a1.y), bflo(a1.z), bfhi(a1.z), bflo(a1.w), bfhi(a1.w)};
            const float gg[8] = {bflo(gv.x), bfhi(gv.x), bflo(gv.y), bfhi(gv.y), bflo(gv.z), bfhi(gv.z), bflo(gv.w), bfhi(gv.w)};
            float r[8];
#pragma unroll
            for (int e = 0; e < 8; ++e) { const float v = w0[e] * xm[e] + w1[e] * x0[e] + w2[e] * xp[e] + bb[e]; r[e] = gelu_tanh(v) * gg[e]; }
            v4u o; o.x = pk2(r[0], r[1]); o.y = pk2(r[2], r[3]); o.z = pk2(r[4], r[5]); o.w = pk2(r[6], r[7]);
            *(GAS v4u*)(ap + (size_t)i * NUP + DFF) = o;
            am = a0; a0 = a1;
        }
    }
}

__device__ __forceinline__ void final_norm(Frame& F) {
    const float* part = (const float*)(F.ws + WS_PART); const float* nf = F.in[14]; const bf16* hb = (const bf16*)(F.ws + WS_HB);
    for (int m = F.gw; m < M; m += F.NGW) {
        float s = 0.f;
#pragma unroll
        for (int t = 0; t < 16; ++t) s += part[(size_t)t * M + m];
        const float rstd = 1.0f / sqrtf(s * (1.0f / 1024.0f) + EPS);
        GAS f32x4* xr = (GAS f32x4*)(F.out + (size_t)m * D) + F.lane; const GAS f32x4* gr = (const GAS f32x4*)nf + F.lane; const GAS v2u* hr = (const GAS v2u*)(hb + (size_t)m * D) + F.lane;
#pragma unroll
        for (int j = 0; j < 4; ++j) { const v2u h = hr[64 * j]; const f32x4 gq = gr[64 * j]; f32x4 v = {bflo(h.x), bfhi(h.x), bflo(h.y), bfhi(h.y)}; xr[64 * j] = v * rstd * gq; }
    }
}

struct Args { const float* in[15]; float* out; unsigned char* ws; int ph_lo, ph_hi; int pad0, pad1; };

struct CfgP1 { static constexpr int st1 = 4, st2 = 10, st3 = 16, ld0 = D, ld1 = AW; static constexpr long off1 = (long)(Y_Q - Y_U), off2 = (long)(Y_K - Y_U), off3 = (long)(Y_V - Y_U); };
struct CfgGate { static constexpr int st1 = 4, st2 = 1 << 20, st3 = 1 << 20, ld0 = D, ld1 = D; static constexpr long off1 = (long)Y_U - (long)Y_V, off2 = 0, off3 = 0; };
struct CfgOne { static constexpr int st1 = 1 << 20, st2 = 1 << 20, st3 = 1 << 20, ld0 = D, ld1 = D; static constexpr long off1 = 0, off2 = 0, off3 = 0; };
struct CfgUp { static constexpr int st1 = 1 << 20, st2 = 1 << 20, st3 = 1 << 20, ld0 = NUP, ld1 = NUP; static constexpr long off1 = 0, off2 = 0, off3 = 0; };
template <int MODE, class CFG, int GN, int GK, int GLDA> __device__ __forceinline__ void run_gemm_b(Frame& F, const bf16* A, const bf16* Bt, bf16* O, const bf16* X1, const bf16* X2) {
    pg8::EpiB<MODE, CFG> E; E.O = O; E.part = (const float*)(F.ws + WS_PART); E.X1 = X1; E.X2 = X2;
    pg8::gemm_phase<pg8::EpiB<MODE, CFG>, GN, GK, GLDA, PG8_ALIGN, PG8_SP2>(F.lds + RING_OFF, A, Bt, F.G, (int)blockIdx.x, E);
}
template <int GK, int GLDA> __device__ __forceinline__ void run_gemm_r(Frame& F, const bf16* A, const bf16* Bt) {
    pg8::EpiRes E{(bf16*)(F.ws + WS_HB), (float*)(F.ws + WS_PART), M};
    pg8::gemm_phase<pg8::EpiRes, D, GK, GLDA, PG8_ALIGN, PG8_SP2>(F.lds + RING_OFF, A, Bt, F.G, (int)blockIdx.x, E);
}

constexpr size_t SIDE_OFF = 96 * MiB;
constexpr int XBUF_OFF = RING_BYTES + 4096;
__device__ __forceinline__ void conv_fixup(Frame& F, int l) {
    const float* cw = F.in[10] + (size_t)l * 3 * DFF; const float* side = (const float*)(F.ws + WS_Y + SIDE_OFF); bf16* ACT = (bf16*)(F.ws + WS_Y);
    constexpr int SS = 64 * DFF;
    pg8::StaticOrder So; So.init(M, D, F.G, (int)blockIdx.x); pg8::Unit u;
    for (int i = 0; So.next(i, u); ++i) {
        const int pm = u.pm;
        for (int t = F.tid; t < 2 * (DFF / 4); t += NWAVES * 64) {
            const int which = t / (DFF / 4), c = (t - which * (DFF / 4)) * 4;
            if (which == 0 ? ((pm & 7) == 0) : ((pm & 7) == 7)) continue;
            const f32x4 pre = *(const GAS f32x4*)(side + (size_t)(which ? 4 : 2) * SS + (size_t)pm * DFF + c);
            const f32x4 g = *(const GAS f32x4*)(side + (size_t)(which ? 5 : 3) * SS + (size_t)pm * DFF + c);
            const f32x4 nb = which ? *(const GAS f32x4*)(side + (size_t)(pm + 1) * DFF + c) : *(const GAS f32x4*)(side + SS + (size_t)(pm - 1) * DFF + c);
            const f32x4 w = *(const GAS f32x4*)(cw + (which ? 2 * DFF : 0) + c);
            float o[4];
#pragma unroll
            for (int e = 0; e < 4; ++e) { const float x = pre[e] + w[e] * nb[e]; o[e] = x * __builtin_amdgcn_rcpf(1.0f + __builtin_amdgcn_exp2f(x * (-2.3022082f + -0.10294324f * x * x))) * g[e]; }
            v2u wv; wv.x = pg8::cvt_pk_bf16(o[0], o[1]); wv.y = pg8::cvt_pk_bf16(o[2], o[3]);
            *(GAS v2u*)(ACT + (size_t)(pm * 256 + (which ? 255 : 0)) * DFF + c) = wv;
        }
    }
    VM_WAIT(); __syncthreads();
}

struct P3Prog {
    unsigned char* ws; int G, c;
    __device__ __forceinline__ bool get(int i, pg8::UnitD& u) const {
        const int it = i >> 2, sub = i & 3; const int Lw = it * G + c; if (Lw >= 256) return false;
        const int wgid = (Lw & 7) * 32 + (Lw >> 3);
        const int pm = (wgid >> 5) * 8 + (wgid & 7), pn = (wgid & 31) >> 3;
        u.pm = pm; u.pn = pn; u.sub = sub;
        const unsigned char* A; const unsigned char* Bt; int K = D, lda = D;
        if (sub <= 1) { A = ws + WS_HB; Bt = ws + WS_W + WO_WIN + (size_t)(NUQKV + sub * D) * D * 2; }
        else if (sub == 2) { A = ws + WS_Y + Y_K; Bt = ws + WS_W + WO_WC; }
        else { A = ws + WS_Y + Y_Q; Bt = ws + WS_W + WO_WB; K = AO; lda = AW; }
        u.K = K; u.lda = lda; u.nt = K / 64;
        u.A = (const char*)A + (size_t)pm * 256 * lda * 2; u.Bt = (const char*)Bt + (size_t)pn * 256 * K * 2;
        return true;
    }
    __device__ __forceinline__ void epi(const pg8::f32x4 (&acc)[2][2][4][2], const pg8::UnitD& u, int wr, int wc, int fr, int fq) const {
        const int lane = fr + 16 * fq, col0 = u.pn * 256 + wc * 32 + 8 * fq;
        bf16* SGP = (bf16*)(ws + WS_Y + Y_V); bf16* SGA = (bf16*)(ws + WS_Y + Y_U); bf16* T1 = (bf16*)(ws + WS_Y + Y_Q) + 512; const float* part = (const float*)(ws + WS_PART);
        if (u.sub == 0) pg8::epi_bf16<1>(acc, u.pm, col0, wr, fr, lane, SGP, D, part, nullptr, 0, nullptr, 0);
        else if (u.sub == 1) pg8::epi_bf16<1>(acc, u.pm, col0, wr, fr, lane, SGA, D, part, nullptr, 0, nullptr, 0);
        else if (u.sub == 2) pg8::epi_bf16<2>(acc, u.pm, col0, wr, fr, lane, T1, AW, part, SGP, D, nullptr, 0);
        else pg8::epi_bf16<3>(acc, u.pm, col0, wr, fr, lane, SGP, D, part, T1, AW, SGA, D);
    }
};

#define IN(k) (lo <= (k) && (k) < hi)
#define SEAM(k) do { if (IN(k) && IN((k) + 1)) xcd_barrier(bar); } while (0)
template <int L> __device__ __forceinline__ void layer_phases(Frame& F, int lo, int hi, const XcdBarrier& bar) {
    constexpr int pb = 1 + 10 * L;
    unsigned char* ws = F.ws;
    bf16* HB = (bf16*)(ws + WS_HB);
    bf16* YU = (bf16*)(ws + WS_Y + Y_U); bf16* YQ = (bf16*)(ws + WS_Y + Y_Q); bf16* YK = (bf16*)(ws + WS_Y + Y_K); bf16* YV = (bf16*)(ws + WS_Y + Y_V);
    bf16* W_IN = (bf16*)(ws + WS_W + WO_WIN);
    if (IN(pb + 0)) { run_gemm_b<0, CfgP1, NUQKV, D, D>(F, HB, W_IN, YU, nullptr, nullptr); SEAM(pb + 0); }
#if defined(ATTN_ORACLE)
    if (IN(pb + 1)) { attn_simple(F); SEAM(pb + 1); }
#else
    if (IN(pb + 1)) { attn_mfma(F); SEAM(pb + 1); }
#endif
#if defined(ATTN_ORACLE)
    if (IN(pb + 2)) { pool_simple(F); SEAM(pb + 2); }
#else
    if (IN(pb + 2)) { attn_combine(F); pool_slide(F); SEAM(pb + 2); }
#endif
    if (IN(pb + 3)) { P3Prog P{F.ws, F.G, (int)blockIdx.x}; pg8::gemm_stream<P3Prog>(F.lds + RING_OFF, P); if (IN(pb + 6)) xcd_barrier(bar); }
    if (IN(pb + 6)) { run_gemm_r<D, D>(F, YV, (const bf16*)(ws + WS_W + WO_WO)); SEAM(pb + 6); }
    if (IN(pb + 7)) {
        pg8::EpiConv E{YU, (const float*)(ws + WS_PART), F.in[10] + (size_t)L * 3 * DFF, F.in[11] + (size_t)L * DFF, (float*)(ws + WS_Y + SIDE_OFF), (LAS float*)(F.lds + XBUF_OFF)};
        pg8::gemm_phase<pg8::EpiConv, NUP, D, D, PG8_ALIGN, PG8_SP2>(F.lds + RING_OFF, HB, (const bf16*)(ws + WS_W + WO_WUP), F.G, (int)blockIdx.x, E);
        if (IN(pb + 9)) xcd_barrier(bar);
    }
    if (IN(pb + 9)) {
        conv_fixup(F, L);
        run_gemm_r<DFF, DFF>(F, YU, (const bf16*)(ws + WS_W + WO_WDN + L * WDN_BYTES));
        if (L + 1 < DEPTH) convert_weights(F, L + 1, false);
        SEAM(pb + 9);
    }
}
#undef IN
#undef SEAM

__global__ void __launch_bounds__(NWAVES * 64, 2) fwd_kernel(Args args) {
    extern __shared__ __attribute__((aligned(16))) unsigned char lds[];
    Frame F;
    F.lds = (LAS unsigned char*)lds;
    F.MISC = (volatile LAS unsigned*)(F.lds + MISC_OFF);
    F.tid = threadIdx.x; F.lane = F.tid & 63; F.wave = __builtin_amdgcn_readfirstlane(F.tid >> 6);
    F.G = gridDim.x; { const int bx = blockIdx.x; F.vcu = (F.G % 8 == 0) ? (bx % 8) * (F.G / 8) + bx / 8 : bx; }
    F.gw = F.vcu * NWAVES + F.wave; F.NGW = F.G * NWAVES;
    F.ws = args.ws; F.ctl = (gu32*)(args.ws + WS_CTL); F.out = args.out;
    F.in = args.in;
    for (int u = F.tid; u < (LDS_BYTES - LDSCTL_OFF) / 4; u += NWAVES * 64) ((LAS unsigned*)(F.lds + LDSCTL_OFF))[u] = 0u;
    __syncthreads();
    const int lo = args.ph_lo, hi = args.ph_hi;
    XcdBarrier bar; bar.bar = (unsigned*)(F.ctl + CW_BAR); bar.x = 0; bar.st = nullptr;
    if (hi - lo > 1) bar = xcd_barrier_post((unsigned*)(F.ctl + CW_BAR), F.MISC + 8);

#define IN(k) (lo <= (k) && (k) < hi)
#define SEAM(k) do { if (IN(k) && IN((k) + 1)) xcd_barrier(bar); } while (0)
    if (IN(0)) { convert_weights(F, 0, true); p0_x_rows(F); SEAM(0); }
    layer_phases<0>(F, lo, hi, bar);
    layer_phases<1>(F, lo, hi, bar);
    if (IN(N_PHASES - 1)) final_norm(F);
}
#undef IN
#undef SEAM

#ifdef DBG_STOP
__global__ void dbg_dump(const unsigned char* ws, float* out, size_t o0, size_t o1, size_t o2, size_t o3, int n_off, int is_f32) {
    const size_t n = (size_t)M * D;
    for (size_t i = (size_t)blockIdx.x * blockDim.x + threadIdx.x; i < n; i += (size_t)gridDim.x * blockDim.x) {
        float acc = 0.f; const size_t offs[4] = {o0, o1, o2, o3};
        for (int r = 0; r < n_off; ++r) { if (is_f32) acc += ((const float*)(ws + offs[r]))[i]; else acc += __uint_as_float((unsigned)((const unsigned short*)(ws + offs[r]))[i] << 16); }
        out[i] = acc;
    }
}
#endif
extern "C" void kernel_launch(void* const* d_in, const int* in_sizes, int n_in, void* d_out, int out_size, void* d_ws, size_t ws_size, hipStream_t stream) {
    static int grid = 0;
    if (grid == 0) {
        if (n_in != 15 || in_sizes[0] != M * D || out_size != M * D || ws_size < WS_END) { fprintf(stderr, "kernel_launch: unexpected problem shape (n_in %d, in0 %d, out %d, ws %zu); nothing launched\n", n_in, n_in > 0 ? in_sizes[0] : -1, out_size, ws_size); grid = -1; return; }
        int dev = 0, cus = 0, per_cu = 0;
        if (hipGetDevice(&dev) != hipSuccess || hipDeviceGetAttribute(&cus, hipDeviceAttributeMultiprocessorCount, dev) != hipSuccess) { grid = -1; return; }
        if (hipFuncSetAttribute((const void*)fwd_kernel, hipFuncAttributeMaxDynamicSharedMemorySize, LDS_BYTES) != hipSuccess) { fprintf(stderr, "kernel_launch: hipFuncSetAttribute failed\n"); grid = -1; return; }
        if (hipOccupancyMaxActiveBlocksPerMultiprocessor(&per_cu, (const void*)fwd_kernel, NWAVES * 64, LDS_BYTES) != hipSuccess || per_cu < 1) { fprintf(stderr, "kernel_launch: occupancy query reports %d blocks per CU\n", per_cu); (void)hipGetLastError(); grid = -1; return; }
        grid = cus;
    }
    if (grid < 0) return;
    (void)hipMemsetAsync((char*)d_ws + WS_CTL, 0, CTL_ZERO_BYTES, stream);
    Args a{};
    for (int i = 0; i < 15; ++i) a.in[i] = (const float*)d_in[i];
    a.out = (float*)d_out; a.ws = (unsigned char*)d_ws;
#if MK_N_LAUNCHES == 1
    a.ph_lo = 0; a.ph_hi = N_PHASES;
    hipLaunchKernelGGL(fwd_kernel, dim3(grid), dim3(NWAVES * 64), LDS_BYTES, stream, a);
#else
#ifdef DBG_STOP
    for (int p = 0; p <= DBG_STOP; ++p) { a.ph_lo = p; a.ph_hi = p + 1; hipLaunchKernelGGL(fwd_kernel, dim3(grid), dim3(NWAVES * 64), LDS_BYTES, stream, a); }
    { const size_t offs[4] = {DBG_OFFS}; hipLaunchKernelGGL(dbg_dump, dim3(2048), dim3(256), 0, stream, (const unsigned char*)d_ws, (float*)d_out, offs[0], offs[1], offs[2], offs[3], DBG_NOFF, DBG_F32); }
#else
    for (int p = 0; p < N_PHASES; ++p) { a.ph_lo = p; a.ph_hi = p + 1; hipLaunchKernelGGL(fwd_kernel, dim3(grid), dim3(NWAVES * 64), LDS_BYTES, stream, a); }
#endif
#endif
}
```
